# Optimizing an MI355X kernel written in HIP

```python
import math
import jax, jax.numpy as jnp
from jax import lax
import numpy as np

D_MODEL = 1024
BATCH = 4
SEQ = 8192
DEPTH = 4

D_MIX = 1024
A_HEADS = 8
A_HEAD_DIM = 64
A_WIDTH = A_HEADS * A_HEAD_DIM
IDX_HEADS = 8
IDX_DIM = 64
TOPK_MAX = 256
Q_BLOCK = 128
B_WIDTH = 256
CONV_WIDTH = 31
C_HEADS = 4
C_KEY_DIM = 32
C_VAL_DIM = 64
C_WIDTH = C_HEADS * C_VAL_DIM
GATE_RANK = 16
GATE_TAU = 16.0
GLA_CHUNK = 64
ROPE_THETA = 10000.0
ROPE_DIM = 64
DEEPNORM_ALPHA = (2 * DEPTH) ** 0.25
DEEPNORM_BETA = (8 * DEPTH) ** -0.25
EPS = 1e-5

IN_SIZES = (A_WIDTH, A_WIDTH, A_WIDTH, A_WIDTH,
            IDX_HEADS * IDX_DIM, IDX_DIM, IDX_HEADS,
            2 * B_WIDTH, B_WIDTH,
            C_HEADS * C_KEY_DIM, C_HEADS * C_KEY_DIM,
            C_WIDTH, C_WIDTH, GATE_RANK)
D_IN = sum(IN_SIZES)

kernel_name = "hybrid_dsa_conformer_gla_deepnorm"


def _split_in(h):
    points, acc = [], 0
    for s in IN_SIZES[:-1]:
        acc += s
        points.append(acc)
    return jnp.split(h, points, axis=-1)


def _layernorm(x, g, b):
    xf = x.astype(jnp.float32)
    mu = jnp.mean(xf, axis=-1, keepdims=True)
    var = jnp.mean(jnp.square(xf - mu), axis=-1, keepdims=True)
    y = (xf - mu) * lax.rsqrt(var + EPS) * g.astype(jnp.float32) + b.astype(jnp.float32)
    return y.astype(x.dtype)


def _rope_tables(positions):
    inv = ROPE_THETA ** (-jnp.arange(0, ROPE_DIM, 2, dtype=jnp.float32) / ROPE_DIM)
    ang = positions.astype(jnp.float32)[..., None] * inv
    return jnp.cos(ang), jnp.sin(ang)


def _rope(x, cos, sin):
    x1, x2 = jnp.split(x, 2, axis=-1)
    c = cos[:, :, None, :].astype(x.dtype)
    s = sin[:, :, None, :].astype(x.dtype)
    return jnp.concatenate([x1 * c - x2 * s, x2 * c + x1 * s], axis=-1)


def _dsa_attention(q, k, v, qi, ki, wi):
    B, T, H, dh = q.shape
    topk = min(TOPK_MAX, T // 4)
    nb = T // Q_BLOCK
    scale = dh ** -0.5
    s_pos = jnp.arange(T)

    def to_blocks(a):
        return jnp.moveaxis(a.reshape((B, nb, Q_BLOCK) + a.shape[2:]), 1, 0)

    def block(args):
        qb, qib, wib, start = args
        t_pos = start + jnp.arange(Q_BLOCK)
        causal = s_pos[None, :] <= t_pos[:, None]
        idx_logits = jnp.einsum('bqhd,bsd->bqhs', qib, ki)
        score = jnp.einsum('bqh,bqhs->bqs', wib, jax.nn.relu(idx_logits)).astype(jnp.float32)
        score = jnp.where(causal[None], score, -jnp.inf)
        _, sel = lax.top_k(score, topk)
        k_sel = jax.vmap(lambda kb, ib: kb[ib])(k, sel)
        v_sel = jax.vmap(lambda vb, ib: vb[ib])(v, sel)
        logits = jnp.einsum('bqhd,bqkhd->bhqk', qb, k_sel).astype(jnp.float32) * scale
        valid = sel <= t_pos[None, :, None]
        logits = jnp.where(valid[:, None], logits, -jnp.inf)
        p = jax.nn.softmax(logits, axis=-1).astype(v.dtype)
        return jnp.einsum('bhqk,bqkhd->bqhd', p, v_sel)

    starts = jnp.arange(nb) * Q_BLOCK
    out = lax.map(block, (to_blocks(q), to_blocks(qi), to_blocks(wi), starts))
    return jnp.moveaxis(out, 0, 1).reshape(B, T, H, dh)


def _conformer_conv(u, conv_w, conv_b, ln_g, ln_b, pw_w, pw_b):
    val, gate = jnp.split(u, 2, axis=-1)
    h = val * jax.nn.sigmoid(gate)
    h = lax.conv_general_dilated(h, conv_w[:, None, :].astype(h.dtype), window_strides=(1,),
                                 padding=((CONV_WIDTH - 1, 0),),
                                 dimension_numbers=('NWC', 'WIO', 'NWC'),
                                 feature_group_count=B_WIDTH) + conv_b
    h = jax.nn.silu(_layernorm(h, ln_g, ln_b))
    return h @ pw_w + pw_b


def _gla(q, k, v, log_a):
    B, T, H, dk = q.shape
    dv = v.shape[-1]
    C = GLA_CHUNK
    n = T // C

    def to_chunks(a):
        return a.reshape(B, n, C, H, a.shape[-1]).transpose(1, 0, 3, 2, 4).astype(jnp.float32)

    qc, kc, vc, gc = to_chunks(q * (dk ** -0.5)), to_chunks(k), to_chunks(v), to_chunks(log_a)
    causal = jnp.tril(jnp.ones((C, C), dtype=bool))[None, None, :, :, None]

    def step(S, inp):
        qb, kb, vb, gb = inp
        b = jnp.cumsum(gb, axis=2)
        o_inter = jnp.einsum('bhcd,bhde->bhce', qb * jnp.exp(b), S)
        diff = b[:, :, :, None, :] - b[:, :, None, :, :]
        decay = jnp.exp(jnp.where(causal, diff, -jnp.inf))
        A = jnp.einsum('bhid,bhjd,bhijd->bhij', qb, kb, decay)
        o_intra = jnp.einsum('bhij,bhje->bhie', A, vb)
        b_last = b[:, :, -1:, :]
        S_new = jnp.exp(b_last[:, :, 0, :])[..., None] * S + \
            jnp.einsum('bhcd,bhce->bhde', kb * jnp.exp(b_last - b), vb)
        return S_new, o_inter + o_intra

    S0 = jnp.zeros((B, H, dk, dv), jnp.float32)
    _, o = lax.scan(step, S0, (qc, kc, vc, gc))
    return o.transpose(1, 0, 3, 2, 4).reshape(B, T, H, dv)


def _layer(x, cos, sin, w_in, conv_w, conv_b, cln_g, cln_b, pw_w, pw_b,
           gate_w2, gate_b, gnorm_g, w_out, ln_g, ln_b):
    B, T, _ = x.shape
    h = x @ w_in
    (a_q, a_k, a_v, a_g, i_q, i_k, i_w, b_glu, b_g,
     c_q, c_k, c_v, c_g, c_lr) = _split_in(h)

    q = _rope(a_q.reshape(B, T, A_HEADS, A_HEAD_DIM), cos, sin)
    k = _rope(a_k.reshape(B, T, A_HEADS, A_HEAD_DIM), cos, sin)
    v = a_v.reshape(B, T, A_HEADS, A_HEAD_DIM)
    qi = _rope(i_q.reshape(B, T, IDX_HEADS, IDX_DIM), cos, sin)
    ki = _rope(i_k[:, :, None, :], cos, sin)[:, :, 0, :]
    wi = i_w * (IDX_HEADS ** -0.5 * IDX_DIM ** -0.5)
    y_a = _dsa_attention(q, k, v, qi, ki, wi).reshape(B, T, A_WIDTH) * jax.nn.silu(a_g)

    y_b = _conformer_conv(b_glu, conv_w, conv_b, cln_g, cln_b, pw_w, pw_b) * jax.nn.silu(b_g)

    log_a = jax.nn.log_sigmoid((c_lr @ gate_w2 + gate_b).astype(jnp.float32)) / GATE_TAU
    o = _gla(c_q.reshape(B, T, C_HEADS, C_KEY_DIM), c_k.reshape(B, T, C_HEADS, C_KEY_DIM),
             c_v.reshape(B, T, C_HEADS, C_VAL_DIM), log_a.reshape(B, T, C_HEADS, C_KEY_DIM))
    o = o * lax.rsqrt(jnp.mean(jnp.square(o), axis=-1, keepdims=True) + EPS) * \
        gnorm_g.astype(jnp.float32).reshape(C_HEADS, C_VAL_DIM)
    y_c = o.reshape(B, T, C_WIDTH).astype(x.dtype) * jax.nn.silu(c_g)

    y = jnp.concatenate([y_a.astype(x.dtype), y_b.astype(x.dtype), y_c], axis=-1) @ w_out
    return _layernorm(DEEPNORM_ALPHA * x + y, ln_g, ln_b)


def setup_inputs(seed: int = 0) -> dict:
    key = jax.random.key(seed)
    ks = jax.random.split(key, 16)

    def nrm(k, shape, scale):
        return jax.random.normal(k, shape, jnp.float32) * scale

    x = nrm(ks[0], (BATCH, SEQ, D_MODEL), 1.0)
    positions = jnp.broadcast_to(jnp.arange(SEQ, dtype=jnp.int32), (BATCH, SEQ))
    w_in = nrm(ks[1], (DEPTH, D_MODEL, D_IN), D_MODEL ** -0.5)
    conv_w = nrm(ks[2], (DEPTH, CONV_WIDTH, B_WIDTH), CONV_WIDTH ** -0.5)
    conv_b = nrm(ks[3], (DEPTH, B_WIDTH), 0.02)
    cln_g = 1.0 + nrm(ks[4], (DEPTH, B_WIDTH), 0.05)
    cln_b = nrm(ks[5], (DEPTH, B_WIDTH), 0.02)
    pw_w = nrm(ks[6], (DEPTH, B_WIDTH, B_WIDTH), B_WIDTH ** -0.5)
    pw_b = nrm(ks[7], (DEPTH, B_WIDTH), 0.02)
    gate_w2 = nrm(ks[8], (DEPTH, GATE_RANK, C_HEADS * C_KEY_DIM), GATE_RANK ** -0.5)
    gate_b = nrm(ks[9], (DEPTH, C_HEADS * C_KEY_DIM), 0.1)
    gnorm_g = 1.0 + nrm(ks[10], (DEPTH, C_WIDTH), 0.05)
    w_out = nrm(ks[11], (DEPTH, D_MIX, D_MODEL), DEEPNORM_BETA * D_MIX ** -0.5)
    ln_g = 1.0 + nrm(ks[12], (DEPTH, D_MODEL), 0.05)
    ln_b = nrm(ks[13], (DEPTH, D_MODEL), 0.02)
    return {"x": x, "positions": positions, "w_in": w_in, "conv_w": conv_w, "conv_b": conv_b,
            "cln_g": cln_g, "cln_b": cln_b, "pw_w": pw_w, "pw_b": pw_b,
            "gate_w2": gate_w2, "gate_b": gate_b, "gnorm_g": gnorm_g,
            "w_out": w_out, "ln_g": ln_g, "ln_b": ln_b}


def reference(x, positions, w_in, conv_w, conv_b, cln_g, cln_b, pw_w, pw_b,
              gate_w2, gate_b, gnorm_g, w_out, ln_g, ln_b):
    cos, sin = _rope_tables(positions)
    for i in range(DEPTH):
        x = _layer(x, cos, sin, w_in[i], conv_w[i], conv_b[i], cln_g[i], cln_b[i],
                   pw_w[i], pw_b[i], gate_w2[i], gate_b[i], gnorm_g[i],
                   w_out[i], ln_g[i], ln_b[i])
    return x
```

```cpp
#include <hip/hip_runtime.h>
#include <hip/hip_cooperative_groups.h>
#include <cstdio>
#include <cmath>
namespace cg = cooperative_groups;

typedef unsigned short bf16_t;
typedef short bf16x8 __attribute__((ext_vector_type(8)));
typedef float f32x4 __attribute__((ext_vector_type(4)));
typedef float f32x16 __attribute__((ext_vector_type(16)));
typedef unsigned u32x4 __attribute__((ext_vector_type(4)));
typedef unsigned u32x2 __attribute__((ext_vector_type(2)));
typedef unsigned long long u64;

constexpr int NB = 4, T = 8192, NTOK = NB * T, DM = 1024, DIN = 4184, NPAD = 4352, HP = 4160, DEPTH = 4;
constexpr int HQ = 0, HK = 512, HV = 1024, HQI = 1536, HKI = 2048, HGLU = 2112, HCQ = 2624, HCK = 2752, HCV = 2880, HAG = 3136, HBG = 3648, HCG = 3904;
constexpr float EPS = 1e-5f;
constexpr float ALPHA = 1.6817928305074290f;
constexpr float QSCALE = 0.125f * 1.4426950408889634f;
constexpr float WI_SCALE = 0.04419417382415922f;
constexpr float SIG_UNIT = 5.66f;
constexpr int CAP = 128;

constexpr size_t WS_WIN = 0;
constexpr size_t WS_WOUT = WS_WIN + (size_t)DEPTH * NPAD * 1024 * 2;
constexpr size_t WS_PWT = WS_WOUT + (size_t)DEPTH * 1024 * 1024 * 2;
constexpr size_t WS_ROPE = WS_PWT + (size_t)DEPTH * 256 * 256 * 2;
constexpr size_t WS_XB = WS_ROPE + (size_t)NTOK * 32 * 8;
constexpr size_t WS_H = WS_XB + (size_t)NTOK * 1024 * 2;
constexpr size_t WS_SIDE = WS_H + (size_t)NTOK * HP * 2;
constexpr size_t WS_BCUM = WS_SIDE + (size_t)NTOK * 24 * 4;
constexpr size_t WS_U = WS_BCUM + (size_t)NTOK * 128 * 4;
constexpr size_t WS_DEC = WS_U + (size_t)2048 * 2048 * 4;
constexpr size_t WS_VT = WS_DEC + (size_t)2048 * 32 * 4;
constexpr size_t WS_KF = WS_VT + (size_t)NTOK * 512 * 2;
constexpr size_t WS_BAR = WS_KF + (size_t)NTOK * 512 * 2;
constexpr size_t WS_KMAX = WS_BAR + 256;
constexpr size_t WS_END = WS_KMAX + 256;

#ifndef PROBE_PHASE
#define PROBE_PHASE 0
#endif
constexpr int LDS_BYTES = 147456;

struct Params {
    const float* x; const int* pos; const float* w_in; const float* conv_w; const float* conv_b; const float* cln_g; const float* cln_b;
    const float* pw_w; const float* pw_b; const float* gate_w2; const float* gate_b; const float* gnorm_g; const float* w_out; const float* ln_g; const float* ln_b;
    float* out; unsigned char* ws;
    float inv_freq[32];
};

__device__ __forceinline__ unsigned f2bf(float f) { unsigned u = __float_as_uint(f); return (u + 0x7fffu + ((u >> 16) & 1u)) >> 16; }
__device__ __forceinline__ float bf2f(unsigned b) { return __uint_as_float(b << 16); }
typedef float f32x2_t __attribute__((ext_vector_type(2)));
typedef __bf16 bf16x2_t __attribute__((ext_vector_type(2)));
__device__ __forceinline__ unsigned pk2(float lo, float hi) { f32x2_t v = {lo, hi}; bf16x2_t b = __builtin_convertvector(v, bf16x2_t); return __builtin_bit_cast(unsigned, b); }
__device__ __forceinline__ float bflo(unsigned w) { return __uint_as_float(w << 16); }
__device__ __forceinline__ float bfhi(unsigned w) { return __uint_as_float(w & 0xffff0000u); }
__device__ __forceinline__ float silu_f(float v) { return v / (1.f + __expf(-v)); }
__device__ __forceinline__ float sigmoid_f(float v) { return 1.f / (1.f + __expf(-v)); }
__device__ __forceinline__ int bperm_i(int idx, int v) { return __builtin_amdgcn_ds_bpermute(idx << 2, v); }
__device__ __forceinline__ float sxor_f(float v, int lane, int m) { return __int_as_float(bperm_i(lane ^ m, __float_as_int(v))); }
__device__ __forceinline__ int sxor_i(int v, int lane, int m) { return bperm_i(lane ^ m, v); }
__device__ __forceinline__ float wave_sum(float v, int lane) {
#pragma unroll
    for (int o = 32; o >= 1; o >>= 1) v += sxor_f(v, lane, o);
    return v;
}
__device__ __forceinline__ int otid(int wid_s) { int l; asm volatile("v_mbcnt_lo_u32_b32 %0, -1, 0\n\tv_mbcnt_hi_u32_b32 %0, -1, %0" : "=v"(l)); return (wid_s << 6) | l; }
#define WAVE_SYNC() do { __builtin_amdgcn_fence(__ATOMIC_RELEASE, "wavefront"); __builtin_amdgcn_wave_barrier(); __builtin_amdgcn_fence(__ATOMIC_ACQUIRE, "wavefront"); } while (0)

__device__ __forceinline__ int l2orig(int l) {
    if (l < 1536) return l;
    if (l < 2048) return 2048 + (l - 1536);
    if (l < 2112) return 2560 + (l - 2048);
    if (l < 2624) return 2632 + (l - 2112);
    if (l < 2752) return 3400 + (l - 2624);
    if (l < 2880) return 3528 + (l - 2752);
    if (l < 3136) return 3656 + (l - 2880);
    if (l < 3648) return 1536 + (l - 3136);
    if (l < 3904) return 3144 + (l - 3648);
    if (l < 4160) return 3912 + (l - 3904);
    if (l < 4168) return 2624 + (l - 4160);
    if (l < 4184) return 4168 + (l - 4168);
    return -1;
}
__device__ __forceinline__ int npos2logical(int np) {
    const int hb = np & ~127, p = np & 127, wc = p >> 5, n = (p >> 4) & 1, fr = p & 15;
    return hb + (wc >> 1) * 64 + n * 32 + (wc & 1) * 16 + fr;
}

__device__ __forceinline__ void sincos_acc(float angf, float& c, float& s) {
    const double a = (double)angf;
    const double n = rint(a * 0.15915494309189535);
    double r = fma(-n, 6.283185307179586, a);
    r = fma(-n, 2.4492935982947064e-16, r);
    const double r2 = r * r;
    double ts = r, tc = 1.0, ss = r, cc = 1.0;
#pragma unroll
    for (int k = 1; k <= 14; ++k) {
        tc = -tc * r2 * (1.0 / (double)((2 * k - 1) * (2 * k)));
        ts = -ts * r2 * (1.0 / (double)((2 * k) * (2 * k + 1)));
        cc += tc; ss += ts;
    }
    c = (float)cc; s = (float)ss;
}

__device__ __forceinline__ void prologue(const Params& p, long gtid, long gthreads) {
    bf16_t* win = (bf16_t*)(p.ws + WS_WIN);
    for (long idx = gtid; idx < (long)DEPTH * 128 * NPAD; idx += gthreads) {
        const int np = (int)(idx % NPAD); const long r = idx / NPAD; const int kc = (int)(r % 128); const int l = (int)(r / 128);
        const int oc = l2orig(npos2logical(np));
        u32x4 w = {0u, 0u, 0u, 0u};
        if (oc >= 0) {
            const float* src = p.w_in + ((long)l * 1024 + kc * 8) * DIN + oc;
            float v[8];
#pragma unroll
            for (int i = 0; i < 8; ++i) v[i] = src[(long)i * DIN];
            w.x = pk2(v[0], v[1]); w.y = pk2(v[2], v[3]); w.z = pk2(v[4], v[5]); w.w = pk2(v[6], v[7]);
        }
        *(u32x4*)(win + ((long)l * NPAD + np) * 1024 + kc * 8) = w;
    }
    bf16_t* wout = (bf16_t*)(p.ws + WS_WOUT);
    for (long idx = gtid; idx < (long)DEPTH * 128 * 1024; idx += gthreads) {
        const int n = (int)(idx % 1024); const long r = idx / 1024; const int kc = (int)(r % 128); const int l = (int)(r / 128);
        const float* src = p.w_out + ((long)l * 1024 + kc * 8) * 1024 + n;
        float v[8];
#pragma unroll
        for (int i = 0; i < 8; ++i) v[i] = src[(long)i * 1024];
        u32x4 w; w.x = pk2(v[0], v[1]); w.y = pk2(v[2], v[3]); w.z = pk2(v[4], v[5]); w.w = pk2(v[6], v[7]);
        *(u32x4*)(wout + ((long)l * 1024 + n) * 1024 + kc * 8) = w;
    }
    bf16_t* pwt = (bf16_t*)(p.ws + WS_PWT);
    for (long idx = gtid; idx < (long)DEPTH * 32 * 256; idx += gthreads) {
        const int n = (int)(idx % 256); const long r = idx / 256; const int kc = (int)(r % 32); const int l = (int)(r / 32);
        const float* src = p.pw_w + ((long)l * 256 + kc * 8) * 256 + n;
        float v[8];
#pragma unroll
        for (int i = 0; i < 8; ++i) v[i] = src[(long)i * 256];
        u32x4 w; w.x = pk2(v[0], v[1]); w.y = pk2(v[2], v[3]); w.z = pk2(v[4], v[5]); w.w = pk2(v[6], v[7]);
        *(u32x4*)(pwt + ((long)l * 256 + n) * 256 + kc * 8) = w;
    }
    float2* rope = (float2*)(p.ws + WS_ROPE);
    for (long idx = gtid; idx < (long)NTOK * 32; idx += gthreads) {
        const int j = (int)(idx & 31); const long tok = idx >> 5;
        const float ang = (float)p.pos[tok] * p.inv_freq[j];
        float c, s; sincos_acc(ang, c, s);
        rope[idx] = make_float2(c, s);
    }
    if (gtid < 32) ((unsigned*)(p.ws + WS_KMAX))[gtid] = 0u;
    bf16_t* xb = (bf16_t*)(p.ws + WS_XB);
    for (long idx = gtid; idx < (long)NTOK * 128; idx += gthreads) {
        const f32x4 a = *(const f32x4*)(p.x + idx * 8), b = *(const f32x4*)(p.x + idx * 8 + 4);
        u32x4 w; w.x = pk2(a[0], a[1]); w.y = pk2(a[2], a[3]); w.z = pk2(b[0], b[1]); w.w = pk2(b[2], b[3]);
        *(u32x4*)(xb + idx * 8) = w;
    }
}

constexpr int BM = 256, BK = 64, HALF = 128, HT = HALF * BK;
__device__ __forceinline__ int lds_byte(int r, int c) {
    int st = (r >> 4) * 2 + (c >> 5), rr = r & 15, cc = c & 31, ob = rr * 64 + cc * 2;
    return st * 1024 + (ob ^ (((ob >> 9) & 1) << 5));
}
__device__ __forceinline__ void stage_rc(int b, int& R, int& C) {
    int st = b / 1024, sb = b % 1024, swz = sb ^ (((sb >> 9) & 1) << 5);
    R = (st >> 1) * 16 + swz / 64; C = (st & 1) * 32 + (swz % 64) / 2;
}
__device__ __forceinline__ void tile_of(int L, int nM, int nN, int& pm, int& pn) {
    const int nwg = nM * nN; int wgid = L;
    { const int q = nwg / 8, r = nwg % 8, xcd = wgid % 8, off = wgid / 8; wgid = (xcd < r ? xcd * (q + 1) : r * (q + 1) + (xcd - r) * q) + off; }
    const int nig = 8 * nN, gid = wgid / nig, fm = gid * 8, gsz = (nM - fm) < 8 ? (nM - fm) : 8;
    pm = fm + ((wgid % nig) % gsz); pn = (wgid % nig) / gsz;
}

#define LAS __attribute__((address_space(3)))
template <class Epi>
__device__ __forceinline__ void gemm_tile(LAS unsigned char* lds, const bf16_t* A, int lda, const bf16_t* Bt, int K, int pm, int pn, const Epi& epi, int wid_s) {
    const int tid = otid(wid_s), wid = __builtin_amdgcn_readfirstlane(tid >> 6), lane = tid & 63, wr = wid >> 2, wc = wid & 3, fr = lane & 15, fq = lane >> 4;
    const int nt = K / BK;
    unsigned voffA[2], voffB[2];
#pragma unroll
    for (int i = 0; i < 2; ++i) { int R, C; stage_rc(tid * 16 + i * 8192, R, C); voffA[i] = (unsigned)(R * lda + C) * 2u; voffB[i] = (unsigned)(R * K + C) * 2u; }
    const size_t kstep = (size_t)(BK * 2), hstepA = (size_t)HALF * lda * 2, hstepB = (size_t)HALF * K * 2;
    const unsigned ldsw = (unsigned)wid * 1024u;
    const int aoff = lds_byte(wr * 64 + fr, fq * 8), boff = lds_byte(wc * 32 + fr, fq * 8);
    const char* cA = (const char*)A + (size_t)pm * 2 * hstepA; const char* cB = (const char*)Bt + (size_t)pn * 2 * hstepB;
#define HTB (HALF * BK * 2)
#define SA(b, h) (((b) * 2 + (h)) * HTB)
#define SB(b, h) ((4 + (b) * 2 + (h)) * HTB)
#define STAGE(bufoff, gbase, voff) do { _Pragma("unroll") for (int _i = 0; _i < 2; ++_i) \
        __builtin_amdgcn_global_load_lds((const unsigned*)((const char*)(gbase) + (voff)[_i]), (LAS unsigned*)(lds + (bufoff) + ldsw + _i * 8192), 16, 0, 0); } while (0)
#define LDA(dst, b, h) do { _Pragma("unroll") for (int m = 0; m < 4; ++m) _Pragma("unroll") for (int k = 0; k < 2; ++k) dst[m][k] = *(const LAS bf16x8*)(lds + SA(b, h) + aoff + m * 2048 + k * 1024); } while (0)
#define LDB(dst, b, h) do { _Pragma("unroll") for (int n = 0; n < 2; ++n) _Pragma("unroll") for (int k = 0; k < 2; ++k) dst[n][k] = *(const LAS bf16x8*)(lds + SB(b, h) + boff + n * 2048 + k * 1024); } while (0)
#define MMA(ai, bj, At_, Bt_) do { __builtin_amdgcn_s_setprio(1); _Pragma("unroll") for (int m = 0; m < 4; ++m) _Pragma("unroll") for (int n = 0; n < 2; ++n) _Pragma("unroll") for (int k = 0; k < 2; ++k) \
        acc[ai][bj][m][n] = __builtin_amdgcn_mfma_f32_16x16x32_bf16(Bt_[n][k], At_[m][k], acc[ai][bj][m][n], 0, 0, 0); __builtin_amdgcn_s_setprio(0); } while (0)
#define WAIT_V(n) asm volatile("s_waitcnt vmcnt(" #n ")" ::: "memory")
#define WAIT_L(n) asm volatile("s_waitcnt lgkmcnt(" #n ")" ::: "memory")
#define BAR __builtin_amdgcn_s_barrier()
#define SCHED __builtin_amdgcn_sched_barrier(0)
    f32x4 acc[2][2][4][2];
#pragma unroll
    for (int a = 0; a < 2; ++a)
#pragma unroll
        for (int b = 0; b < 2; ++b)
#pragma unroll
            for (int m = 0; m < 4; ++m)
#pragma unroll
                for (int n = 0; n < 2; ++n) acc[a][b][m][n] = (f32x4){0.f, 0.f, 0.f, 0.f};
    bf16x8 At[4][2], B0[2][2], B1[2][2];
    STAGE(SB(0, 0), cB, voffB); STAGE(SA(0, 0), cA, voffA); STAGE(SB(0, 1), cB + hstepB, voffB); STAGE(SA(0, 1), cA + hstepA, voffA);
    if (wr == 1) BAR;
    WAIT_V(4); BAR;
    STAGE(SB(1, 0), cB + kstep, voffB); STAGE(SA(1, 0), cA + kstep, voffA); STAGE(SB(1, 1), cB + hstepB + kstep, voffB);
    WAIT_V(6); BAR;
    for (int t = 0; t < nt - 2; t += 2) {
        const char* a1 = cA + (size_t)(t + 1) * kstep; const char* a2 = cA + (size_t)(t + 2) * kstep; const char* b2 = cB + (size_t)(t + 2) * kstep;
        const char* a3 = a2 + kstep; const char* b3 = b2 + kstep;
        LDB(B0, 0, 0); SCHED; LDA(At, 0, 0); STAGE(SA(1, 1), a1 + hstepA, voffA);
        WAIT_L(8); BAR; WAIT_L(0); MMA(0, 0, At, B0); BAR; SCHED;
        LDB(B1, 0, 1); STAGE(SB(0, 0), b2, voffB);
        BAR; WAIT_L(0); MMA(0, 1, At, B1); BAR;
        LDA(At, 0, 1); STAGE(SA(0, 0), a2, voffA);
        BAR; WAIT_L(0); MMA(1, 0, At, B0); BAR; SCHED;
        STAGE(SB(0, 1), b2 + hstepB, voffB);
        WAIT_V(6); BAR; MMA(1, 1, At, B1); BAR;
        LDB(B0, 1, 0); SCHED; LDA(At, 1, 0); STAGE(SA(0, 1), a2 + hstepA, voffA);
        WAIT_L(8); BAR; WAIT_L(0); MMA(0, 0, At, B0); BAR; SCHED;
        LDB(B1, 1, 1); STAGE(SB(1, 0), b3, voffB);
        BAR; WAIT_L(0); MMA(0, 1, At, B1); BAR;
        LDA(At, 1, 1); STAGE(SA(1, 0), a3, voffA);
        BAR; WAIT_L(0); MMA(1, 0, At, B0); BAR; SCHED;
        STAGE(SB(1, 1), b3 + hstepB, voffB);
        WAIT_V(6); BAR; MMA(1, 1, At, B1); BAR;
    }
    { const char* a1 = cA + (size_t)(nt - 1) * kstep;
      LDB(B0, 0, 0); LDA(At, 0, 0); STAGE(SA(1, 1), a1 + hstepA, voffA);
      BAR; WAIT_L(0); MMA(0, 0, At, B0); BAR;
      LDB(B1, 0, 1); BAR; WAIT_L(0); MMA(0, 1, At, B1); BAR;
      LDA(At, 0, 1); WAIT_V(4); BAR; WAIT_L(0); MMA(1, 0, At, B0); MMA(1, 1, At, B1); BAR; }
    { LDB(B0, 1, 0); LDA(At, 1, 0); WAIT_V(2); BAR; WAIT_L(0); MMA(0, 0, At, B0); BAR;
      LDB(B1, 1, 1); WAIT_V(0); BAR; WAIT_L(0); MMA(0, 1, At, B1); BAR;
      LDA(At, 1, 1); BAR; WAIT_L(0); MMA(1, 0, At, B0); MMA(1, 1, At, B1); BAR; }
    if (wr == 0) BAR;
    epi(acc, pm * BM, pn * BM, wr, wc, fr, fq);
#undef SA
#undef SB
#undef STAGE
#undef LDA
#undef LDB
#undef MMA
}

struct EpiIn {
    bf16_t* H; float* side; const float* rope; bf16_t* VT; bf16_t* KF; unsigned* kmax; bool dry;
    __device__ __forceinline__ void operator()(f32x4 (&acc)[2][2][4][2], int brow, int bcol, int wr, int wc, int fr, int fq) const {
#pragma unroll
        for (int bj = 0; bj < 2; ++bj) {
            const int hb = bcol + bj * HALF;
            if (hb >= 4224 || dry) continue;
            const int gbase = hb + (wc >> 1) * 64, g64 = gbase >> 6, d0 = (wc & 1) * 16 + 4 * fq;
            const bool rp = (g64 < 16) || (g64 >= 24 && g64 <= 32);
            const float qs = (g64 < 8) ? QSCALE : 1.f;
            float kabs = 0.f;
#pragma unroll
            for (int ai = 0; ai < 2; ++ai)
#pragma unroll
                for (int m = 0; m < 4; ++m) {
                    const long row = brow + ai * HALF + wr * 64 + m * 16 + fr;
                    f32x4 o1 = acc[ai][bj][m][0], o2 = acc[ai][bj][m][1];
                    if (rp) {
                        const f32x4 c0 = *(const f32x4*)(rope + (row * 32 + d0) * 2), c1 = *(const f32x4*)(rope + (row * 32 + d0) * 2 + 4);
                        const f32x4 x1 = o1, x2 = o2;
                        o1[0] = (x1[0] * c0[0] - x2[0] * c0[1]) * qs; o2[0] = (x2[0] * c0[0] + x1[0] * c0[1]) * qs;
                        o1[1] = (x1[1] * c0[2] - x2[1] * c0[3]) * qs; o2[1] = (x2[1] * c0[2] + x1[1] * c0[3]) * qs;
                        o1[2] = (x1[2] * c1[0] - x2[2] * c1[1]) * qs; o2[2] = (x2[2] * c1[0] + x1[2] * c1[1]) * qs;
                        o1[3] = (x1[3] * c1[2] - x2[3] * c1[3]) * qs; o2[3] = (x2[3] * c1[2] + x1[3] * c1[3]) * qs;
                    }
                    if (g64 >= 8 && g64 < 24) {
                        const int bb = (int)(row >> 13), tt = (int)(row & (T - 1)), tile = tt >> 5, tk = tt & 31;
                        if (g64 < 16) {
                            kabs = fmaxf(kabs, fmaxf(fmaxf(fabsf(o1[0]), fabsf(o1[1])), fmaxf(fabsf(o1[2]), fabsf(o1[3]))));
                            kabs = fmaxf(kabs, fmaxf(fmaxf(fabsf(o2[0]), fabsf(o2[1])), fmaxf(fabsf(o2[2]), fabsf(o2[3]))));
                            const long base = ((long)(bb * 8 + (g64 - 8)) * 256 + tile) * 4;
                            const int ks = d0 >> 4, hk = (d0 >> 3) & 1, j0 = d0 & 7;
                            u32x2 w1, w2; w1.x = pk2(o1[0], o1[1]); w1.y = pk2(o1[2], o1[3]); w2.x = pk2(o2[0], o2[1]); w2.y = pk2(o2[2], o2[3]);
                            const auto sx = __builtin_amdgcn_permlane16_swap(w1.x, w2.x, false, false), sy = __builtin_amdgcn_permlane16_swap(w1.y, w2.y, false, false);
                            u32x4 wv; long slot;
                            if (fq & 1) { wv.x = sx[0]; wv.y = sy[0]; wv.z = w2.x; wv.w = w2.y; slot = (base + ks + 2) * 64 + hk * 32 + tk; }
                            else { wv.x = w1.x; wv.y = w1.y; wv.z = sx[1]; wv.w = sy[1]; slot = (base + ks) * 64 + hk * 32 + tk; }
                            *(u32x4*)(KF + slot * 8) = wv;
                        } else {
                            const int s = tk >> 4, u = tk & 15, hv = (u >> 2) & 1, jv = (u >> 3) * 4 + (u & 3);
                            const long base = (((long)(bb * 8 + (g64 - 16)) * 256 + tile) * 2) * 2 + s;
                            bf16_t* v0 = VT + ((base) * 64 + hv * 32 + d0) * 8 + jv;
                            bf16_t* v1 = VT + ((base + 2) * 64 + hv * 32 + d0) * 8 + jv;
#pragma unroll
                            for (int j = 0; j < 4; ++j) { v0[j * 8] = (bf16_t)f2bf(o1[j]); v1[j * 8] = (bf16_t)f2bf(o2[j]); }
                        }
                    } else if (gbase < 4160) {
                        bf16_t* hp = H + row * HP + gbase + d0;
                        u32x2 w1, w2; w1.x = pk2(o1[0], o1[1]); w1.y = pk2(o1[2], o1[3]); w2.x = pk2(o2[0], o2[1]); w2.y = pk2(o2[2], o2[3]);
                        const auto sx = __builtin_amdgcn_permlane16_swap(w1.x, w2.x, false, false), sy = __builtin_amdgcn_permlane16_swap(w1.y, w2.y, false, false);
                        u32x4 wv;
                        if (fq & 1) { wv.x = sx[0]; wv.y = sy[0]; wv.z = w2.x; wv.w = w2.y; hp += 32 - 4; }
                        else { wv.x = w1.x; wv.y = w1.y; wv.z = sx[1]; wv.w = sy[1]; }
                        *(u32x4*)hp = wv;
                    } else if (d0 < 8) { *(f32x4*)(side + row * 24 + d0) = o1 * WI_SCALE; }
                    else if (d0 < 24) { *(f32x4*)(side + row * 24 + d0) = o1; }
                }
            if (g64 >= 8 && g64 < 16) {
#pragma unroll
                for (int o = 32; o >= 1; o >>= 1) kabs = fmaxf(kabs, sxor_f(kabs, fq * 16 + fr, o));
                if ((threadIdx.x & 63) == 0) atomicMax(kmax + (brow >> 13) * 8 + (g64 - 8), __float_as_uint(kabs));
            }
        }
    }
};
struct EpiOut {
    const float* xres; float* out; bool dry;
    __device__ __forceinline__ void operator()(f32x4 (&acc)[2][2][4][2], int brow, int bcol, int wr, int wc, int fr, int fq) const {
#pragma unroll
        for (int ai = 0; ai < 2; ++ai)
#pragma unroll
            for (int m = 0; m < 4; ++m)
#pragma unroll
                for (int bj = 0; bj < 2; ++bj)
#pragma unroll
                    for (int n = 0; n < 2; ++n) {
                        const long idx = (long)(brow + ai * HALF + wr * 64 + m * 16 + fr) * DM + (bcol + bj * HALF + wc * 32 + n * 16 + 4 * fq);
                        const f32x4 xr = *(const f32x4*)(xres + idx);
                        if (!dry) *(f32x4*)(out + idx) = xr * ALPHA + acc[ai][bj][m][n];
                    }
    }
};

__device__ __forceinline__ void ln_phase(const Params& p, int layer, int wave_g, int nwaves, int lane, bool dry) {
    bf16_t* xb = (bf16_t*)(p.ws + WS_XB);
    const float* g = p.ln_g + layer * DM; const float* bb = p.ln_b + layer * DM;
    for (int row = wave_g; row < NTOK; row += nwaves) {
        float* zr = p.out + (long)row * DM;
        f32x4 v[4]; float s = 0.f;
#pragma unroll
        for (int r = 0; r < 4; ++r) { v[r] = *(const f32x4*)(zr + r * 256 + lane * 4); s += v[r][0] + v[r][1] + v[r][2] + v[r][3]; }
        const float mu = wave_sum(s, lane) * (1.f / DM);
        float q = 0.f;
#pragma unroll
        for (int r = 0; r < 4; ++r)
#pragma unroll
            for (int e = 0; e < 4; ++e) { const float d = v[r][e] - mu; q += d * d; }
        const float rstd = rsqrtf(wave_sum(q, lane) * (1.f / DM) + EPS);
#pragma unroll
        for (int r = 0; r < 4; ++r) {
            const f32x4 gg = *(const f32x4*)(g + r * 256 + lane * 4), bv = *(const f32x4*)(bb + r * 256 + lane * 4);
            f32x4 y;
#pragma unroll
            for (int e = 0; e < 4; ++e) y[e] = (v[r][e] - mu) * rstd * gg[e] + bv[e];
            if (dry) continue;
            *(f32x4*)(zr + r * 256 + lane * 4) = y;
            u32x2 w; w.x = pk2(y[0], y[1]); w.y = pk2(y[2], y[3]);
            *(u32x2*)(xb + (long)row * DM + r * 256 + lane * 4) = w;
        }
    }
}

__device__ __forceinline__ void conformer_tile(const Params& p, int layer, unsigned char* lds, int tile, bool dry, int wid_s) {
    bf16_t* H = (bf16_t*)(p.ws + WS_H);
    const int tid = otid(wid_s), lane = tid & 63, w = tid >> 6;
    const int tok0 = tile * 64, b = tok0 / T, tl0 = tok0 % T;
    bf16_t* hg = (bf16_t*)lds;
    float* cv = (float*)(lds + 49152);
    for (int idx = tid; idx < 94 * 32; idx += 512) {
        const int r = idx >> 5, cc = (idx & 31) * 8, tl = tl0 - 30 + r;
        u32x4 o = {0u, 0u, 0u, 0u};
        if (tl >= 0) {
            const bf16_t* src = H + ((long)b * T + tl) * HP + HGLU + cc;
            const u32x4 va = *(const u32x4*)src, ga = *(const u32x4*)(src + 256);
            o.x = pk2(bflo(va.x) * sigmoid_f(bflo(ga.x)), bfhi(va.x) * sigmoid_f(bfhi(ga.x)));
            o.y = pk2(bflo(va.y) * sigmoid_f(bflo(ga.y)), bfhi(va.y) * sigmoid_f(bfhi(ga.y)));
            o.z = pk2(bflo(va.z) * sigmoid_f(bflo(ga.z)), bfhi(va.z) * sigmoid_f(bfhi(ga.z)));
            o.w = pk2(bflo(va.w) * sigmoid_f(bflo(ga.w)), bfhi(va.w) * sigmoid_f(bfhi(ga.w)));
        }
        *(u32x4*)(hg + r * 256 + cc) = o;
    }
    __syncthreads();
    {
        const int c = tid & 255, half = tid >> 8;
        const float* cw = p.conv_w + (long)layer * 31 * 256 + c;
        float wj[31];
#pragma unroll
        for (int j = 0; j < 31; ++j) wj[j] = cw[j * 256];
        const float cb = p.conv_b[layer * 256 + c];
        float win[62];
#pragma unroll
        for (int r = 0; r < 62; ++r) win[r] = bf2f(hg[(half * 32 + r) * 256 + c]);
#pragma unroll
        for (int tt = 0; tt < 32; ++tt) {
            float a = cb;
#pragma unroll
            for (int j = 0; j < 31; ++j) a = fmaf(win[tt + j], wj[j], a);
            cv[(half * 32 + tt) * 256 + c] = a;
        }
    }
    __syncthreads();
    bf16_t* at = (bf16_t*)lds;
    {
        const f32x4 gg = *(const f32x4*)(p.cln_g + layer * 256 + lane * 4), bv = *(const f32x4*)(p.cln_b + layer * 256 + lane * 4);
#pragma unroll
        for (int tt = 0; tt < 8; ++tt) {
            const int t = w * 8 + tt;
            const f32x4 v = *(const f32x4*)(cv + t * 256 + lane * 4);
            const float mu = wave_sum(v[0] + v[1] + v[2] + v[3], lane) * (1.f / 256.f);
            float q = 0.f;
#pragma unroll
            for (int e = 0; e < 4; ++e) { const float d = v[e] - mu; q += d * d; }
            const float rstd = rsqrtf(wave_sum(q, lane) * (1.f / 256.f) + EPS);
            float y[4];
#pragma unroll
            for (int e = 0; e < 4; ++e) y[e] = silu_f((v[e] - mu) * rstd * gg[e] + bv[e]);
            u32x2 o; o.x = pk2(y[0], y[1]); o.y = pk2(y[2], y[3]);
            *(u32x2*)(at + t * 264 + lane * 4) = o;
        }
    }
    __syncthreads();
    {
        f32x16 acc0 = {}, acc1 = {};
        const bf16_t* pwt = (const bf16_t*)(p.ws + WS_PWT) + (long)layer * 65536 + (w * 32 + (lane & 31)) * 256 + 8 * (lane >> 5);
        const bf16_t* ap = at + (lane & 31) * 264 + 8 * (lane >> 5);
#pragma unroll 4
        for (int ks = 0; ks < 16; ++ks) {
            const bf16x8 bfr = *(const bf16x8*)(pwt + ks * 16);
            const bf16x8 a0 = *(const bf16x8*)(ap + ks * 16), a1 = *(const bf16x8*)(ap + 32 * 264 + ks * 16);
            acc0 = __builtin_amdgcn_mfma_f32_32x32x16_bf16(a0, bfr, acc0, 0, 0, 0);
            acc1 = __builtin_amdgcn_mfma_f32_32x32x16_bf16(a1, bfr, acc1, 0, 0, 0);
        }
        const int ch = w * 32 + (lane & 31);
        const float pb = p.pw_b[layer * 256 + ch];
#pragma unroll
        for (int i = 0; i < 16; ++i) {
            const int row = (i & 3) + 8 * (i >> 2) + 4 * (lane >> 5);
            bf16_t* g0 = H + (long)(tok0 + row) * HP + HBG + ch;
            bf16_t* g1 = H + (long)(tok0 + 32 + row) * HP + HBG + ch;
            const unsigned r0 = f2bf((acc0[i] + pb) * silu_f(bf2f(*g0))), r1 = f2bf((acc1[i] + pb) * silu_f(bf2f(*g1)));
            if (!dry) { *g0 = (bf16_t)r0; *g1 = (bf16_t)r1; }
        }
    }
    __syncthreads();
}

__device__ __forceinline__ float rdlane(float v, int l) { return __uint_as_float(__builtin_amdgcn_readlane(__float_as_uint(v), l)); }

__device__ __forceinline__ void gla_local_item(const Params& p, int layer, int item_, int lane, bool dry) {
    const int item = __builtin_amdgcn_readfirstlane(item_);
    bf16_t* H = (bf16_t*)(p.ws + WS_H);
    const float* side = (const float*)(p.ws + WS_SIDE);
    float* bcum = (float*)(p.ws + WS_BCUM); float* U = (float*)(p.ws + WS_U); float* DEC = (float*)(p.ws + WS_DEC);
    const int bh = item >> 7, c = item & 127, b = bh >> 2, h = bh & 3;
    const long tok0 = (long)b * T + c * 64, tok = tok0 + lane;
    float clr[16];
#pragma unroll
    for (int r = 0; r < 4; ++r) { const f32x4 v = *(const f32x4*)(side + tok * 24 + 8 + r * 4); clr[r * 4] = v[0]; clr[r * 4 + 1] = v[1]; clr[r * 4 + 2] = v[2]; clr[r * 4 + 3] = v[3]; }
    const float* gw = p.gate_w2 + (long)layer * 16 * 128 + h * 32; const float* gb = p.gate_b + layer * 128 + h * 32;
    float* bcp = bcum + tok * 128 + h * 32;
#pragma unroll 1
    for (int d = 0; d < 32; ++d) {
        float z = gb[d];
#pragma unroll
        for (int r = 0; r < 16; ++r) z = fmaf(clr[r], gw[r * 128 + d], z);
        float g = (fminf(z, 0.f) - __logf(1.f + __expf(-fabsf(z)))) * (1.f / 16.f);
#pragma unroll
        for (int o = 1; o < 64; o <<= 1) { const float up = __int_as_float(bperm_i((lane - o) & 63, __float_as_int(g))); if (lane >= o) g += up; }
        bcp[d] = g;
    }
    float bc[32];
#pragma unroll
    for (int r = 0; r < 8; ++r) { const f32x4 v = *(const f32x4*)(bcp + r * 4); bc[r * 4] = v[0]; bc[r * 4 + 1] = v[1]; bc[r * 4 + 2] = v[2]; bc[r * 4 + 3] = v[3]; }
    float kk[32];
    {
        const bf16_t* kp = H + tok * HP + HCK + h * 32;
#pragma unroll
        for (int r = 0; r < 4; ++r) {
            const u32x4 kv = *(const u32x4*)(kp + r * 8);
            kk[r * 8 + 0] = bflo(kv.x); kk[r * 8 + 1] = bfhi(kv.x); kk[r * 8 + 2] = bflo(kv.y); kk[r * 8 + 3] = bfhi(kv.y);
            kk[r * 8 + 4] = bflo(kv.z); kk[r * 8 + 5] = bfhi(kv.z); kk[r * 8 + 6] = bflo(kv.w); kk[r * 8 + 7] = bfhi(kv.w);
        }
#pragma unroll
        for (int d = 0; d < 32; ++d) { const float bl = rdlane(bc[d], 63); kk[d] *= __expf(bl - bc[d]); }
    }
    float acc[32];
#pragma unroll
    for (int d = 0; d < 32; ++d) acc[d] = 0.f;
    const bf16_t* vp = H + tok0 * HP + HCV + h * 64 + lane;
#pragma unroll 1
    for (int t8 = 0; t8 < 64; t8 += 8) {
        float vv[8];
#pragma unroll
        for (int u = 0; u < 8; ++u) vv[u] = bf2f(vp[(long)(t8 + u) * HP]);
#pragma unroll
        for (int u = 0; u < 8; ++u)
#pragma unroll
            for (int d = 0; d < 32; ++d) acc[d] = fmaf(rdlane(kk[d], t8 + u), vv[u], acc[d]);
    }
#pragma unroll
    for (int d = 0; d < 32; ++d) if (!dry) U[(long)item * 2048 + d * 64 + lane] = acc[d];
    if (lane == 63) {
#pragma unroll
        for (int r = 0; r < 8; ++r) { f32x4 v = {__expf(bc[r * 4]), __expf(bc[r * 4 + 1]), __expf(bc[r * 4 + 2]), __expf(bc[r * 4 + 3])}; *(f32x4*)(DEC + item * 32 + r * 4) = v; }
    }
}

__device__ __forceinline__ void gla_scan(const Params& p, int gt) {
    float* U = (float*)(p.ws + WS_U); const float* DEC = (const float*)(p.ws + WS_DEC);
    const int bh = gt >> 11, de = gt & 2047, d = de >> 6;
    float s = 0.f;
    for (int c0 = 0; c0 < 128; c0 += 32) {
        float u[32], dc[32];
#pragma unroll
        for (int i = 0; i < 32; ++i) { u[i] = U[(long)(bh * 128 + c0 + i) * 2048 + de]; dc[i] = DEC[(bh * 128 + c0 + i) * 32 + d]; }
#pragma unroll
        for (int i = 0; i < 32; ++i) { U[(long)(bh * 128 + c0 + i) * 2048 + de] = s; s = fmaf(dc[i], s, u[i]); }
    }
}

__device__ __forceinline__ void gla_out_item(const Params& p, int layer, unsigned char* ldsw, int item_, int lane, bool dry) {
    const int item = __builtin_amdgcn_readfirstlane(item_);
    bf16_t* H = (bf16_t*)(p.ws + WS_H);
    const float* bcum = (const float*)(p.ws + WS_BCUM); const float* U = (const float*)(p.ws + WS_U);
    float* sA = (float*)ldsw; bf16_t* sV = (bf16_t*)(ldsw + 8192);
    const int bh = item >> 7, c = item & 127, b = bh >> 2, h = bh & 3;
    const long tok = (long)b * T + c * 64 + lane;
#pragma unroll
    for (int r = 0; r < 8; ++r) *(f32x4*)(sA + r * 256 + lane * 4) = *(const f32x4*)(U + (long)item * 2048 + r * 256 + lane * 4);
#pragma unroll
    for (int r = 0; r < 8; ++r) *(u32x4*)(sV + lane * 64 + r * 8) = *(const u32x4*)(H + tok * HP + HCV + h * 64 + r * 8);
    WAVE_SYNC();
    float o[64];
#pragma unroll
    for (int e = 0; e < 64; ++e) o[e] = 0.f;
    {
        const bf16_t* qp = H + tok * HP + HCQ + h * 32; const float* bp = bcum + tok * 128 + h * 32;
#pragma unroll 1
        for (int d = 0; d < 32; ++d) {
            const float qd = bf2f(qp[d]) * 0.17677669529663687f * __expf(bp[d]);
#pragma unroll
            for (int e4 = 0; e4 < 16; ++e4) {
                const f32x4 s4 = *(const f32x4*)(sA + d * 64 + e4 * 4);
                o[e4 * 4] = fmaf(qd, s4[0], o[e4 * 4]); o[e4 * 4 + 1] = fmaf(qd, s4[1], o[e4 * 4 + 1]);
                o[e4 * 4 + 2] = fmaf(qd, s4[2], o[e4 * 4 + 2]); o[e4 * 4 + 3] = fmaf(qd, s4[3], o[e4 * 4 + 3]);
            }
        }
    }
    WAVE_SYNC();
    {
        const bf16_t* kp = H + tok * HP + HCK + h * 32;
#pragma unroll
        for (int r = 0; r < 4; ++r) {
            const u32x4 kv = *(const u32x4*)(kp + r * 8);
            const f32x4 b0 = *(const f32x4*)(bcum + tok * 128 + h * 32 + r * 8), b1 = *(const f32x4*)(bcum + tok * 128 + h * 32 + r * 8 + 4);
            f32x4 k0 = {bflo(kv.x) * __expf(-b0[0]), bfhi(kv.x) * __expf(-b0[1]), bflo(kv.y) * __expf(-b0[2]), bfhi(kv.y) * __expf(-b0[3])};
            f32x4 k1 = {bflo(kv.z) * __expf(-b1[0]), bfhi(kv.z) * __expf(-b1[1]), bflo(kv.w) * __expf(-b1[2]), bfhi(kv.w) * __expf(-b1[3])};
            *(f32x4*)(sA + lane * 32 + r * 8) = k0; *(f32x4*)(sA + lane * 32 + r * 8 + 4) = k1;
        }
    }
    float qe[32];
    {
        const bf16_t* qp = H + tok * HP + HCQ + h * 32;
#pragma unroll
        for (int r = 0; r < 4; ++r) {
            const u32x4 qv = *(const u32x4*)(qp + r * 8);
            const f32x4 b0 = *(const f32x4*)(bcum + tok * 128 + h * 32 + r * 8), b1 = *(const f32x4*)(bcum + tok * 128 + h * 32 + r * 8 + 4);
            const float qq[8] = {bflo(qv.x), bfhi(qv.x), bflo(qv.y), bfhi(qv.y), bflo(qv.z), bfhi(qv.z), bflo(qv.w), bfhi(qv.w)};
            const float bb[8] = {b0[0], b0[1], b0[2], b0[3], b1[0], b1[1], b1[2], b1[3]};
#pragma unroll
            for (int e = 0; e < 8; ++e) qe[r * 8 + e] = qq[e] * 0.17677669529663687f * __expf(bb[e]);
        }
    }
    WAVE_SYNC();
#pragma unroll 1
    for (int j = 0; j < 64; ++j) {
        float a = 0.f;
#pragma unroll
        for (int d4 = 0; d4 < 8; ++d4) {
            const f32x4 k4 = *(const f32x4*)(sA + j * 32 + d4 * 4);
            a = fmaf(qe[d4 * 4], k4[0], a); a = fmaf(qe[d4 * 4 + 1], k4[1], a); a = fmaf(qe[d4 * 4 + 2], k4[2], a); a = fmaf(qe[d4 * 4 + 3], k4[3], a);
        }
        if (j > lane) a = 0.f;
#pragma unroll
        for (int e8 = 0; e8 < 8; ++e8) {
            const u32x4 v8 = *(const u32x4*)(sV + j * 64 + e8 * 8);
            o[e8 * 8 + 0] = fmaf(a, bflo(v8.x), o[e8 * 8 + 0]); o[e8 * 8 + 1] = fmaf(a, bfhi(v8.x), o[e8 * 8 + 1]);
            o[e8 * 8 + 2] = fmaf(a, bflo(v8.y), o[e8 * 8 + 2]); o[e8 * 8 + 3] = fmaf(a, bfhi(v8.y), o[e8 * 8 + 3]);
            o[e8 * 8 + 4] = fmaf(a, bflo(v8.z), o[e8 * 8 + 4]); o[e8 * 8 + 5] = fmaf(a, bfhi(v8.z), o[e8 * 8 + 5]);
            o[e8 * 8 + 6] = fmaf(a, bflo(v8.w), o[e8 * 8 + 6]); o[e8 * 8 + 7] = fmaf(a, bfhi(v8.w), o[e8 * 8 + 7]);
        }
    }
    float ss = 0.f;
#pragma unroll
    for (int e = 0; e < 64; ++e) ss = fmaf(o[e], o[e], ss);
    const float rms = rsqrtf(ss * (1.f / 64.f) + EPS);
    const float* gn = p.gnorm_g + layer * 256 + h * 64;
    bf16_t* cg_p = H + tok * HP + HCG + h * 64;
#pragma unroll
    for (int r = 0; r < 8; ++r) {
        const u32x4 gv = *(const u32x4*)(cg_p + r * 8);
        const float gq[8] = {bflo(gv.x), bfhi(gv.x), bflo(gv.y), bfhi(gv.y), bflo(gv.z), bfhi(gv.z), bflo(gv.w), bfhi(gv.w)};
        float y[8];
#pragma unroll
        for (int e = 0; e < 8; ++e) y[e] = o[r * 8 + e] * rms * gn[r * 8 + e] * silu_f(gq[e]);
        u32x4 w; w.x = pk2(y[0], y[1]); w.y = pk2(y[2], y[3]); w.z = pk2(y[4], y[5]); w.w = pk2(y[6], y[7]);
        if (!dry) *(u32x4*)(cg_p + r * 8) = w;
    }
    WAVE_SYNC();
}

constexpr int MPITCH = 260;
constexpr int HPITCH = 516;
constexpr int L_HIST = 0;
constexpr int L_CAND = 66560;
constexpr int L_CCNT = L_CAND + 65536;
constexpr int L_QINF = L_CCNT + 2048;
constexpr int L_MTAB = L_QINF + 1024 + 64;
static_assert(L_MTAB + 256 <= LDS_BYTES, "dsa lds");
constexpr int SUBCAP = 32;

__device__ __forceinline__ unsigned mono_bits(float f) { const unsigned u = __float_as_uint(f); return u ^ ((u >> 31) ? 0xffffffffu : 0x80000000u); }
__device__ __forceinline__ void idx_loadk(const bf16_t* Hb, int s0, int lane, bf16x8 (&kf)[2][2]) {
    const bf16_t* kp = Hb + (long)(s0 + (lane & 15)) * HP + HKI + 8 * (lane >> 4);
#pragma unroll
    for (int kb = 0; kb < 2; ++kb)
#pragma unroll
        for (int ks = 0; ks < 2; ++ks) kf[kb][ks] = *(const bf16x8*)(kp + (long)kb * 16 * HP + ks * 32);
}
__device__ __forceinline__ void idx_scores(const bf16x8 (&kf)[2][2], const bf16x8 (&qf)[8][2], const bf16x8 (&ql)[2][2], const float (&wh)[8], float (&score)[8]) {
    f32x4 lin[2];
#pragma unroll
    for (int kb = 0; kb < 2; ++kb) {
        lin[kb] = (f32x4){0.f, 0.f, 0.f, 0.f};
#pragma unroll
        for (int ks = 0; ks < 2; ++ks) {
            lin[kb] = __builtin_amdgcn_mfma_f32_16x16x32_bf16(kf[kb][ks], ql[0][ks], lin[kb], 0, 0, 0);
            lin[kb] = __builtin_amdgcn_mfma_f32_16x16x32_bf16(kf[kb][ks], ql[1][ks], lin[kb], 0, 0, 0);
        }
    }
#pragma unroll
    for (int i = 0; i < 8; ++i) score[i] = lin[i >> 2][i & 3];
#pragma unroll
    for (int hd = 0; hd < 8; ++hd) {
        f32x4 acc[2];
#pragma unroll
        for (int kb = 0; kb < 2; ++kb) {
            acc[kb] = (f32x4){0.f, 0.f, 0.f, 0.f};
#pragma unroll
            for (int ks = 0; ks < 2; ++ks) acc[kb] = __builtin_amdgcn_mfma_f32_16x16x32_bf16(kf[kb][ks], qf[hd][ks], acc[kb], 0, 0, 0);
        }
#pragma unroll
        for (int kb = 0; kb < 2; ++kb)
#pragma unroll
            for (int i = 0; i < 4; ++i) score[kb * 4 + i] = fmaf(fabsf(acc[kb][i]), wh[hd], score[kb * 4 + i]);
        if ((hd & 3) == 3) __builtin_amdgcn_sched_barrier(0);
    }
}

template <bool FAST>
__device__ __forceinline__ void attn_tile(const bf16x8 (&kf)[4], const bf16x8 (&vf)[4], const bf16x8 (&qfr)[2][4], f32x16 (&O)[2][2], float (&mrun)[2], float (&lrun)[2],
                                          const unsigned* hist, const float* mtab, int r32, int hh, int tile) {
#pragma unroll
    for (int qb = 0; qb < 2; ++qb) {
        f32x16 S;
        const unsigned mw = hist[(qb * 32 + r32) * MPITCH + tile] >> (4 * hh);
#pragma unroll
        for (int g4 = 0; g4 < 4; ++g4) {
            const f32x4 m4 = *(const f32x4*)(mtab + ((mw >> (8 * g4)) & 15u) * 4);
            S[4 * g4] = m4[0]; S[4 * g4 + 1] = m4[1]; S[4 * g4 + 2] = m4[2]; S[4 * g4 + 3] = m4[3];
        }
#pragma unroll
        for (int ks = 0; ks < 4; ++ks) S = __builtin_amdgcn_mfma_f32_32x32x16_bf16(kf[ks], qfr[qb][ks], S, 0, 0, 0);
        float pr[16]; float ps = 0.f;
        if (FAST) {
#pragma unroll
            for (int i = 0; i < 16; ++i) { pr[i] = __builtin_amdgcn_exp2f(S[i]); ps += pr[i]; }
        } else {
            float mx = fmaxf(fmaxf(S[0], S[1]), S[2]);
#pragma unroll
            for (int i = 3; i < 15; i += 2) mx = fmaxf(fmaxf(mx, S[i]), S[i + 1]);
            mx = fmaxf(mx, S[15]);
            { const auto sw = __builtin_amdgcn_permlane32_swap(__float_as_uint(mx), __float_as_uint(mx), false, false); mx = fmaxf(__uint_as_float(sw[0]), __uint_as_float(sw[1])); }
            if (__any(mx > mrun[qb])) {
                const float mnew = fmaxf(mx, mrun[qb]);
                const float alpha = __builtin_amdgcn_exp2f(mrun[qb] - mnew);
                mrun[qb] = mnew; lrun[qb] *= alpha;
#pragma unroll
                for (int db = 0; db < 2; ++db)
#pragma unroll
                    for (int i = 0; i < 16; ++i) O[db][qb][i] *= alpha;
            }
            const float mref = fmaxf(mrun[qb], -1000.f);
#pragma unroll
            for (int i = 0; i < 16; ++i) { pr[i] = __builtin_amdgcn_exp2f(S[i] - mref); ps += pr[i]; }
        }
        lrun[qb] += ps;
        bf16x8 pf[2];
#pragma unroll
        for (int s = 0; s < 2; ++s) {
            u32x4 pw; pw.x = pk2(pr[8 * s], pr[8 * s + 1]); pw.y = pk2(pr[8 * s + 2], pr[8 * s + 3]); pw.z = pk2(pr[8 * s + 4], pr[8 * s + 5]); pw.w = pk2(pr[8 * s + 6], pr[8 * s + 7]);
            pf[s] = __builtin_bit_cast(bf16x8, pw);
        }
#pragma unroll
        for (int db = 0; db < 2; ++db)
#pragma unroll
            for (int s = 0; s < 2; ++s) O[db][qb] = __builtin_amdgcn_mfma_f32_32x32x16_bf16(vf[db * 2 + s], pf[s], O[db][qb], 0, 0, 0);
    }
}
template <bool FAST>
__device__ __forceinline__ void attn_loop(const bf16_t* Kp, const bf16_t* Vp, const bf16x8 (&qfr)[2][4], f32x16 (&O)[2][2], float (&mrun)[2], float (&lrun)[2],
                                          const unsigned* hist, const float* mtab, int r32, int hh, int nt32, bool dry2) {
    bf16x8 kf[4], vf[4], kg[4], vg[4];
#pragma unroll
    for (int ks = 0; ks < 4; ++ks) { kf[ks] = *(const bf16x8*)(Kp + ks * 512); vf[ks] = *(const bf16x8*)(Vp + ks * 512); }
#pragma unroll 1
    for (int tile = 0; tile < nt32; tile += 2) {
        {
            const int tn = dry2 ? 0 : tile + 1;
#pragma unroll
            for (int ks = 0; ks < 4; ++ks) { kg[ks] = *(const bf16x8*)(Kp + (long)tn * 2048 + ks * 512); vg[ks] = *(const bf16x8*)(Vp + (long)tn * 2048 + ks * 512); }
        }
        attn_tile<FAST>(kf, vf, qfr, O, mrun, lrun, hist, mtab, r32, hh, tile);
        {
            const int tn = dry2 ? 0 : ((tile + 2 < nt32) ? tile + 2 : tile);
#pragma unroll
            for (int ks = 0; ks < 4; ++ks) { kf[ks] = *(const bf16x8*)(Kp + (long)tn * 2048 + ks * 512); vf[ks] = *(const bf16x8*)(Vp + (long)tn * 2048 + ks * 512); }
        }
        attn_tile<FAST>(kg, vg, qfr, O, mrun, lrun, hist, mtab, r32, hh, tile + 1);
    }
}

__device__ __forceinline__ void dsa_item(const Params& p, unsigned char* lds, int b, int qblk, bool dry, int wid_s) {
    bf16_t* H = (bf16_t*)(p.ws + WS_H);
    const float* side = (const float*)(p.ws + WS_SIDE);
    const bf16_t* Hb = H + (long)b * T * HP;
    const int tid = otid(wid_s), lane = tid & 63, w = tid >> 6, hq = lane >> 4;
    const int qg = w & 3, kh = w >> 2;
    const int t0 = qblk * 64, qloc = qg * 16 + (lane & 15), t = t0 + qloc;
    unsigned* hist = (unsigned*)(lds + L_HIST);
    unsigned* cand = (unsigned*)(lds + L_CAND);
    unsigned* ccnt = (unsigned*)(lds + L_CCNT);
    int* qinf = (int*)(lds + L_QINF);

    for (int i = tid; i < 64 * MPITCH; i += 512) hist[i] = 0u;
    if (tid < 64) ((float*)(lds + L_MTAB))[tid] = ((tid >> 2) >> (tid & 3)) & 1 ? 0.f : -1e30f;
    bf16x8 qf[8][2]; bf16x8 ql[2][2]; float wi[8]; float inv, fb0c;
    {
        const bf16_t* qp = Hb + (long)t * HP + HQI + 8 * hq;
#pragma unroll
        for (int hd = 0; hd < 8; ++hd)
#pragma unroll
            for (int ks = 0; ks < 2; ++ks) qf[hd][ks] = *(const bf16x8*)(qp + hd * 64 + ks * 32);
        const float* sp = side + ((long)b * T + t) * 24;
        const f32x4 w0 = *(const f32x4*)sp, w1 = *(const f32x4*)(sp + 4);
        wi[0] = w0[0]; wi[1] = w0[1]; wi[2] = w0[2]; wi[3] = w0[3]; wi[4] = w1[0]; wi[5] = w1[1]; wi[6] = w1[2]; wi[7] = w1[3];
        float n2 = 0.f;
#pragma unroll
        for (int i = 0; i < 8; ++i) n2 = fmaf(wi[i], wi[i], n2);
        const float nrm = fmaxf(SIG_UNIT * sqrtf(n2), 1e-30f);
        inv = 64.f / nrm;
        fb0c = 256.f - 64.f * 3.19f * (wi[0] + wi[1] + wi[2] + wi[3] + wi[4] + wi[5] + wi[6] + wi[7]) / nrm;
#pragma unroll
        for (int i = 0; i < 8; ++i) wi[i] *= 0.5f;
#pragma unroll
        for (int ks = 0; ks < 2; ++ks) {
            float ql_f[8];
#pragma unroll
            for (int j = 0; j < 8; ++j) ql_f[j] = 0.f;
#pragma unroll
            for (int hd = 0; hd < 8; ++hd) {
                const u32x4 qv = __builtin_bit_cast(u32x4, qf[hd][ks]);
                ql_f[0] = fmaf(wi[hd], bflo(qv.x), ql_f[0]); ql_f[1] = fmaf(wi[hd], bfhi(qv.x), ql_f[1]); ql_f[2] = fmaf(wi[hd], bflo(qv.y), ql_f[2]); ql_f[3] = fmaf(wi[hd], bfhi(qv.y), ql_f[3]);
                ql_f[4] = fmaf(wi[hd], bflo(qv.z), ql_f[4]); ql_f[5] = fmaf(wi[hd], bfhi(qv.z), ql_f[5]); ql_f[6] = fmaf(wi[hd], bflo(qv.w), ql_f[6]); ql_f[7] = fmaf(wi[hd], bfhi(qv.w), ql_f[7]);
            }
            u32x4 hi4; hi4.x = pk2(ql_f[0], ql_f[1]); hi4.y = pk2(ql_f[2], ql_f[3]); hi4.z = pk2(ql_f[4], ql_f[5]); hi4.w = pk2(ql_f[6], ql_f[7]);
            u32x4 lo4;
            lo4.x = pk2(ql_f[0] - bflo(hi4.x), ql_f[1] - bfhi(hi4.x)); lo4.y = pk2(ql_f[2] - bflo(hi4.y), ql_f[3] - bfhi(hi4.y));
            lo4.z = pk2(ql_f[4] - bflo(hi4.z), ql_f[5] - bfhi(hi4.z)); lo4.w = pk2(ql_f[6] - bflo(hi4.w), ql_f[7] - bfhi(hi4.w));
            ql[0][ks] = __builtin_bit_cast(bf16x8, hi4); ql[1][ks] = __builtin_bit_cast(bf16x8, lo4);
        }
    }
    const int ntile = (t0 + 64 + 127) >> 7;
    const int tmaxw = t0 + qg * 16 + 15;
    __syncthreads();
    int nit = 0;
    { const int v = tmaxw - kh * 64; if (v >= 0) nit = 2 * (v >> 7) + (((v & 127) >= 32) ? 2 : 1); }
    float fa = inv, fbias = fb0c;
    bool active = true;
#pragma unroll 1
    for (int level = 0; level < 2; ++level) {
        unsigned* hbase = level ? cand : hist;
        const bool wave_on = __any(active);
        if (wave_on) {
            const unsigned incv = 1u << ((qloc & 1) * 16);
            unsigned* hrow = hbase + (qloc >> 1) * HPITCH;
            bf16x8 kf[2][2];
            idx_loadk(Hb, kh * 64, lane, kf);
#pragma unroll 1
            for (int it = 0; it < nit; ++it) {
                const int s0 = (it >> 1) * 128 + kh * 64 + (it & 1) * 32;
                const int itn = (it + 1 < nit) ? it + 1 : it;
                bf16x8 kn[2][2];
                idx_loadk(Hb, (itn >> 1) * 128 + kh * 64 + (itn & 1) * 32, lane, kn);
                float score[8];
                idx_scores(kf, qf, ql, wi, score);
                if (s0 + 31 <= t0 + qg * 16) {
#pragma unroll
                    for (int i = 0; i < 8; ++i) { const unsigned bin = (unsigned)__builtin_amdgcn_fmed3f(fmaf(score[i], fa, fbias), 0.f, 511.5f); atomicAdd(hrow + bin, incv); }
                } else {
#pragma unroll
                    for (int i = 0; i < 8; ++i) {
                        const int s = s0 + (i >> 2) * 16 + hq * 4 + (i & 3);
                        if (s <= t) { const unsigned bin = (unsigned)__builtin_amdgcn_fmed3f(fmaf(score[i], fa, fbias), 0.f, 511.5f); atomicAdd(hrow + bin, incv); }
                    }
                }
#pragma unroll
                for (int kb = 0; kb < 2; ++kb)
#pragma unroll
                    for (int ks = 0; ks < 2; ++ks) kf[kb][ks] = kn[kb][ks];
            }
        }
        __syncthreads();
#pragma unroll 1
        for (int qq = 0; qq < 8; ++qq) {
            const int q = w * 8 + qq;
            if (level && !qinf[q * 4 + 3]) continue;
            const u32x4 wa = *(const u32x4*)(hbase + (q >> 1) * HPITCH + 8 * lane), wb = *(const u32x4*)(hbase + (q >> 1) * HPITCH + 8 * lane + 4);
            const int sh = (q & 1) * 16;
            const unsigned c[8] = {(wa.x >> sh) & 0xffffu, (wa.y >> sh) & 0xffffu, (wa.z >> sh) & 0xffffu, (wa.w >> sh) & 0xffffu, (wb.x >> sh) & 0xffffu, (wb.y >> sh) & 0xffffu, (wb.z >> sh) & 0xffffu, (wb.w >> sh) & 0xffffu};
            const unsigned tot = c[0] + c[1] + c[2] + c[3] + c[4] + c[5] + c[6] + c[7];
            unsigned S = tot;
#pragma unroll
            for (int o = 1; o < 64; o <<= 1) { const unsigned dn = (unsigned)bperm_i((lane + o) & 63, (int)S); if (lane + o < 64) S += dn; }
            const unsigned total = (unsigned)__builtin_amdgcn_readfirstlane((int)S);
            const u64 bal = __ballot(S >= 256u);
            int b1 = -1, r1 = 0, n1 = 0;
            if (total >= 256u) {
                const int Ls = 63 - __clzll(bal);
                unsigned cum = S - tot; bool found = false; int lb = -1, lr = 0, ln = 0;
#pragma unroll
                for (int j = 7; j >= 0; --j) { const bool hit = !found && (cum + c[j] >= 256u); if (hit) { lb = 8 * lane + j; lr = 256 - (int)cum; ln = (int)c[j]; found = true; } cum += c[j]; }
                b1 = bperm_i(Ls, lb); r1 = bperm_i(Ls, lr); n1 = bperm_i(Ls, ln);
            }
            if (lane == 0) { qinf[q * 4] = b1; qinf[q * 4 + 1] = r1; qinf[q * 4 + 2] = n1; }
        }
        __syncthreads();
        if (level == 0) { for (int i = tid; i < 64 * MPITCH; i += 512) hist[i] = 0u; }
        if (tid == 0) qinf[256] = 0;
        __syncthreads();
        if (wave_on) {
            const int b1 = qinf[qloc * 4];
            const float fsel = !active ? __builtin_inff() : ((b1 < 0) ? -__builtin_inff() : ((b1 >= 511) ? __builtin_inff() : (float)(b1 + 1)));
            const float fcand = !active ? __builtin_inff() : ((b1 <= 0) ? -__builtin_inff() : (float)b1);
            const float fb1 = (float)(b1 < 0 ? 0 : b1);
            unsigned* cslot = cand + (qloc * 8 + kh * 4 + hq) * SUBCAP; int ncand = 0;
            bf16x8 kf[2][2];
            idx_loadk(Hb, kh * 64, lane, kf);
#pragma unroll 1
            for (int it = 0; it < nit; ++it) {
                const int s0 = (it >> 1) * 128 + kh * 64 + (it & 1) * 32;
                const int itn = (it + 1 < nit) ? it + 1 : it;
                bf16x8 kn[2][2];
                idx_loadk(Hb, (itn >> 1) * 128 + kh * 64 + (itn & 1) * 32, lane, kn);
                float score[8];
                idx_scores(kf, qf, ql, wi, score);
                unsigned m0 = 0u;
                const int tlim = (s0 + 31 <= t0 + qg * 16) ? 0x7fffffff : t;
#pragma unroll
                for (int i = 0; i < 8; ++i) {
                    const int rr = (i >> 2) * 16 + hq * 4 + (i & 3), s = s0 + rr;
                    const float fb = fmaf(score[i], fa, fbias);
                    if (fb >= fcand && s <= tlim) {
                        if (fb >= fsel) m0 |= 1u << rr;
                        else {
                            const unsigned q19 = (unsigned)__builtin_amdgcn_fmed3f((fb - fb1) * 524288.f, 0.f, 524287.f);
                            if (ncand < SUBCAP) cslot[ncand] = (q19 << 13) | (unsigned)(8191 - s);
                            ++ncand;
                        }
                    }
                }
                if (m0) atomicOr(&hist[qloc * MPITCH + (s0 >> 5)], m0);
#pragma unroll
                for (int kb = 0; kb < 2; ++kb)
#pragma unroll
                    for (int ks = 0; ks < 2; ++ks) kf[kb][ks] = kn[kb][ks];
            }
            ccnt[qloc * 8 + kh * 4 + hq] = (unsigned)ncand;
        } else ccnt[qloc * 8 + kh * 4 + hq] = 0u;
        __syncthreads();
#pragma unroll 1
        for (int qq = 0; qq < 8; ++qq) {
            const int q = w * 8 + qq;
            if (level && !qinf[q * 4 + 3]) continue;
            const int r1 = qinf[q * 4 + 1];
            const int wr_ = lane >> 3, sl0 = (lane & 7) * 4;
            int cw = (int)ccnt[q * 8 + wr_];
            const bool ovf = __any(cw > SUBCAP) && (level == 0);
            if (lane == 0) { qinf[q * 4 + 3] = ovf ? 1 : 0; if (ovf) qinf[256] = 1; }
            if (ovf || r1 <= 0) continue;
            if (cw > SUBCAP) cw = SUBCAP;
            const u32x4 mine = *(const u32x4*)(cand + (q * 8 + wr_) * SUBCAP + sl0);
            int rk0 = 0, rk1 = 0, rk2 = 0, rk3 = 0;
#pragma unroll 1
            for (int ww = 0; ww < 8; ++ww) {
                int cn = (int)ccnt[q * 8 + ww]; if (cn > SUBCAP) cn = SUBCAP;
                const unsigned* cl = cand + (q * 8 + ww) * SUBCAP;
#pragma unroll 1
                for (int j = 0; j < cn; ++j) { const unsigned cv = cl[j]; rk0 += (cv > mine.x); rk1 += (cv > mine.y); rk2 += (cv > mine.z); rk3 += (cv > mine.w); }
            }
            if (sl0 + 0 < cw && rk0 < r1) { const int s = 8191 - (int)(mine.x & 8191u); atomicOr(&hist[q * MPITCH + (s >> 5)], 1u << (s & 31)); }
            if (sl0 + 1 < cw && rk1 < r1) { const int s = 8191 - (int)(mine.y & 8191u); atomicOr(&hist[q * MPITCH + (s >> 5)], 1u << (s & 31)); }
            if (sl0 + 2 < cw && rk2 < r1) { const int s = 8191 - (int)(mine.z & 8191u); atomicOr(&hist[q * MPITCH + (s >> 5)], 1u << (s & 31)); }
            if (sl0 + 3 < cw && rk3 < r1) { const int s = 8191 - (int)(mine.w & 8191u); atomicOr(&hist[q * MPITCH + (s >> 5)], 1u << (s & 31)); }
        }
        __syncthreads();
        if (level == 1 || qinf[256] == 0) break;
        {
            const bool mine_ovf = qinf[qloc * 4 + 3] != 0;
            const int b1 = qinf[qloc * 4];
            active = mine_ovf;
            fa = mine_ovf ? inv * 510.f : 0.f;
            fbias = mine_ovf ? fmaf(fb0c - (float)b1, 510.f, 1.f) : -1.f;
        }
        for (int i = tid; i < 32 * HPITCH; i += 512) cand[i] = 0u;
        __syncthreads();
    }
    for (int rep2_ = ((PROBE_PHASE == 41) ? 0 : 1); rep2_ < 2; ++rep2_) {
        const bool dry2 = dry || ((PROBE_PHASE == 41) && (rep2_ == 0) && (p.pos[0] == 0));
        const int head = w, r32 = lane & 31, hh = lane >> 5;
        bf16x8 qfr[2][4];
        float q1 = 0.f;
#pragma unroll
        for (int qb = 0; qb < 2; ++qb) {
            float qa = 0.f;
#pragma unroll
            for (int ks = 0; ks < 4; ++ks) {
                qfr[qb][ks] = *(const bf16x8*)(Hb + (long)(t0 + qb * 32 + r32) * HP + HQ + head * 64 + ks * 16 + 8 * hh);
                const u32x4 qv = __builtin_bit_cast(u32x4, qfr[qb][ks]);
                qa += fabsf(bflo(qv.x)) + fabsf(bfhi(qv.x)) + fabsf(bflo(qv.y)) + fabsf(bfhi(qv.y)) + fabsf(bflo(qv.z)) + fabsf(bfhi(qv.z)) + fabsf(bflo(qv.w)) + fabsf(bfhi(qv.w));
            }
            q1 = fmaxf(q1, qa);
        }
        q1 += sxor_f(q1, lane, 32);
#pragma unroll
        for (int o = 16; o >= 1; o >>= 1) q1 = fmaxf(q1, sxor_f(q1, lane, o));
        const float kmx = __uint_as_float(((const unsigned*)(p.ws + WS_KMAX))[b * 8 + head]);
        const bool fast = (q1 * kmx * 1.02f) < 100.f;
        f32x16 O[2][2];
#pragma unroll
        for (int a = 0; a < 2; ++a)
#pragma unroll
            for (int c2 = 0; c2 < 2; ++c2)
#pragma unroll
                for (int i = 0; i < 16; ++i) O[a][c2][i] = 0.f;
        float mrun[2] = {-1e30f, -1e30f}, lrun[2] = {0.f, 0.f};
        const bf16_t* Kp = (const bf16_t*)(p.ws + WS_KF) + ((long)(b * 8 + head) * 256 * 4 * 64 + lane) * 8;
        const bf16_t* Vp = (const bf16_t*)(p.ws + WS_VT) + ((long)(b * 8 + head) * 256 * 4 * 64 + lane) * 8;
        const int nt32 = (t0 + 64) >> 5;
        if (fast) attn_loop<true>(Kp, Vp, qfr, O, mrun, lrun, hist, (const float*)(lds + L_MTAB), r32, hh, nt32, dry2);
        else attn_loop<false>(Kp, Vp, qfr, O, mrun, lrun, hist, (const float*)(lds + L_MTAB), r32, hh, nt32, dry2);
#pragma unroll
        for (int qb = 0; qb < 2; ++qb) {
            const float lt = lrun[qb] + sxor_f(lrun[qb], lane, 32);
            const float il = 1.f / lt;
            bf16_t* gp = H + ((long)b * T + t0 + qb * 32 + r32) * HP + HAG + head * 64 + 4 * hh;
#pragma unroll
            for (int db = 0; db < 2; ++db)
#pragma unroll
                for (int g4 = 0; g4 < 4; ++g4) {
                    bf16_t* gq = gp + db * 32 + 8 * g4;
                    const u32x2 gv = *(const u32x2*)gq;
                    u32x2 wv;
                    wv.x = pk2(O[db][qb][4 * g4] * il * silu_f(bflo(gv.x)), O[db][qb][4 * g4 + 1] * il * silu_f(bfhi(gv.x)));
                    wv.y = pk2(O[db][qb][4 * g4 + 2] * il * silu_f(bflo(gv.y)), O[db][qb][4 * g4 + 3] * il * silu_f(bfhi(gv.y)));
                    if (!dry2) *(u32x2*)gq = wv;
                }
        }
    }
    __syncthreads();
}

__device__ __forceinline__ void gbar(unsigned* ctr, unsigned target) {
    __syncthreads();
    if (threadIdx.x == 0) {
        __builtin_amdgcn_fence(__ATOMIC_RELEASE, "agent");
        __hip_atomic_fetch_add(ctr, 1u, __ATOMIC_RELAXED, __HIP_MEMORY_SCOPE_AGENT);
        while (__hip_atomic_load(ctr, __ATOMIC_RELAXED, __HIP_MEMORY_SCOPE_AGENT) < target) __builtin_amdgcn_s_sleep(2);
        __builtin_amdgcn_fence(__ATOMIC_ACQUIRE, "agent");
    }
    __syncthreads();
}

__global__ void __launch_bounds__(512) fwd_megakernel(Params p0) {
    extern __shared__ __attribute__((aligned(16))) unsigned char lds[];
    cg::grid_group grid = cg::this_grid();
    const int G = gridDim.x, c = blockIdx.x;
    const int wid_s = __builtin_amdgcn_readfirstlane((int)(threadIdx.x >> 6));

    unsigned* barctr = (unsigned*)(p0.ws + WS_BAR); unsigned bar_n = 0;
    if (c == 0 && threadIdx.x == 0) __hip_atomic_store(barctr, 0u, __ATOMIC_RELAXED, __HIP_MEMORY_SCOPE_AGENT);
    for (int rep0_ = (PROBE_PHASE == 8 ? 0 : 1); rep0_ < 2; ++rep0_) prologue(p0, (long)c * 512 + threadIdx.x, (long)G * 512);
    grid.sync();

#pragma unroll 1
    for (int layer = 0; layer < DEPTH; ++layer) {
        Params p = p0;
        { size_t zoff = 0; asm volatile("" : "+s"(zoff)); p.ws = p0.ws + zoff; }
        bf16_t* H = (bf16_t*)(p.ws + WS_H);
        {
for (int rep_ = (PROBE_PHASE == 1 ? 0 : 1); rep_ < 2; ++rep_) { const bool dry = (PROBE_PHASE == 1) && (rep_ == 0) && (p.pos[0] == 0);
            EpiIn e; e.H = H; e.side = (float*)(p.ws + WS_SIDE); e.rope = (const float*)(p.ws + WS_ROPE); e.VT = (bf16_t*)(p.ws + WS_VT); e.KF = (bf16_t*)(p.ws + WS_KF); e.kmax = (unsigned*)(p.ws + WS_KMAX); e.dry = dry;
            const bf16_t* A = (const bf16_t*)(p.ws + WS_XB);
            const bf16_t* Bt = (const bf16_t*)(p.ws + WS_WIN) + (long)layer * NPAD * 1024;
#pragma unroll 1
            for (int L = c; L < 128 * 17; L += G) { int pm, pn; tile_of(L, 128, 17, pm, pn); gemm_tile((LAS unsigned char*)lds, A, 1024, Bt, 1024, pm, pn, e, wid_s); }
}
        }
        gbar(barctr, (++bar_n) * (unsigned)G); if (PROBE_PHASE == 9) gbar(barctr, (++bar_n) * (unsigned)G);
        {
for (int rep_ = (PROBE_PHASE == 2 ? 0 : 1); rep_ < 2; ++rep_) { const bool dry = (PROBE_PHASE == 2) && (rep_ == 0) && (p.pos[0] == 0);
            const int tid = otid(wid_s), lane = tid & 63, w = tid >> 6;
#pragma unroll 1
            for (int g = c; g < 256; g += G) gla_local_item(p, layer, g * 8 + w, lane, dry);
}
        }
for (int rep_ = (PROBE_PHASE == 3 ? 0 : 1); rep_ < 2; ++rep_) { const bool dry = (PROBE_PHASE == 3) && (rep_ == 0) && (p.pos[0] == 0);
#pragma unroll 1
        for (int tile = c; tile < 512; tile += G) conformer_tile(p, layer, lds, tile, dry, wid_s);
}
        gbar(barctr, (++bar_n) * (unsigned)G); if (PROBE_PHASE == 9) gbar(barctr, (++bar_n) * (unsigned)G);
        {
            const int tid = otid(wid_s);
#pragma unroll 1
            for (int g = c; g < 64; g += G) gla_scan(p, g * 512 + tid);
        }
for (int rep_ = (PROBE_PHASE == 4 ? 0 : 1); rep_ < 2; ++rep_) { const bool dry = (PROBE_PHASE == 4) && (rep_ == 0) && (p.pos[0] == 0);
#pragma unroll 1
        for (int it = c; it < 512; it += G) {
            const int pr = it >> 1, second = it & 1;
            const int xcd = pr & 7, j = pr >> 3, b = xcd >> 1, par = xcd & 1;
            const int qblk = second ? (2 * j + par) : 127 - (2 * j + par);
            dsa_item(p, lds, b, qblk, dry, wid_s);
        }
}
        gbar(barctr, (++bar_n) * (unsigned)G); if (PROBE_PHASE == 9) gbar(barctr, (++bar_n) * (unsigned)G);
        {
for (int rep_ = (PROBE_PHASE == 5 ? 0 : 1); rep_ < 2; ++rep_) { const bool dry = (PROBE_PHASE == 5) && (rep_ == 0) && (p.pos[0] == 0);
            const int tid = otid(wid_s), lane = tid & 63, w = tid >> 6;
#pragma unroll 1
            for (int g = c; g < 256; g += G) gla_out_item(p, layer, lds + w * 16384, g * 8 + w, lane, dry);
}
        }
        gbar(barctr, (++bar_n) * (unsigned)G); if (PROBE_PHASE == 9) gbar(barctr, (++bar_n) * (unsigned)G);
        {
for (int rep_ = (PROBE_PHASE == 6 ? 0 : 1); rep_ < 2; ++rep_) { const bool dry = (PROBE_PHASE == 6) && (rep_ == 0) && (p.pos[0] == 0);
            EpiOut e; e.xres = (layer == 0) ? p.x : p.out; e.out = p.out; e.dry = dry;
            const bf16_t* A = H + HAG;
            const bf16_t* Bt = (const bf16_t*)(p.ws + WS_WOUT) + (long)layer * 1024 * 1024;
#pragma unroll 1
            for (int L = c; L < 128 * 4; L += G) { int pm, pn; tile_of(L, 128, 4, pm, pn); gemm_tile((LAS unsigned char*)lds, A, HP, Bt, 1024, pm, pn, e, wid_s); }
}
        }
        gbar(barctr, (++bar_n) * (unsigned)G); if (PROBE_PHASE == 9) gbar(barctr, (++bar_n) * (unsigned)G);
        {
for (int rep_ = (PROBE_PHASE == 7 ? 0 : 1); rep_ < 2; ++rep_) { const bool dry = (PROBE_PHASE == 7) && (rep_ == 0) && (p.pos[0] == 0);
            const int tid = otid(wid_s), lane = tid & 63, w = tid >> 6;
            ln_phase(p, layer, c * 8 + w, G * 8, lane, dry);
            if (c == 0 && tid < 32) ((unsigned*)(p.ws + WS_KMAX))[tid] = 0u;
}
        }
        gbar(barctr, (++bar_n) * (unsigned)G); if (PROBE_PHASE == 9) gbar(barctr, (++bar_n) * (unsigned)G);
    }
}

extern "C" void kernel_launch(void* const* d_in, const int* in_sizes, int n_in, void* d_out, int out_size, void* d_ws, size_t ws_size, hipStream_t stream) {
    static int grid_blocks = 0;
    if (grid_blocks == 0) {
        if (n_in != 15 || ws_size < WS_END) { fprintf(stderr, "kernel_launch: unexpected inputs (n_in %d, ws %zu < %zu)\n", n_in, ws_size, (size_t)WS_END); grid_blocks = -1; return; }
        int dev = 0, cus = 0, per_cu = 0;
        hipGetDevice(&dev);
        hipDeviceGetAttribute(&cus, hipDeviceAttributeMultiprocessorCount, dev);
        if (hipFuncSetAttribute((const void*)fwd_megakernel, hipFuncAttributeMaxDynamicSharedMemorySize, LDS_BYTES) != hipSuccess) { fprintf(stderr, "kernel_launch: hipFuncSetAttribute failed\n"); grid_blocks = -1; return; }
        hipOccupancyMaxActiveBlocksPerMultiprocessor(&per_cu, (const void*)fwd_megakernel, 512, LDS_BYTES);
        if (per_cu < 1) per_cu = 1;
        grid_blocks = cus * per_cu;
    }
    if (grid_blocks < 0) return;
    Params p{};
    p.x = (const float*)d_in[0]; p.pos = (const int*)d_in[1]; p.w_in = (const float*)d_in[2]; p.conv_w = (const float*)d_in[3]; p.conv_b = (const float*)d_in[4];
    p.cln_g = (const float*)d_in[5]; p.cln_b = (const float*)d_in[6]; p.pw_w = (const float*)d_in[7]; p.pw_b = (const float*)d_in[8];
    p.gate_w2 = (const float*)d_in[9]; p.gate_b = (const float*)d_in[10]; p.gnorm_g = (const float*)d_in[11]; p.w_out = (const float*)d_in[12];
    p.ln_g = (const float*)d_in[13]; p.ln_b = (const float*)d_in[14];
    p.out = (float*)d_out; p.ws = (unsigned char*)d_ws;
    for (int j = 0; j < 32; ++j) p.inv_freq[j] = (float)pow(10000.0, -(double)j / 32.0);
    void* args[] = {&p};
    hipError_t e = hipLaunchCooperativeKernel((const void*)fwd_megakernel, dim3(grid_blocks), dim3(512), args, LDS_BYTES, stream);
    if (e != hipSuccess) fprintf(stderr, "cooperative launch failed: %s (grid %d)\n", hipGetErrorString(e), grid_blocks);
}
```

```cpp
#include <hip/hip_runtime.h>
#include <hip/hip_cooperative_groups.h>
#include <cstdio>
#include <cmath>
namespace cg = cooperative_groups;

typedef unsigned short bf16_t;
typedef short bf16x8 __attribute__((ext_vector_type(8)));
typedef float f32x4 __attribute__((ext_vector_type(4)));
typedef float f32x16 __attribute__((ext_vector_type(16)));
typedef unsigned u32x4 __attribute__((ext_vector_type(4)));
typedef unsigned u32x2 __attribute__((ext_vector_type(2)));
typedef unsigned long long u64;

constexpr int NB = 4, T = 8192, NTOK = NB * T, DM = 1024, DIN = 4184, NPAD = 4352, HP = 4160, DEPTH = 4;
constexpr int HQ = 0, HK = 512, HV = 1024, HQI = 1536, HKI = 2048, HGLU = 2112, HCQ = 2624, HCK = 2752, HCV = 2880, HAG = 3136, HBG = 3648, HCG = 3904;
constexpr float EPS = 1e-5f;
constexpr float ALPHA = 1.6817928305074290f;
constexpr float QSCALE = 0.125f * 1.4426950408889634f;
constexpr float WI_SCALE = 0.04419417382415922f;
constexpr float SIG_UNIT = 5.66f;
constexpr int CAP = 128;

constexpr size_t WS_WIN = 0;
constexpr size_t WS_WOUT = WS_WIN + (size_t)DEPTH * NPAD * 1024 * 2;
constexpr size_t WS_PWT = WS_WOUT + (size_t)DEPTH * 1024 * 1024 * 2;
constexpr size_t WS_ROPE = WS_PWT + (size_t)DEPTH * 256 * 256 * 2;
constexpr size_t WS_XB = WS_ROPE + (size_t)NTOK * 32 * 8;
constexpr size_t WS_H = WS_XB + (size_t)NTOK * 1024 * 2;
constexpr size_t WS_SIDE = WS_H + (size_t)NTOK * HP * 2;
constexpr size_t WS_BCUM = WS_SIDE + (size_t)NTOK * 24 * 4;
constexpr size_t WS_U = WS_BCUM + (size_t)NTOK * 128 * 4;
constexpr size_t WS_DEC = WS_U + (size_t)2048 * 2048 * 4;
constexpr size_t WS_VT = WS_DEC + (size_t)2048 * 32 * 4;
constexpr size_t WS_KF = WS_VT + (size_t)NTOK * 512 * 2;
constexpr size_t WS_BAR = WS_KF + (size_t)NTOK * 512 * 2;
constexpr size_t WS_KMAX = WS_BAR + 256;
constexpr size_t WS_END = WS_KMAX + 256;

#ifndef PROBE_PHASE
#define PROBE_PHASE 0
#endif
constexpr int LDS_BYTES = 147456;

struct Params {
    const float* x; const int* pos; const float* w_in; const float* conv_w; const float* conv_b; const float* cln_g; const float* cln_b;
    const float* pw_w; const float* pw_b; const float* gate_w2; const float* gate_b; const float* gnorm_g; const float* w_out; const float* ln_g; const float* ln_b;
    float* out; unsigned char* ws;
    float inv_freq[32];
};

__device__ __forceinline__ unsigned f2bf(float f) { unsigned u = __float_as_uint(f); return (u + 0x7fffu + ((u >> 16) & 1u)) >> 16; }
__device__ __forceinline__ float bf2f(unsigned b) { return __uint_as_float(b << 16); }
typedef float f32x2_t __attribute__((ext_vector_type(2)));
typedef __bf16 bf16x2_t __attribute__((ext_vector_type(2)));
__device__ __forceinline__ unsigned pk2(float lo, float hi) { f32x2_t v = {lo, hi}; bf16x2_t b = __builtin_convertvector(v, bf16x2_t); return __builtin_bit_cast(unsigned, b); }
__device__ __forceinline__ float bflo(unsigned w) { return __uint_as_float(w << 16); }
__device__ __forceinline__ float bfhi(unsigned w) { return __uint_as_float(w & 0xffff0000u); }
__device__ __forceinline__ float silu_f(float v) { return v / (1.f + __expf(-v)); }
__device__ __forceinline__ float sigmoid_f(float v) { return 1.f / (1.f + __expf(-v)); }
__device__ __forceinline__ int bperm_i(int idx, int v) { return __builtin_amdgcn_ds_bpermute(idx << 2, v); }
__device__ __forceinline__ float sxor_f(float v, int lane, int m) { return __int_as_float(bperm_i(lane ^ m, __float_as_int(v))); }
__device__ __forceinline__ int sxor_i(int v, int lane, int m) { return bperm_i(lane ^ m, v); }
__device__ __forceinline__ float wave_sum(float v, int lane) {
#pragma unroll
    for (int o = 32; o >= 1; o >>= 1) v += sxor_f(v, lane, o);
    return v;
}
__device__ __forceinline__ int otid(int wid_s) { int l; asm volatile("v_mbcnt_lo_u32_b32 %0, -1, 0\n\tv_mbcnt_hi_u32_b32 %0, -1, %0" : "=v"(l)); return (wid_s << 6) | l; }
#define WAVE_SYNC() do { __builtin_amdgcn_fence(__ATOMIC_RELEASE, "wavefront"); __builtin_amdgcn_wave_barrier(); __builtin_amdgcn_fence(__ATOMIC_ACQUIRE, "wavefront"); } while (0)

__device__ __forceinline__ int l2orig(int l) {
    if (l < 1536) return l;
    if (l < 2048) return 2048 + (l - 1536);
    if (l < 2112) return 2560 + (l - 2048);
    if (l < 2624) return 2632 + (l - 2112);
    if (l < 2752) return 3400 + (l - 2624);
    if (l < 2880) return 3528 + (l - 2752);
    if (l < 3136) return 3656 + (l - 2880);
    if (l < 3648) return 1536 + (l - 3136);
    if (l < 3904) return 3144 + (l - 3648);
    if (l < 4160) return 3912 + (l - 3904);
    if (l < 4168) return 2624 + (l - 4160);
    if (l < 4184) return 4168 + (l - 4168);
    return -1;
}
__device__ __forceinline__ int npos2logical(int np) {
    const int hb = np & ~127, p = np & 127, wc = p >> 5, n = (p >> 4) & 1, fr = p & 15;
    return hb + (wc >> 1) * 64 + n * 32 + (wc & 1) * 16 + fr;
}

__device__ __forceinline__ void sincos_acc(float angf, float& c, float& s) {
    const double a = (double)angf;
    const double n = rint(a * 0.15915494309189535);
    double r = fma(-n, 6.283185307179586, a);
    r = fma(-n, 2.4492935982947064e-16, r);
    const double r2 = r * r;
    double ts = r, tc = 1.0, ss = r, cc = 1.0;
#pragma unroll
    for (int k = 1; k <= 14; ++k) {
        tc = -tc * r2 * (1.0 / (double)((2 * k - 1) * (2 * k)));
        ts = -ts * r2 * (1.0 / (double)((2 * k) * (2 * k + 1)));
        cc += tc; ss += ts;
    }
    c = (float)cc; s = (float)ss;
}

__device__ __forceinline__ void prologue(const Params& p, long gtid, long gthreads) {
    bf16_t* win = (bf16_t*)(p.ws + WS_WIN);
    for (long idx = gtid; idx < (long)DEPTH * 128 * NPAD; idx += gthreads) {
        const int np = (int)(idx % NPAD); const long r = idx / NPAD; const int kc = (int)(r % 128); const int l = (int)(r / 128);
        const int oc = l2orig(npos2logical(np));
        u32x4 w = {0u, 0u, 0u, 0u};
        if (oc >= 0) {
            const float* src = p.w_in + ((long)l * 1024 + kc * 8) * DIN + oc;
            float v[8];
#pragma unroll
            for (int i = 0; i < 8; ++i) v[i] = src[(long)i * DIN];
            w.x = pk2(v[0], v[1]); w.y = pk2(v[2], v[3]); w.z = pk2(v[4], v[5]); w.w = pk2(v[6], v[7]);
        }
        *(u32x4*)(win + ((long)l * NPAD + np) * 1024 + kc * 8) = w;
    }
    bf16_t* wout = (bf16_t*)(p.ws + WS_WOUT);
    for (long idx = gtid; idx < (long)DEPTH * 128 * 1024; idx += gthreads) {
        const int n = (int)(idx % 1024); const long r = idx / 1024; const int kc = (int)(r % 128); const int l = (int)(r / 128);
        const float* src = p.w_out + ((long)l * 1024 + kc * 8) * 1024 + n;
        float v[8];
#pragma unroll
        for (int i = 0; i < 8; ++i) v[i] = src[(long)i * 1024];
        u32x4 w; w.x = pk2(v[0], v[1]); w.y = pk2(v[2], v[3]); w.z = pk2(v[4], v[5]); w.w = pk2(v[6], v[7]);
        *(u32x4*)(wout + ((long)l * 1024 + n) * 1024 + kc * 8) = w;
    }
    bf16_t* pwt = (bf16_t*)(p.ws + WS_PWT);
    for (long idx = gtid; idx < (long)DEPTH * 32 * 256; idx += gthreads) {
        const int n = (int)(idx % 256); const long r = idx / 256; const int kc = (int)(r % 32); const int l = (int)(r / 32);
        const float* src = p.pw_w + ((long)l * 256 + kc * 8) * 256 + n;
        float v[8];
#pragma unroll
        for (int i = 0; i < 8; ++i) v[i] = src[(long)i * 256];
        u32x4 w; w.x = pk2(v[0], v[1]); w.y = pk2(v[2], v[3]); w.z = pk2(v[4], v[5]); w.w = pk2(v[6], v[7]);
        *(u32x4*)(pwt + ((long)l * 256 + n) * 256 + kc * 8) = w;
    }
    float2* rope = (float2*)(p.ws + WS_ROPE);
    for (long idx = gtid; idx < (long)NTOK * 32; idx += gthreads) {
        const int j = (int)(idx & 31); const long tok = idx >> 5;
        const float ang = (float)p.pos[tok] * p.inv_freq[j];
        float c, s; sincos_acc(ang, c, s);
        rope[idx] = make_float2(c, s);
    }
    if (gtid < 32) ((unsigned*)(p.ws + WS_KMAX))[gtid] = 0u;
    bf16_t* xb = (bf16_t*)(p.ws + WS_XB);
    for (long idx = gtid; idx < (long)NTOK * 128; idx += gthreads) {
        const f32x4 a = *(const f32x4*)(p.x + idx * 8), b = *(const f32x4*)(p.x + idx * 8 + 4);
        u32x4 w; w.x = pk2(a[0], a[1]); w.y = pk2(a[2], a[3]); w.z = pk2(b[0], b[1]); w.w = pk2(b[2], b[3]);
        *(u32x4*)(xb + idx * 8) = w;
    }
}

constexpr int BM = 256, BK = 64, HALF = 128, HT = HALF * BK;
__device__ __forceinline__ int lds_byte(int r, int c) {
    int st = (r >> 4) * 2 + (c >> 5), rr = r & 15, cc = c & 31, ob = rr * 64 + cc * 2;
    return st * 1024 + (ob ^ (((ob >> 9) & 1) << 5));
}
__device__ __forceinline__ void stage_rc(int b, int& R, int& C) {
    int st = b / 1024, sb = b % 1024, swz = sb ^ (((sb >> 9) & 1) << 5);
    R = (st >> 1) * 16 + swz / 64; C = (st & 1) * 32 + (swz % 64) / 2;
}
__device__ __forceinline__ void tile_of(int L, int nM, int nN, int& pm, int& pn) {
    const int nwg = nM * nN; int wgid = L;
    { const int q = nwg / 8, r = nwg % 8, xcd = wgid % 8, off = wgid / 8; wgid = (xcd < r ? xcd * (q + 1) : r * (q + 1) + (xcd - r) * q) + off; }
    const int nig = 8 * nN, gid = wgid / nig, fm = gid * 8, gsz = (nM - fm) < 8 ? (nM - fm) : 8;
    pm = fm + ((wgid % nig) % gsz); pn = (wgid % nig) / gsz;
}

#define LAS __attribute__((address_space(3)))
template <class Epi>
__device__ __forceinline__ void gemm_tile(LAS unsigned char* lds, const bf16_t* A, int lda, const bf16_t* Bt, int K, int pm, int pn, const Epi& epi, int wid_s) {
    const int tid = otid(wid_s), wid = __builtin_amdgcn_readfirstlane(tid >> 6), lane = tid & 63, wr = wid >> 2, wc = wid & 3, fr = lane & 15, fq = lane >> 4;
    const int nt = K / BK;
    unsigned voffA[2], voffB[2];
#pragma unroll
    for (int i = 0; i < 2; ++i) { int R, C; stage_rc(tid * 16 + i * 8192, R, C); voffA[i] = (unsigned)(R * lda + C) * 2u; voffB[i] = (unsigned)(R * K + C) * 2u; }
    const size_t kstep = (size_t)(BK * 2), hstepA = (size_t)HALF * lda * 2, hstepB = (size_t)HALF * K * 2;
    const unsigned ldsw = (unsigned)wid * 1024u;
    const int aoff = lds_byte(wr * 64 + fr, fq * 8), boff = lds_byte(wc * 32 + fr, fq * 8);
    const char* cA = (const char*)A + (size_t)pm * 2 * hstepA; const char* cB = (const char*)Bt + (size_t)pn * 2 * hstepB;
#define HTB (HALF * BK * 2)
#define SA(b, h) (((b) * 2 + (h)) * HTB)
#define SB(b, h) ((4 + (b) * 2 + (h)) * HTB)
#define STAGE(bufoff, gbase, voff) do { _Pragma("unroll") for (int _i = 0; _i < 2; ++_i) \
        __builtin_amdgcn_global_load_lds((const unsigned*)((const char*)(gbase) + (voff)[_i]), (LAS unsigned*)(lds + (bufoff) + ldsw + _i * 8192), 16, 0, 0); } while (0)
#define LDA(dst, b, h) do { _Pragma("unroll") for (int m = 0; m < 4; ++m) _Pragma("unroll") for (int k = 0; k < 2; ++k) dst[m][k] = *(const LAS bf16x8*)(lds + SA(b, h) + aoff + m * 2048 + k * 1024); } while (0)
#define LDB(dst, b, h) do { _Pragma("unroll") for (int n = 0; n < 2; ++n) _Pragma("unroll") for (int k = 0; k < 2; ++k) dst[n][k] = *(const LAS bf16x8*)(lds + SB(b, h) + boff + n * 2048 + k * 1024); } while (0)
#define MMA(ai, bj, At_, Bt_) do { __builtin_amdgcn_s_setprio(1); _Pragma("unroll") for (int m = 0; m < 4; ++m) _Pragma("unroll") for (int n = 0; n < 2; ++n) _Pragma("unroll") for (int k = 0; k < 2; ++k) \
        acc[ai][bj][m][n] = __builtin_amdgcn_mfma_f32_16x16x32_bf16(Bt_[n][k], At_[m][k], acc[ai][bj][m][n], 0, 0, 0); __builtin_amdgcn_s_setprio(0); } while (0)
#define WAIT_V(n) asm volatile("s_waitcnt vmcnt(" #n ")" ::: "memory")
#define WAIT_L(n) asm volatile("s_waitcnt lgkmcnt(" #n ")" ::: "memory")
#define BAR __builtin_amdgcn_s_barrier()
#define SCHED __builtin_amdgcn_sched_barrier(0)
    f32x4 acc[2][2][4][2];
#pragma unroll
    for (int a = 0; a < 2; ++a)
#pragma unroll
        for (int b = 0; b < 2; ++b)
#pragma unroll
            for (int m = 0; m < 4; ++m)
#pragma unroll
                for (int n = 0; n < 2; ++n) acc[a][b][m][n] = (f32x4){0.f, 0.f, 0.f, 0.f};
    bf16x8 At[4][2], B0[2][2], B1[2][2];
    STAGE(SB(0, 0), cB, voffB); STAGE(SA(0, 0), cA, voffA); STAGE(SB(0, 1), cB + hstepB, voffB); STAGE(SA(0, 1), cA + hstepA, voffA);
    if (wr == 1) BAR;
    WAIT_V(4); BAR;
    STAGE(SB(1, 0), cB + kstep, voffB); STAGE(SA(1, 0), cA + kstep, voffA); STAGE(SB(1, 1), cB + hstepB + kstep, voffB);
    WAIT_V(6); BAR;
    for (int t = 0; t < nt - 2; t += 2) {
        const char* a1 = cA + (size_t)(t + 1) * kstep; const char* a2 = cA + (size_t)(t + 2) * kstep; const char* b2 = cB + (size_t)(t + 2) * kstep;
        const char* a3 = a2 + kstep; const char* b3 = b2 + kstep;
        LDB(B0, 0, 0); SCHED; LDA(At, 0, 0); STAGE(SA(1, 1), a1 + hstepA, voffA);
        WAIT_L(8); BAR; WAIT_L(0); MMA(0, 0, At, B0); BAR; SCHED;
        LDB(B1, 0, 1); STAGE(SB(0, 0), b2, voffB);
        BAR; WAIT_L(0); MMA(0, 1, At, B1); BAR;
        LDA(At, 0, 1); STAGE(SA(0, 0), a2, voffA);
        BAR; WAIT_L(0); MMA(1, 0, At, B0); BAR; SCHED;
        STAGE(SB(0, 1), b2 + hstepB, voffB);
        WAIT_V(6); BAR; MMA(1, 1, At, B1); BAR;
        LDB(B0, 1, 0); SCHED; LDA(At, 1, 0); STAGE(SA(0, 1), a2 + hstepA, voffA);
        WAIT_L(8); BAR; WAIT_L(0); MMA(0, 0, At, B0); BAR; SCHED;
        LDB(B1, 1, 1); STAGE(SB(1, 0), b3, voffB);
        BAR; WAIT_L(0); MMA(0, 1, At, B1); BAR;
        LDA(At, 1, 1); STAGE(SA(1, 0), a3, voffA);
        BAR; WAIT_L(0); MMA(1, 0, At, B0); BAR; SCHED;
        STAGE(SB(1, 1), b3 + hstepB, voffB);
        WAIT_V(6); BAR; MMA(1, 1, At, B1); BAR;
    }
    { const char* a1 = cA + (size_t)(nt - 1) * kstep;
      LDB(B0, 0, 0); LDA(At, 0, 0); STAGE(SA(1, 1), a1 + hstepA, voffA);
      BAR; WAIT_L(0); MMA(0, 0, At, B0); BAR;
      LDB(B1, 0, 1); BAR; WAIT_L(0); MMA(0, 1, At, B1); BAR;
      LDA(At, 0, 1); WAIT_V(4); BAR; WAIT_L(0); MMA(1, 0, At, B0); MMA(1, 1, At, B1); BAR; }
    { LDB(B0, 1, 0); LDA(At, 1, 0); WAIT_V(2); BAR; WAIT_L(0); MMA(0, 0, At, B0); BAR;
      LDB(B1, 1, 1); WAIT_V(0); BAR; WAIT_L(0); MMA(0, 1, At, B1); BAR;
      LDA(At, 1, 1); BAR; WAIT_L(0); MMA(1, 0, At, B0); MMA(1, 1, At, B1); BAR; }
    if (wr == 0) BAR;
    epi(acc, pm * BM, pn * BM, wr, wc, fr, fq);
#undef SA
#undef SB
#undef STAGE
#undef LDA
#undef LDB
#undef MMA
}

struct EpiIn {
    bf16_t* H; float* side; const float* rope; bf16_t* VT; bf16_t* KF; unsigned* kmax; bool dry;
    __device__ __forceinline__ void operator()(f32x4 (&acc)[2][2][4][2], int brow, int bcol, int wr, int wc, int fr, int fq) const {
#pragma unroll
        for (int bj = 0; bj < 2; ++bj) {
            const int hb = bcol + bj * HALF;
            if (hb >= 4224 || dry) continue;
            const int gbase = hb + (wc >> 1) * 64, g64 = gbase >> 6, d0 = (wc & 1) * 16 + 4 * fq;
            const bool rp = (g64 < 16) || (g64 >= 24 && g64 <= 32);
            const float qs = (g64 < 8) ? QSCALE : 1.f;
            float kabs = 0.f;
#pragma unroll
            for (int ai = 0; ai < 2; ++ai)
#pragma unroll
                for (int m = 0; m < 4; ++m) {
                    const long row = brow + ai * HALF + wr * 64 + m * 16 + fr;
                    f32x4 o1 = acc[ai][bj][m][0], o2 = acc[ai][bj][m][1];
                    if (rp) {
                        const f32x4 c0 = *(const f32x4*)(rope + (row * 32 + d0) * 2), c1 = *(const f32x4*)(rope + (row * 32 + d0) * 2 + 4);
                        const f32x4 x1 = o1, x2 = o2;
                        o1[0] = (x1[0] * c0[0] - x2[0] * c0[1]) * qs; o2[0] = (x2[0] * c0[0] + x1[0] * c0[1]) * qs;
                        o1[1] = (x1[1] * c0[2] - x2[1] * c0[3]) * qs; o2[1] = (x2[1] * c0[2] + x1[1] * c0[3]) * qs;
                        o1[2] = (x1[2] * c1[0] - x2[2] * c1[1]) * qs; o2[2] = (x2[2] * c1[0] + x1[2] * c1[1]) * qs;
                        o1[3] = (x1[3] * c1[2] - x2[3] * c1[3]) * qs; o2[3] = (x2[3] * c1[2] + x1[3] * c1[3]) * qs;
                    }
                    if (g64 >= 8 && g64 < 24) {
                        const int bb = (int)(row >> 13), tt = (int)(row & (T - 1)), tile = tt >> 5, tk = tt & 31;
                        if (g64 < 16) {
                            kabs = fmaxf(kabs, fmaxf(fmaxf(fabsf(o1[0]), fabsf(o1[1])), fmaxf(fabsf(o1[2]), fabsf(o1[3]))));
                            kabs = fmaxf(kabs, fmaxf(fmaxf(fabsf(o2[0]), fabsf(o2[1])), fmaxf(fabsf(o2[2]), fabsf(o2[3]))));
                            const long base = ((long)(bb * 8 + (g64 - 8)) * 256 + tile) * 4;
                            const int ks = d0 >> 4, hk = (d0 >> 3) & 1, j0 = d0 & 7;
                            u32x2 w1, w2; w1.x = pk2(o1[0], o1[1]); w1.y = pk2(o1[2], o1[3]); w2.x = pk2(o2[0], o2[1]); w2.y = pk2(o2[2], o2[3]);
                            const auto sx = __builtin_amdgcn_permlane16_swap(w1.x, w2.x, false, false), sy = __builtin_amdgcn_permlane16_swap(w1.y, w2.y, false, false);
                            u32x4 wv; long slot;
                            if (fq & 1) { wv.x = sx[0]; wv.y = sy[0]; wv.z = w2.x; wv.w = w2.y; slot = (base + ks + 2) * 64 + hk * 32 + tk; }
                            else { wv.x = w1.x; wv.y = w1.y; wv.z = sx[1]; wv.w = sy[1]; slot = (base + ks) * 64 + hk * 32 + tk; }
                            *(u32x4*)(KF + slot * 8) = wv;
                        } else {
                            const int s = tk >> 4, u = tk & 15, hv = (u >> 2) & 1, jv = (u >> 3) * 4 + (u & 3);
                            const long base = (((long)(bb * 8 + (g64 - 16)) * 256 + tile) * 2) * 2 + s;
                            bf16_t* v0 = VT + ((base) * 64 + hv * 32 + d0) * 8 + jv;
                            bf16_t* v1 = VT + ((base + 2) * 64 + hv * 32 + d0) * 8 + jv;
#pragma unroll
                            for (int j = 0; j < 4; ++j) { v0[j * 8] = (bf16_t)f2bf(o1[j]); v1[j * 8] = (bf16_t)f2bf(o2[j]); }
                        }
                    } else if (gbase < 4160) {
                        bf16_t* hp = H + row * HP + gbase + d0;
                        u32x2 w1, w2; w1.x = pk2(o1[0], o1[1]); w1.y = pk2(o1[2], o1[3]); w2.x = pk2(o2[0], o2[1]); w2.y = pk2(o2[2], o2[3]);
                        const auto sx = __builtin_amdgcn_permlane16_swap(w1.x, w2.x, false, false), sy = __builtin_amdgcn_permlane16_swap(w1.y, w2.y, false, false);
                        u32x4 wv;
                        if (fq & 1) { wv.x = sx[0]; wv.y = sy[0]; wv.z = w2.x; wv.w = w2.y; hp += 32 - 4; }
                        else { wv.x = w1.x; wv.y = w1.y; wv.z = sx[1]; wv.w = sy[1]; }
                        *(u32x4*)hp = wv;
                    } else if (d0 < 8) { *(f32x4*)(side + row * 24 + d0) = o1 * WI_SCALE; }
                    else if (d0 < 24) { *(f32x4*)(side + row * 24 + d0) = o1; }
                }
            if (g64 >= 8 && g64 < 16) {
#pragma unroll
                for (int o = 32; o >= 1; o >>= 1) kabs = fmaxf(kabs, sxor_f(kabs, fq * 16 + fr, o));
                if ((threadIdx.x & 63) == 0) atomicMax(kmax + (brow >> 13) * 8 + (g64 - 8), __float_as_uint(kabs));
            }
        }
    }
};
struct EpiOut {
    const float* xres; float* out; bool dry;
    __device__ __forceinline__ void operator()(f32x4 (&acc)[2][2][4][2], int brow, int bcol, int wr, int wc, int fr, int fq) const {
#pragma unroll
        for (int ai = 0; ai < 2; ++ai)
#pragma unroll
            for (int m = 0; m < 4; ++m)
#pragma unroll
                for (int bj = 0; bj < 2; ++bj)
#pragma unroll
                    for (int n = 0; n < 2; ++n) {
                        const long idx = (long)(brow + ai * HALF + wr * 64 + m * 16 + fr) * DM + (bcol + bj * HALF + wc * 32 + n * 16 + 4 * fq);
                        const f32x4 xr = *(const f32x4*)(xres + idx);
                        if (!dry) *(f32x4*)(out + idx) = xr * ALPHA + acc[ai][bj][m][n];
                    }
    }
};

__device__ __forceinline__ void ln_phase(const Params& p, int layer, int wave_g, int nwaves, int lane, bool dry) {
    bf16_t* xb = (bf16_t*)(p.ws + WS_XB);
    const float* g = p.ln_g + layer * DM; const float* bb = p.ln_b + layer * DM;
    for (int row = wave_g; row < NTOK; row += nwaves) {
        float* zr = p.out + (long)row * DM;
        f32x4 v[4]; float s = 0.f;
#pragma unroll
        for (int r = 0; r < 4; ++r) { v[r] = *(const f32x4*)(zr + r * 256 + lane * 4); s += v[r][0] + v[r][1] + v[r][2] + v[r][3]; }
        const float mu = wave_sum(s, lane) * (1.f / DM);
        float q = 0.f;
#pragma unroll
        for (int r = 0; r < 4; ++r)
#pragma unroll
            for (int e = 0; e < 4; ++e) { const float d = v[r][e] - mu; q += d * d; }
        const float rstd = rsqrtf(wave_sum(q, lane) * (1.f / DM) + EPS);
#pragma unroll
        for (int r = 0; r < 4; ++r) {
            const f32x4 gg = *(const f32x4*)(g + r * 256 + lane * 4), bv = *(const f32x4*)(bb + r * 256 + lane * 4);
            f32x4 y;
#pragma unroll
            for (int e = 0; e < 4; ++e) y[e] = (v[r][e] - mu) * rstd * gg[e] + bv[e];
            if (dry) continue;
            *(f32x4*)(zr + r * 256 + lane * 4) = y;
            u32x2 w; w.x = pk2(y[0], y[1]); w.y = pk2(y[2], y[3]);
            *(u32x2*)(xb + (long)row * DM + r * 256 + lane * 4) = w;
        }
    }
}

__device__ __forceinline__ void conformer_tile(const Params& p, int layer, unsigned char* lds, int tile, bool dry, int wid_s) {
    bf16_t* H = (bf16_t*)(p.ws + WS_H);
    const int tid = otid(wid_s), lane = tid & 63, w = tid >> 6;
    const int tok0 = tile * 64, b = tok0 / T, tl0 = tok0 % T;
    bf16_t* hg = (bf16_t*)lds;
    float* cv = (float*)(lds + 49152);
    for (int idx = tid; idx < 94 * 32; idx += 512) {
        const int r = idx >> 5, cc = (idx & 31) * 8, tl = tl0 - 30 + r;
        u32x4 o = {0u, 0u, 0u, 0u};
        if (tl >= 0) {
            const bf16_t* src = H + ((long)b * T + tl) * HP + HGLU + cc;
            const u32x4 va = *(const u32x4*)src, ga = *(const u32x4*)(src + 256);
            o.x = pk2(bflo(va.x) * sigmoid_f(bflo(ga.x)), bfhi(va.x) * sigmoid_f(bfhi(ga.x)));
            o.y = pk2(bflo(va.y) * sigmoid_f(bflo(ga.y)), bfhi(va.y) * sigmoid_f(bfhi(ga.y)));
            o.z = pk2(bflo(va.z) * sigmoid_f(bflo(ga.z)), bfhi(va.z) * sigmoid_f(bfhi(ga.z)));
            o.w = pk2(bflo(va.w) * sigmoid_f(bflo(ga.w)), bfhi(va.w) * sigmoid_f(bfhi(ga.w)));
        }
        *(u32x4*)(hg + r * 256 + cc) = o;
    }
    __syncthreads();
    {
        const int c = tid & 255, half = tid >> 8;
        const float* cw = p.conv_w + (long)layer * 31 * 256 + c;
        float wj[31];
#pragma unroll
        for (int j = 0; j < 31; ++j) wj[j] = cw[j * 256];
        const float cb = p.conv_b[layer * 256 + c];
        float win[62];
#pragma unroll
        for (int r = 0; r < 62; ++r) win[r] = bf2f(hg[(half * 32 + r) * 256 + c]);
#pragma unroll
        for (int tt = 0; tt < 32; ++tt) {
            float a = cb;
#pragma unroll
            for (int j = 0; j < 31; ++j) a = fmaf(win[tt + j], wj[j], a);
            cv[(half * 32 + tt) * 256 + c] = a;
        }
    }
    __syncthreads();
    bf16_t* at = (bf16_t*)lds;
    {
        const f32x4 gg = *(const f32x4*)(p.cln_g + layer * 256 + lane * 4), bv = *(const f32x4*)(p.cln_b + layer * 256 + lane * 4);
#pragma unroll
        for (int tt = 0; tt < 8; ++tt) {
            const int t = w * 8 + tt;
            const f32x4 v = *(const f32x4*)(cv + t * 256 + lane * 4);
            const float mu = wave_sum(v[0] + v[1] + v[2] + v[3], lane) * (1.f / 256.f);
            float q = 0.f;
#pragma unroll
            for (int e = 0; e < 4; ++e) { const float d = v[e] - mu; q += d * d; }
            const float rstd = rsqrtf(wave_sum(q, lane) * (1.f / 256.f) + EPS);
            float y[4];
#pragma unroll
            for (int e = 0; e < 4; ++e) y[e] = silu_f((v[e] - mu) * rstd * gg[e] + bv[e]);
            u32x2 o; o.x = pk2(y[0], y[1]); o.y = pk2(y[2], y[3]);
            *(u32x2*)(at + t * 264 + lane * 4) = o;
        }
    }
    __syncthreads();
    {
        f32x16 acc0 = {}, acc1 = {};
        const bf16_t* pwt = (const bf16_t*)(p.ws + WS_PWT) + (long)layer * 65536 + (w * 32 + (lane & 31)) * 256 + 8 * (lane >> 5);
        const bf16_t* ap = at + (lane & 31) * 264 + 8 * (lane >> 5);
#pragma unroll 4
        for (int ks = 0; ks < 16; ++ks) {
            const bf16x8 bfr = *(const bf16x8*)(pwt + ks * 16);
            const bf16x8 a0 = *(const bf16x8*)(ap + ks * 16), a1 = *(const bf16x8*)(ap + 32 * 264 + ks * 16);
            acc0 = __builtin_amdgcn_mfma_f32_32x32x16_bf16(a0, bfr, acc0, 0, 0, 0);
            acc1 = __builtin_amdgcn_mfma_f32_32x32x16_bf16(a1, bfr, acc1, 0, 0, 0);
        }
        const int ch = w * 32 + (lane & 31);
        const float pb = p.pw_b[layer * 256 + ch];
#pragma unroll
        for (int i = 0; i < 16; ++i) {
            const int row = (i & 3) + 8 * (i >> 2) + 4 * (lane >> 5);
            bf16_t* g0 = H + (long)(tok0 + row) * HP + HBG + ch;
            bf16_t* g1 = H + (long)(tok0 + 32 + row) * HP + HBG + ch;
            const unsigned r0 = f2bf((acc0[i] + pb) * silu_f(bf2f(*g0))), r1 = f2bf((acc1[i] + pb) * silu_f(bf2f(*g1)));
            if (!dry) { *g0 = (bf16_t)r0; *g1 = (bf16_t)r1; }
        }
    }
    __syncthreads();
}

__device__ __forceinline__ float rdlane(float v, int l) { return __uint_as_float(__builtin_amdgcn_readlane(__float_as_uint(v), l)); }

__device__ __forceinline__ void gla_local_item(const Params& p, int layer, int item_, int lane, bool dry) {
    const int item = __builtin_amdgcn_readfirstlane(item_);
    bf16_t* H = (bf16_t*)(p.ws + WS_H);
    const float* side = (const float*)(p.ws + WS_SIDE);
    float* bcum = (float*)(p.ws + WS_BCUM); float* U = (float*)(p.ws + WS_U); float* DEC = (float*)(p.ws + WS_DEC);
    const int bh = item >> 7, c = item & 127, b = bh >> 2, h = bh & 3;
    const long tok0 = (long)b * T + c * 64, tok = tok0 + lane;
    float clr[16];
#pragma unroll
    for (int r = 0; r < 4; ++r) { const f32x4 v = *(const f32x4*)(side + tok * 24 + 8 + r * 4); clr[r * 4] = v[0]; clr[r * 4 + 1] = v[1]; clr[r * 4 + 2] = v[2]; clr[r * 4 + 3] = v[3]; }
    const float* gw = p.gate_w2 + (long)layer * 16 * 128 + h * 32; const float* gb = p.gate_b + layer * 128 + h * 32;
    float* bcp = bcum + tok * 128 + h * 32;
#pragma unroll 1
    for (int d = 0; d < 32; ++d) {
        float z = gb[d];
#pragma unroll
        for (int r = 0; r < 16; ++r) z = fmaf(clr[r], gw[r * 128 + d], z);
        float g = (fminf(z, 0.f) - __logf(1.f + __expf(-fabsf(z)))) * (1.f / 16.f);
#pragma unroll
        for (int o = 1; o < 64; o <<= 1) { const float up = __int_as_float(bperm_i((lane - o) & 63, __float_as_int(g))); if (lane >= o) g += up; }
        bcp[d] = g;
    }
    float bc[32];
#pragma unroll
    for (int r = 0; r < 8; ++r) { const f32x4 v = *(const f32x4*)(bcp + r * 4); bc[r * 4] = v[0]; bc[r * 4 + 1] = v[1]; bc[r * 4 + 2] = v[2]; bc[r * 4 + 3] = v[3]; }
    float kk[32];
    {
        const bf16_t* kp = H + tok * HP + HCK + h * 32;
#pragma unroll
        for (int r = 0; r < 4; ++r) {
            const u32x4 kv = *(const u32x4*)(kp + r * 8);
            kk[r * 8 + 0] = bflo(kv.x); kk[r * 8 + 1] = bfhi(kv.x); kk[r * 8 + 2] = bflo(kv.y); kk[r * 8 + 3] = bfhi(kv.y);
            kk[r * 8 + 4] = bflo(kv.z); kk[r * 8 + 5] = bfhi(kv.z); kk[r * 8 + 6] = bflo(kv.w); kk[r * 8 + 7] = bfhi(kv.w);
        }
#pragma unroll
        for (int d = 0; d < 32; ++d) { const float bl = rdlane(bc[d], 63); kk[d] *= __expf(bl - bc[d]); }
    }
    float acc[32];
#pragma unroll
    for (int d = 0; d < 32; ++d) acc[d] = 0.f;
    const bf16_t* vp = H + tok0 * HP + HCV + h * 64 + lane;
#pragma unroll 1
    for (int t8 = 0; t8 < 64; t8 += 8) {
        float vv[8];
#pragma unroll
        for (int u = 0; u < 8; ++u) vv[u] = bf2f(vp[(long)(t8 + u) * HP]);
#pragma unroll
        for (int u = 0; u < 8; ++u)
#pragma unroll
            for (int d = 0; d < 32; ++d) acc[d] = fmaf(rdlane(kk[d], t8 + u), vv[u], acc[d]);
    }
#pragma unroll
    for (int d = 0; d < 32; ++d) if (!dry) U[(long)item * 2048 + d * 64 + lane] = acc[d];
    if (lane == 63) {
#pragma unroll
        for (int r = 0; r < 8; ++r) { f32x4 v = {__expf(bc[r * 4]), __expf(bc[r * 4 + 1]), __expf(bc[r * 4 + 2]), __expf(bc[r * 4 + 3])}; *(f32x4*)(DEC + item * 32 + r * 4) = v; }
    }
}

__device__ __forceinline__ void gla_scan(const Params& p, int gt) {
    float* U = (float*)(p.ws + WS_U); const float* DEC = (const float*)(p.ws + WS_DEC);
    const int bh = gt >> 11, de = gt & 2047, d = de >> 6;
    float s = 0.f;
    for (int c0 = 0; c0 < 128; c0 += 32) {
        float u[32], dc[32];
#pragma unroll
        for (int i = 0; i < 32; ++i) { u[i] = U[(long)(bh * 128 + c0 + i) * 2048 + de]; dc[i] = DEC[(bh * 128 + c0 + i) * 32 + d]; }
#pragma unroll
        for (int i = 0; i < 32; ++i) { U[(long)(bh * 128 + c0 + i) * 2048 + de] = s; s = fmaf(dc[i], s, u[i]); }
    }
}

__device__ __forceinline__ void gla_out_item(const Params& p, int layer, unsigned char* ldsw, int item_, int lane, bool dry) {
    const int item = __builtin_amdgcn_readfirstlane(item_);
    bf16_t* H = (bf16_t*)(p.ws + WS_H);
    const float* bcum = (const float*)(p.ws + WS_BCUM); const float* U = (const float*)(p.ws + WS_U);
    float* sA = (float*)ldsw; bf16_t* sV = (bf16_t*)(ldsw + 8192);
    const int bh = item >> 7, c = item & 127, b = bh >> 2, h = bh & 3;
    const long tok = (long)b * T + c * 64 + lane;
#pragma unroll
    for (int r = 0; r < 8; ++r) *(f32x4*)(sA + r * 256 + lane * 4) = *(const f32x4*)(U + (long)item * 2048 + r * 256 + lane * 4);
#pragma unroll
    for (int r = 0; r < 8; ++r) *(u32x4*)(sV + lane * 64 + r * 8) = *(const u32x4*)(H + tok * HP + HCV + h * 64 + r * 8);
    WAVE_SYNC();
    float o[64];
#pragma unroll
    for (int e = 0; e < 64; ++e) o[e] = 0.f;
    {
        const bf16_t* qp = H + tok * HP + HCQ + h * 32; const float* bp = bcum + tok * 128 + h * 32;
#pragma unroll 1
        for (int d = 0; d < 32; ++d) {
            const float qd = bf2f(qp[d]) * 0.17677669529663687f * __expf(bp[d]);
#pragma unroll
            for (int e4 = 0; e4 < 16; ++e4) {
                const f32x4 s4 = *(const f32x4*)(sA + d * 64 + e4 * 4);
                o[e4 * 4] = fmaf(qd, s4[0], o[e4 * 4]); o[e4 * 4 + 1] = fmaf(qd, s4[1], o[e4 * 4 + 1]);
                o[e4 * 4 + 2] = fmaf(qd, s4[2], o[e4 * 4 + 2]); o[e4 * 4 + 3] = fmaf(qd, s4[3], o[e4 * 4 + 3]);
            }
        }
    }
    WAVE_SYNC();
    {
        const bf16_t* kp = H + tok * HP + HCK + h * 32;
#pragma unroll
        for (int r = 0; r < 4; ++r) {
            const u32x4 kv = *(const u32x4*)(kp + r * 8);
            const f32x4 b0 = *(const f32x4*)(bcum + tok * 128 + h * 32 + r * 8), b1 = *(const f32x4*)(bcum + tok * 128 + h * 32 + r * 8 + 4);
            f32x4 k0 = {bflo(kv.x) * __expf(-b0[0]), bfhi(kv.x) * __expf(-b0[1]), bflo(kv.y) * __expf(-b0[2]), bfhi(kv.y) * __expf(-b0[3])};
            f32x4 k1 = {bflo(kv.z) * __expf(-b1[0]), bfhi(kv.z) * __expf(-b1[1]), bflo(kv.w) * __expf(-b1[2]), bfhi(kv.w) * __expf(-b1[3])};
            *(f32x4*)(sA + lane * 32 + r * 8) = k0; *(f32x4*)(sA + lane * 32 + r * 8 + 4) = k1;
        }
    }
    float qe[32];
    {
        const bf16_t* qp = H + tok * HP + HCQ + h * 32;
#pragma unroll
        for (int r = 0; r < 4; ++r) {
            const u32x4 qv = *(const u32x4*)(qp + r * 8);
            const f32x4 b0 = *(const f32x4*)(bcum + tok * 128 + h * 32 + r * 8), b1 = *(const f32x4*)(bcum + tok * 128 + h * 32 + r * 8 + 4);
            const float qq[8] = {bflo(qv.x), bfhi(qv.x), bflo(qv.y), bfhi(qv.y), bflo(qv.z), bfhi(qv.z), bflo(qv.w), bfhi(qv.w)};
            const float bb[8] = {b0[0], b0[1], b0[2], b0[3], b1[0], b1[1], b1[2], b1[3]};
#pragma unroll
            for (int e = 0; e < 8; ++e) qe[r * 8 + e] = qq[e] * 0.17677669529663687f * __expf(bb[e]);
        }
    }
    WAVE_SYNC();
#pragma unroll 1
    for (int j = 0; j < 64; ++j) {
        float a = 0.f;
#pragma unroll
        for (int d4 = 0; d4 < 8; ++d4) {
            const f32x4 k4 = *(const f32x4*)(sA + j * 32 + d4 * 4);
            a = fmaf(qe[d4 * 4], k4[0], a); a = fmaf(qe[d4 * 4 + 1], k4[1], a); a = fmaf(qe[d4 * 4 + 2], k4[2], a); a = fmaf(qe[d4 * 4 + 3], k4[3], a);
        }
        if (j > lane) a = 0.f;
#pragma unroll
        for (int e8 = 0; e8 < 8; ++e8) {
            const u32x4 v8 = *(const u32x4*)(sV + j * 64 + e8 * 8);
            o[e8 * 8 + 0] = fmaf(a, bflo(v8.x), o[e8 * 8 + 0]); o[e8 * 8 + 1] = fmaf(a, bfhi(v8.x), o[e8 * 8 + 1]);
            o[e8 * 8 + 2] = fmaf(a, bflo(v8.y), o[e8 * 8 + 2]); o[e8 * 8 + 3] = fmaf(a, bfhi(v8.y), o[e8 * 8 + 3]);
            o[e8 * 8 + 4] = fmaf(a, bflo(v8.z), o[e8 * 8 + 4]); o[e8 * 8 + 5] = fmaf(a, bfhi(v8.z), o[e8 * 8 + 5]);
            o[e8 * 8 + 6] = fmaf(a, bflo(v8.w), o[e8 * 8 + 6]); o[e8 * 8 + 7] = fmaf(a, bfhi(v8.w), o[e8 * 8 + 7]);
        }
    }
    float ss = 0.f;
#pragma unroll
    for (int e = 0; e < 64; ++e) ss = fmaf(o[e], o[e], ss);
    const float rms = rsqrtf(ss * (1.f / 64.f) + EPS);
    const float* gn = p.gnorm_g + layer * 256 + h * 64;
    bf16_t* cg_p = H + tok * HP + HCG + h * 64;
#pragma unroll
    for (int r = 0; r < 8; ++r) {
        const u32x4 gv = *(const u32x4*)(cg_p + r * 8);
        const float gq[8] = {bflo(gv.x), bfhi(gv.x), bflo(gv.y), bfhi(gv.y), bflo(gv.z), bfhi(gv.z), bflo(gv.w), bfhi(gv.w)};
        float y[8];
#pragma unroll
        for (int e = 0; e < 8; ++e) y[e] = o[r * 8 + e] * rms * gn[r * 8 + e] * silu_f(gq[e]);
        u32x4 w; w.x = pk2(y[0], y[1]); w.y = pk2(y[2], y[3]); w.z = pk2(y[4], y[5]); w.w = pk2(y[6], y[7]);
        if (!dry) *(u32x4*)(cg_p + r * 8) = w;
    }
    WAVE_SYNC();
}

constexpr int MPITCH = 260;
constexpr int HPITCH = 516;
constexpr int L_HIST = 0;
constexpr int L_CAND = 66560;
constexpr int L_CCNT = L_CAND + 65536;
constexpr int L_QINF = L_CCNT + 2048;
constexpr int L_MTAB = L_QINF + 1024 + 64;
static_assert(L_MTAB + 8192 <= LDS_BYTES, "dsa lds");
__device__ __forceinline__ int mpos(int rr) { return 16 * ((rr >> 2) & 1) + (rr & 3) + 4 * (rr >> 3); }
constexpr int SUBCAP = 32;

__device__ __forceinline__ unsigned mono_bits(float f) { const unsigned u = __float_as_uint(f); return u ^ ((u >> 31) ? 0xffffffffu : 0x80000000u); }
__device__ __forceinline__ void idx_loadk(const bf16_t* Hb, int s0, int lane, bf16x8 (&kf)[2][2]) {
    const bf16_t* kp = Hb + (long)(s0 + (lane & 15)) * HP + HKI + 8 * (lane >> 4);
#pragma unroll
    for (int kb = 0; kb < 2; ++kb)
#pragma unroll
        for (int ks = 0; ks < 2; ++ks) kf[kb][ks] = *(const bf16x8*)(kp + (long)kb * 16 * HP + ks * 32);
}
__device__ __forceinline__ void idx_scores(const bf16x8 (&kf)[2][2], const bf16x8 (&qf)[8][2], const bf16x8 (&ql)[2][2], const float (&wh)[8], float (&score)[8]) {
    f32x4 lin[2];
#pragma unroll
    for (int kb = 0; kb < 2; ++kb) {
        lin[kb] = (f32x4){0.f, 0.f, 0.f, 0.f};
#pragma unroll
        for (int ks = 0; ks < 2; ++ks) {
            lin[kb] = __builtin_amdgcn_mfma_f32_16x16x32_bf16(kf[kb][ks], ql[0][ks], lin[kb], 0, 0, 0);
            lin[kb] = __builtin_amdgcn_mfma_f32_16x16x32_bf16(kf[kb][ks], ql[1][ks], lin[kb], 0, 0, 0);
        }
    }
#pragma unroll
    for (int i = 0; i < 8; ++i) score[i] = lin[i >> 2][i & 3];
#pragma unroll
    for (int hd = 0; hd < 8; ++hd) {
        f32x4 acc[2];
#pragma unroll
        for (int kb = 0; kb < 2; ++kb) {
            acc[kb] = (f32x4){0.f, 0.f, 0.f, 0.f};
#pragma unroll
            for (int ks = 0; ks < 2; ++ks) acc[kb] = __builtin_amdgcn_mfma_f32_16x16x32_bf16(kf[kb][ks], qf[hd][ks], acc[kb], 0, 0, 0);
        }
#pragma unroll
        for (int kb = 0; kb < 2; ++kb)
#pragma unroll
            for (int i = 0; i < 4; ++i) score[kb * 4 + i] = fmaf(fabsf(acc[kb][i]), wh[hd], score[kb * 4 + i]);
        if ((hd & 3) == 3) __builtin_amdgcn_sched_barrier(0);
    }
}

template <bool FAST>
__device__ __forceinline__ void attn_tile(const bf16x8 (&kf)[4], const bf16x8 (&vf)[4], const bf16x8 (&qfr)[2][4], f32x16 (&O)[2][2], float (&mrun)[2], float (&lrun)[2],
                                          const unsigned* hist, const float* mtab, int r32, int hh, int tile) {
#pragma unroll
    for (int qb = 0; qb < 2; ++qb) {
        f32x16 S;
        const unsigned mw = hist[(qb * 32 + r32) * MPITCH + tile] >> (16 * hh);
#pragma unroll
        for (int g8 = 0; g8 < 2; ++g8) {
            const float* mt = mtab + ((mw >> (8 * g8)) & 255u) * 8;
            const f32x4 ma = *(const f32x4*)mt, mb = *(const f32x4*)(mt + 4);
            S[8 * g8] = ma[0]; S[8 * g8 + 1] = ma[1]; S[8 * g8 + 2] = ma[2]; S[8 * g8 + 3] = ma[3];
            S[8 * g8 + 4] = mb[0]; S[8 * g8 + 5] = mb[1]; S[8 * g8 + 6] = mb[2]; S[8 * g8 + 7] = mb[3];
        }
#pragma unroll
        for (int ks = 0; ks < 4; ++ks) S = __builtin_amdgcn_mfma_f32_32x32x16_bf16(kf[ks], qfr[qb][ks], S, 0, 0, 0);
        float pr[16]; float ps = 0.f;
        if (FAST) {
#pragma unroll
            for (int i = 0; i < 16; ++i) { pr[i] = __builtin_amdgcn_exp2f(S[i]); ps += pr[i]; }
        } else {
            float mx = fmaxf(fmaxf(S[0], S[1]), S[2]);
#pragma unroll
            for (int i = 3; i < 15; i += 2) mx = fmaxf(fmaxf(mx, S[i]), S[i + 1]);
            mx = fmaxf(mx, S[15]);
            { const auto sw = __builtin_amdgcn_permlane32_swap(__float_as_uint(mx), __float_as_uint(mx), false, false); mx = fmaxf(__uint_as_float(sw[0]), __uint_as_float(sw[1])); }
            if (__any(mx > mrun[qb])) {
                const float mnew = fmaxf(mx, mrun[qb]);
                const float alpha = __builtin_amdgcn_exp2f(mrun[qb] - mnew);
                mrun[qb] = mnew; lrun[qb] *= alpha;
#pragma unroll
                for (int db = 0; db < 2; ++db)
#pragma unroll
                    for (int i = 0; i < 16; ++i) O[db][qb][i] *= alpha;
            }
            const float mref = fmaxf(mrun[qb], -1000.f);
#pragma unroll
            for (int i = 0; i < 16; ++i) { pr[i] = __builtin_amdgcn_exp2f(S[i] - mref); ps += pr[i]; }
        }
        lrun[qb] += ps;
        bf16x8 pf[2];
#pragma unroll
        for (int s = 0; s < 2; ++s) {
            u32x4 pw; pw.x = pk2(pr[8 * s], pr[8 * s + 1]); pw.y = pk2(pr[8 * s + 2], pr[8 * s + 3]); pw.z = pk2(pr[8 * s + 4], pr[8 * s + 5]); pw.w = pk2(pr[8 * s + 6], pr[8 * s + 7]);
            pf[s] = __builtin_bit_cast(bf16x8, pw);
        }
#pragma unroll
        for (int db = 0; db < 2; ++db)
#pragma unroll
            for (int s = 0; s < 2; ++s) O[db][qb] = __builtin_amdgcn_mfma_f32_32x32x16_bf16(vf[db * 2 + s], pf[s], O[db][qb], 0, 0, 0);
    }
}
template <bool FAST>
__device__ __forceinline__ void attn_loop(const bf16_t* Kp, const bf16_t* Vp, const bf16x8 (&qfr)[2][4], f32x16 (&O)[2][2], float (&mrun)[2], float (&lrun)[2],
                                          const unsigned* hist, const float* mtab, int r32, int hh, int nt32, bool dry2) {
    bf16x8 kf[4], vf[4], kg[4], vg[4];
#pragma unroll
    for (int ks = 0; ks < 4; ++ks) { kf[ks] = *(const bf16x8*)(Kp + ks * 512); vf[ks] = *(const bf16x8*)(Vp + ks * 512); }
#pragma unroll 1
    for (int tile = 0; tile < nt32; tile += 2) {
        {
            const int tn = dry2 ? 0 : tile + 1;
#pragma unroll
            for (int ks = 0; ks < 4; ++ks) { kg[ks] = *(const bf16x8*)(Kp + (long)tn * 2048 + ks * 512); vg[ks] = *(const bf16x8*)(Vp + (long)tn * 2048 + ks * 512); }
        }
        attn_tile<FAST>(kf, vf, qfr, O, mrun, lrun, hist, mtab, r32, hh, tile);
        {
            const int tn = dry2 ? 0 : ((tile + 2 < nt32) ? tile + 2 : tile);
#pragma unroll
            for (int ks = 0; ks < 4; ++ks) { kf[ks] = *(const bf16x8*)(Kp + (long)tn * 2048 + ks * 512); vf[ks] = *(const bf16x8*)(Vp + (long)tn * 2048 + ks * 512); }
        }
        attn_tile<FAST>(kg, vg, qfr, O, mrun, lrun, hist, mtab, r32, hh, tile + 1);
    }
}

__device__ __forceinline__ void dsa_item(const Params& p, unsigned char* lds, int b, int qblk, bool dry, int wid_s) {
    bf16_t* H = (bf16_t*)(p.ws + WS_H);
    const float* side = (const float*)(p.ws + WS_SIDE);
    const bf16_t* Hb = H + (long)b * T * HP;
    const int tid = otid(wid_s), lane = tid & 63, w = tid >> 6, hq = lane >> 4;
    const int qg = w & 3, kh = w >> 2;
    const int t0 = qblk * 64, qloc = qg * 16 + (lane & 15), t = t0 + qloc;
    unsigned* hist = (unsigned*)(lds + L_HIST);
    unsigned* cand = (unsigned*)(lds + L_CAND);
    unsigned* ccnt = (unsigned*)(lds + L_CCNT);
    int* qinf = (int*)(lds + L_QINF);

    for (int i = tid; i < 64 * MPITCH; i += 512) hist[i] = 0u;
    for (int i = tid; i < 2048; i += 512) ((float*)(lds + L_MTAB))[i] = ((i >> 3) >> (i & 7)) & 1 ? 0.f : -1e30f;
    bf16x8 qf[8][2]; bf16x8 ql[2][2]; float wi[8]; float inv, fb0c;
    {
        const bf16_t* qp = Hb + (long)t * HP + HQI + 8 * hq;
#pragma unroll
        for (int hd = 0; hd < 8; ++hd)
#pragma unroll
            for (int ks = 0; ks < 2; ++ks) qf[hd][ks] = *(const bf16x8*)(qp + hd * 64 + ks * 32);
        const float* sp = side + ((long)b * T + t) * 24;
        const f32x4 w0 = *(const f32x4*)sp, w1 = *(const f32x4*)(sp + 4);
        wi[0] = w0[0]; wi[1] = w0[1]; wi[2] = w0[2]; wi[3] = w0[3]; wi[4] = w1[0]; wi[5] = w1[1]; wi[6] = w1[2]; wi[7] = w1[3];
        float n2 = 0.f;
#pragma unroll
        for (int i = 0; i < 8; ++i) n2 = fmaf(wi[i], wi[i], n2);
        const float nrm = fmaxf(SIG_UNIT * sqrtf(n2), 1e-30f);
        inv = 64.f / nrm;
        fb0c = 256.f - 64.f * 3.19f * (wi[0] + wi[1] + wi[2] + wi[3] + wi[4] + wi[5] + wi[6] + wi[7]) / nrm;
#pragma unroll
        for (int i = 0; i < 8; ++i) wi[i] *= 0.5f;
#pragma unroll
        for (int ks = 0; ks < 2; ++ks) {
            float ql_f[8];
#pragma unroll
            for (int j = 0; j < 8; ++j) ql_f[j] = 0.f;
#pragma unroll
            for (int hd = 0; hd < 8; ++hd) {
                const u32x4 qv = __builtin_bit_cast(u32x4, qf[hd][ks]);
                ql_f[0] = fmaf(wi[hd], bflo(qv.x), ql_f[0]); ql_f[1] = fmaf(wi[hd], bfhi(qv.x), ql_f[1]); ql_f[2] = fmaf(wi[hd], bflo(qv.y), ql_f[2]); ql_f[3] = fmaf(wi[hd], bfhi(qv.y), ql_f[3]);
                ql_f[4] = fmaf(wi[hd], bflo(qv.z), ql_f[4]); ql_f[5] = fmaf(wi[hd], bfhi(qv.z), ql_f[5]); ql_f[6] = fmaf(wi[hd], bflo(qv.w), ql_f[6]); ql_f[7] = fmaf(wi[hd], bfhi(qv.w), ql_f[7]);
            }
            u32x4 hi4; hi4.x = pk2(ql_f[0], ql_f[1]); hi4.y = pk2(ql_f[2], ql_f[3]); hi4.z = pk2(ql_f[4], ql_f[5]); hi4.w = pk2(ql_f[6], ql_f[7]);
            u32x4 lo4;
            lo4.x = pk2(ql_f[0] - bflo(hi4.x), ql_f[1] - bfhi(hi4.x)); lo4.y = pk2(ql_f[2] - bflo(hi4.y), ql_f[3] - bfhi(hi4.y));
            lo4.z = pk2(ql_f[4] - bflo(hi4.z), ql_f[5] - bfhi(hi4.z)); lo4.w = pk2(ql_f[6] - bflo(hi4.w), ql_f[7] - bfhi(hi4.w));
            ql[0][ks] = __builtin_bit_cast(bf16x8, hi4); ql[1][ks] = __builtin_bit_cast(bf16x8, lo4);
        }
    }
    const int ntile = (t0 + 64 + 127) >> 7;
    const int tmaxw = t0 + qg * 16 + 15;
    __syncthreads();
    int nit = 0;
    { const int v = tmaxw - kh * 64; if (v >= 0) nit = 2 * (v >> 7) + (((v & 127) >= 32) ? 2 : 1); }
    float fa = inv, fbias = fb0c;
    bool active = true;
#pragma unroll 1
    for (int level = 0; level < 2; ++level) {
        unsigned* hbase = level ? cand : hist;
        const bool wave_on = __any(active);
        if (wave_on) {
            const unsigned incv = 1u << ((qloc & 1) * 16);
            unsigned* hrow = hbase + (qloc >> 1) * HPITCH;
            bf16x8 kf[2][2];
            idx_loadk(Hb, kh * 64, lane, kf);
#pragma unroll 1
            for (int it = 0; it < nit; ++it) {
                const int s0 = (it >> 1) * 128 + kh * 64 + (it & 1) * 32;
                const int itn = (it + 1 < nit) ? it + 1 : it;
                bf16x8 kn[2][2];
                idx_loadk(Hb, (itn >> 1) * 128 + kh * 64 + (itn & 1) * 32, lane, kn);
                float score[8];
                idx_scores(kf, qf, ql, wi, score);
                if (s0 + 31 <= t0 + qg * 16) {
#pragma unroll
                    for (int i = 0; i < 8; ++i) { const unsigned bin = (unsigned)__builtin_amdgcn_fmed3f(fmaf(score[i], fa, fbias), 0.f, 511.5f); atomicAdd(hrow + bin, incv); }
                } else {
#pragma unroll
                    for (int i = 0; i < 8; ++i) {
                        const int s = s0 + (i >> 2) * 16 + hq * 4 + (i & 3);
                        if (s <= t) { const unsigned bin = (unsigned)__builtin_amdgcn_fmed3f(fmaf(score[i], fa, fbias), 0.f, 511.5f); atomicAdd(hrow + bin, incv); }
                    }
                }
#pragma unroll
                for (int kb = 0; kb < 2; ++kb)
#pragma unroll
                    for (int ks = 0; ks < 2; ++ks) kf[kb][ks] = kn[kb][ks];
            }
        }
        __syncthreads();
#pragma unroll 1
        for (int qq = 0; qq < 8; ++qq) {
            const int q = w * 8 + qq;
            if (level && !qinf[q * 4 + 3]) continue;
            const u32x4 wa = *(const u32x4*)(hbase + (q >> 1) * HPITCH + 8 * lane), wb = *(const u32x4*)(hbase + (q >> 1) * HPITCH + 8 * lane + 4);
            const int sh = (q & 1) * 16;
            const unsigned c[8] = {(wa.x >> sh) & 0xffffu, (wa.y >> sh) & 0xffffu, (wa.z >> sh) & 0xffffu, (wa.w >> sh) & 0xffffu, (wb.x >> sh) & 0xffffu, (wb.y >> sh) & 0xffffu, (wb.z >> sh) & 0xffffu, (wb.w >> sh) & 0xffffu};
            const unsigned tot = c[0] + c[1] + c[2] + c[3] + c[4] + c[5] + c[6] + c[7];
            unsigned S = tot;
#pragma unroll
            for (int o = 1; o < 64; o <<= 1) { const unsigned dn = (unsigned)bperm_i((lane + o) & 63, (int)S); if (lane + o < 64) S += dn; }
            const unsigned total = (unsigned)__builtin_amdgcn_readfirstlane((int)S);
            const u64 bal = __ballot(S >= 256u);
            int b1 = -1, r1 = 0, n1 = 0;
            if (total >= 256u) {
                const int Ls = 63 - __clzll(bal);
                unsigned cum = S - tot; bool found = false; int lb = -1, lr = 0, ln = 0;
#pragma unroll
                for (int j = 7; j >= 0; --j) { const bool hit = !found && (cum + c[j] >= 256u); if (hit) { lb = 8 * lane + j; lr = 256 - (int)cum; ln = (int)c[j]; found = true; } cum += c[j]; }
                b1 = bperm_i(Ls, lb); r1 = bperm_i(Ls, lr); n1 = bperm_i(Ls, ln);
            }
            if (lane == 0) { qinf[q * 4] = b1; qinf[q * 4 + 1] = r1; qinf[q * 4 + 2] = n1; }
        }
        __syncthreads();
        if (level == 0) { for (int i = tid; i < 64 * MPITCH; i += 512) hist[i] = 0u; }
        if (tid == 0) qinf[256] = 0;
        __syncthreads();
        if (wave_on) {
            const int b1 = qinf[qloc * 4];
            const float fsel = !active ? __builtin_inff() : ((b1 < 0) ? -__builtin_inff() : ((b1 >= 511) ? __builtin_inff() : (float)(b1 + 1)));
            const float fcand = !active ? __builtin_inff() : ((b1 <= 0) ? -__builtin_inff() : (float)b1);
            const float fb1 = (float)(b1 < 0 ? 0 : b1);
            unsigned* cslot = cand + (qloc * 8 + kh * 4 + hq) * SUBCAP; int ncand = 0;
            bf16x8 kf[2][2];
            idx_loadk(Hb, kh * 64, lane, kf);
#pragma unroll 1
            for (int it = 0; it < nit; ++it) {
                const int s0 = (it >> 1) * 128 + kh * 64 + (it & 1) * 32;
                const int itn = (it + 1 < nit) ? it + 1 : it;
                bf16x8 kn[2][2];
                idx_loadk(Hb, (itn >> 1) * 128 + kh * 64 + (itn & 1) * 32, lane, kn);
                float score[8];
                idx_scores(kf, qf, ql, wi, score);
                unsigned m0 = 0u;
                const int tlim = (s0 + 31 <= t0 + qg * 16) ? 0x7fffffff : t;
#pragma unroll
                for (int i = 0; i < 8; ++i) {
                    const int rr = (i >> 2) * 16 + hq * 4 + (i & 3), s = s0 + rr;
                    const float fb = fmaf(score[i], fa, fbias);
                    if (fb >= fcand && s <= tlim) {
                        if (fb >= fsel) m0 |= 1u << (16 * (hq & 1) + 4 * (hq >> 1) + (i & 3) + 8 * (i >> 2));
                        else {
                            const unsigned q19 = (unsigned)__builtin_amdgcn_fmed3f((fb - fb1) * 524288.f, 0.f, 524287.f);
                            if (ncand < SUBCAP) cslot[ncand] = (q19 << 13) | (unsigned)(8191 - s);
                            ++ncand;
                        }
                    }
                }
                if (m0) atomicOr(&hist[qloc * MPITCH + (s0 >> 5)], m0);
#pragma unroll
                for (int kb = 0; kb < 2; ++kb)
#pragma unroll
                    for (int ks = 0; ks < 2; ++ks) kf[kb][ks] = kn[kb][ks];
            }
            ccnt[qloc * 8 + kh * 4 + hq] = (unsigned)ncand;
        } else ccnt[qloc * 8 + kh * 4 + hq] = 0u;
        __syncthreads();
#pragma unroll 1
        for (int qq = 0; qq < 8; ++qq) {
            const int q = w * 8 + qq;
            if (level && !qinf[q * 4 + 3]) continue;
            const int r1 = qinf[q * 4 + 1];
            const int wr_ = lane >> 3, sl0 = (lane & 7) * 4;
            int cw = (int)ccnt[q * 8 + wr_];
            const bool ovf = __any(cw > SUBCAP) && (level == 0);
            if (lane == 0) { qinf[q * 4 + 3] = ovf ? 1 : 0; if (ovf) qinf[256] = 1; }
            if (ovf || r1 <= 0) continue;
            if (cw > SUBCAP) cw = SUBCAP;
            const u32x4 mine = *(const u32x4*)(cand + (q * 8 + wr_) * SUBCAP + sl0);
            int rk0 = 0, rk1 = 0, rk2 = 0, rk3 = 0;
#pragma unroll 1
            for (int ww = 0; ww < 8; ++ww) {
                int cn = (int)ccnt[q * 8 + ww]; if (cn > SUBCAP) cn = SUBCAP;
                const unsigned* cl = cand + (q * 8 + ww) * SUBCAP;
#pragma unroll 1
                for (int j = 0; j < cn; ++j) { const unsigned cv = cl[j]; rk0 += (cv > mine.x); rk1 += (cv > mine.y); rk2 += (cv > mine.z); rk3 += (cv > mine.w); }
            }
            if (sl0 + 0 < cw && rk0 < r1) { const int s = 8191 - (int)(mine.x & 8191u); atomicOr(&hist[q * MPITCH + (s >> 5)], 1u << mpos(s & 31)); }
            if (sl0 + 1 < cw && rk1 < r1) { const int s = 8191 - (int)(mine.y & 8191u); atomicOr(&hist[q * MPITCH + (s >> 5)], 1u << mpos(s & 31)); }
            if (sl0 + 2 < cw && rk2 < r1) { const int s = 8191 - (int)(mine.z & 8191u); atomicOr(&hist[q * MPITCH + (s >> 5)], 1u << mpos(s & 31)); }
            if (sl0 + 3 < cw && rk3 < r1) { const int s = 8191 - (int)(mine.w & 8191u); atomicOr(&hist[q * MPITCH + (s >> 5)], 1u << mpos(s & 31)); }
        }
        __syncthreads();
        if (level == 1 || qinf[256] == 0) break;
        {
            const bool mine_ovf = qinf[qloc * 4 + 3] != 0;
            const int b1 = qinf[qloc * 4];
            active = mine_ovf;
            fa = mine_ovf ? inv * 510.f : 0.f;
            fbias = mine_ovf ? fmaf(fb0c - (float)b1, 510.f, 1.f) : -1.f;
        }
        for (int i = tid; i < 32 * HPITCH; i += 512) cand[i] = 0u;
        __syncthreads();
    }
    for (int rep2_ = ((PROBE_PHASE == 41) ? 0 : 1); rep2_ < 2; ++rep2_) {
        const bool dry2 = dry || ((PROBE_PHASE == 41) && (rep2_ == 0) && (p.pos[0] == 0));
        const int head = w, r32 = lane & 31, hh = lane >> 5;
        bf16x8 qfr[2][4];
        float q1 = 0.f;
#pragma unroll
        for (int qb = 0; qb < 2; ++qb) {
            float qa = 0.f;
#pragma unroll
            for (int ks = 0; ks < 4; ++ks) {
                qfr[qb][ks] = *(const bf16x8*)(Hb + (long)(t0 + qb * 32 + r32) * HP + HQ + head * 64 + ks * 16 + 8 * hh);
                const u32x4 qv = __builtin_bit_cast(u32x4, qfr[qb][ks]);
                qa += fabsf(bflo(qv.x)) + fabsf(bfhi(qv.x)) + fabsf(bflo(qv.y)) + fabsf(bfhi(qv.y)) + fabsf(bflo(qv.z)) + fabsf(bfhi(qv.z)) + fabsf(bflo(qv.w)) + fabsf(bfhi(qv.w));
            }
            q1 = fmaxf(q1, qa);
        }
        q1 += sxor_f(q1, lane, 32);
#pragma unroll
        for (int o = 16; o >= 1; o >>= 1) q1 = fmaxf(q1, sxor_f(q1, lane, o));
        const float kmx = __uint_as_float(((const unsigned*)(p.ws + WS_KMAX))[b * 8 + head]);
        const bool fast = (q1 * kmx * 1.02f) < 100.f;
        f32x16 O[2][2];
#pragma unroll
        for (int a = 0; a < 2; ++a)
#pragma unroll
            for (int c2 = 0; c2 < 2; ++c2)
#pragma unroll
                for (int i = 0; i < 16; ++i) O[a][c2][i] = 0.f;
        float mrun[2] = {-1e30f, -1e30f}, lrun[2] = {0.f, 0.f};
        const bf16_t* Kp = (const bf16_t*)(p.ws + WS_KF) + ((long)(b * 8 + head) * 256 * 4 * 64 + lane) * 8;
        const bf16_t* Vp = (const bf16_t*)(p.ws + WS_VT) + ((long)(b * 8 + head) * 256 * 4 * 64 + lane) * 8;
        const int nt32 = (t0 + 64) >> 5;
        if (fast) attn_loop<true>(Kp, Vp, qfr, O, mrun, lrun, hist, (const float*)(lds + L_MTAB), r32, hh, nt32, dry2);
        else attn_loop<false>(Kp, Vp, qfr, O, mrun, lrun, hist, (const float*)(lds + L_MTAB), r32, hh, nt32, dry2);
#pragma unroll
        for (int qb = 0; qb < 2; ++qb) {
            const float lt = lrun[qb] + sxor_f(lrun[qb], lane, 32);
            const float il = 1.f / lt;
            bf16_t* gp = H + ((long)b * T + t0 + qb * 32 + r32) * HP + HAG + head * 64 + 4 * hh;
#pragma unroll
            for (int db = 0; db < 2; ++db)
#pragma unroll
                for (int g4 = 0; g4 < 4; ++g4) {
                    bf16_t* gq = gp + db * 32 + 8 * g4;
                    const u32x2 gv = *(const u32x2*)gq;
                    u32x2 wv;
                    wv.x = pk2(O[db][qb][4 * g4] * il * silu_f(bflo(gv.x)), O[db][qb][4 * g4 + 1] * il * silu_f(bfhi(gv.x)));
                    wv.y = pk2(O[db][qb][4 * g4 + 2] * il * silu_f(bflo(gv.y)), O[db][qb][4 * g4 + 3] * il * silu_f(bfhi(gv.y)));
                    if (!dry2) *(u32x2*)gq = wv;
                }
        }
    }
    __syncthreads();
}

__device__ __forceinline__ void gbar(unsigned* ctr, unsigned target) {
    __syncthreads();
    if (threadIdx.x == 0) {
        __builtin_amdgcn_fence(__ATOMIC_RELEASE, "agent");
        __hip_atomic_fetch_add(ctr, 1u, __ATOMIC_RELAXED, __HIP_MEMORY_SCOPE_AGENT);
        while (__hip_atomic_load(ctr, __ATOMIC_RELAXED, __HIP_MEMORY_SCOPE_AGENT) < target) __builtin_amdgcn_s_sleep(2);
        __builtin_amdgcn_fence(__ATOMIC_ACQUIRE, "agent");
    }
    __syncthreads();
}

__global__ void __launch_bounds__(512) fwd_megakernel(Params p0) {
    extern __shared__ __attribute__((aligned(16))) unsigned char lds[];
    cg::grid_group grid = cg::this_grid();
    const int G = gridDim.x, c = blockIdx.x;
    const int wid_s = __builtin_amdgcn_readfirstlane((int)(threadIdx.x >> 6));

    unsigned* barctr = (unsigned*)(p0.ws + WS_BAR); unsigned bar_n = 0;
    if (c == 0 && threadIdx.x == 0) __hip_atomic_store(barctr, 0u, __ATOMIC_RELAXED, __HIP_MEMORY_SCOPE_AGENT);
    for (int rep0_ = (PROBE_PHASE == 8 ? 0 : 1); rep0_ < 2; ++rep0_) prologue(p0, (long)c * 512 + threadIdx.x, (long)G * 512);
    grid.sync();

#pragma unroll 1
    for (int layer = 0; layer < DEPTH; ++layer) {
        Params p = p0;
        { size_t zoff = 0; asm volatile("" : "+s"(zoff)); p.ws = p0.ws + zoff; }
        bf16_t* H = (bf16_t*)(p.ws + WS_H);
        {
for (int rep_ = (PROBE_PHASE == 1 ? 0 : 1); rep_ < 2; ++rep_) { const bool dry = (PROBE_PHASE == 1) && (rep_ == 0) && (p.pos[0] == 0);
            EpiIn e; e.H = H; e.side = (float*)(p.ws + WS_SIDE); e.rope = (const float*)(p.ws + WS_ROPE); e.VT = (bf16_t*)(p.ws + WS_VT); e.KF = (bf16_t*)(p.ws + WS_KF); e.kmax = (unsigned*)(p.ws + WS_KMAX); e.dry = dry;
            const bf16_t* A = (const bf16_t*)(p.ws + WS_XB);
            const bf16_t* Bt = (const bf16_t*)(p.ws + WS_WIN) + (long)layer * NPAD * 1024;
#pragma unroll 1
            for (int L = c; L < 128 * 17; L += G) { int pm, pn; tile_of(L, 128, 17, pm, pn); gemm_tile((LAS unsigned char*)lds, A, 1024, Bt, 1024, pm, pn, e, wid_s); }
}
        }
        gbar(barctr, (++bar_n) * (unsigned)G); if (PROBE_PHASE == 9) gbar(barctr, (++bar_n) * (unsigned)G);
        {
for (int rep_ = (PROBE_PHASE == 2 ? 0 : 1); rep_ < 2; ++rep_) { const bool dry = (PROBE_PHASE == 2) && (rep_ == 0) && (p.pos[0] == 0);
            const int tid = otid(wid_s), lane = tid & 63, w = tid >> 6;
#pragma unroll 1
            for (int g = c; g < 256; g += G) gla_local_item(p, layer, g * 8 + w, lane, dry);
}
        }
for (int rep_ = (PROBE_PHASE == 3 ? 0 : 1); rep_ < 2; ++rep_) { const bool dry = (PROBE_PHASE == 3) && (rep_ == 0) && (p.pos[0] == 0);
#pragma unroll 1
        for (int tile = c; tile < 512; tile += G) conformer_tile(p, layer, lds, tile, dry, wid_s);
}
        gbar(barctr, (++bar_n) * (unsigned)G); if (PROBE_PHASE == 9) gbar(barctr, (++bar_n) * (unsigned)G);
        {
            const int tid = otid(wid_s);
#pragma unroll 1
            for (int g = c; g < 64; g += G) gla_scan(p, g * 512 + tid);
        }
for (int rep_ = (PROBE_PHASE == 4 ? 0 : 1); rep_ < 2; ++rep_) { const bool dry = (PROBE_PHASE == 4) && (rep_ == 0) && (p.pos[0] == 0);
#pragma unroll 1
        for (int it = c; it < 512; it += G) {
            const int pr = it >> 1, second = it & 1;
            const int xcd = pr & 7, j = pr >> 3, b = xcd >> 1, par = xcd & 1;
            const int qblk = second ? (2 * j + par) : 127 - (2 * j + par);
            dsa_item(p, lds, b, qblk, dry, wid_s);
        }
}
        gbar(barctr, (++bar_n) * (unsigned)G); if (PROBE_PHASE == 9) gbar(barctr, (++bar_n) * (unsigned)G);
        {
for (int rep_ = (PROBE_PHASE == 5 ? 0 : 1); rep_ < 2; ++rep_) { const bool dry = (PROBE_PHASE == 5) && (rep_ == 0) && (p.pos[0] == 0);
            const int tid = otid(wid_s), lane = tid & 63, w = tid >> 6;
#pragma unroll 1
            for (int g = c; g < 256; g += G) gla_out_item(p, layer, lds + w * 16384, g * 8 + w, lane, dry);
}
        }
        gbar(barctr, (++bar_n) * (unsigned)G); if (PROBE_PHASE == 9) gbar(barctr, (++bar_n) * (unsigned)G);
        {
for (int rep_ = (PROBE_PHASE == 6 ? 0 : 1); rep_ < 2; ++rep_) { const bool dry = (PROBE_PHASE == 6) && (rep_ == 0) && (p.pos[0] == 0);
            EpiOut e; e.xres = (layer == 0) ? p.x : p.out; e.out = p.out; e.dry = dry;
            const bf16_t* A = H + HAG;
            const bf16_t* Bt = (const bf16_t*)(p.ws + WS_WOUT) + (long)layer * 1024 * 1024;
#pragma unroll 1
            for (int L = c; L < 128 * 4; L += G) { int pm, pn; tile_of(L, 128, 4, pm, pn); gemm_tile((LAS unsigned char*)lds, A, HP, Bt, 1024, pm, pn, e, wid_s); }
}
        }
        gbar(barctr, (++bar_n) * (unsigned)G); if (PROBE_PHASE == 9) gbar(barctr, (++bar_n) * (unsigned)G);
        {
for (int rep_ = (PROBE_PHASE == 7 ? 0 : 1); rep_ < 2; ++rep_) { const bool dry = (PROBE_PHASE == 7) && (rep_ == 0) && (p.pos[0] == 0);
            const int tid = otid(wid_s), lane = tid & 63, w = tid >> 6;
            ln_phase(p, layer, c * 8 + w, G * 8, lane, dry);
            if (c == 0 && tid < 32) ((unsigned*)(p.ws + WS_KMAX))[tid] = 0u;
}
        }
        gbar(barctr, (++bar_n) * (unsigned)G); if (PROBE_PHASE == 9) gbar(barctr, (++bar_n) * (unsigned)G);
    }
}

extern "C" void kernel_launch(void* const* d_in, const int* in_sizes, int n_in, void* d_out, int out_size, void* d_ws, size_t ws_size, hipStream_t stream) {
    static int grid_blocks = 0;
    if (grid_blocks == 0) {
        if (n_in != 15 || ws_size < WS_END) { fprintf(stderr, "kernel_launch: unexpected inputs (n_in %d, ws %zu < %zu)\n", n_in, ws_size, (size_t)WS_END); grid_blocks = -1; return; }
        int dev = 0, cus = 0, per_cu = 0;
        hipGetDevice(&dev);
        hipDeviceGetAttribute(&cus, hipDeviceAttributeMultiprocessorCount, dev);
        if (hipFuncSetAttribute((const void*)fwd_megakernel, hipFuncAttributeMaxDynamicSharedMemorySize, LDS_BYTES) != hipSuccess) { fprintf(stderr, "kernel_launch: hipFuncSetAttribute failed\n"); grid_blocks = -1; return; }
        hipOccupancyMaxActiveBlocksPerMultiprocessor(&per_cu, (const void*)fwd_megakernel, 512, LDS_BYTES);
        if (per_cu < 1) per_cu = 1;
        grid_blocks = cus * per_cu;
    }
    if (grid_blocks < 0) return;
    Params p{};
    p.x = (const float*)d_in[0]; p.pos = (const int*)d_in[1]; p.w_in = (const float*)d_in[2]; p.conv_w = (const float*)d_in[3]; p.conv_b = (const float*)d_in[4];
    p.cln_g = (const float*)d_in[5]; p.cln_b = (const float*)d_in[6]; p.pw_w = (const float*)d_in[7]; p.pw_b = (const float*)d_in[8];
    p.gate_w2 = (const float*)d_in[9]; p.gate_b = (const float*)d_in[10]; p.gnorm_g = (const float*)d_in[11]; p.w_out = (const float*)d_in[12];
    p.ln_g = (const float*)d_in[13]; p.ln_b = (const float*)d_in[14];
    p.out = (float*)d_out; p.ws = (unsigned char*)d_ws;
    for (int j = 0; j < 32; ++j) p.inv_freq[j] = (float)pow(10000.0, -(double)j / 32.0);
    void* args[] = {&p};
    hipError_t e = hipLaunchCooperativeKernel((const void*)fwd_megakernel, dim3(grid_blocks), dim3(512), args, LDS_BYTES, stream);
    if (e != hipSuccess) fprintf(stderr, "cooperative launch failed: %s (grid %d)\n", hipGetErrorString(e), grid_blocks);
}
```

```cpp
#include <hip/hip_runtime.h>
#include <hip/hip_cooperative_groups.h>
#include <cstdio>
#include <cmath>
namespace cg = cooperative_groups;

typedef unsigned short bf16_t;
typedef short bf16x8 __attribute__((ext_vector_type(8)));
typedef float f32x4 __attribute__((ext_vector_type(4)));
typedef float f32x16 __attribute__((ext_vector_type(16)));
typedef unsigned u32x4 __attribute__((ext_vector_type(4)));
typedef unsigned u32x2 __attribute__((ext_vector_type(2)));
typedef unsigned long long u64;

constexpr int NB = 4, T = 8192, NTOK = NB * T, DM = 1024, DIN = 4184, NPAD = 4352, HP = 4160, DEPTH = 4;
constexpr int HQ = 0, HK = 512, HV = 1024, HQI = 1536, HKI = 2048, HGLU = 2112, HCQ = 2624, HCK = 2752, HCV = 2880, HAG = 3136, HBG = 3648, HCG = 3904;
constexpr float EPS = 1e-5f;
constexpr float ALPHA = 1.6817928305074290f;
constexpr float QSCALE = 0.125f * 1.4426950408889634f;
constexpr float WI_SCALE = 0.04419417382415922f;
constexpr float SIG_UNIT = 5.66f;
constexpr int CAP = 128;

constexpr size_t WS_WIN = 0;
constexpr size_t WS_WOUT = WS_WIN + (size_t)DEPTH * NPAD * 1024 * 2;
constexpr size_t WS_PWT = WS_WOUT + (size_t)DEPTH * 1024 * 1024 * 2;
constexpr size_t WS_ROPE = WS_PWT + (size_t)DEPTH * 256 * 256 * 2;
constexpr size_t WS_XB = WS_ROPE + (size_t)NTOK * 32 * 8;
constexpr size_t WS_H = WS_XB + (size_t)NTOK * 1024 * 2;
constexpr size_t WS_SIDE = WS_H + (size_t)NTOK * HP * 2;
constexpr size_t WS_BCUM = WS_SIDE + (size_t)NTOK * 24 * 4;
constexpr size_t WS_U = WS_BCUM + (size_t)NTOK * 128 * 4;
constexpr size_t WS_DEC = WS_U + (size_t)2048 * 2048 * 4;
constexpr size_t WS_VT = WS_DEC + (size_t)2048 * 32 * 4;
constexpr size_t WS_KF = WS_VT + (size_t)NTOK * 512 * 2;
constexpr size_t WS_BAR = WS_KF + (size_t)NTOK * 512 * 2;
constexpr size_t WS_KMAX = WS_BAR + 256;
constexpr size_t WS_END = WS_KMAX + 256;

#ifndef PROBE_PHASE
#define PROBE_PHASE 0
#endif
constexpr int LDS_BYTES = 147456;

struct Params {
    const float* x; const int* pos; const float* w_in; const float* conv_w; const float* conv_b; const float* cln_g; const float* cln_b;
    const float* pw_w; const float* pw_b; const float* gate_w2; const float* gate_b; const float* gnorm_g; const float* w_out; const float* ln_g; const float* ln_b;
    float* out; unsigned char* ws;
    float inv_freq[32];
};

__device__ __forceinline__ unsigned f2bf(float f) { unsigned u = __float_as_uint(f); return (u + 0x7fffu + ((u >> 16) & 1u)) >> 16; }
__device__ __forceinline__ float bf2f(unsigned b) { return __uint_as_float(b << 16); }
typedef float f32x2_t __attribute__((ext_vector_type(2)));
typedef __bf16 bf16x2_t __attribute__((ext_vector_type(2)));
__device__ __forceinline__ unsigned pk2(float lo, float hi) { f32x2_t v = {lo, hi}; bf16x2_t b = __builtin_convertvector(v, bf16x2_t); return __builtin_bit_cast(unsigned, b); }
__device__ __forceinline__ float bflo(unsigned w) { return __uint_as_float(w << 16); }
__device__ __forceinline__ float bfhi(unsigned w) { return __uint_as_float(w & 0xffff0000u); }
__device__ __forceinline__ float silu_f(float v) { return v / (1.f + __expf(-v)); }
__device__ __forceinline__ float sigmoid_f(float v) { return 1.f / (1.f + __expf(-v)); }
__device__ __forceinline__ int bperm_i(int idx, int v) { return __builtin_amdgcn_ds_bpermute(idx << 2, v); }
__device__ __forceinline__ float sxor_f(float v, int lane, int m) { return __int_as_float(bperm_i(lane ^ m, __float_as_int(v))); }
__device__ __forceinline__ int sxor_i(int v, int lane, int m) { return bperm_i(lane ^ m, v); }
__device__ __forceinline__ float wave_sum(float v, int lane) {
#pragma unroll
    for (int o = 32; o >= 1; o >>= 1) v += sxor_f(v, lane, o);
    return v;
}
__device__ __forceinline__ int otid(int wid_s) { int l; asm volatile("v_mbcnt_lo_u32_b32 %0, -1, 0\n\tv_mbcnt_hi_u32_b32 %0, -1, %0" : "=v"(l)); return (wid_s << 6) | l; }
#define WAVE_SYNC() do { __builtin_amdgcn_fence(__ATOMIC_RELEASE, "wavefront"); __builtin_amdgcn_wave_barrier(); __builtin_amdgcn_fence(__ATOMIC_ACQUIRE, "wavefront"); } while (0)

__device__ __forceinline__ int l2orig(int l) {
    if (l < 1536) return l;
    if (l < 2048) return 2048 + (l - 1536);
    if (l < 2112) return 2560 + (l - 2048);
    if (l < 2624) return 2632 + (l - 2112);
    if (l < 2752) return 3400 + (l - 2624);
    if (l < 2880) return 3528 + (l - 2752);
    if (l < 3136) return 3656 + (l - 2880);
    if (l < 3648) return 1536 + (l - 3136);
    if (l < 3904) return 3144 + (l - 3648);
    if (l < 4160) return 3912 + (l - 3904);
    if (l < 4168) return 2624 + (l - 4160);
    if (l < 4184) return 4168 + (l - 4168);
    return -1;
}
__device__ __forceinline__ int npos2logical(int np) {
    const int hb = np & ~127, p = np & 127, wc = p >> 5, n = (p >> 4) & 1, fr = p & 15;
    return hb + (wc >> 1) * 64 + n * 32 + (wc & 1) * 16 + fr;
}

__device__ __forceinline__ void sincos_acc(float angf, float& c, float& s) {
    const double a = (double)angf;
    const double n = rint(a * 0.15915494309189535);
    double r = fma(-n, 6.283185307179586, a);
    r = fma(-n, 2.4492935982947064e-16, r);
    const double r2 = r * r;
    double ts = r, tc = 1.0, ss = r, cc = 1.0;
#pragma unroll
    for (int k = 1; k <= 14; ++k) {
        tc = -tc * r2 * (1.0 / (double)((2 * k - 1) * (2 * k)));
        ts = -ts * r2 * (1.0 / (double)((2 * k) * (2 * k + 1)));
        cc += tc; ss += ts;
    }
    c = (float)cc; s = (float)ss;
}

__device__ __forceinline__ void prologue(const Params& p, long gtid, long gthreads) {
    bf16_t* win = (bf16_t*)(p.ws + WS_WIN);
    for (long idx = gtid; idx < (long)DEPTH * 128 * NPAD; idx += gthreads) {
        const int np = (int)(idx % NPAD); const long r = idx / NPAD; const int kc = (int)(r % 128); const int l = (int)(r / 128);
        const int oc = l2orig(npos2logical(np));
        u32x4 w = {0u, 0u, 0u, 0u};
        if (oc >= 0) {
            const float* src = p.w_in + ((long)l * 1024 + kc * 8) * DIN + oc;
            float v[8];
#pragma unroll
            for (int i = 0; i < 8; ++i) v[i] = src[(long)i * DIN];
            w.x = pk2(v[0], v[1]); w.y = pk2(v[2], v[3]); w.z = pk2(v[4], v[5]); w.w = pk2(v[6], v[7]);
        }
        *(u32x4*)(win + ((long)l * NPAD + np) * 1024 + kc * 8) = w;
    }
    bf16_t* wout = (bf16_t*)(p.ws + WS_WOUT);
    for (long idx = gtid; idx < (long)DEPTH * 128 * 1024; idx += gthreads) {
        const int n = (int)(idx % 1024); const long r = idx / 1024; const int kc = (int)(r % 128); const int l = (int)(r / 128);
        const float* src = p.w_out + ((long)l * 1024 + kc * 8) * 1024 + n;
        float v[8];
#pragma unroll
        for (int i = 0; i < 8; ++i) v[i] = src[(long)i * 1024];
        u32x4 w; w.x = pk2(v[0], v[1]); w.y = pk2(v[2], v[3]); w.z = pk2(v[4], v[5]); w.w = pk2(v[6], v[7]);
        *(u32x4*)(wout + ((long)l * 1024 + n) * 1024 + kc * 8) = w;
    }
    bf16_t* pwt = (bf16_t*)(p.ws + WS_PWT);
    for (long idx = gtid; idx < (long)DEPTH * 32 * 256; idx += gthreads) {
        const int n = (int)(idx % 256); const long r = idx / 256; const int kc = (int)(r % 32); const int l = (int)(r / 32);
        const float* src = p.pw_w + ((long)l * 256 + kc * 8) * 256 + n;
        float v[8];
#pragma unroll
        for (int i = 0; i < 8; ++i) v[i] = src[(long)i * 256];
        u32x4 w; w.x = pk2(v[0], v[1]); w.y = pk2(v[2], v[3]); w.z = pk2(v[4], v[5]); w.w = pk2(v[6], v[7]);
        *(u32x4*)(pwt + ((long)l * 256 + n) * 256 + kc * 8) = w;
    }
    float2* rope = (float2*)(p.ws + WS_ROPE);
    for (long idx = gtid; idx < (long)NTOK * 32; idx += gthreads) {
        const int j = (int)(idx & 31); const long tok = idx >> 5;
        const float ang = (float)p.pos[tok] * p.inv_freq[j];
        float c, s; sincos_acc(ang, c, s);
        rope[idx] = make_float2(c, s);
    }
    if (gtid < 32) ((unsigned*)(p.ws + WS_KMAX))[gtid] = 0u;
    bf16_t* xb = (bf16_t*)(p.ws + WS_XB);
    for (long idx = gtid; idx < (long)NTOK * 128; idx += gthreads) {
        const f32x4 a = *(const f32x4*)(p.x + idx * 8), b = *(const f32x4*)(p.x + idx * 8 + 4);
        u32x4 w; w.x = pk2(a[0], a[1]); w.y = pk2(a[2], a[3]); w.z = pk2(b[0], b[1]); w.w = pk2(b[2], b[3]);
        *(u32x4*)(xb + idx * 8) = w;
    }
}

constexpr int BM = 256, BK = 64, HALF = 128, HT = HALF * BK;
__device__ __forceinline__ int lds_byte(int r, int c) {
    int st = (r >> 4) * 2 + (c >> 5), rr = r & 15, cc = c & 31, ob = rr * 64 + cc * 2;
    return st * 1024 + (ob ^ (((ob >> 9) & 1) << 5));
}
__device__ __forceinline__ void stage_rc(int b, int& R, int& C) {
    int st = b / 1024, sb = b % 1024, swz = sb ^ (((sb >> 9) & 1) << 5);
    R = (st >> 1) * 16 + swz / 64; C = (st & 1) * 32 + (swz % 64) / 2;
}
__device__ __forceinline__ void tile_of(int L, int nM, int nN, int& pm, int& pn) {
    const int nwg = nM * nN; int wgid = L;
    { const int q = nwg / 8, r = nwg % 8, xcd = wgid % 8, off = wgid / 8; wgid = (xcd < r ? xcd * (q + 1) : r * (q + 1) + (xcd - r) * q) + off; }
    const int nig = 8 * nN, gid = wgid / nig, fm = gid * 8, gsz = (nM - fm) < 8 ? (nM - fm) : 8;
    pm = fm + ((wgid % nig) % gsz); pn = (wgid % nig) / gsz;
}

#define LAS __attribute__((address_space(3)))
template <class Epi>
__device__ __forceinline__ void gemm_tile(LAS unsigned char* lds, const bf16_t* A, int lda, const bf16_t* Bt, int K, int pm, int pn, const Epi& epi, int wid_s) {
    const int tid = otid(wid_s), wid = __builtin_amdgcn_readfirstlane(tid >> 6), lane = tid & 63, wr = wid >> 2, wc = wid & 3, fr = lane & 15, fq = lane >> 4;
    const int nt = K / BK;
    unsigned voffA[2], voffB[2];
#pragma unroll
    for (int i = 0; i < 2; ++i) { int R, C; stage_rc(tid * 16 + i * 8192, R, C); voffA[i] = (unsigned)(R * lda + C) * 2u; voffB[i] = (unsigned)(R * K + C) * 2u; }
    const size_t kstep = (size_t)(BK * 2), hstepA = (size_t)HALF * lda * 2, hstepB = (size_t)HALF * K * 2;
    const unsigned ldsw = (unsigned)wid * 1024u;
    const int aoff = lds_byte(wr * 64 + fr, fq * 8), boff = lds_byte(wc * 32 + fr, fq * 8);
    const char* cA = (const char*)A + (size_t)pm * 2 * hstepA; const char* cB = (const char*)Bt + (size_t)pn * 2 * hstepB;
#define HTB (HALF * BK * 2)
#define SA(b, h) (((b) * 2 + (h)) * HTB)
#define SB(b, h) ((4 + (b) * 2 + (h)) * HTB)
#define STAGE(bufoff, gbase, voff) do { _Pragma("unroll") for (int _i = 0; _i < 2; ++_i) \
        __builtin_amdgcn_global_load_lds((const unsigned*)((const char*)(gbase) + (voff)[_i]), (LAS unsigned*)(lds + (bufoff) + ldsw + _i * 8192), 16, 0, 0); } while (0)
#define LDA(dst, b, h) do { _Pragma("unroll") for (int m = 0; m < 4; ++m) _Pragma("unroll") for (int k = 0; k < 2; ++k) dst[m][k] = *(const LAS bf16x8*)(lds + SA(b, h) + aoff + m * 2048 + k * 1024); } while (0)
#define LDB(dst, b, h) do { _Pragma("unroll") for (int n = 0; n < 2; ++n) _Pragma("unroll") for (int k = 0; k < 2; ++k) dst[n][k] = *(const LAS bf16x8*)(lds + SB(b, h) + boff + n * 2048 + k * 1024); } while (0)
#define MMA(ai, bj, At_, Bt_) do { __builtin_amdgcn_s_setprio(1); _Pragma("unroll") for (int m = 0; m < 4; ++m) _Pragma("unroll") for (int n = 0; n < 2; ++n) _Pragma("unroll") for (int k = 0; k < 2; ++k) \
        acc[ai][bj][m][n] = __builtin_amdgcn_mfma_f32_16x16x32_bf16(Bt_[n][k], At_[m][k], acc[ai][bj][m][n], 0, 0, 0); __builtin_amdgcn_s_setprio(0); } while (0)
#define WAIT_V(n) asm volatile("s_waitcnt vmcnt(" #n ")" ::: "memory")
#define WAIT_L(n) asm volatile("s_waitcnt lgkmcnt(" #n ")" ::: "memory")
#define BAR __builtin_amdgcn_s_barrier()
#define SCHED __builtin_amdgcn_sched_barrier(0)
    f32x4 acc[2][2][4][2];
#pragma unroll
    for (int a = 0; a < 2; ++a)
#pragma unroll
        for (int b = 0; b < 2; ++b)
#pragma unroll
            for (int m = 0; m < 4; ++m)
#pragma unroll
                for (int n = 0; n < 2; ++n) acc[a][b][m][n] = (f32x4){0.f, 0.f, 0.f, 0.f};
    bf16x8 At[4][2], B0[2][2], B1[2][2];
    STAGE(SB(0, 0), cB, voffB); STAGE(SA(0, 0), cA, voffA); STAGE(SB(0, 1), cB + hstepB, voffB); STAGE(SA(0, 1), cA + hstepA, voffA);
    if (wr == 1) BAR;
    WAIT_V(4); BAR;
    STAGE(SB(1, 0), cB + kstep, voffB); STAGE(SA(1, 0), cA + kstep, voffA); STAGE(SB(1, 1), cB + hstepB + kstep, voffB);
    WAIT_V(6); BAR;
    for (int t = 0; t < nt - 2; t += 2) {
        const char* a1 = cA + (size_t)(t + 1) * kstep; const char* a2 = cA + (size_t)(t + 2) * kstep; const char* b2 = cB + (size_t)(t + 2) * kstep;
        const char* a3 = a2 + kstep; const char* b3 = b2 + kstep;
        LDB(B0, 0, 0); SCHED; LDA(At, 0, 0); STAGE(SA(1, 1), a1 + hstepA, voffA);
        WAIT_L(8); BAR; WAIT_L(0); MMA(0, 0, At, B0); BAR; SCHED;
        LDB(B1, 0, 1); STAGE(SB(0, 0), b2, voffB);
        BAR; WAIT_L(0); MMA(0, 1, At, B1); BAR;
        LDA(At, 0, 1); STAGE(SA(0, 0), a2, voffA);
        BAR; WAIT_L(0); MMA(1, 0, At, B0); BAR; SCHED;
        STAGE(SB(0, 1), b2 + hstepB, voffB);
        WAIT_V(6); BAR; MMA(1, 1, At, B1); BAR;
        LDB(B0, 1, 0); SCHED; LDA(At, 1, 0); STAGE(SA(0, 1), a2 + hstepA, voffA);
        WAIT_L(8); BAR; WAIT_L(0); MMA(0, 0, At, B0); BAR; SCHED;
        LDB(B1, 1, 1); STAGE(SB(1, 0), b3, voffB);
        BAR; WAIT_L(0); MMA(0, 1, At, B1); BAR;
        LDA(At, 1, 1); STAGE(SA(1, 0), a3, voffA);
        BAR; WAIT_L(0); MMA(1, 0, At, B0); BAR; SCHED;
        STAGE(SB(1, 1), b3 + hstepB, voffB);
        WAIT_V(6); BAR; MMA(1, 1, At, B1); BAR;
    }
    { const char* a1 = cA + (size_t)(nt - 1) * kstep;
      LDB(B0, 0, 0); LDA(At, 0, 0); STAGE(SA(1, 1), a1 + hstepA, voffA);
      BAR; WAIT_L(0); MMA(0, 0, At, B0); BAR;
      LDB(B1, 0, 1); BAR; WAIT_L(0); MMA(0, 1, At, B1); BAR;
      LDA(At, 0, 1); WAIT_V(4); BAR; WAIT_L(0); MMA(1, 0, At, B0); MMA(1, 1, At, B1); BAR; }
    { LDB(B0, 1, 0); LDA(At, 1, 0); WAIT_V(2); BAR; WAIT_L(0); MMA(0, 0, At, B0); BAR;
      LDB(B1, 1, 1); WAIT_V(0); BAR; WAIT_L(0); MMA(0, 1, At, B1); BAR;
      LDA(At, 1, 1); BAR; WAIT_L(0); MMA(1, 0, At, B0); MMA(1, 1, At, B1); BAR; }
    if (wr == 0) BAR;
    epi(acc, pm * BM, pn * BM, wr, wc, fr, fq);
#undef SA
#undef SB
#undef STAGE
#undef LDA
#undef LDB
#undef MMA
}

struct EpiIn {
    bf16_t* H; float* side; const float* rope; bf16_t* VT; bf16_t* KF; unsigned* kmax; bool dry;
    __device__ __forceinline__ void operator()(f32x4 (&acc)[2][2][4][2], int brow, int bcol, int wr, int wc, int fr, int fq) const {
#pragma unroll
        for (int bj = 0; bj < 2; ++bj) {
            const int hb = bcol + bj * HALF;
            if (hb >= 4224 || dry) continue;
            const int gbase = hb + (wc >> 1) * 64, g64 = gbase >> 6, d0 = (wc & 1) * 16 + 4 * fq;
            const bool rp = (g64 < 16) || (g64 >= 24 && g64 <= 32);
            const float qs = (g64 < 8) ? QSCALE : 1.f;
            float kabs = 0.f;
#pragma unroll
            for (int ai = 0; ai < 2; ++ai)
#pragma unroll
                for (int m = 0; m < 4; ++m) {
                    const long row = brow + ai * HALF + wr * 64 + m * 16 + fr;
                    f32x4 o1 = acc[ai][bj][m][0], o2 = acc[ai][bj][m][1];
                    if (rp) {
                        const f32x4 c0 = *(const f32x4*)(rope + (row * 32 + d0) * 2), c1 = *(const f32x4*)(rope + (row * 32 + d0) * 2 + 4);
                        const f32x4 x1 = o1, x2 = o2;
                        o1[0] = (x1[0] * c0[0] - x2[0] * c0[1]) * qs; o2[0] = (x2[0] * c0[0] + x1[0] * c0[1]) * qs;
                        o1[1] = (x1[1] * c0[2] - x2[1] * c0[3]) * qs; o2[1] = (x2[1] * c0[2] + x1[1] * c0[3]) * qs;
                        o1[2] = (x1[2] * c1[0] - x2[2] * c1[1]) * qs; o2[2] = (x2[2] * c1[0] + x1[2] * c1[1]) * qs;
                        o1[3] = (x1[3] * c1[2] - x2[3] * c1[3]) * qs; o2[3] = (x2[3] * c1[2] + x1[3] * c1[3]) * qs;
                    }
                    if (g64 >= 8 && g64 < 24) {
                        const int bb = (int)(row >> 13), tt = (int)(row & (T - 1)), tile = tt >> 5, tk = tt & 31;
                        if (g64 < 16) {
                            kabs = fmaxf(kabs, fmaxf(fmaxf(fabsf(o1[0]), fabsf(o1[1])), fmaxf(fabsf(o1[2]), fabsf(o1[3]))));
                            kabs = fmaxf(kabs, fmaxf(fmaxf(fabsf(o2[0]), fabsf(o2[1])), fmaxf(fabsf(o2[2]), fabsf(o2[3]))));
                            const long base = ((long)(bb * 8 + (g64 - 8)) * 256 + tile) * 4;
                            const int ks = d0 >> 4, hk = (d0 >> 3) & 1, j0 = d0 & 7;
                            u32x2 w1, w2; w1.x = pk2(o1[0], o1[1]); w1.y = pk2(o1[2], o1[3]); w2.x = pk2(o2[0], o2[1]); w2.y = pk2(o2[2], o2[3]);
                            const auto sx = __builtin_amdgcn_permlane16_swap(w1.x, w2.x, false, false), sy = __builtin_amdgcn_permlane16_swap(w1.y, w2.y, false, false);
                            u32x4 wv; long slot;
                            if (fq & 1) { wv.x = sx[0]; wv.y = sy[0]; wv.z = w2.x; wv.w = w2.y; slot = (base + ks + 2) * 64 + hk * 32 + tk; }
                            else { wv.x = w1.x; wv.y = w1.y; wv.z = sx[1]; wv.w = sy[1]; slot = (base + ks) * 64 + hk * 32 + tk; }
                            *(u32x4*)(KF + slot * 8) = wv;
                        } else {
                            const int s = tk >> 4, u = tk & 15, hv = (u >> 2) & 1, jv = (u >> 3) * 4 + (u & 3);
                            const long base = (((long)(bb * 8 + (g64 - 16)) * 256 + tile) * 2) * 2 + s;
                            bf16_t* v0 = VT + ((base) * 64 + hv * 32 + d0) * 8 + jv;
                            bf16_t* v1 = VT + ((base + 2) * 64 + hv * 32 + d0) * 8 + jv;
#pragma unroll
                            for (int j = 0; j < 4; ++j) { v0[j * 8] = (bf16_t)f2bf(o1[j]); v1[j * 8] = (bf16_t)f2bf(o2[j]); }
                        }
                    } else if (gbase < 4160) {
                        bf16_t* hp = H + row * HP + gbase + d0;
                        u32x2 w1, w2; w1.x = pk2(o1[0], o1[1]); w1.y = pk2(o1[2], o1[3]); w2.x = pk2(o2[0], o2[1]); w2.y = pk2(o2[2], o2[3]);
                        const auto sx = __builtin_amdgcn_permlane16_swap(w1.x, w2.x, false, false), sy = __builtin_amdgcn_permlane16_swap(w1.y, w2.y, false, false);
                        u32x4 wv;
                        if (fq & 1) { wv.x = sx[0]; wv.y = sy[0]; wv.z = w2.x; wv.w = w2.y; hp += 32 - 4; }
                        else { wv.x = w1.x; wv.y = w1.y; wv.z = sx[1]; wv.w = sy[1]; }
                        *(u32x4*)hp = wv;
                    } else if (d0 < 8) { *(f32x4*)(side + row * 24 + d0) = o1 * WI_SCALE; }
                    else if (d0 < 24) { *(f32x4*)(side + row * 24 + d0) = o1; }
                }
            if (g64 >= 8 && g64 < 16) {
#pragma unroll
                for (int o = 32; o >= 1; o >>= 1) kabs = fmaxf(kabs, sxor_f(kabs, fq * 16 + fr, o));
                if ((threadIdx.x & 63) == 0) atomicMax(kmax + (brow >> 13) * 8 + (g64 - 8), __float_as_uint(kabs));
            }
        }
    }
};
struct EpiOut {
    const float* xres; float* out; bool dry;
    __device__ __forceinline__ void operator()(f32x4 (&acc)[2][2][4][2], int brow, int bcol, int wr, int wc, int fr, int fq) const {
#pragma unroll
        for (int ai = 0; ai < 2; ++ai)
#pragma unroll
            for (int m = 0; m < 4; ++m)
#pragma unroll
                for (int bj = 0; bj < 2; ++bj)
#pragma unroll
                    for (int n = 0; n < 2; ++n) {
                        const long idx = (long)(brow + ai * HALF + wr * 64 + m * 16 + fr) * DM + (bcol + bj * HALF + wc * 32 + n * 16 + 4 * fq);
                        const f32x4 xr = *(const f32x4*)(xres + idx);
                        if (!dry) *(f32x4*)(out + idx) = xr * ALPHA + acc[ai][bj][m][n];
                    }
    }
};

__device__ __forceinline__ void ln_phase(const Params& p, int layer, int wave_g, int nwaves, int lane, bool dry) {
    bf16_t* xb = (bf16_t*)(p.ws + WS_XB);
    const float* g = p.ln_g + layer * DM; const float* bb = p.ln_b + layer * DM;
    for (int row = wave_g; row < NTOK; row += nwaves) {
        float* zr = p.out + (long)row * DM;
        f32x4 v[4]; float s = 0.f;
#pragma unroll
        for (int r = 0; r < 4; ++r) { v[r] = *(const f32x4*)(zr + r * 256 + lane * 4); s += v[r][0] + v[r][1] + v[r][2] + v[r][3]; }
        const float mu = wave_sum(s, lane) * (1.f / DM);
        float q = 0.f;
#pragma unroll
        for (int r = 0; r < 4; ++r)
#pragma unroll
            for (int e = 0; e < 4; ++e) { const float d = v[r][e] - mu; q += d * d; }
        const float rstd = rsqrtf(wave_sum(q, lane) * (1.f / DM) + EPS);
#pragma unroll
        for (int r = 0; r < 4; ++r) {
            const f32x4 gg = *(const f32x4*)(g + r * 256 + lane * 4), bv = *(const f32x4*)(bb + r * 256 + lane * 4);
            f32x4 y;
#pragma unroll
            for (int e = 0; e < 4; ++e) y[e] = (v[r][e] - mu) * rstd * gg[e] + bv[e];
            if (dry) continue;
            *(f32x4*)(zr + r * 256 + lane * 4) = y;
            u32x2 w; w.x = pk2(y[0], y[1]); w.y = pk2(y[2], y[3]);
            *(u32x2*)(xb + (long)row * DM + r * 256 + lane * 4) = w;
        }
    }
}

__device__ __forceinline__ void conformer_tile(const Params& p, int layer, unsigned char* lds, int tile, bool dry, int wid_s) {
    bf16_t* H = (bf16_t*)(p.ws + WS_H);
    const int tid = otid(wid_s), lane = tid & 63, w = tid >> 6;
    const int tok0 = tile * 64, b = tok0 / T, tl0 = tok0 % T;
    bf16_t* hg = (bf16_t*)lds;
    float* cv = (float*)(lds + 49152);
    for (int idx = tid; idx < 94 * 32; idx += 512) {
        const int r = idx >> 5, cc = (idx & 31) * 8, tl = tl0 - 30 + r;
        u32x4 o = {0u, 0u, 0u, 0u};
        if (tl >= 0) {
            const bf16_t* src = H + ((long)b * T + tl) * HP + HGLU + cc;
            const u32x4 va = *(const u32x4*)src, ga = *(const u32x4*)(src + 256);
            o.x = pk2(bflo(va.x) * sigmoid_f(bflo(ga.x)), bfhi(va.x) * sigmoid_f(bfhi(ga.x)));
            o.y = pk2(bflo(va.y) * sigmoid_f(bflo(ga.y)), bfhi(va.y) * sigmoid_f(bfhi(ga.y)));
            o.z = pk2(bflo(va.z) * sigmoid_f(bflo(ga.z)), bfhi(va.z) * sigmoid_f(bfhi(ga.z)));
            o.w = pk2(bflo(va.w) * sigmoid_f(bflo(ga.w)), bfhi(va.w) * sigmoid_f(bfhi(ga.w)));
        }
        *(u32x4*)(hg + r * 256 + cc) = o;
    }
    __syncthreads();
    {
        const int c = tid & 255, half = tid >> 8;
        const float* cw = p.conv_w + (long)layer * 31 * 256 + c;
        float wj[31];
#pragma unroll
        for (int j = 0; j < 31; ++j) wj[j] = cw[j * 256];
        const float cb = p.conv_b[layer * 256 + c];
        float win[62];
#pragma unroll
        for (int r = 0; r < 62; ++r) win[r] = bf2f(hg[(half * 32 + r) * 256 + c]);
#pragma unroll
        for (int tt = 0; tt < 32; ++tt) {
            float a = cb;
#pragma unroll
            for (int j = 0; j < 31; ++j) a = fmaf(win[tt + j], wj[j], a);
            cv[(half * 32 + tt) * 256 + c] = a;
        }
    }
    __syncthreads();
    bf16_t* at = (bf16_t*)lds;
    {
        const f32x4 gg = *(const f32x4*)(p.cln_g + layer * 256 + lane * 4), bv = *(const f32x4*)(p.cln_b + layer * 256 + lane * 4);
#pragma unroll
        for (int tt = 0; tt < 8; ++tt) {
            const int t = w * 8 + tt;
            const f32x4 v = *(const f32x4*)(cv + t * 256 + lane * 4);
            const float mu = wave_sum(v[0] + v[1] + v[2] + v[3], lane) * (1.f / 256.f);
            float q = 0.f;
#pragma unroll
            for (int e = 0; e < 4; ++e) { const float d = v[e] - mu; q += d * d; }
            const float rstd = rsqrtf(wave_sum(q, lane) * (1.f / 256.f) + EPS);
            float y[4];
#pragma unroll
            for (int e = 0; e < 4; ++e) y[e] = silu_f((v[e] - mu) * rstd * gg[e] + bv[e]);
            u32x2 o; o.x = pk2(y[0], y[1]); o.y = pk2(y[2], y[3]);
            *(u32x2*)(at + t * 264 + lane * 4) = o;
        }
    }
    __syncthreads();
    {
        f32x16 acc0 = {}, acc1 = {};
        const bf16_t* pwt = (const bf16_t*)(p.ws + WS_PWT) + (long)layer * 65536 + (w * 32 + (lane & 31)) * 256 + 8 * (lane >> 5);
        const bf16_t* ap = at + (lane & 31) * 264 + 8 * (lane >> 5);
#pragma unroll 4
        for (int ks = 0; ks < 16; ++ks) {
            const bf16x8 bfr = *(const bf16x8*)(pwt + ks * 16);
            const bf16x8 a0 = *(const bf16x8*)(ap + ks * 16), a1 = *(const bf16x8*)(ap + 32 * 264 + ks * 16);
            acc0 = __builtin_amdgcn_mfma_f32_32x32x16_bf16(a0, bfr, acc0, 0, 0, 0);
            acc1 = __builtin_amdgcn_mfma_f32_32x32x16_bf16(a1, bfr, acc1, 0, 0, 0);
        }
        const int ch = w * 32 + (lane & 31);
        const float pb = p.pw_b[layer * 256 + ch];
#pragma unroll
        for (int i = 0; i < 16; ++i) {
            const int row = (i & 3) + 8 * (i >> 2) + 4 * (lane >> 5);
            bf16_t* g0 = H + (long)(tok0 + row) * HP + HBG + ch;
            bf16_t* g1 = H + (long)(tok0 + 32 + row) * HP + HBG + ch;
            const unsigned r0 = f2bf((acc0[i] + pb) * silu_f(bf2f(*g0))), r1 = f2bf((acc1[i] + pb) * silu_f(bf2f(*g1)));
            if (!dry) { *g0 = (bf16_t)r0; *g1 = (bf16_t)r1; }
        }
    }
    __syncthreads();
}

__device__ __forceinline__ float rdlane(float v, int l) { return __uint_as_float(__builtin_amdgcn_readlane(__float_as_uint(v), l)); }

__device__ __forceinline__ void gla_local_item(const Params& p, int layer, int item_, int lane, bool dry) {
    const int item = __builtin_amdgcn_readfirstlane(item_);
    bf16_t* H = (bf16_t*)(p.ws + WS_H);
    const float* side = (const float*)(p.ws + WS_SIDE);
    float* bcum = (float*)(p.ws + WS_BCUM); float* U = (float*)(p.ws + WS_U); float* DEC = (float*)(p.ws + WS_DEC);
    const int bh = item >> 7, c = item & 127, b = bh >> 2, h = bh & 3;
    const long tok0 = (long)b * T + c * 64, tok = tok0 + lane;
    float clr[16];
#pragma unroll
    for (int r = 0; r < 4; ++r) { const f32x4 v = *(const f32x4*)(side + tok * 24 + 8 + r * 4); clr[r * 4] = v[0]; clr[r * 4 + 1] = v[1]; clr[r * 4 + 2] = v[2]; clr[r * 4 + 3] = v[3]; }
    const float* gw = p.gate_w2 + (long)layer * 16 * 128 + h * 32; const float* gb = p.gate_b + layer * 128 + h * 32;
    float* bcp = bcum + tok * 128 + h * 32;
#pragma unroll 1
    for (int d = 0; d < 32; ++d) {
        float z = gb[d];
#pragma unroll
        for (int r = 0; r < 16; ++r) z = fmaf(clr[r], gw[r * 128 + d], z);
        float g = (fminf(z, 0.f) - __logf(1.f + __expf(-fabsf(z)))) * (1.f / 16.f);
#pragma unroll
        for (int o = 1; o < 64; o <<= 1) { const float up = __int_as_float(bperm_i((lane - o) & 63, __float_as_int(g))); if (lane >= o) g += up; }
        bcp[d] = g;
    }
    float bc[32];
#pragma unroll
    for (int r = 0; r < 8; ++r) { const f32x4 v = *(const f32x4*)(bcp + r * 4); bc[r * 4] = v[0]; bc[r * 4 + 1] = v[1]; bc[r * 4 + 2] = v[2]; bc[r * 4 + 3] = v[3]; }
    float kk[32];
    {
        const bf16_t* kp = H + tok * HP + HCK + h * 32;
#pragma unroll
        for (int r = 0; r < 4; ++r) {
            const u32x4 kv = *(const u32x4*)(kp + r * 8);
            kk[r * 8 + 0] = bflo(kv.x); kk[r * 8 + 1] = bfhi(kv.x); kk[r * 8 + 2] = bflo(kv.y); kk[r * 8 + 3] = bfhi(kv.y);
            kk[r * 8 + 4] = bflo(kv.z); kk[r * 8 + 5] = bfhi(kv.z); kk[r * 8 + 6] = bflo(kv.w); kk[r * 8 + 7] = bfhi(kv.w);
        }
#pragma unroll
        for (int d = 0; d < 32; ++d) { const float bl = rdlane(bc[d], 63); kk[d] *= __expf(bl - bc[d]); }
    }
    float acc[32];
#pragma unroll
    for (int d = 0; d < 32; ++d) acc[d] = 0.f;
    const bf16_t* vp = H + tok0 * HP + HCV + h * 64 + lane;
#pragma unroll 1
    for (int t8 = 0; t8 < 64; t8 += 8) {
        float vv[8];
#pragma unroll
        for (int u = 0; u < 8; ++u) vv[u] = bf2f(vp[(long)(t8 + u) * HP]);
#pragma unroll
        for (int u = 0; u < 8; ++u)
#pragma unroll
            for (int d = 0; d < 32; ++d) acc[d] = fmaf(rdlane(kk[d], t8 + u), vv[u], acc[d]);
    }
#pragma unroll
    for (int d = 0; d < 32; ++d) if (!dry) U[(long)item * 2048 + d * 64 + lane] = acc[d];
    if (lane == 63) {
#pragma unroll
        for (int r = 0; r < 8; ++r) { f32x4 v = {__expf(bc[r * 4]), __expf(bc[r * 4 + 1]), __expf(bc[r * 4 + 2]), __expf(bc[r * 4 + 3])}; *(f32x4*)(DEC + item * 32 + r * 4) = v; }
    }
}

__device__ __forceinline__ void gla_scan(const Params& p, int gt) {
    float* U = (float*)(p.ws + WS_U); const float* DEC = (const float*)(p.ws + WS_DEC);
    const int bh = gt >> 11, de = gt & 2047, d = de >> 6;
    float s = 0.f;
    for (int c0 = 0; c0 < 128; c0 += 32) {
        float u[32], dc[32];
#pragma unroll
        for (int i = 0; i < 32; ++i) { u[i] = U[(long)(bh * 128 + c0 + i) * 2048 + de]; dc[i] = DEC[(bh * 128 + c0 + i) * 32 + d]; }
#pragma unroll
        for (int i = 0; i < 32; ++i) { U[(long)(bh * 128 + c0 + i) * 2048 + de] = s; s = fmaf(dc[i], s, u[i]); }
    }
}

__device__ __forceinline__ void gla_out_item(const Params& p, int layer, unsigned char* ldsw, int item_, int lane, bool dry) {
    const int item = __builtin_amdgcn_readfirstlane(item_);
    bf16_t* H = (bf16_t*)(p.ws + WS_H);
    const float* bcum = (const float*)(p.ws + WS_BCUM); const float* U = (const float*)(p.ws + WS_U);
    float* sA = (float*)ldsw; bf16_t* sV = (bf16_t*)(ldsw + 8192);
    const int bh = item >> 7, c = item & 127, b = bh >> 2, h = bh & 3;
    const long tok = (long)b * T + c * 64 + lane;
#pragma unroll
    for (int r = 0; r < 8; ++r) *(f32x4*)(sA + r * 256 + lane * 4) = *(const f32x4*)(U + (long)item * 2048 + r * 256 + lane * 4);
#pragma unroll
    for (int r = 0; r < 8; ++r) *(u32x4*)(sV + lane * 64 + r * 8) = *(const u32x4*)(H + tok * HP + HCV + h * 64 + r * 8);
    WAVE_SYNC();
    float o[64];
#pragma unroll
    for (int e = 0; e < 64; ++e) o[e] = 0.f;
    {
        const bf16_t* qp = H + tok * HP + HCQ + h * 32; const float* bp = bcum + tok * 128 + h * 32;
#pragma unroll 1
        for (int d = 0; d < 32; ++d) {
            const float qd = bf2f(qp[d]) * 0.17677669529663687f * __expf(bp[d]);
#pragma unroll
            for (int e4 = 0; e4 < 16; ++e4) {
                const f32x4 s4 = *(const f32x4*)(sA + d * 64 + e4 * 4);
                o[e4 * 4] = fmaf(qd, s4[0], o[e4 * 4]); o[e4 * 4 + 1] = fmaf(qd, s4[1], o[e4 * 4 + 1]);
                o[e4 * 4 + 2] = fmaf(qd, s4[2], o[e4 * 4 + 2]); o[e4 * 4 + 3] = fmaf(qd, s4[3], o[e4 * 4 + 3]);
            }
        }
    }
    WAVE_SYNC();
    {
        const bf16_t* kp = H + tok * HP + HCK + h * 32;
#pragma unroll
        for (int r = 0; r < 4; ++r) {
            const u32x4 kv = *(const u32x4*)(kp + r * 8);
            const f32x4 b0 = *(const f32x4*)(bcum + tok * 128 + h * 32 + r * 8), b1 = *(const f32x4*)(bcum + tok * 128 + h * 32 + r * 8 + 4);
            f32x4 k0 = {bflo(kv.x) * __expf(-b0[0]), bfhi(kv.x) * __expf(-b0[1]), bflo(kv.y) * __expf(-b0[2]), bfhi(kv.y) * __expf(-b0[3])};
            f32x4 k1 = {bflo(kv.z) * __expf(-b1[0]), bfhi(kv.z) * __expf(-b1[1]), bflo(kv.w) * __expf(-b1[2]), bfhi(kv.w) * __expf(-b1[3])};
            *(f32x4*)(sA + lane * 32 + r * 8) = k0; *(f32x4*)(sA + lane * 32 + r * 8 + 4) = k1;
        }
    }
    float qe[32];
    {
        const bf16_t* qp = H + tok * HP + HCQ + h * 32;
#pragma unroll
        for (int r = 0; r < 4; ++r) {
            const u32x4 qv = *(const u32x4*)(qp + r * 8);
            const f32x4 b0 = *(const f32x4*)(bcum + tok * 128 + h * 32 + r * 8), b1 = *(const f32x4*)(bcum + tok * 128 + h * 32 + r * 8 + 4);
            const float qq[8] = {bflo(qv.x), bfhi(qv.x), bflo(qv.y), bfhi(qv.y), bflo(qv.z), bfhi(qv.z), bflo(qv.w), bfhi(qv.w)};
            const float bb[8] = {b0[0], b0[1], b0[2], b0[3], b1[0], b1[1], b1[2], b1[3]};
#pragma unroll
            for (int e = 0; e < 8; ++e) qe[r * 8 + e] = qq[e] * 0.17677669529663687f * __expf(bb[e]);
        }
    }
    WAVE_SYNC();
#pragma unroll 1
    for (int j = 0; j < 64; ++j) {
        float a = 0.f;
#pragma unroll
        for (int d4 = 0; d4 < 8; ++d4) {
            const f32x4 k4 = *(const f32x4*)(sA + j * 32 + d4 * 4);
            a = fmaf(qe[d4 * 4], k4[0], a); a = fmaf(qe[d4 * 4 + 1], k4[1], a); a = fmaf(qe[d4 * 4 + 2], k4[2], a); a = fmaf(qe[d4 * 4 + 3], k4[3], a);
        }
        if (j > lane) a = 0.f;
#pragma unroll
        for (int e8 = 0; e8 < 8; ++e8) {
            const u32x4 v8 = *(const u32x4*)(sV + j * 64 + e8 * 8);
            o[e8 * 8 + 0] = fmaf(a, bflo(v8.x), o[e8 * 8 + 0]); o[e8 * 8 + 1] = fmaf(a, bfhi(v8.x), o[e8 * 8 + 1]);
            o[e8 * 8 + 2] = fmaf(a, bflo(v8.y), o[e8 * 8 + 2]); o[e8 * 8 + 3] = fmaf(a, bfhi(v8.y), o[e8 * 8 + 3]);
            o[e8 * 8 + 4] = fmaf(a, bflo(v8.z), o[e8 * 8 + 4]); o[e8 * 8 + 5] = fmaf(a, bfhi(v8.z), o[e8 * 8 + 5]);
            o[e8 * 8 + 6] = fmaf(a, bflo(v8.w), o[e8 * 8 + 6]); o[e8 * 8 + 7] = fmaf(a, bfhi(v8.w), o[e8 * 8 + 7]);
        }
    }
    float ss = 0.f;
#pragma unroll
    for (int e = 0; e < 64; ++e) ss = fmaf(o[e], o[e], ss);
    const float rms = rsqrtf(ss * (1.f / 64.f) + EPS);
    const float* gn = p.gnorm_g + layer * 256 + h * 64;
    bf16_t* cg_p = H + tok * HP + HCG + h * 64;
#pragma unroll
    for (int r = 0; r < 8; ++r) {
        const u32x4 gv = *(const u32x4*)(cg_p + r * 8);
        const float gq[8] = {bflo(gv.x), bfhi(gv.x), bflo(gv.y), bfhi(gv.y), bflo(gv.z), bfhi(gv.z), bflo(gv.w), bfhi(gv.w)};
        float y[8];
#pragma unroll
        for (int e = 0; e < 8; ++e) y[e] = o[r * 8 + e] * rms * gn[r * 8 + e] * silu_f(gq[e]);
        u32x4 w; w.x = pk2(y[0], y[1]); w.y = pk2(y[2], y[3]); w.z = pk2(y[4], y[5]); w.w = pk2(y[6], y[7]);
        if (!dry) *(u32x4*)(cg_p + r * 8) = w;
    }
    WAVE_SYNC();
}

constexpr int MPITCH = 260;
constexpr int HPITCH = 516;
constexpr int L_HIST = 0;
constexpr int L_CAND = 66560;
constexpr int L_CCNT = L_CAND + 65536;
constexpr int L_QINF = L_CCNT + 2048;
constexpr int L_MTAB = L_QINF + 1024 + 64;
static_assert(L_MTAB + 8192 <= LDS_BYTES, "dsa lds");
__device__ __forceinline__ int mpos(int rr) { return 16 * ((rr >> 2) & 1) + (rr & 3) + 4 * (rr >> 3); }
constexpr int SUBCAP = 32;

__device__ __forceinline__ unsigned mono_bits(float f) { const unsigned u = __float_as_uint(f); return u ^ ((u >> 31) ? 0xffffffffu : 0x80000000u); }
__device__ __forceinline__ void idx_loadk(const bf16_t* Hb, int s0, int lane, bf16x8 (&kf)[2][2]) {
    const bf16_t* kp = Hb + (long)(s0 + (lane & 15)) * HP + HKI + 8 * (lane >> 4);
#pragma unroll
    for (int kb = 0; kb < 2; ++kb)
#pragma unroll
        for (int ks = 0; ks < 2; ++ks) kf[kb][ks] = *(const bf16x8*)(kp + (long)kb * 16 * HP + ks * 32);
}
__device__ __forceinline__ void idx_scores(const bf16x8 (&kf)[2][2], const bf16x8 (&qf)[8][2], const bf16x8 (&ql)[2][2], const float (&wh)[8], float (&score)[8]) {
    f32x4 lin[2];
#pragma unroll
    for (int kb = 0; kb < 2; ++kb) {
        lin[kb] = (f32x4){0.f, 0.f, 0.f, 0.f};
#pragma unroll
        for (int ks = 0; ks < 2; ++ks) {
            lin[kb] = __builtin_amdgcn_mfma_f32_16x16x32_bf16(kf[kb][ks], ql[0][ks], lin[kb], 0, 0, 0);
            lin[kb] = __builtin_amdgcn_mfma_f32_16x16x32_bf16(kf[kb][ks], ql[1][ks], lin[kb], 0, 0, 0);
        }
    }
#pragma unroll
    for (int i = 0; i < 8; ++i) score[i] = lin[i >> 2][i & 3];
#pragma unroll
    for (int hd = 0; hd < 8; ++hd) {
        f32x4 acc[2];
#pragma unroll
        for (int kb = 0; kb < 2; ++kb) {
            acc[kb] = (f32x4){0.f, 0.f, 0.f, 0.f};
#pragma unroll
            for (int ks = 0; ks < 2; ++ks) acc[kb] = __builtin_amdgcn_mfma_f32_16x16x32_bf16(kf[kb][ks], qf[hd][ks], acc[kb], 0, 0, 0);
        }
#pragma unroll
        for (int kb = 0; kb < 2; ++kb)
#pragma unroll
            for (int i = 0; i < 4; ++i) score[kb * 4 + i] = fmaf(fabsf(acc[kb][i]), wh[hd], score[kb * 4 + i]);
        if ((hd & 3) == 3) __builtin_amdgcn_sched_barrier(0);
    }
}

template <bool FAST>
__device__ __forceinline__ void attn_tile(const bf16x8 (&kf)[4], const bf16x8 (&vf)[4], const bf16x8 (&qfr)[2][4], f32x16 (&O)[2][2], float (&mrun)[2], float (&lrun)[2],
                                          const unsigned* hist, const float* mtab, int r32, int hh, int tile) {
#pragma unroll
    for (int qb = 0; qb < 2; ++qb) {
        f32x16 S;
        const unsigned mw = hist[(qb * 32 + r32) * MPITCH + tile] >> (16 * hh);
#pragma unroll
        for (int g8 = 0; g8 < 2; ++g8) {
            const float* mt = mtab + ((mw >> (8 * g8)) & 255u) * 8;
            const f32x4 ma = *(const f32x4*)mt, mb = *(const f32x4*)(mt + 4);
            S[8 * g8] = ma[0]; S[8 * g8 + 1] = ma[1]; S[8 * g8 + 2] = ma[2]; S[8 * g8 + 3] = ma[3];
            S[8 * g8 + 4] = mb[0]; S[8 * g8 + 5] = mb[1]; S[8 * g8 + 6] = mb[2]; S[8 * g8 + 7] = mb[3];
        }
#pragma unroll
        for (int ks = 0; ks < 4; ++ks) S = __builtin_amdgcn_mfma_f32_32x32x16_bf16(kf[ks], qfr[qb][ks], S, 0, 0, 0);
        float pr[16]; float ps = 0.f;
        if (FAST) {
#pragma unroll
            for (int i = 0; i < 16; ++i) { pr[i] = __builtin_amdgcn_exp2f(S[i]); ps += pr[i]; }
        } else {
            float mx = fmaxf(fmaxf(S[0], S[1]), S[2]);
#pragma unroll
            for (int i = 3; i < 15; i += 2) mx = fmaxf(fmaxf(mx, S[i]), S[i + 1]);
            mx = fmaxf(mx, S[15]);
            { const auto sw = __builtin_amdgcn_permlane32_swap(__float_as_uint(mx), __float_as_uint(mx), false, false); mx = fmaxf(__uint_as_float(sw[0]), __uint_as_float(sw[1])); }
            if (__any(mx > mrun[qb])) {
                const float mnew = fmaxf(mx, mrun[qb]);
                const float alpha = __builtin_amdgcn_exp2f(mrun[qb] - mnew);
                mrun[qb] = mnew; lrun[qb] *= alpha;
#pragma unroll
                for (int db = 0; db < 2; ++db)
#pragma unroll
                    for (int i = 0; i < 16; ++i) O[db][qb][i] *= alpha;
            }
            const float mref = fmaxf(mrun[qb], -1000.f);
#pragma unroll
            for (int i = 0; i < 16; ++i) { pr[i] = __builtin_amdgcn_exp2f(S[i] - mref); ps += pr[i]; }
        }
        lrun[qb] += ps;
        bf16x8 pf[2];
#pragma unroll
        for (int s = 0; s < 2; ++s) {
            u32x4 pw; pw.x = pk2(pr[8 * s], pr[8 * s + 1]); pw.y = pk2(pr[8 * s + 2], pr[8 * s + 3]); pw.z = pk2(pr[8 * s + 4], pr[8 * s + 5]); pw.w = pk2(pr[8 * s + 6], pr[8 * s + 7]);
            pf[s] = __builtin_bit_cast(bf16x8, pw);
        }
#pragma unroll
        for (int db = 0; db < 2; ++db)
#pragma unroll
            for (int s = 0; s < 2; ++s) O[db][qb] = __builtin_amdgcn_mfma_f32_32x32x16_bf16(vf[db * 2 + s], pf[s], O[db][qb], 0, 0, 0);
    }
}
template <bool FAST>
__device__ __forceinline__ void attn_loop(const bf16_t* Kp, const bf16_t* Vp, const bf16x8 (&qfr)[2][4], f32x16 (&O)[2][2], float (&mrun)[2], float (&lrun)[2],
                                          const unsigned* hist, const float* mtab, int r32, int hh, int nt32, bool dry2) {
    bf16x8 kf[4], vf[4], kg[4], vg[4];
#pragma unroll
    for (int ks = 0; ks < 4; ++ks) { kf[ks] = *(const bf16x8*)(Kp + ks * 512); vf[ks] = *(const bf16x8*)(Vp + ks * 512); }
#pragma unroll 1
    for (int tile = 0; tile < nt32; tile += 2) {
        {
            const int tn = dry2 ? 0 : tile + 1;
#pragma unroll
            for (int ks = 0; ks < 4; ++ks) { kg[ks] = *(const bf16x8*)(Kp + (long)tn * 2048 + ks * 512); vg[ks] = *(const bf16x8*)(Vp + (long)tn * 2048 + ks * 512); }
        }
        attn_tile<FAST>(kf, vf, qfr, O, mrun, lrun, hist, mtab, r32, hh, tile);
        {
            const int tn = dry2 ? 0 : ((tile + 2 < nt32) ? tile + 2 : tile);
#pragma unroll
            for (int ks = 0; ks < 4; ++ks) { kf[ks] = *(const bf16x8*)(Kp + (long)tn * 2048 + ks * 512); vf[ks] = *(const bf16x8*)(Vp + (long)tn * 2048 + ks * 512); }
        }
        attn_tile<FAST>(kg, vg, qfr, O, mrun, lrun, hist, mtab, r32, hh, tile + 1);
    }
}

__device__ __forceinline__ void dsa_item(const Params& p, unsigned char* lds, int b, int qblk, bool dry, int wid_s) {
    bf16_t* H = (bf16_t*)(p.ws + WS_H);
    const float* side = (const float*)(p.ws + WS_SIDE);
    const bf16_t* Hb = H + (long)b * T * HP;
    const int tid = otid(wid_s), lane = tid & 63, w = tid >> 6, hq = lane >> 4;
    const int qg = w & 3, kh = w >> 2;
    const int t0 = qblk * 64, qloc = qg * 16 + (lane & 15), t = t0 + qloc;
    unsigned* hist = (unsigned*)(lds + L_HIST);
    unsigned* cand = (unsigned*)(lds + L_CAND);
    unsigned* ccnt = (unsigned*)(lds + L_CCNT);
    int* qinf = (int*)(lds + L_QINF);

    for (int i = tid; i < 64 * MPITCH; i += 512) hist[i] = 0u;
    for (int i = tid; i < 2048; i += 512) ((float*)(lds + L_MTAB))[i] = ((i >> 3) >> (i & 7)) & 1 ? 0.f : -1e30f;
    bf16x8 qf[8][2]; bf16x8 ql[2][2]; float wi[8]; float inv, fb0c;
    {
        const bf16_t* qp = Hb + (long)t * HP + HQI + 8 * hq;
#pragma unroll
        for (int hd = 0; hd < 8; ++hd)
#pragma unroll
            for (int ks = 0; ks < 2; ++ks) qf[hd][ks] = *(const bf16x8*)(qp + hd * 64 + ks * 32);
        const float* sp = side + ((long)b * T + t) * 24;
        const f32x4 w0 = *(const f32x4*)sp, w1 = *(const f32x4*)(sp + 4);
        wi[0] = w0[0]; wi[1] = w0[1]; wi[2] = w0[2]; wi[3] = w0[3]; wi[4] = w1[0]; wi[5] = w1[1]; wi[6] = w1[2]; wi[7] = w1[3];
        float n2 = 0.f;
#pragma unroll
        for (int i = 0; i < 8; ++i) n2 = fmaf(wi[i], wi[i], n2);
        const float nrm = fmaxf(SIG_UNIT * sqrtf(n2), 1e-30f);
        inv = 64.f / nrm;
        fb0c = 256.f - 64.f * 3.19f * (wi[0] + wi[1] + wi[2] + wi[3] + wi[4] + wi[5] + wi[6] + wi[7]) / nrm;
#pragma unroll
        for (int i = 0; i < 8; ++i) wi[i] *= 0.5f;
#pragma unroll
        for (int ks = 0; ks < 2; ++ks) {
            float ql_f[8];
#pragma unroll
            for (int j = 0; j < 8; ++j) ql_f[j] = 0.f;
#pragma unroll
            for (int hd = 0; hd < 8; ++hd) {
                const u32x4 qv = __builtin_bit_cast(u32x4, qf[hd][ks]);
                ql_f[0] = fmaf(wi[hd], bflo(qv.x), ql_f[0]); ql_f[1] = fmaf(wi[hd], bfhi(qv.x), ql_f[1]); ql_f[2] = fmaf(wi[hd], bflo(qv.y), ql_f[2]); ql_f[3] = fmaf(wi[hd], bfhi(qv.y), ql_f[3]);
                ql_f[4] = fmaf(wi[hd], bflo(qv.z), ql_f[4]); ql_f[5] = fmaf(wi[hd], bfhi(qv.z), ql_f[5]); ql_f[6] = fmaf(wi[hd], bflo(qv.w), ql_f[6]); ql_f[7] = fmaf(wi[hd], bfhi(qv.w), ql_f[7]);
            }
            u32x4 hi4; hi4.x = pk2(ql_f[0], ql_f[1]); hi4.y = pk2(ql_f[2], ql_f[3]); hi4.z = pk2(ql_f[4], ql_f[5]); hi4.w = pk2(ql_f[6], ql_f[7]);
            u32x4 lo4;
            lo4.x = pk2(ql_f[0] - bflo(hi4.x), ql_f[1] - bfhi(hi4.x)); lo4.y = pk2(ql_f[2] - bflo(hi4.y), ql_f[3] - bfhi(hi4.y));
            lo4.z = pk2(ql_f[4] - bflo(hi4.z), ql_f[5] - bfhi(hi4.z)); lo4.w = pk2(ql_f[6] - bflo(hi4.w), ql_f[7] - bfhi(hi4.w));
            ql[0][ks] = __builtin_bit_cast(bf16x8, hi4); ql[1][ks] = __builtin_bit_cast(bf16x8, lo4);
        }
    }
    const int ntile = (t0 + 64 + 127) >> 7;
    const int tmaxw = t0 + qg * 16 + 15;
    __syncthreads();
    int nit = 0;
    { const int v = tmaxw - kh * 64; if (v >= 0) nit = 2 * (v >> 7) + (((v & 127) >= 32) ? 2 : 1); }
    float fa = inv, fbias = fb0c;
    bool active = true;
#pragma unroll 1
    for (int level = 0; level < 2; ++level) {
        unsigned* hbase = level ? cand : hist;
        const bool wave_on = __any(active);
        if (wave_on) {
            const unsigned incv = 1u << ((qloc & 1) * 16);
            unsigned* hrow = hbase + (qloc >> 1) * HPITCH;
            bf16x8 kf[2][2];
            idx_loadk(Hb, kh * 64, lane, kf);
#pragma unroll 1
            for (int it = 0; it < nit; ++it) {
                const int s0 = (it >> 1) * 128 + kh * 64 + (it & 1) * 32;
                const int itn = (it + 1 < nit) ? it + 1 : it;
                bf16x8 kn[2][2];
                idx_loadk(Hb, (itn >> 1) * 128 + kh * 64 + (itn & 1) * 32, lane, kn);
                float score[8];
                idx_scores(kf, qf, ql, wi, score);
                if (s0 + 31 <= t0 + qg * 16) {
#pragma unroll
                    for (int i = 0; i < 8; ++i) { const unsigned bin = (unsigned)__builtin_amdgcn_fmed3f(fmaf(score[i], fa, fbias), 0.f, 511.5f); atomicAdd(hrow + bin, incv); }
                } else {
#pragma unroll
                    for (int i = 0; i < 8; ++i) {
                        const int s = s0 + (i >> 2) * 16 + hq * 4 + (i & 3);
                        if (s <= t) { const unsigned bin = (unsigned)__builtin_amdgcn_fmed3f(fmaf(score[i], fa, fbias), 0.f, 511.5f); atomicAdd(hrow + bin, incv); }
                    }
                }
#pragma unroll
                for (int kb = 0; kb < 2; ++kb)
#pragma unroll
                    for (int ks = 0; ks < 2; ++ks) kf[kb][ks] = kn[kb][ks];
            }
        }
        __syncthreads();
#pragma unroll 1
        for (int qq = 0; qq < 8; ++qq) {
            const int q = w * 8 + qq;
            if (level && !qinf[q * 4 + 3]) continue;
            const u32x4 wa = *(const u32x4*)(hbase + (q >> 1) * HPITCH + 8 * lane), wb = *(const u32x4*)(hbase + (q >> 1) * HPITCH + 8 * lane + 4);
            const int sh = (q & 1) * 16;
            const unsigned c[8] = {(wa.x >> sh) & 0xffffu, (wa.y >> sh) & 0xffffu, (wa.z >> sh) & 0xffffu, (wa.w >> sh) & 0xffffu, (wb.x >> sh) & 0xffffu, (wb.y >> sh) & 0xffffu, (wb.z >> sh) & 0xffffu, (wb.w >> sh) & 0xffffu};
            const unsigned tot = c[0] + c[1] + c[2] + c[3] + c[4] + c[5] + c[6] + c[7];
            unsigned S = tot;
#pragma unroll
            for (int o = 1; o < 64; o <<= 1) { const unsigned dn = (unsigned)bperm_i((lane + o) & 63, (int)S); if (lane + o < 64) S += dn; }
            const unsigned total = (unsigned)__builtin_amdgcn_readfirstlane((int)S);
            const u64 bal = __ballot(S >= 256u);
            int b1 = -1, r1 = 0, n1 = 0;
            if (total >= 256u) {
                const int Ls = 63 - __clzll(bal);
                unsigned cum = S - tot; bool found = false; int lb = -1, lr = 0, ln = 0;
#pragma unroll
                for (int j = 7; j >= 0; --j) { const bool hit = !found && (cum + c[j] >= 256u); if (hit) { lb = 8 * lane + j; lr = 256 - (int)cum; ln = (int)c[j]; found = true; } cum += c[j]; }
                b1 = bperm_i(Ls, lb); r1 = bperm_i(Ls, lr); n1 = bperm_i(Ls, ln);
            }
            if (lane == 0) { qinf[q * 4] = b1; qinf[q * 4 + 1] = r1; qinf[q * 4 + 2] = n1; }
        }
        __syncthreads();
        if (level == 0) { for (int i = tid; i < 64 * MPITCH; i += 512) hist[i] = 0u; }
        if (tid == 0) qinf[256] = 0;
        __syncthreads();
        if (wave_on) {
            const int b1 = qinf[qloc * 4];
            const float fsel = !active ? __builtin_inff() : ((b1 < 0) ? -__builtin_inff() : ((b1 >= 511) ? __builtin_inff() : (float)(b1 + 1)));
            const float fcand = !active ? __builtin_inff() : ((b1 <= 0) ? -__builtin_inff() : (float)b1);
            const float fb1 = (float)(b1 < 0 ? 0 : b1);
            unsigned* cslot = cand + (qloc * 8 + kh * 4 + hq) * SUBCAP; int ncand = 0;
            bf16x8 kf[2][2];
            idx_loadk(Hb, kh * 64, lane, kf);
#pragma unroll 1
            for (int it = 0; it < nit; ++it) {
                const int s0 = (it >> 1) * 128 + kh * 64 + (it & 1) * 32;
                const int itn = (it + 1 < nit) ? it + 1 : it;
                bf16x8 kn[2][2];
                idx_loadk(Hb, (itn >> 1) * 128 + kh * 64 + (itn & 1) * 32, lane, kn);
                float score[8];
                idx_scores(kf, qf, ql, wi, score);
                unsigned m0 = 0u;
                if (s0 + 31 <= t0 + qg * 16) {
#pragma unroll
                    for (int i = 0; i < 8; ++i) {
                        const int rr = (i >> 2) * 16 + hq * 4 + (i & 3), s = s0 + rr;
                        const float fb = fmaf(score[i], fa, fbias);
                        if (fb >= fcand) {
                            if (fb >= fsel) m0 |= 1u << (16 * (hq & 1) + 4 * (hq >> 1) + (i & 3) + 8 * (i >> 2));
                            else {
                                const unsigned q19 = (unsigned)__builtin_amdgcn_fmed3f((fb - fb1) * 524288.f, 0.f, 524287.f);
                                if (ncand < SUBCAP) cslot[ncand] = (q19 << 13) | (unsigned)(8191 - s);
                                ++ncand;
                            }
                        }
                    }
                } else {
#pragma unroll
                    for (int i = 0; i < 8; ++i) {
                        const int rr = (i >> 2) * 16 + hq * 4 + (i & 3), s = s0 + rr;
                        const float fb = fmaf(score[i], fa, fbias);
                        if (fb >= fcand && s <= t) {
                            if (fb >= fsel) m0 |= 1u << (16 * (hq & 1) + 4 * (hq >> 1) + (i & 3) + 8 * (i >> 2));
                            else {
                                const unsigned q19 = (unsigned)__builtin_amdgcn_fmed3f((fb - fb1) * 524288.f, 0.f, 524287.f);
                                if (ncand < SUBCAP) cslot[ncand] = (q19 << 13) | (unsigned)(8191 - s);
                                ++ncand;
                            }
                        }
                    }
                }
                if (m0) atomicOr(&hist[qloc * MPITCH + (s0 >> 5)], m0);
#pragma unroll
                for (int kb = 0; kb < 2; ++kb)
#pragma unroll
                    for (int ks = 0; ks < 2; ++ks) kf[kb][ks] = kn[kb][ks];
            }
            ccnt[qloc * 8 + kh * 4 + hq] = (unsigned)ncand;
        } else ccnt[qloc * 8 + kh * 4 + hq] = 0u;
        __syncthreads();
#pragma unroll 1
        for (int qq = 0; qq < 8; ++qq) {
            const int q = w * 8 + qq;
            if (level && !qinf[q * 4 + 3]) continue;
            const int r1 = qinf[q * 4 + 1];
            const int wr_ = lane >> 3, sl0 = (lane & 7) * 4;
            int cw = (int)ccnt[q * 8 + wr_];
            const bool ovf = __any(cw > SUBCAP) && (level == 0);
            if (lane == 0) { qinf[q * 4 + 3] = ovf ? 1 : 0; if (ovf) qinf[256] = 1; }
            if (ovf || r1 <= 0) continue;
            if (cw > SUBCAP) cw = SUBCAP;
            const u32x4 mine = *(const u32x4*)(cand + (q * 8 + wr_) * SUBCAP + sl0);
            int rk0 = 0, rk1 = 0, rk2 = 0, rk3 = 0;
#pragma unroll 1
            for (int ww = 0; ww < 8; ++ww) {
                int cn = (int)ccnt[q * 8 + ww]; if (cn > SUBCAP) cn = SUBCAP;
                const unsigned* cl = cand + (q * 8 + ww) * SUBCAP;
#pragma unroll 1
                for (int j = 0; j < cn; ++j) { const unsigned cv = cl[j]; rk0 += (cv > mine.x); rk1 += (cv > mine.y); rk2 += (cv > mine.z); rk3 += (cv > mine.w); }
            }
            if (sl0 + 0 < cw && rk0 < r1) { const int s = 8191 - (int)(mine.x & 8191u); atomicOr(&hist[q * MPITCH + (s >> 5)], 1u << mpos(s & 31)); }
            if (sl0 + 1 < cw && rk1 < r1) { const int s = 8191 - (int)(mine.y & 8191u); atomicOr(&hist[q * MPITCH + (s >> 5)], 1u << mpos(s & 31)); }
            if (sl0 + 2 < cw && rk2 < r1) { const int s = 8191 - (int)(mine.z & 8191u); atomicOr(&hist[q * MPITCH + (s >> 5)], 1u << mpos(s & 31)); }
            if (sl0 + 3 < cw && rk3 < r1) { const int s = 8191 - (int)(mine.w & 8191u); atomicOr(&hist[q * MPITCH + (s >> 5)], 1u << mpos(s & 31)); }
        }
        __syncthreads();
        if (level == 1 || qinf[256] == 0) break;
        {
            const bool mine_ovf = qinf[qloc * 4 + 3] != 0;
            const int b1 = qinf[qloc * 4];
            active = mine_ovf;
            fa = mine_ovf ? inv * 510.f : 0.f;
            fbias = mine_ovf ? fmaf(fb0c - (float)b1, 510.f, 1.f) : -1.f;
        }
        for (int i = tid; i < 32 * HPITCH; i += 512) cand[i] = 0u;
        __syncthreads();
    }
    for (int rep2_ = ((PROBE_PHASE == 41) ? 0 : 1); rep2_ < 2; ++rep2_) {
        const bool dry2 = dry || ((PROBE_PHASE == 41) && (rep2_ == 0) && (p.pos[0] == 0));
        const int head = w, r32 = lane & 31, hh = lane >> 5;
        bf16x8 qfr[2][4];
        float q1 = 0.f;
#pragma unroll
        for (int qb = 0; qb < 2; ++qb) {
            float qa = 0.f;
#pragma unroll
            for (int ks = 0; ks < 4; ++ks) {
                qfr[qb][ks] = *(const bf16x8*)(Hb + (long)(t0 + qb * 32 + r32) * HP + HQ + head * 64 + ks * 16 + 8 * hh);
                const u32x4 qv = __builtin_bit_cast(u32x4, qfr[qb][ks]);
                qa += fabsf(bflo(qv.x)) + fabsf(bfhi(qv.x)) + fabsf(bflo(qv.y)) + fabsf(bfhi(qv.y)) + fabsf(bflo(qv.z)) + fabsf(bfhi(qv.z)) + fabsf(bflo(qv.w)) + fabsf(bfhi(qv.w));
            }
            q1 = fmaxf(q1, qa);
        }
        q1 += sxor_f(q1, lane, 32);
#pragma unroll
        for (int o = 16; o >= 1; o >>= 1) q1 = fmaxf(q1, sxor_f(q1, lane, o));
        const float kmx = __uint_as_float(((const unsigned*)(p.ws + WS_KMAX))[b * 8 + head]);
        const bool fast = (q1 * kmx * 1.02f) < 100.f;
        f32x16 O[2][2];
#pragma unroll
        for (int a = 0; a < 2; ++a)
#pragma unroll
            for (int c2 = 0; c2 < 2; ++c2)
#pragma unroll
                for (int i = 0; i < 16; ++i) O[a][c2][i] = 0.f;
        float mrun[2] = {-1e30f, -1e30f}, lrun[2] = {0.f, 0.f};
        const bf16_t* Kp = (const bf16_t*)(p.ws + WS_KF) + ((long)(b * 8 + head) * 256 * 4 * 64 + lane) * 8;
        const bf16_t* Vp = (const bf16_t*)(p.ws + WS_VT) + ((long)(b * 8 + head) * 256 * 4 * 64 + lane) * 8;
        const int nt32 = (t0 + 64) >> 5;
        if (fast) attn_loop<true>(Kp, Vp, qfr, O, mrun, lrun, hist, (const float*)(lds + L_MTAB), r32, hh, nt32, dry2);
        else attn_loop<false>(Kp, Vp, qfr, O, mrun, lrun, hist, (const float*)(lds + L_MTAB), r32, hh, nt32, dry2);
#pragma unroll
        for (int qb = 0; qb < 2; ++qb) {
            const float lt = lrun[qb] + sxor_f(lrun[qb], lane, 32);
            const float il = 1.f / lt;
            bf16_t* gp = H + ((long)b * T + t0 + qb * 32 + r32) * HP + HAG + head * 64 + 4 * hh;
#pragma unroll
            for (int db = 0; db < 2; ++db)
#pragma unroll
                for (int g4 = 0; g4 < 4; ++g4) {
                    bf16_t* gq = gp + db * 32 + 8 * g4;
                    const u32x2 gv = *(const u32x2*)gq;
                    u32x2 wv;
                    wv.x = pk2(O[db][qb][4 * g4] * il * silu_f(bflo(gv.x)), O[db][qb][4 * g4 + 1] * il * silu_f(bfhi(gv.x)));
                    wv.y = pk2(O[db][qb][4 * g4 + 2] * il * silu_f(bflo(gv.y)), O[db][qb][4 * g4 + 3] * il * silu_f(bfhi(gv.y)));
                    if (!dry2) *(u32x2*)gq = wv;
                }
        }
    }
    __syncthreads();
}

__device__ __forceinline__ void gbar(unsigned* ctr, unsigned target) {
    __syncthreads();
    if (threadIdx.x == 0) {
        __builtin_amdgcn_fence(__ATOMIC_RELEASE, "agent");
        __hip_atomic_fetch_add(ctr, 1u, __ATOMIC_RELAXED, __HIP_MEMORY_SCOPE_AGENT);
        while (__hip_atomic_load(ctr, __ATOMIC_RELAXED, __HIP_MEMORY_SCOPE_AGENT) < target) __builtin_amdgcn_s_sleep(2);
        __builtin_amdgcn_fence(__ATOMIC_ACQUIRE, "agent");
    }
    __syncthreads();
}

__global__ void __launch_bounds__(512) fwd_megakernel(Params p0) {
    extern __shared__ __attribute__((aligned(16))) unsigned char lds[];
    cg::grid_group grid = cg::this_grid();
    const int G = gridDim.x, c = blockIdx.x;
    const int wid_s = __builtin_amdgcn_readfirstlane((int)(threadIdx.x >> 6));

    unsigned* barctr = (unsigned*)(p0.ws + WS_BAR); unsigned bar_n = 0;
    if (c == 0 && threadIdx.x == 0) __hip_atomic_store(barctr, 0u, __ATOMIC_RELAXED, __HIP_MEMORY_SCOPE_AGENT);
    for (int rep0_ = (PROBE_PHASE == 8 ? 0 : 1); rep0_ < 2; ++rep0_) prologue(p0, (long)c * 512 + threadIdx.x, (long)G * 512);
    grid.sync();

#pragma unroll 1
    for (int layer = 0; layer < DEPTH; ++layer) {
        Params p = p0;
        { size_t zoff = 0; asm volatile("" : "+s"(zoff)); p.ws = p0.ws + zoff; }
        bf16_t* H = (bf16_t*)(p.ws + WS_H);
        {
for (int rep_ = (PROBE_PHASE == 1 ? 0 : 1); rep_ < 2; ++rep_) { const bool dry = (PROBE_PHASE == 1) && (rep_ == 0) && (p.pos[0] == 0);
            EpiIn e; e.H = H; e.side = (float*)(p.ws + WS_SIDE); e.rope = (const float*)(p.ws + WS_ROPE); e.VT = (bf16_t*)(p.ws + WS_VT); e.KF = (bf16_t*)(p.ws + WS_KF); e.kmax = (unsigned*)(p.ws + WS_KMAX); e.dry = dry;
            const bf16_t* A = (const bf16_t*)(p.ws + WS_XB);
            const bf16_t* Bt = (const bf16_t*)(p.ws + WS_WIN) + (long)layer * NPAD * 1024;
#pragma unroll 1
            for (int L = c; L < 128 * 17; L += G) { int pm, pn; tile_of(L, 128, 17, pm, pn); gemm_tile((LAS unsigned char*)lds, A, 1024, Bt, 1024, pm, pn, e, wid_s); }
}
        }
        gbar(barctr, (++bar_n) * (unsigned)G); if (PROBE_PHASE == 9) gbar(barctr, (++bar_n) * (unsigned)G);
        {
for (int rep_ = (PROBE_PHASE == 2 ? 0 : 1); rep_ < 2; ++rep_) { const bool dry = (PROBE_PHASE == 2) && (rep_ == 0) && (p.pos[0] == 0);
            const int tid = otid(wid_s), lane = tid & 63, w = tid >> 6;
#pragma unroll 1
            for (int g = c; g < 256; g += G) gla_local_item(p, layer, g * 8 + w, lane, dry);
}
        }
for (int rep_ = (PROBE_PHASE == 3 ? 0 : 1); rep_ < 2; ++rep_) { const bool dry = (PROBE_PHASE == 3) && (rep_ == 0) && (p.pos[0] == 0);
#pragma unroll 1
        for (int tile = c; tile < 512; tile += G) conformer_tile(p, layer, lds, tile, dry, wid_s);
}
        gbar(barctr, (++bar_n) * (unsigned)G); if (PROBE_PHASE == 9) gbar(barctr, (++bar_n) * (unsigned)G);
        {
            const int tid = otid(wid_s);
#pragma unroll 1
            for (int g = c; g < 64; g += G) gla_scan(p, g * 512 + tid);
        }
for (int rep_ = (PROBE_PHASE == 4 ? 0 : 1); rep_ < 2; ++rep_) { const bool dry = (PROBE_PHASE == 4) && (rep_ == 0) && (p.pos[0] == 0);
#pragma unroll 1
        for (int it = c; it < 512; it += G) {
            const int pr = it >> 1, second = it & 1;
            const int xcd = pr & 7, j = pr >> 3, b = xcd >> 1, par = xcd & 1;
            const int qblk = second ? (2 * j + par) : 127 - (2 * j + par);
            dsa_item(p, lds, b, qblk, dry, wid_s);
        }
}
        gbar(barctr, (++bar_n) * (unsigned)G); if (PROBE_PHASE == 9) gbar(barctr, (++bar_n) * (unsigned)G);
        {
for (int rep_ = (PROBE_PHASE == 5 ? 0 : 1); rep_ < 2; ++rep_) { const bool dry = (PROBE_PHASE == 5) && (rep_ == 0) && (p.pos[0] == 0);
            const int tid = otid(wid_s), lane = tid & 63, w = tid >> 6;
#pragma unroll 1
            for (int g = c; g < 256; g += G) gla_out_item(p, layer, lds + w * 16384, g * 8 + w, lane, dry);
}
        }
        gbar(barctr, (++bar_n) * (unsigned)G); if (PROBE_PHASE == 9) gbar(barctr, (++bar_n) * (unsigned)G);
        {
for (int rep_ = (PROBE_PHASE == 6 ? 0 : 1); rep_ < 2; ++rep_) { const bool dry = (PROBE_PHASE == 6) && (rep_ == 0) && (p.pos[0] == 0);
            EpiOut e; e.xres = (layer == 0) ? p.x : p.out; e.out = p.out; e.dry = dry;
            const bf16_t* A = H + HAG;
            const bf16_t* Bt = (const bf16_t*)(p.ws + WS_WOUT) + (long)layer * 1024 * 1024;
#pragma unroll 1
            for (int L = c; L < 128 * 4; L += G) { int pm, pn; tile_of(L, 128, 4, pm, pn); gemm_tile((LAS unsigned char*)lds, A, HP, Bt, 1024, pm, pn, e, wid_s); }
}
        }
        gbar(barctr, (++bar_n) * (unsigned)G); if (PROBE_PHASE == 9) gbar(barctr, (++bar_n) * (unsigned)G);
        {
for (int rep_ = (PROBE_PHASE == 7 ? 0 : 1); rep_ < 2; ++rep_) { const bool dry = (PROBE_PHASE == 7) && (rep_ == 0) && (p.pos[0] == 0);
            const int tid = otid(wid_s), lane = tid & 63, w = tid >> 6;
            ln_phase(p, layer, c * 8 + w, G * 8, lane, dry);
            if (c == 0 && tid < 32) ((unsigned*)(p.ws + WS_KMAX))[tid] = 0u;
}
        }
        gbar(barctr, (++bar_n) * (unsigned)G); if (PROBE_PHASE == 9) gbar(barctr, (++bar_n) * (unsigned)G);
    }
}

extern "C" void kernel_launch(void* const* d_in, const int* in_sizes, int n_in, void* d_out, int out_size, void* d_ws, size_t ws_size, hipStream_t stream) {
    static int grid_blocks = 0;
    if (grid_blocks == 0) {
        if (n_in != 15 || ws_size < WS_END) { fprintf(stderr, "kernel_launch: unexpected inputs (n_in %d, ws %zu < %zu)\n", n_in, ws_size, (size_t)WS_END); grid_blocks = -1; return; }
        int dev = 0, cus = 0, per_cu = 0;
        hipGetDevice(&dev);
        hipDeviceGetAttribute(&cus, hipDeviceAttributeMultiprocessorCount, dev);
        if (hipFuncSetAttribute((const void*)fwd_megakernel, hipFuncAttributeMaxDynamicSharedMemorySize, LDS_BYTES) != hipSuccess) { fprintf(stderr, "kernel_launch: hipFuncSetAttribute failed\n"); grid_blocks = -1; return; }
        hipOccupancyMaxActiveBlocksPerMultiprocessor(&per_cu, (const void*)fwd_megakernel, 512, LDS_BYTES);
        if (per_cu < 1) per_cu = 1;
        grid_blocks = cus * per_cu;
    }
    if (grid_blocks < 0) return;
    Params p{};
    p.x = (const float*)d_in[0]; p.pos = (const int*)d_in[1]; p.w_in = (const float*)d_in[2]; p.conv_w = (const float*)d_in[3]; p.conv_b = (const float*)d_in[4];
    p.cln_g = (const float*)d_in[5]; p.cln_b = (const float*)d_in[6]; p.pw_w = (const float*)d_in[7]; p.pw_b = (const float*)d_in[8];
    p.gate_w2 = (const float*)d_in[9]; p.gate_b = (const float*)d_in[10]; p.gnorm_g = (const float*)d_in[11]; p.w_out = (const float*)d_in[12];
    p.ln_g = (const float*)d_in[13]; p.ln_b = (const float*)d_in[14];
    p.out = (float*)d_out; p.ws = (unsigned char*)d_ws;
    for (int j = 0; j < 32; ++j) p.inv_freq[j] = (float)pow(10000.0, -(double)j / 32.0);
    void* args[] = {&p};
    hipError_t e = hipLaunchCooperativeKernel((const void*)fwd_megakernel, dim3(grid_blocks), dim3(512), args, LDS_BYTES, stream);
    if (e != hipSuccess) fprintf(stderr, "cooperative launch failed: %s (grid %d)\n", hipGetErrorString(e), grid_blocks);
}
```

```cpp
#include <hip/hip_runtime.h>
#include <hip/hip_cooperative_groups.h>
#include <cstdio>
#include <cmath>
namespace cg = cooperative_groups;

typedef unsigned short bf16_t;
typedef short bf16x8 __attribute__((ext_vector_type(8)));
typedef float f32x4 __attribute__((ext_vector_type(4)));
typedef float f32x16 __attribute__((ext_vector_type(16)));
typedef unsigned u32x4 __attribute__((ext_vector_type(4)));
typedef unsigned u32x2 __attribute__((ext_vector_type(2)));
typedef unsigned long long u64;

constexpr int NB = 4, T = 8192, NTOK = NB * T, DM = 1024, DIN = 4184, NPAD = 4352, HP = 4160, DEPTH = 4;
constexpr int HQ = 0, HK = 512, HV = 1024, HQI = 1536, HKI = 2048, HGLU = 2112, HCQ = 2624, HCK = 2752, HCV = 2880, HAG = 3136, HBG = 3648, HCG = 3904;
constexpr float EPS = 1e-5f;
constexpr float ALPHA = 1.6817928305074290f;
constexpr float QSCALE = 0.125f * 1.4426950408889634f;
constexpr float WI_SCALE = 0.04419417382415922f;
constexpr float SIG_UNIT = 5.66f;
constexpr int CAP = 128;

constexpr size_t WS_WIN = 0;
constexpr size_t WS_WOUT = WS_WIN + (size_t)DEPTH * NPAD * 1024 * 2;
constexpr size_t WS_PWT = WS_WOUT + (size_t)DEPTH * 1024 * 1024 * 2;
constexpr size_t WS_ROPE = WS_PWT + (size_t)DEPTH * 256 * 256 * 2;
constexpr size_t WS_XB = WS_ROPE + (size_t)NTOK * 32 * 8;
constexpr size_t WS_H = WS_XB + (size_t)NTOK * 1024 * 2;
constexpr size_t WS_SIDE = WS_H + (size_t)NTOK * HP * 2;
constexpr size_t WS_BCUM = WS_SIDE + (size_t)NTOK * 24 * 4;
constexpr size_t WS_U = WS_BCUM + (size_t)NTOK * 128 * 4;
constexpr size_t WS_DEC = WS_U + (size_t)2048 * 2048 * 4;
constexpr size_t WS_VT = WS_DEC + (size_t)2048 * 32 * 4;
constexpr size_t WS_KF = WS_VT + (size_t)NTOK * 512 * 2;
constexpr size_t WS_BAR = WS_KF + (size_t)NTOK * 512 * 2;
constexpr size_t WS_KMAX = WS_BAR + 256;
constexpr size_t WS_END = WS_KMAX + 256;

#ifndef PROBE_PHASE
#define PROBE_PHASE 0
#endif
constexpr int LDS_BYTES = 147456;

struct Params {
    const float* x; const int* pos; const float* w_in; const float* conv_w; const float* conv_b; const float* cln_g; const float* cln_b;
    const float* pw_w; const float* pw_b; const float* gate_w2; const float* gate_b; const float* gnorm_g; const float* w_out; const float* ln_g; const float* ln_b;
    float* out; unsigned char* ws;
    float inv_freq[32];
};

__device__ __forceinline__ unsigned f2bf(float f) { unsigned u = __float_as_uint(f); return (u + 0x7fffu + ((u >> 16) & 1u)) >> 16; }
__device__ __forceinline__ float bf2f(unsigned b) { return __uint_as_float(b << 16); }
typedef float f32x2_t __attribute__((ext_vector_type(2)));
typedef __bf16 bf16x2_t __attribute__((ext_vector_type(2)));
__device__ __forceinline__ unsigned pk2(float lo, float hi) { f32x2_t v = {lo, hi}; bf16x2_t b = __builtin_convertvector(v, bf16x2_t); return __builtin_bit_cast(unsigned, b); }
__device__ __forceinline__ float bflo(unsigned w) { return __uint_as_float(w << 16); }
__device__ __forceinline__ float bfhi(unsigned w) { return __uint_as_float(w & 0xffff0000u); }
__device__ __forceinline__ float silu_f(float v) { return v / (1.f + __expf(-v)); }
__device__ __forceinline__ float sigmoid_f(float v) { return 1.f / (1.f + __expf(-v)); }
__device__ __forceinline__ int bperm_i(int idx, int v) { return __builtin_amdgcn_ds_bpermute(idx << 2, v); }
__device__ __forceinline__ float sxor_f(float v, int lane, int m) { return __int_as_float(bperm_i(lane ^ m, __float_as_int(v))); }
__device__ __forceinline__ int sxor_i(int v, int lane, int m) { return bperm_i(lane ^ m, v); }
__device__ __forceinline__ float wave_sum(float v, int lane) {
#pragma unroll
    for (int o = 32; o >= 1; o >>= 1) v += sxor_f(v, lane, o);
    return v;
}
__device__ __forceinline__ int otid(int wid_s) { int l; asm volatile("v_mbcnt_lo_u32_b32 %0, -1, 0\n\tv_mbcnt_hi_u32_b32 %0, -1, %0" : "=v"(l)); return (wid_s << 6) | l; }
#define WAVE_SYNC() do { __builtin_amdgcn_fence(__ATOMIC_RELEASE, "wavefront"); __builtin_amdgcn_wave_barrier(); __builtin_amdgcn_fence(__ATOMIC_ACQUIRE, "wavefront"); } while (0)

__device__ __forceinline__ int l2orig(int l) {
    if (l < 1536) return l;
    if (l < 2048) return 2048 + (l - 1536);
    if (l < 2112) return 2560 + (l - 2048);
    if (l < 2624) return 2632 + (l - 2112);
    if (l < 2752) return 3400 + (l - 2624);
    if (l < 2880) return 3528 + (l - 2752);
    if (l < 3136) return 3656 + (l - 2880);
    if (l < 3648) return 1536 + (l - 3136);
    if (l < 3904) return 3144 + (l - 3648);
    if (l < 4160) return 3912 + (l - 3904);
    if (l < 4168) return 2624 + (l - 4160);
    if (l < 4184) return 4168 + (l - 4168);
    return -1;
}
__device__ __forceinline__ int npos2logical(int np) {
    const int hb = np & ~127, p = np & 127, wc = p >> 5, n = (p >> 4) & 1, fr = p & 15;
    return hb + (wc >> 1) * 64 + n * 32 + (wc & 1) * 16 + fr;
}

__device__ __forceinline__ void sincos_acc(float angf, float& c, float& s) {
    const double a = (double)angf;
    const double n = rint(a * 0.15915494309189535);
    double r = fma(-n, 6.283185307179586, a);
    r = fma(-n, 2.4492935982947064e-16, r);
    const double r2 = r * r;
    double ts = r, tc = 1.0, ss = r, cc = 1.0;
#pragma unroll
    for (int k = 1; k <= 14; ++k) {
        tc = -tc * r2 * (1.0 / (double)((2 * k - 1) * (2 * k)));
        ts = -ts * r2 * (1.0 / (double)((2 * k) * (2 * k + 1)));
        cc += tc; ss += ts;
    }
    c = (float)cc; s = (float)ss;
}

__device__ __forceinline__ void prologue(const Params& p, long gtid, long gthreads) {
    bf16_t* win = (bf16_t*)(p.ws + WS_WIN);
    for (long idx = gtid; idx < (long)DEPTH * 128 * NPAD; idx += gthreads) {
        const int np = (int)(idx % NPAD); const long r = idx / NPAD; const int kc = (int)(r % 128); const int l = (int)(r / 128);
        const int oc = l2orig(npos2logical(np));
        u32x4 w = {0u, 0u, 0u, 0u};
        if (oc >= 0) {
            const float* src = p.w_in + ((long)l * 1024 + kc * 8) * DIN + oc;
            float v[8];
#pragma unroll
            for (int i = 0; i < 8; ++i) v[i] = src[(long)i * DIN];
            w.x = pk2(v[0], v[1]); w.y = pk2(v[2], v[3]); w.z = pk2(v[4], v[5]); w.w = pk2(v[6], v[7]);
        }
        *(u32x4*)(win + ((long)l * NPAD + np) * 1024 + kc * 8) = w;
    }
    bf16_t* wout = (bf16_t*)(p.ws + WS_WOUT);
    for (long idx = gtid; idx < (long)DEPTH * 128 * 1024; idx += gthreads) {
        const int n = (int)(idx % 1024); const long r = idx / 1024; const int kc = (int)(r % 128); const int l = (int)(r / 128);
        const float* src = p.w_out + ((long)l * 1024 + kc * 8) * 1024 + n;
        float v[8];
#pragma unroll
        for (int i = 0; i < 8; ++i) v[i] = src[(long)i * 1024];
        u32x4 w; w.x = pk2(v[0], v[1]); w.y = pk2(v[2], v[3]); w.z = pk2(v[4], v[5]); w.w = pk2(v[6], v[7]);
        *(u32x4*)(wout + ((long)l * 1024 + n) * 1024 + kc * 8) = w;
    }
    bf16_t* pwt = (bf16_t*)(p.ws + WS_PWT);
    for (long idx = gtid; idx < (long)DEPTH * 32 * 256; idx += gthreads) {
        const int n = (int)(idx % 256); const long r = idx / 256; const int kc = (int)(r % 32); const int l = (int)(r / 32);
        const float* src = p.pw_w + ((long)l * 256 + kc * 8) * 256 + n;
        float v[8];
#pragma unroll
        for (int i = 0; i < 8; ++i) v[i] = src[(long)i * 256];
        u32x4 w; w.x = pk2(v[0], v[1]); w.y = pk2(v[2], v[3]); w.z = pk2(v[4], v[5]); w.w = pk2(v[6], v[7]);
        *(u32x4*)(pwt + ((long)l * 256 + n) * 256 + kc * 8) = w;
    }
    float2* rope = (float2*)(p.ws + WS_ROPE);
    for (long idx = gtid; idx < (long)NTOK * 32; idx += gthreads) {
        const int j = (int)(idx & 31); const long tok = idx >> 5;
        const float ang = (float)p.pos[tok] * p.inv_freq[j];
        float c, s; sincos_acc(ang, c, s);
        rope[idx] = make_float2(c, s);
    }
    if (gtid < 32) ((unsigned*)(p.ws + WS_KMAX))[gtid] = 0u;
    bf16_t* xb = (bf16_t*)(p.ws + WS_XB);
    for (long idx = gtid; idx < (long)NTOK * 128; idx += gthreads) {
        const f32x4 a = *(const f32x4*)(p.x + idx * 8), b = *(const f32x4*)(p.x + idx * 8 + 4);
        u32x4 w; w.x = pk2(a[0], a[1]); w.y = pk2(a[2], a[3]); w.z = pk2(b[0], b[1]); w.w = pk2(b[2], b[3]);
        *(u32x4*)(xb + idx * 8) = w;
    }
}

constexpr int BM = 256, BK = 64, HALF = 128, HT = HALF * BK;
__device__ __forceinline__ int lds_byte(int r, int c) {
    int st = (r >> 4) * 2 + (c >> 5), rr = r & 15, cc = c & 31, ob = rr * 64 + cc * 2;
    return st * 1024 + (ob ^ (((ob >> 9) & 1) << 5));
}
__device__ __forceinline__ void stage_rc(int b, int& R, int& C) {
    int st = b / 1024, sb = b % 1024, swz = sb ^ (((sb >> 9) & 1) << 5);
    R = (st >> 1) * 16 + swz / 64; C = (st & 1) * 32 + (swz % 64) / 2;
}
__device__ __forceinline__ void tile_of(int L, int nM, int nN, int& pm, int& pn) {
    const int nwg = nM * nN; int wgid = L;
    { const int q = nwg / 8, r = nwg % 8, xcd = wgid % 8, off = wgid / 8; wgid = (xcd < r ? xcd * (q + 1) : r * (q + 1) + (xcd - r) * q) + off; }
    const int nig = 8 * nN, gid = wgid / nig, fm = gid * 8, gsz = (nM - fm) < 8 ? (nM - fm) : 8;
    pm = fm + ((wgid % nig) % gsz); pn = (wgid % nig) / gsz;
}

#define LAS __attribute__((address_space(3)))
template <class Epi>
__device__ __forceinline__ void gemm_tile(LAS unsigned char* lds, const bf16_t* A, int lda, const bf16_t* Bt, int K, int pm, int pn, const Epi& epi, int wid_s) {
    const int tid = otid(wid_s), wid = __builtin_amdgcn_readfirstlane(tid >> 6), lane = tid & 63, wr = wid >> 2, wc = wid & 3, fr = lane & 15, fq = lane >> 4;
    const int nt = K / BK;
    unsigned voffA[2], voffB[2];
#pragma unroll
    for (int i = 0; i < 2; ++i) { int R, C; stage_rc(tid * 16 + i * 8192, R, C); voffA[i] = (unsigned)(R * lda + C) * 2u; voffB[i] = (unsigned)(R * K + C) * 2u; }
    const size_t kstep = (size_t)(BK * 2), hstepA = (size_t)HALF * lda * 2, hstepB = (size_t)HALF * K * 2;
    const unsigned ldsw = (unsigned)wid * 1024u;
    const int aoff = lds_byte(wr * 64 + fr, fq * 8), boff = lds_byte(wc * 32 + fr, fq * 8);
    const char* cA = (const char*)A + (size_t)pm * 2 * hstepA; const char* cB = (const char*)Bt + (size_t)pn * 2 * hstepB;
#define HTB (HALF * BK * 2)
#define SA(b, h) (((b) * 2 + (h)) * HTB)
#define SB(b, h) ((4 + (b) * 2 + (h)) * HTB)
#define STAGE(bufoff, gbase, voff) do { _Pragma("unroll") for (int _i = 0; _i < 2; ++_i) \
        __builtin_amdgcn_global_load_lds((const unsigned*)((const char*)(gbase) + (voff)[_i]), (LAS unsigned*)(lds + (bufoff) + ldsw + _i * 8192), 16, 0, 0); } while (0)
#define LDA(dst, b, h) do { _Pragma("unroll") for (int m = 0; m < 4; ++m) _Pragma("unroll") for (int k = 0; k < 2; ++k) dst[m][k] = *(const LAS bf16x8*)(lds + SA(b, h) + aoff + m * 2048 + k * 1024); } while (0)
#define LDB(dst, b, h) do { _Pragma("unroll") for (int n = 0; n < 2; ++n) _Pragma("unroll") for (int k = 0; k < 2; ++k) dst[n][k] = *(const LAS bf16x8*)(lds + SB(b, h) + boff + n * 2048 + k * 1024); } while (0)
#define MMA(ai, bj, At_, Bt_) do { __builtin_amdgcn_s_setprio(1); _Pragma("unroll") for (int m = 0; m < 4; ++m) _Pragma("unroll") for (int n = 0; n < 2; ++n) _Pragma("unroll") for (int k = 0; k < 2; ++k) \
        acc[ai][bj][m][n] = __builtin_amdgcn_mfma_f32_16x16x32_bf16(Bt_[n][k], At_[m][k], acc[ai][bj][m][n], 0, 0, 0); __builtin_amdgcn_s_setprio(0); } while (0)
#define WAIT_V(n) asm volatile("s_waitcnt vmcnt(" #n ")" ::: "memory")
#define WAIT_L(n) asm volatile("s_waitcnt lgkmcnt(" #n ")" ::: "memory")
#define BAR __builtin_amdgcn_s_barrier()
#define SCHED __builtin_amdgcn_sched_barrier(0)
    f32x4 acc[2][2][4][2];
#pragma unroll
    for (int a = 0; a < 2; ++a)
#pragma unroll
        for (int b = 0; b < 2; ++b)
#pragma unroll
            for (int m = 0; m < 4; ++m)
#pragma unroll
                for (int n = 0; n < 2; ++n) acc[a][b][m][n] = (f32x4){0.f, 0.f, 0.f, 0.f};
    bf16x8 At[4][2], B0[2][2], B1[2][2];
    STAGE(SB(0, 0), cB, voffB); STAGE(SA(0, 0), cA, voffA); STAGE(SB(0, 1), cB + hstepB, voffB); STAGE(SA(0, 1), cA + hstepA, voffA);
    if (wr == 1) BAR;
    WAIT_V(4); BAR;
    STAGE(SB(1, 0), cB + kstep, voffB); STAGE(SA(1, 0), cA + kstep, voffA); STAGE(SB(1, 1), cB + hstepB + kstep, voffB);
    WAIT_V(6); BAR;
    for (int t = 0; t < nt - 2; t += 2) {
        const char* a1 = cA + (size_t)(t + 1) * kstep; const char* a2 = cA + (size_t)(t + 2) * kstep; const char* b2 = cB + (size_t)(t + 2) * kstep;
        const char* a3 = a2 + kstep; const char* b3 = b2 + kstep;
        LDB(B0, 0, 0); SCHED; LDA(At, 0, 0); STAGE(SA(1, 1), a1 + hstepA, voffA);
        WAIT_L(8); BAR; WAIT_L(0); MMA(0, 0, At, B0); BAR; SCHED;
        LDB(B1, 0, 1); STAGE(SB(0, 0), b2, voffB);
        BAR; WAIT_L(0); MMA(0, 1, At, B1); BAR;
        LDA(At, 0, 1); STAGE(SA(0, 0), a2, voffA);
        BAR; WAIT_L(0); MMA(1, 0, At, B0); BAR; SCHED;
        STAGE(SB(0, 1), b2 + hstepB, voffB);
        WAIT_V(6); BAR; MMA(1, 1, At, B1); BAR;
        LDB(B0, 1, 0); SCHED; LDA(At, 1, 0); STAGE(SA(0, 1), a2 + hstepA, voffA);
        WAIT_L(8); BAR; WAIT_L(0); MMA(0, 0, At, B0); BAR; SCHED;
        LDB(B1, 1, 1); STAGE(SB(1, 0), b3, voffB);
        BAR; WAIT_L(0); MMA(0, 1, At, B1); BAR;
        LDA(At, 1, 1); STAGE(SA(1, 0), a3, voffA);
        BAR; WAIT_L(0); MMA(1, 0, At, B0); BAR; SCHED;
        STAGE(SB(1, 1), b3 + hstepB, voffB);
        WAIT_V(6); BAR; MMA(1, 1, At, B1); BAR;
    }
    { const char* a1 = cA + (size_t)(nt - 1) * kstep;
      LDB(B0, 0, 0); LDA(At, 0, 0); STAGE(SA(1, 1), a1 + hstepA, voffA);
      BAR; WAIT_L(0); MMA(0, 0, At, B0); BAR;
      LDB(B1, 0, 1); BAR; WAIT_L(0); MMA(0, 1, At, B1); BAR;
      LDA(At, 0, 1); WAIT_V(4); BAR; WAIT_L(0); MMA(1, 0, At, B0); MMA(1, 1, At, B1); BAR; }
    { LDB(B0, 1, 0); LDA(At, 1, 0); WAIT_V(2); BAR; WAIT_L(0); MMA(0, 0, At, B0); BAR;
      LDB(B1, 1, 1); WAIT_V(0); BAR; WAIT_L(0); MMA(0, 1, At, B1); BAR;
      LDA(At, 1, 1); BAR; WAIT_L(0); MMA(1, 0, At, B0); MMA(1, 1, At, B1); BAR; }
    if (wr == 0) BAR;
    epi(acc, pm * BM, pn * BM, wr, wc, fr, fq);
#undef SA
#undef SB
#undef STAGE
#undef LDA
#undef LDB
#undef MMA
}

struct EpiIn {
    bf16_t* H; float* side; const float* rope; bf16_t* VT; bf16_t* KF; unsigned* kmax; bool dry;
    __device__ __forceinline__ void operator()(f32x4 (&acc)[2][2][4][2], int brow, int bcol, int wr, int wc, int fr, int fq) const {
#pragma unroll
        for (int bj = 0; bj < 2; ++bj) {
            const int hb = bcol + bj * HALF;
            if (hb >= 4224 || dry) continue;
            const int gbase = hb + (wc >> 1) * 64, g64 = gbase >> 6, d0 = (wc & 1) * 16 + 4 * fq;
            const bool rp = (g64 < 16) || (g64 >= 24 && g64 <= 32);
            const float qs = (g64 < 8) ? QSCALE : 1.f;
            float kabs = 0.f;
#pragma unroll
            for (int ai = 0; ai < 2; ++ai)
#pragma unroll
                for (int m = 0; m < 4; ++m) {
                    const long row = brow + ai * HALF + wr * 64 + m * 16 + fr;
                    f32x4 o1 = acc[ai][bj][m][0], o2 = acc[ai][bj][m][1];
                    if (rp) {
                        const f32x4 c0 = *(const f32x4*)(rope + (row * 32 + d0) * 2), c1 = *(const f32x4*)(rope + (row * 32 + d0) * 2 + 4);
                        const f32x4 x1 = o1, x2 = o2;
                        o1[0] = (x1[0] * c0[0] - x2[0] * c0[1]) * qs; o2[0] = (x2[0] * c0[0] + x1[0] * c0[1]) * qs;
                        o1[1] = (x1[1] * c0[2] - x2[1] * c0[3]) * qs; o2[1] = (x2[1] * c0[2] + x1[1] * c0[3]) * qs;
                        o1[2] = (x1[2] * c1[0] - x2[2] * c1[1]) * qs; o2[2] = (x2[2] * c1[0] + x1[2] * c1[1]) * qs;
                        o1[3] = (x1[3] * c1[2] - x2[3] * c1[3]) * qs; o2[3] = (x2[3] * c1[2] + x1[3] * c1[3]) * qs;
                    }
                    if (g64 >= 8 && g64 < 24) {
                        const int bb = (int)(row >> 13), tt = (int)(row & (T - 1)), tile = tt >> 5, tk = tt & 31;
                        if (g64 < 16) {
                            kabs = fmaxf(kabs, fmaxf(fmaxf(fabsf(o1[0]), fabsf(o1[1])), fmaxf(fabsf(o1[2]), fabsf(o1[3]))));
                            kabs = fmaxf(kabs, fmaxf(fmaxf(fabsf(o2[0]), fabsf(o2[1])), fmaxf(fabsf(o2[2]), fabsf(o2[3]))));
                            const long base = ((long)(bb * 8 + (g64 - 8)) * 256 + tile) * 4;
                            const int ks = d0 >> 4, hk = (d0 >> 3) & 1, j0 = d0 & 7;
                            u32x2 w1, w2; w1.x = pk2(o1[0], o1[1]); w1.y = pk2(o1[2], o1[3]); w2.x = pk2(o2[0], o2[1]); w2.y = pk2(o2[2], o2[3]);
                            const auto sx = __builtin_amdgcn_permlane16_swap(w1.x, w2.x, false, false), sy = __builtin_amdgcn_permlane16_swap(w1.y, w2.y, false, false);
                            u32x4 wv; long slot;
                            if (fq & 1) { wv.x = sx[0]; wv.y = sy[0]; wv.z = w2.x; wv.w = w2.y; slot = (base + ks + 2) * 64 + hk * 32 + tk; }
                            else { wv.x = w1.x; wv.y = w1.y; wv.z = sx[1]; wv.w = sy[1]; slot = (base + ks) * 64 + hk * 32 + tk; }
                            *(u32x4*)(KF + slot * 8) = wv;
                        } else {
                            const int s = tk >> 4, u = tk & 15, hv = (u >> 2) & 1, jv = (u >> 3) * 4 + (u & 3);
                            const long base = (((long)(bb * 8 + (g64 - 16)) * 256 + tile) * 2) * 2 + s;
                            bf16_t* v0 = VT + ((base) * 64 + hv * 32 + d0) * 8 + jv;
                            bf16_t* v1 = VT + ((base + 2) * 64 + hv * 32 + d0) * 8 + jv;
#pragma unroll
                            for (int j = 0; j < 4; ++j) { v0[j * 8] = (bf16_t)f2bf(o1[j]); v1[j * 8] = (bf16_t)f2bf(o2[j]); }
                        }
                    } else if (gbase < 4160) {
                        bf16_t* hp = H + row * HP + gbase + d0;
                        u32x2 w1, w2; w1.x = pk2(o1[0], o1[1]); w1.y = pk2(o1[2], o1[3]); w2.x = pk2(o2[0], o2[1]); w2.y = pk2(o2[2], o2[3]);
                        const auto sx = __builtin_amdgcn_permlane16_swap(w1.x, w2.x, false, false), sy = __builtin_amdgcn_permlane16_swap(w1.y, w2.y, false, false);
                        u32x4 wv;
                        if (fq & 1) { wv.x = sx[0]; wv.y = sy[0]; wv.z = w2.x; wv.w = w2.y; hp += 32 - 4; }
                        else { wv.x = w1.x; wv.y = w1.y; wv.z = sx[1]; wv.w = sy[1]; }
                        *(u32x4*)hp = wv;
                    } else if (d0 < 8) { *(f32x4*)(side + row * 24 + d0) = o1 * WI_SCALE; }
                    else if (d0 < 24) { *(f32x4*)(side + row * 24 + d0) = o1; }
                }
            if (g64 >= 8 && g64 < 16) {
#pragma unroll
                for (int o = 32; o >= 1; o >>= 1) kabs = fmaxf(kabs, sxor_f(kabs, fq * 16 + fr, o));
                if ((threadIdx.x & 63) == 0) atomicMax(kmax + (brow >> 13) * 8 + (g64 - 8), __float_as_uint(kabs));
            }
        }
    }
};
struct EpiOut {
    const float* xres; float* out; bool dry;
    __device__ __forceinline__ void operator()(f32x4 (&acc)[2][2][4][2], int brow, int bcol, int wr, int wc, int fr, int fq) const {
#pragma unroll
        for (int ai = 0; ai < 2; ++ai)
#pragma unroll
            for (int m = 0; m < 4; ++m)
#pragma unroll
                for (int bj = 0; bj < 2; ++bj)
#pragma unroll
                    for (int n = 0; n < 2; ++n) {
                        const long idx = (long)(brow + ai * HALF + wr * 64 + m * 16 + fr) * DM + (bcol + bj * HALF + wc * 32 + n * 16 + 4 * fq);
                        const f32x4 xr = *(const f32x4*)(xres + idx);
                        if (!dry) *(f32x4*)(out + idx) = xr * ALPHA + acc[ai][bj][m][n];
                    }
    }
};

__device__ __forceinline__ void ln_phase(const Params& p, int layer, int wave_g, int nwaves, int lane, bool dry) {
    bf16_t* xb = (bf16_t*)(p.ws + WS_XB);
    const float* g = p.ln_g + layer * DM; const float* bb = p.ln_b + layer * DM;
    for (int row = wave_g; row < NTOK; row += nwaves) {
        float* zr = p.out + (long)row * DM;
        f32x4 v[4]; float s = 0.f;
#pragma unroll
        for (int r = 0; r < 4; ++r) { v[r] = *(const f32x4*)(zr + r * 256 + lane * 4); s += v[r][0] + v[r][1] + v[r][2] + v[r][3]; }
        const float mu = wave_sum(s, lane) * (1.f / DM);
        float q = 0.f;
#pragma unroll
        for (int r = 0; r < 4; ++r)
#pragma unroll
            for (int e = 0; e < 4; ++e) { const float d = v[r][e] - mu; q += d * d; }
        const float rstd = rsqrtf(wave_sum(q, lane) * (1.f / DM) + EPS);
#pragma unroll
        for (int r = 0; r < 4; ++r) {
            const f32x4 gg = *(const f32x4*)(g + r * 256 + lane * 4), bv = *(const f32x4*)(bb + r * 256 + lane * 4);
            f32x4 y;
#pragma unroll
            for (int e = 0; e < 4; ++e) y[e] = (v[r][e] - mu) * rstd * gg[e] + bv[e];
            if (dry) continue;
            *(f32x4*)(zr + r * 256 + lane * 4) = y;
            u32x2 w; w.x = pk2(y[0], y[1]); w.y = pk2(y[2], y[3]);
            *(u32x2*)(xb + (long)row * DM + r * 256 + lane * 4) = w;
        }
    }
}

__device__ __forceinline__ void conformer_tile(const Params& p, int layer, unsigned char* lds, int tile, bool dry, int wid_s) {
    bf16_t* H = (bf16_t*)(p.ws + WS_H);
    const int tid = otid(wid_s), lane = tid & 63, w = tid >> 6;
    const int tok0 = tile * 64, b = tok0 / T, tl0 = tok0 % T;
    bf16_t* hg = (bf16_t*)lds;
    float* cv = (float*)(lds + 49152);
    for (int idx = tid; idx < 94 * 32; idx += 512) {
        const int r = idx >> 5, cc = (idx & 31) * 8, tl = tl0 - 30 + r;
        u32x4 o = {0u, 0u, 0u, 0u};
        if (tl >= 0) {
            const bf16_t* src = H + ((long)b * T + tl) * HP + HGLU + cc;
            const u32x4 va = *(const u32x4*)src, ga = *(const u32x4*)(src + 256);
            o.x = pk2(bflo(va.x) * sigmoid_f(bflo(ga.x)), bfhi(va.x) * sigmoid_f(bfhi(ga.x)));
            o.y = pk2(bflo(va.y) * sigmoid_f(bflo(ga.y)), bfhi(va.y) * sigmoid_f(bfhi(ga.y)));
            o.z = pk2(bflo(va.z) * sigmoid_f(bflo(ga.z)), bfhi(va.z) * sigmoid_f(bfhi(ga.z)));
            o.w = pk2(bflo(va.w) * sigmoid_f(bflo(ga.w)), bfhi(va.w) * sigmoid_f(bfhi(ga.w)));
        }
        *(u32x4*)(hg + r * 256 + cc) = o;
    }
    __syncthreads();
    {
        const int c = tid & 255, half = tid >> 8;
        const float* cw = p.conv_w + (long)layer * 31 * 256 + c;
        float wj[31];
#pragma unroll
        for (int j = 0; j < 31; ++j) wj[j] = cw[j * 256];
        const float cb = p.conv_b[layer * 256 + c];
        float win[62];
#pragma unroll
        for (int r = 0; r < 62; ++r) win[r] = bf2f(hg[(half * 32 + r) * 256 + c]);
#pragma unroll
        for (int tt = 0; tt < 32; ++tt) {
            float a = cb;
#pragma unroll
            for (int j = 0; j < 31; ++j) a = fmaf(win[tt + j], wj[j], a);
            cv[(half * 32 + tt) * 256 + c] = a;
        }
    }
    __syncthreads();
    bf16_t* at = (bf16_t*)lds;
    {
        const f32x4 gg = *(const f32x4*)(p.cln_g + layer * 256 + lane * 4), bv = *(const f32x4*)(p.cln_b + layer * 256 + lane * 4);
#pragma unroll
        for (int tt = 0; tt < 8; ++tt) {
            const int t = w * 8 + tt;
            const f32x4 v = *(const f32x4*)(cv + t * 256 + lane * 4);
            const float mu = wave_sum(v[0] + v[1] + v[2] + v[3], lane) * (1.f / 256.f);
            float q = 0.f;
#pragma unroll
            for (int e = 0; e < 4; ++e) { const float d = v[e] - mu; q += d * d; }
            const float rstd = rsqrtf(wave_sum(q, lane) * (1.f / 256.f) + EPS);
            float y[4];
#pragma unroll
            for (int e = 0; e < 4; ++e) y[e] = silu_f((v[e] - mu) * rstd * gg[e] + bv[e]);
            u32x2 o; o.x = pk2(y[0], y[1]); o.y = pk2(y[2], y[3]);
            *(u32x2*)(at + t * 264 + lane * 4) = o;
        }
    }
    __syncthreads();
    {
        f32x16 acc0 = {}, acc1 = {};
        const bf16_t* pwt = (const bf16_t*)(p.ws + WS_PWT) + (long)layer * 65536 + (w * 32 + (lane & 31)) * 256 + 8 * (lane >> 5);
        const bf16_t* ap = at + (lane & 31) * 264 + 8 * (lane >> 5);
#pragma unroll 4
        for (int ks = 0; ks < 16; ++ks) {
            const bf16x8 bfr = *(const bf16x8*)(pwt + ks * 16);
            const bf16x8 a0 = *(const bf16x8*)(ap + ks * 16), a1 = *(const bf16x8*)(ap + 32 * 264 + ks * 16);
            acc0 = __builtin_amdgcn_mfma_f32_32x32x16_bf16(a0, bfr, acc0, 0, 0, 0);
            acc1 = __builtin_amdgcn_mfma_f32_32x32x16_bf16(a1, bfr, acc1, 0, 0, 0);
        }
        const int ch = w * 32 + (lane & 31);
        const float pb = p.pw_b[layer * 256 + ch];
#pragma unroll
        for (int i = 0; i < 16; ++i) {
            const int row = (i & 3) + 8 * (i >> 2) + 4 * (lane >> 5);
            bf16_t* g0 = H + (long)(tok0 + row) * HP + HBG + ch;
            bf16_t* g1 = H + (long)(tok0 + 32 + row) * HP + HBG + ch;
            const unsigned r0 = f2bf((acc0[i] + pb) * silu_f(bf2f(*g0))), r1 = f2bf((acc1[i] + pb) * silu_f(bf2f(*g1)));
            if (!dry) { *g0 = (bf16_t)r0; *g1 = (bf16_t)r1; }
        }
    }
    __syncthreads();
}

__device__ __forceinline__ float rdlane(float v, int l) { return __uint_as_float(__builtin_amdgcn_readlane(__float_as_uint(v), l)); }

__device__ __forceinline__ void gla_local_item(const Params& p, int layer, int item_, int lane, bool dry) {
    const int item = __builtin_amdgcn_readfirstlane(item_);
    bf16_t* H = (bf16_t*)(p.ws + WS_H);
    const float* side = (const float*)(p.ws + WS_SIDE);
    float* bcum = (float*)(p.ws + WS_BCUM); float* U = (float*)(p.ws + WS_U); float* DEC = (float*)(p.ws + WS_DEC);
    const int bh = item >> 7, c = item & 127, b = bh >> 2, h = bh & 3;
    const long tok0 = (long)b * T + c * 64, tok = tok0 + lane;
    float clr[16];
#pragma unroll
    for (int r = 0; r < 4; ++r) { const f32x4 v = *(const f32x4*)(side + tok * 24 + 8 + r * 4); clr[r * 4] = v[0]; clr[r * 4 + 1] = v[1]; clr[r * 4 + 2] = v[2]; clr[r * 4 + 3] = v[3]; }
    const float* gw = p.gate_w2 + (long)layer * 16 * 128 + h * 32; const float* gb = p.gate_b + layer * 128 + h * 32;
    float* bcp = bcum + tok * 128 + h * 32;
#pragma unroll 1
    for (int d = 0; d < 32; ++d) {
        float z = gb[d];
#pragma unroll
        for (int r = 0; r < 16; ++r) z = fmaf(clr[r], gw[r * 128 + d], z);
        float g = (fminf(z, 0.f) - __logf(1.f + __expf(-fabsf(z)))) * (1.f / 16.f);
#pragma unroll
        for (int o = 1; o < 64; o <<= 1) { const float up = __int_as_float(bperm_i((lane - o) & 63, __float_as_int(g))); if (lane >= o) g += up; }
        bcp[d] = g;
    }
    float bc[32];
#pragma unroll
    for (int r = 0; r < 8; ++r) { const f32x4 v = *(const f32x4*)(bcp + r * 4); bc[r * 4] = v[0]; bc[r * 4 + 1] = v[1]; bc[r * 4 + 2] = v[2]; bc[r * 4 + 3] = v[3]; }
    float kk[32];
    {
        const bf16_t* kp = H + tok * HP + HCK + h * 32;
#pragma unroll
        for (int r = 0; r < 4; ++r) {
            const u32x4 kv = *(const u32x4*)(kp + r * 8);
            kk[r * 8 + 0] = bflo(kv.x); kk[r * 8 + 1] = bfhi(kv.x); kk[r * 8 + 2] = bflo(kv.y); kk[r * 8 + 3] = bfhi(kv.y);
            kk[r * 8 + 4] = bflo(kv.z); kk[r * 8 + 5] = bfhi(kv.z); kk[r * 8 + 6] = bflo(kv.w); kk[r * 8 + 7] = bfhi(kv.w);
        }
#pragma unroll
        for (int d = 0; d < 32; ++d) { const float bl = rdlane(bc[d], 63); kk[d] *= __expf(bl - bc[d]); }
    }
    float acc[32];
#pragma unroll
    for (int d = 0; d < 32; ++d) acc[d] = 0.f;
    const bf16_t* vp = H + tok0 * HP + HCV + h * 64 + lane;
#pragma unroll 1
    for (int t8 = 0; t8 < 64; t8 += 8) {
        float vv[8];
#pragma unroll
        for (int u = 0; u < 8; ++u) vv[u] = bf2f(vp[(long)(t8 + u) * HP]);
#pragma unroll
        for (int u = 0; u < 8; ++u)
#pragma unroll
            for (int d = 0; d < 32; ++d) acc[d] = fmaf(rdlane(kk[d], t8 + u), vv[u], acc[d]);
    }
#pragma unroll
    for (int d = 0; d < 32; ++d) if (!dry) U[(long)item * 2048 + d * 64 + lane] = acc[d];
    if (lane == 63) {
#pragma unroll
        for (int r = 0; r < 8; ++r) { f32x4 v = {__expf(bc[r * 4]), __expf(bc[r * 4 + 1]), __expf(bc[r * 4 + 2]), __expf(bc[r * 4 + 3])}; *(f32x4*)(DEC + item * 32 + r * 4) = v; }
    }
}

__device__ __forceinline__ void gla_scan(const Params& p, int gt) {
    float* U = (float*)(p.ws + WS_U); const float* DEC = (const float*)(p.ws + WS_DEC);
    const int bh = gt >> 11, de = gt & 2047, d = de >> 6;
    float s = 0.f;
    for (int c0 = 0; c0 < 128; c0 += 32) {
        float u[32], dc[32];
#pragma unroll
        for (int i = 0; i < 32; ++i) { u[i] = U[(long)(bh * 128 + c0 + i) * 2048 + de]; dc[i] = DEC[(bh * 128 + c0 + i) * 32 + d]; }
#pragma unroll
        for (int i = 0; i < 32; ++i) { U[(long)(bh * 128 + c0 + i) * 2048 + de] = s; s = fmaf(dc[i], s, u[i]); }
    }
}

__device__ __forceinline__ void gla_out_item(const Params& p, int layer, unsigned char* ldsw, int item_, int lane, bool dry) {
    const int item = __builtin_amdgcn_readfirstlane(item_);
    bf16_t* H = (bf16_t*)(p.ws + WS_H);
    const float* bcum = (const float*)(p.ws + WS_BCUM); const float* U = (const float*)(p.ws + WS_U);
    float* sA = (float*)ldsw; bf16_t* sV = (bf16_t*)(ldsw + 8192);
    const int bh = item >> 7, c = item & 127, b = bh >> 2, h = bh & 3;
    const long tok = (long)b * T + c * 64 + lane;
#pragma unroll
    for (int r = 0; r < 8; ++r) *(f32x4*)(sA + r * 256 + lane * 4) = *(const f32x4*)(U + (long)item * 2048 + r * 256 + lane * 4);
#pragma unroll
    for (int r = 0; r < 8; ++r) *(u32x4*)(sV + lane * 64 + r * 8) = *(const u32x4*)(H + tok * HP + HCV + h * 64 + r * 8);
    WAVE_SYNC();
    float o[64];
#pragma unroll
    for (int e = 0; e < 64; ++e) o[e] = 0.f;
    {
        const bf16_t* qp = H + tok * HP + HCQ + h * 32; const float* bp = bcum + tok * 128 + h * 32;
#pragma unroll 1
        for (int d = 0; d < 32; ++d) {
            const float qd = bf2f(qp[d]) * 0.17677669529663687f * __expf(bp[d]);
#pragma unroll
            for (int e4 = 0; e4 < 16; ++e4) {
                const f32x4 s4 = *(const f32x4*)(sA + d * 64 + e4 * 4);
                o[e4 * 4] = fmaf(qd, s4[0], o[e4 * 4]); o[e4 * 4 + 1] = fmaf(qd, s4[1], o[e4 * 4 + 1]);
                o[e4 * 4 + 2] = fmaf(qd, s4[2], o[e4 * 4 + 2]); o[e4 * 4 + 3] = fmaf(qd, s4[3], o[e4 * 4 + 3]);
            }
        }
    }
    WAVE_SYNC();
    {
        const bf16_t* kp = H + tok * HP + HCK + h * 32;
#pragma unroll
        for (int r = 0; r < 4; ++r) {
            const u32x4 kv = *(const u32x4*)(kp + r * 8);
            const f32x4 b0 = *(const f32x4*)(bcum + tok * 128 + h * 32 + r * 8), b1 = *(const f32x4*)(bcum + tok * 128 + h * 32 + r * 8 + 4);
            f32x4 k0 = {bflo(kv.x) * __expf(-b0[0]), bfhi(kv.x) * __expf(-b0[1]), bflo(kv.y) * __expf(-b0[2]), bfhi(kv.y) * __expf(-b0[3])};
            f32x4 k1 = {bflo(kv.z) * __expf(-b1[0]), bfhi(kv.z) * __expf(-b1[1]), bflo(kv.w) * __expf(-b1[2]), bfhi(kv.w) * __expf(-b1[3])};
            *(f32x4*)(sA + lane * 32 + r * 8) = k0; *(f32x4*)(sA + lane * 32 + r * 8 + 4) = k1;
        }
    }
    float qe[32];
    {
        const bf16_t* qp = H + tok * HP + HCQ + h * 32;
#pragma unroll
        for (int r = 0; r < 4; ++r) {
            const u32x4 qv = *(const u32x4*)(qp + r * 8);
            const f32x4 b0 = *(const f32x4*)(bcum + tok * 128 + h * 32 + r * 8), b1 = *(const f32x4*)(bcum + tok * 128 + h * 32 + r * 8 + 4);
            const float qq[8] = {bflo(qv.x), bfhi(qv.x), bflo(qv.y), bfhi(qv.y), bflo(qv.z), bfhi(qv.z), bflo(qv.w), bfhi(qv.w)};
            const float bb[8] = {b0[0], b0[1], b0[2], b0[3], b1[0], b1[1], b1[2], b1[3]};
#pragma unroll
            for (int e = 0; e < 8; ++e) qe[r * 8 + e] = qq[e] * 0.17677669529663687f * __expf(bb[e]);
        }
    }
    WAVE_SYNC();
#pragma unroll 1
    for (int j = 0; j < 64; ++j) {
        float a = 0.f;
#pragma unroll
        for (int d4 = 0; d4 < 8; ++d4) {
            const f32x4 k4 = *(const f32x4*)(sA + j * 32 + d4 * 4);
            a = fmaf(qe[d4 * 4], k4[0], a); a = fmaf(qe[d4 * 4 + 1], k4[1], a); a = fmaf(qe[d4 * 4 + 2], k4[2], a); a = fmaf(qe[d4 * 4 + 3], k4[3], a);
        }
        if (j > lane) a = 0.f;
#pragma unroll
        for (int e8 = 0; e8 < 8; ++e8) {
            const u32x4 v8 = *(const u32x4*)(sV + j * 64 + e8 * 8);
            o[e8 * 8 + 0] = fmaf(a, bflo(v8.x), o[e8 * 8 + 0]); o[e8 * 8 + 1] = fmaf(a, bfhi(v8.x), o[e8 * 8 + 1]);
            o[e8 * 8 + 2] = fmaf(a, bflo(v8.y), o[e8 * 8 + 2]); o[e8 * 8 + 3] = fmaf(a, bfhi(v8.y), o[e8 * 8 + 3]);
            o[e8 * 8 + 4] = fmaf(a, bflo(v8.z), o[e8 * 8 + 4]); o[e8 * 8 + 5] = fmaf(a, bfhi(v8.z), o[e8 * 8 + 5]);
            o[e8 * 8 + 6] = fmaf(a, bflo(v8.w), o[e8 * 8 + 6]); o[e8 * 8 + 7] = fmaf(a, bfhi(v8.w), o[e8 * 8 + 7]);
        }
    }
    float ss = 0.f;
#pragma unroll
    for (int e = 0; e < 64; ++e) ss = fmaf(o[e], o[e], ss);
    const float rms = rsqrtf(ss * (1.f / 64.f) + EPS);
    const float* gn = p.gnorm_g + layer * 256 + h * 64;
    bf16_t* cg_p = H + tok * HP + HCG + h * 64;
#pragma unroll
    for (int r = 0; r < 8; ++r) {
        const u32x4 gv = *(const u32x4*)(cg_p + r * 8);
        const float gq[8] = {bflo(gv.x), bfhi(gv.x), bflo(gv.y), bfhi(gv.y), bflo(gv.z), bfhi(gv.z), bflo(gv.w), bfhi(gv.w)};
        float y[8];
#pragma unroll
        for (int e = 0; e < 8; ++e) y[e] = o[r * 8 + e] * rms * gn[r * 8 + e] * silu_f(gq[e]);
        u32x4 w; w.x = pk2(y[0], y[1]); w.y = pk2(y[2], y[3]); w.z = pk2(y[4], y[5]); w.w = pk2(y[6], y[7]);
        if (!dry) *(u32x4*)(cg_p + r * 8) = w;
    }
    WAVE_SYNC();
}

constexpr int MPITCH = 260;
constexpr int HPITCH = 516;
constexpr int L_HIST = 0;
constexpr int L_CAND = 66560;
constexpr int L_CCNT = L_CAND + 65536;
constexpr int L_QINF = L_CCNT + 2048;
constexpr int L_MTAB = L_QINF + 1024 + 64;
static_assert(L_MTAB + 8192 <= LDS_BYTES, "dsa lds");
__device__ __forceinline__ int mpos(int rr) { return 16 * ((rr >> 2) & 1) + (rr & 3) + 4 * (rr >> 3); }
constexpr int SUBCAP = 32;

__device__ __forceinline__ unsigned mono_bits(float f) { const unsigned u = __float_as_uint(f); return u ^ ((u >> 31) ? 0xffffffffu : 0x80000000u); }
__device__ __forceinline__ void idx_loadk(const bf16_t* Hb, int s0, int lane, bf16x8 (&kf)[2][2]) {
    const bf16_t* kp = Hb + (long)(s0 + (lane & 15)) * HP + HKI + 8 * (lane >> 4);
#pragma unroll
    for (int kb = 0; kb < 2; ++kb)
#pragma unroll
        for (int ks = 0; ks < 2; ++ks) kf[kb][ks] = *(const bf16x8*)(kp + (long)kb * 16 * HP + ks * 32);
}
__device__ __forceinline__ void idx_scores(const bf16x8 (&kf)[2][2], const bf16x8 (&qf)[8][2], const bf16x8 (&ql)[2][2], const float (&wh)[8], float (&score)[8]) {
    f32x4 lin[2];
#pragma unroll
    for (int kb = 0; kb < 2; ++kb) {
        lin[kb] = (f32x4){0.f, 0.f, 0.f, 0.f};
#pragma unroll
        for (int ks = 0; ks < 2; ++ks) {
            lin[kb] = __builtin_amdgcn_mfma_f32_16x16x32_bf16(kf[kb][ks], ql[0][ks], lin[kb], 0, 0, 0);
            lin[kb] = __builtin_amdgcn_mfma_f32_16x16x32_bf16(kf[kb][ks], ql[1][ks], lin[kb], 0, 0, 0);
        }
    }
#pragma unroll
    for (int i = 0; i < 8; ++i) score[i] = lin[i >> 2][i & 3];
#pragma unroll
    for (int hd = 0; hd < 8; ++hd) {
        f32x4 acc[2];
#pragma unroll
        for (int kb = 0; kb < 2; ++kb) {
            acc[kb] = (f32x4){0.f, 0.f, 0.f, 0.f};
#pragma unroll
            for (int ks = 0; ks < 2; ++ks) acc[kb] = __builtin_amdgcn_mfma_f32_16x16x32_bf16(kf[kb][ks], qf[hd][ks], acc[kb], 0, 0, 0);
        }
#pragma unroll
        for (int kb = 0; kb < 2; ++kb)
#pragma unroll
            for (int i = 0; i < 4; ++i) score[kb * 4 + i] = fmaf(fabsf(acc[kb][i]), wh[hd], score[kb * 4 + i]);
        if ((hd & 3) == 3) __builtin_amdgcn_sched_barrier(0);
    }
}

template <bool FAST>
__device__ __forceinline__ void attn_tile(const bf16x8 (&kf)[4], const bf16x8 (&vf)[4], const bf16x8 (&qfr)[2][4], f32x16 (&O)[2][2], float (&mrun)[2], float (&lrun)[2],
                                          const unsigned* hist, const float* mtab, int r32, int hh, int tile) {
#pragma unroll
    for (int qb = 0; qb < 2; ++qb) {
        f32x16 S;
        const unsigned mw = hist[(qb * 32 + r32) * MPITCH + tile] >> (16 * hh);
#pragma unroll
        for (int g8 = 0; g8 < 2; ++g8) {
            const float* mt = mtab + ((mw >> (8 * g8)) & 255u) * 8;
            const f32x4 ma = *(const f32x4*)mt, mb = *(const f32x4*)(mt + 4);
            S[8 * g8] = ma[0]; S[8 * g8 + 1] = ma[1]; S[8 * g8 + 2] = ma[2]; S[8 * g8 + 3] = ma[3];
            S[8 * g8 + 4] = mb[0]; S[8 * g8 + 5] = mb[1]; S[8 * g8 + 6] = mb[2]; S[8 * g8 + 7] = mb[3];
        }
#pragma unroll
        for (int ks = 0; ks < 4; ++ks) S = __builtin_amdgcn_mfma_f32_32x32x16_bf16(kf[ks], qfr[qb][ks], S, 0, 0, 0);
        float pr[16]; float ps = 0.f;
        if (FAST) {
#pragma unroll
            for (int i = 0; i < 16; ++i) { pr[i] = __builtin_amdgcn_exp2f(S[i]); ps += pr[i]; }
        } else {
            float mx = fmaxf(fmaxf(S[0], S[1]), S[2]);
#pragma unroll
            for (int i = 3; i < 15; i += 2) mx = fmaxf(fmaxf(mx, S[i]), S[i + 1]);
            mx = fmaxf(mx, S[15]);
            { const auto sw = __builtin_amdgcn_permlane32_swap(__float_as_uint(mx), __float_as_uint(mx), false, false); mx = fmaxf(__uint_as_float(sw[0]), __uint_as_float(sw[1])); }
            if (__any(mx > mrun[qb])) {
                const float mnew = fmaxf(mx, mrun[qb]);
                const float alpha = __builtin_amdgcn_exp2f(mrun[qb] - mnew);
                mrun[qb] = mnew; lrun[qb] *= alpha;
#pragma unroll
                for (int db = 0; db < 2; ++db)
#pragma unroll
                    for (int i = 0; i < 16; ++i) O[db][qb][i] *= alpha;
            }
            const float mref = fmaxf(mrun[qb], -1000.f);
#pragma unroll
            for (int i = 0; i < 16; ++i) { pr[i] = __builtin_amdgcn_exp2f(S[i] - mref); ps += pr[i]; }
        }
        lrun[qb] += ps;
        bf16x8 pf[2];
#pragma unroll
        for (int s = 0; s < 2; ++s) {
            u32x4 pw; pw.x = pk2(pr[8 * s], pr[8 * s + 1]); pw.y = pk2(pr[8 * s + 2], pr[8 * s + 3]); pw.z = pk2(pr[8 * s + 4], pr[8 * s + 5]); pw.w = pk2(pr[8 * s + 6], pr[8 * s + 7]);
            pf[s] = __builtin_bit_cast(bf16x8, pw);
        }
#pragma unroll
        for (int db = 0; db < 2; ++db)
#pragma unroll
            for (int s = 0; s < 2; ++s) O[db][qb] = __builtin_amdgcn_mfma_f32_32x32x16_bf16(vf[db * 2 + s], pf[s], O[db][qb], 0, 0, 0);
    }
}
template <bool FAST>
__device__ __forceinline__ void attn_loop(const bf16_t* Kp, const bf16_t* Vp, const bf16x8 (&qfr)[2][4], f32x16 (&O)[2][2], float (&mrun)[2], float (&lrun)[2],
                                          const unsigned* hist, const float* mtab, int r32, int hh, int nt32, bool dry2) {
    bf16x8 kf[4], vf[4], kg[4], vg[4];
#pragma unroll
    for (int ks = 0; ks < 4; ++ks) { kf[ks] = *(const bf16x8*)(Kp + ks * 512); vf[ks] = *(const bf16x8*)(Vp + ks * 512); }
#pragma unroll 1
    for (int tile = 0; tile < nt32; tile += 2) {
        {
            const int tn = dry2 ? 0 : tile + 1;
#pragma unroll
            for (int ks = 0; ks < 4; ++ks) { kg[ks] = *(const bf16x8*)(Kp + (long)tn * 2048 + ks * 512); vg[ks] = *(const bf16x8*)(Vp + (long)tn * 2048 + ks * 512); }
        }
        attn_tile<FAST>(kf, vf, qfr, O, mrun, lrun, hist, mtab, r32, hh, tile);
        {
            const int tn = dry2 ? 0 : ((tile + 2 < nt32) ? tile + 2 : tile);
#pragma unroll
            for (int ks = 0; ks < 4; ++ks) { kf[ks] = *(const bf16x8*)(Kp + (long)tn * 2048 + ks * 512); vf[ks] = *(const bf16x8*)(Vp + (long)tn * 2048 + ks * 512); }
        }
        attn_tile<FAST>(kg, vg, qfr, O, mrun, lrun, hist, mtab, r32, hh, tile + 1);
    }
}

__device__ __forceinline__ void dsa_item(const Params& p, unsigned char* lds, int b, int qblk, bool dry, int wid_s) {
    bf16_t* H = (bf16_t*)(p.ws + WS_H);
    const float* side = (const float*)(p.ws + WS_SIDE);
    const bf16_t* Hb = H + (long)b * T * HP;
    const int tid = otid(wid_s), lane = tid & 63, w = tid >> 6, hq = lane >> 4;
    const int qg = w & 3, kh = w >> 2;
    const int t0 = qblk * 64, qloc = qg * 16 + (lane & 15), t = t0 + qloc;
    unsigned* hist = (unsigned*)(lds + L_HIST);
    unsigned* cand = (unsigned*)(lds + L_CAND);
    unsigned* ccnt = (unsigned*)(lds + L_CCNT);
    int* qinf = (int*)(lds + L_QINF);

    for (int i = tid; i < 64 * MPITCH; i += 512) hist[i] = 0u;
    for (int i = tid; i < 2048; i += 512) ((float*)(lds + L_MTAB))[i] = ((i >> 3) >> (i & 7)) & 1 ? 0.f : -1e30f;
    bf16x8 qf[8][2]; bf16x8 ql[2][2]; float wi[8]; float inv, fb0c;
    {
        const bf16_t* qp = Hb + (long)t * HP + HQI + 8 * hq;
#pragma unroll
        for (int hd = 0; hd < 8; ++hd)
#pragma unroll
            for (int ks = 0; ks < 2; ++ks) qf[hd][ks] = *(const bf16x8*)(qp + hd * 64 + ks * 32);
        const float* sp = side + ((long)b * T + t) * 24;
        const f32x4 w0 = *(const f32x4*)sp, w1 = *(const f32x4*)(sp + 4);
        wi[0] = w0[0]; wi[1] = w0[1]; wi[2] = w0[2]; wi[3] = w0[3]; wi[4] = w1[0]; wi[5] = w1[1]; wi[6] = w1[2]; wi[7] = w1[3];
        float n2 = 0.f;
#pragma unroll
        for (int i = 0; i < 8; ++i) n2 = fmaf(wi[i], wi[i], n2);
        const float nrm = fmaxf(SIG_UNIT * sqrtf(n2), 1e-30f);
        inv = 64.f / nrm;
        fb0c = 256.f - 64.f * 3.19f * (wi[0] + wi[1] + wi[2] + wi[3] + wi[4] + wi[5] + wi[6] + wi[7]) / nrm;
#pragma unroll
        for (int i = 0; i < 8; ++i) wi[i] *= 0.5f;
#pragma unroll
        for (int ks = 0; ks < 2; ++ks) {
            float ql_f[8];
#pragma unroll
            for (int j = 0; j < 8; ++j) ql_f[j] = 0.f;
#pragma unroll
            for (int hd = 0; hd < 8; ++hd) {
                const u32x4 qv = __builtin_bit_cast(u32x4, qf[hd][ks]);
                ql_f[0] = fmaf(wi[hd], bflo(qv.x), ql_f[0]); ql_f[1] = fmaf(wi[hd], bfhi(qv.x), ql_f[1]); ql_f[2] = fmaf(wi[hd], bflo(qv.y), ql_f[2]); ql_f[3] = fmaf(wi[hd], bfhi(qv.y), ql_f[3]);
                ql_f[4] = fmaf(wi[hd], bflo(qv.z), ql_f[4]); ql_f[5] = fmaf(wi[hd], bfhi(qv.z), ql_f[5]); ql_f[6] = fmaf(wi[hd], bflo(qv.w), ql_f[6]); ql_f[7] = fmaf(wi[hd], bfhi(qv.w), ql_f[7]);
            }
            u32x4 hi4; hi4.x = pk2(ql_f[0], ql_f[1]); hi4.y = pk2(ql_f[2], ql_f[3]); hi4.z = pk2(ql_f[4], ql_f[5]); hi4.w = pk2(ql_f[6], ql_f[7]);
            u32x4 lo4;
            lo4.x = pk2(ql_f[0] - bflo(hi4.x), ql_f[1] - bfhi(hi4.x)); lo4.y = pk2(ql_f[2] - bflo(hi4.y), ql_f[3] - bfhi(hi4.y));
            lo4.z = pk2(ql_f[4] - bflo(hi4.z), ql_f[5] - bfhi(hi4.z)); lo4.w = pk2(ql_f[6] - bflo(hi4.w), ql_f[7] - bfhi(hi4.w));
            ql[0][ks] = __builtin_bit_cast(bf16x8, hi4); ql[1][ks] = __builtin_bit_cast(bf16x8, lo4);
        }
    }
    const int ntile = (t0 + 64 + 127) >> 7;
    const int tmaxw = t0 + qg * 16 + 15;
    __syncthreads();
    int nit = 0;
    { const int v = tmaxw - kh * 64; if (v >= 0) nit = 2 * (v >> 7) + (((v & 127) >= 32) ? 2 : 1); }
    float fa = inv, fbias = fb0c;
    bool active = true;
#pragma unroll 1
    for (int level = 0; level < 2; ++level) {
        unsigned* hbase = level ? cand : hist;
        const bool wave_on = __any(active);
        if (wave_on) {
            const unsigned incv = 1u << ((qloc & 1) * 16);
            unsigned* hrow = hbase + (qloc >> 1) * HPITCH;
            bf16x8 kf[2][2];
            idx_loadk(Hb, kh * 64, lane, kf);
#pragma unroll 1
            for (int it = 0; it < nit; ++it) {
                const int s0 = (it >> 1) * 128 + kh * 64 + (it & 1) * 32;
                const int itn = (it + 1 < nit) ? it + 1 : it;
                bf16x8 kn[2][2];
                idx_loadk(Hb, (itn >> 1) * 128 + kh * 64 + (itn & 1) * 32, lane, kn);
                float score[8];
                idx_scores(kf, qf, ql, wi, score);
                if (s0 + 31 <= t0 + qg * 16) {
#pragma unroll
                    for (int i = 0; i < 8; ++i) { const unsigned bin = (unsigned)__builtin_amdgcn_fmed3f(fmaf(score[i], fa, fbias), 0.f, 511.5f); atomicAdd(hrow + bin, incv); }
                } else {
#pragma unroll
                    for (int i = 0; i < 8; ++i) {
                        const int s = s0 + (i >> 2) * 16 + hq * 4 + (i & 3);
                        if (s <= t) { const unsigned bin = (unsigned)__builtin_amdgcn_fmed3f(fmaf(score[i], fa, fbias), 0.f, 511.5f); atomicAdd(hrow + bin, incv); }
                    }
                }
#pragma unroll
                for (int kb = 0; kb < 2; ++kb)
#pragma unroll
                    for (int ks = 0; ks < 2; ++ks) kf[kb][ks] = kn[kb][ks];
            }
        }
        __syncthreads();
#pragma unroll 1
        for (int qq = 0; qq < 8; ++qq) {
            const int q = w * 8 + qq;
            if (level && !qinf[q * 4 + 3]) continue;
            const u32x4 wa = *(const u32x4*)(hbase + (q >> 1) * HPITCH + 8 * lane), wb = *(const u32x4*)(hbase + (q >> 1) * HPITCH + 8 * lane + 4);
            const int sh = (q & 1) * 16;
            const unsigned c[8] = {(wa.x >> sh) & 0xffffu, (wa.y >> sh) & 0xffffu, (wa.z >> sh) & 0xffffu, (wa.w >> sh) & 0xffffu, (wb.x >> sh) & 0xffffu, (wb.y >> sh) & 0xffffu, (wb.z >> sh) & 0xffffu, (wb.w >> sh) & 0xffffu};
            const unsigned tot = c[0] + c[1] + c[2] + c[3] + c[4] + c[5] + c[6] + c[7];
            unsigned S = tot;
#pragma unroll
            for (int o = 1; o < 64; o <<= 1) { const unsigned dn = (unsigned)bperm_i((lane + o) & 63, (int)S); if (lane + o < 64) S += dn; }
            const unsigned total = (unsigned)__builtin_amdgcn_readfirstlane((int)S);
            const u64 bal = __ballot(S >= 256u);
            int b1 = -1, r1 = 0, n1 = 0;
            if (total >= 256u) {
                const int Ls = 63 - __clzll(bal);
                unsigned cum = S - tot; bool found = false; int lb = -1, lr = 0, ln = 0;
#pragma unroll
                for (int j = 7; j >= 0; --j) { const bool hit = !found && (cum + c[j] >= 256u); if (hit) { lb = 8 * lane + j; lr = 256 - (int)cum; ln = (int)c[j]; found = true; } cum += c[j]; }
                b1 = bperm_i(Ls, lb); r1 = bperm_i(Ls, lr); n1 = bperm_i(Ls, ln);
            }
            if (lane == 0) { qinf[q * 4] = b1; qinf[q * 4 + 1] = r1; qinf[q * 4 + 2] = n1; }
        }
        __syncthreads();
        if (level == 0) { for (int i = tid; i < 64 * MPITCH; i += 512) hist[i] = 0u; }
        if (tid == 0) qinf[256] = 0;
        __syncthreads();
        if (wave_on) {
            const int b1 = qinf[qloc * 4];
            const float fsel = !active ? __builtin_inff() : ((b1 < 0) ? -__builtin_inff() : ((b1 >= 511) ? __builtin_inff() : (float)(b1 + 1)));
            const float fcand = !active ? __builtin_inff() : ((b1 <= 0) ? -__builtin_inff() : (float)b1);
            const float fb1 = (float)(b1 < 0 ? 0 : b1);
            unsigned* cslot = cand + (qloc * 8 + kh * 4 + hq) * SUBCAP; int ncand = 0;
            bf16x8 kf[2][2];
            idx_loadk(Hb, kh * 64, lane, kf);
#pragma unroll 1
            for (int it = 0; it < nit; ++it) {
                const int s0 = (it >> 1) * 128 + kh * 64 + (it & 1) * 32;
                const int itn = (it + 1 < nit) ? it + 1 : it;
                bf16x8 kn[2][2];
                idx_loadk(Hb, (itn >> 1) * 128 + kh * 64 + (itn & 1) * 32, lane, kn);
                float score[8];
                idx_scores(kf, qf, ql, wi, score);
                unsigned m0 = 0u;
                if (s0 + 31 <= t0 + qg * 16) {
#pragma unroll
                    for (int i = 0; i < 8; ++i) {
                        const int rr = (i >> 2) * 16 + hq * 4 + (i & 3), s = s0 + rr;
                        const float fb = fmaf(score[i], fa, fbias);
                        if (fb >= fcand) {
                            if (fb >= fsel) m0 |= 1u << (16 * (hq & 1) + 4 * (hq >> 1) + (i & 3) + 8 * (i >> 2));
                            else {
                                const unsigned q19 = (unsigned)__builtin_amdgcn_fmed3f((fb - fb1) * 524288.f, 0.f, 524287.f);
                                if (ncand < SUBCAP) cslot[ncand] = (q19 << 13) | (unsigned)(8191 - s);
                                ++ncand;
                            }
                        }
                    }
                } else {
#pragma unroll
                    for (int i = 0; i < 8; ++i) {
                        const int rr = (i >> 2) * 16 + hq * 4 + (i & 3), s = s0 + rr;
                        const float fb = fmaf(score[i], fa, fbias);
                        if (fb >= fcand && s <= t) {
                            if (fb >= fsel) m0 |= 1u << (16 * (hq & 1) + 4 * (hq >> 1) + (i & 3) + 8 * (i >> 2));
                            else {
                                const unsigned q19 = (unsigned)__builtin_amdgcn_fmed3f((fb - fb1) * 524288.f, 0.f, 524287.f);
                                if (ncand < SUBCAP) cslot[ncand] = (q19 << 13) | (unsigned)(8191 - s);
                                ++ncand;
                            }
                        }
                    }
                }
                if (m0) atomicOr(&hist[qloc * MPITCH + (s0 >> 5)], m0);
#pragma unroll
                for (int kb = 0; kb < 2; ++kb)
#pragma unroll
                    for (int ks = 0; ks < 2; ++ks) kf[kb][ks] = kn[kb][ks];
            }
            ccnt[qloc * 8 + kh * 4 + hq] = (unsigned)ncand;
        } else ccnt[qloc * 8 + kh * 4 + hq] = 0u;
        __syncthreads();
#pragma unroll 1
        for (int qq = 0; qq < 8; ++qq) {
            const int q = w * 8 + qq;
            if (level && !qinf[q * 4 + 3]) continue;
            const int r1 = qinf[q * 4 + 1];
            const int wr_ = lane >> 3, sl0 = (lane & 7) * 4;
            int cw = (int)ccnt[q * 8 + wr_];
            const bool ovf = __any(cw > SUBCAP) && (level == 0);
            if (lane == 0) { qinf[q * 4 + 3] = ovf ? 1 : 0; if (ovf) qinf[256] = 1; }
            if (ovf || r1 <= 0) continue;
            if (cw > SUBCAP) cw = SUBCAP;
            const u32x4 mine = *(const u32x4*)(cand + (q * 8 + wr_) * SUBCAP + sl0);
            int rk0 = 0, rk1 = 0, rk2 = 0, rk3 = 0;
#pragma unroll 1
            for (int ww = 0; ww < 8; ++ww) {
                int cn = (int)ccnt[q * 8 + ww]; if (cn > SUBCAP) cn = SUBCAP;
                const unsigned* cl = cand + (q * 8 + ww) * SUBCAP;
#pragma unroll 1
                for (int j = 0; j < cn; ++j) { const unsigned cv = cl[j]; rk0 += (cv > mine.x); rk1 += (cv > mine.y); rk2 += (cv > mine.z); rk3 += (cv > mine.w); }
            }
            if (sl0 + 0 < cw && rk0 < r1) { const int s = 8191 - (int)(mine.x & 8191u); atomicOr(&hist[q * MPITCH + (s >> 5)], 1u << mpos(s & 31)); }
            if (sl0 + 1 < cw && rk1 < r1) { const int s = 8191 - (int)(mine.y & 8191u); atomicOr(&hist[q * MPITCH + (s >> 5)], 1u << mpos(s & 31)); }
            if (sl0 + 2 < cw && rk2 < r1) { const int s = 8191 - (int)(mine.z & 8191u); atomicOr(&hist[q * MPITCH + (s >> 5)], 1u << mpos(s & 31)); }
            if (sl0 + 3 < cw && rk3 < r1) { const int s = 8191 - (int)(mine.w & 8191u); atomicOr(&hist[q * MPITCH + (s >> 5)], 1u << mpos(s & 31)); }
        }
        __syncthreads();
        if (level == 1 || qinf[256] == 0) break;
        {
            const bool mine_ovf = qinf[qloc * 4 + 3] != 0;
            const int b1 = qinf[qloc * 4];
            active = mine_ovf;
            fa = mine_ovf ? inv * 510.f : 0.f;
            fbias = mine_ovf ? fmaf(fb0c - (float)b1, 510.f, 1.f) : -1.f;
        }
        for (int i = tid; i < 32 * HPITCH; i += 512) cand[i] = 0u;
        __syncthreads();
    }
    for (int rep2_ = ((PROBE_PHASE == 41) ? 0 : 1); rep2_ < 2; ++rep2_) {
        const bool dry2 = dry || ((PROBE_PHASE == 41) && (rep2_ == 0) && (p.pos[0] == 0));
        const int head = w, r32 = lane & 31, hh = lane >> 5;
        bf16x8 qfr[2][4];
        float q1 = 0.f;
#pragma unroll
        for (int qb = 0; qb < 2; ++qb) {
            float qa = 0.f;
#pragma unroll
            for (int ks = 0; ks < 4; ++ks) {
                qfr[qb][ks] = *(const bf16x8*)(Hb + (long)(t0 + qb * 32 + r32) * HP + HQ + head * 64 + ks * 16 + 8 * hh);
                const u32x4 qv = __builtin_bit_cast(u32x4, qfr[qb][ks]);
                qa += fabsf(bflo(qv.x)) + fabsf(bfhi(qv.x)) + fabsf(bflo(qv.y)) + fabsf(bfhi(qv.y)) + fabsf(bflo(qv.z)) + fabsf(bfhi(qv.z)) + fabsf(bflo(qv.w)) + fabsf(bfhi(qv.w));
            }
            q1 = fmaxf(q1, qa);
        }
        q1 += sxor_f(q1, lane, 32);
#pragma unroll
        for (int o = 16; o >= 1; o >>= 1) q1 = fmaxf(q1, sxor_f(q1, lane, o));
        const float kmx = __uint_as_float(((const unsigned*)(p.ws + WS_KMAX))[b * 8 + head]);
        const bool fast = (q1 * kmx * 1.02f) < 100.f;
        f32x16 O[2][2];
#pragma unroll
        for (int a = 0; a < 2; ++a)
#pragma unroll
            for (int c2 = 0; c2 < 2; ++c2)
#pragma unroll
                for (int i = 0; i < 16; ++i) O[a][c2][i] = 0.f;
        float mrun[2] = {-1e30f, -1e30f}, lrun[2] = {0.f, 0.f};
        const bf16_t* Kp = (const bf16_t*)(p.ws + WS_KF) + ((long)(b * 8 + head) * 256 * 4 * 64 + lane) * 8;
        const bf16_t* Vp = (const bf16_t*)(p.ws + WS_VT) + ((long)(b * 8 + head) * 256 * 4 * 64 + lane) * 8;
        const int nt32 = (t0 + 64) >> 5;
        if (fast) attn_loop<true>(Kp, Vp, qfr, O, mrun, lrun, hist, (const float*)(lds + L_MTAB), r32, hh, nt32, dry2);
        else attn_loop<false>(Kp, Vp, qfr, O, mrun, lrun, hist, (const float*)(lds + L_MTAB), r32, hh, nt32, dry2);
#pragma unroll
        for (int qb = 0; qb < 2; ++qb) {
            const float lt = lrun[qb] + sxor_f(lrun[qb], lane, 32);
            const float il = 1.f / lt;
            bf16_t* gp = H + ((long)b * T + t0 + qb * 32 + r32) * HP + HAG + head * 64 + 4 * hh;
#pragma unroll
            for (int db = 0; db < 2; ++db)
#pragma unroll
                for (int g4 = 0; g4 < 4; ++g4) {
                    bf16_t* gq = gp + db * 32 + 8 * g4;
                    const u32x2 gv = *(const u32x2*)gq;
                    u32x2 wv;
                    wv.x = pk2(O[db][qb][4 * g4] * il * silu_f(bflo(gv.x)), O[db][qb][4 * g4 + 1] * il * silu_f(bfhi(gv.x)));
                    wv.y = pk2(O[db][qb][4 * g4 + 2] * il * silu_f(bflo(gv.y)), O[db][qb][4 * g4 + 3] * il * silu_f(bfhi(gv.y)));
                    if (!dry2) *(u32x2*)gq = wv;
                }
        }
    }
    __syncthreads();
}

__device__ __forceinline__ void gbar(unsigned* ctr, unsigned target) {
    __syncthreads();
    if (threadIdx.x == 0) {
        __builtin_amdgcn_fence(__ATOMIC_RELEASE, "agent");
        __hip_atomic_fetch_add(ctr, 1u, __ATOMIC_RELAXED, __HIP_MEMORY_SCOPE_AGENT);
        while (__hip_atomic_load(ctr, __ATOMIC_RELAXED, __HIP_MEMORY_SCOPE_AGENT) < target) __builtin_amdgcn_s_sleep(2);
        __builtin_amdgcn_fence(__ATOMIC_ACQUIRE, "agent");
    }
    __syncthreads();
}

__global__ void __launch_bounds__(512) fwd_megakernel(Params p0) {
    extern __shared__ __attribute__((aligned(16))) unsigned char lds[];
    cg::grid_group grid = cg::this_grid();
    const int G = gridDim.x, c = blockIdx.x;
    const int wid_s = __builtin_amdgcn_readfirstlane((int)(threadIdx.x >> 6));

    unsigned* barctr = (unsigned*)(p0.ws + WS_BAR); unsigned bar_n = 0;
    if (c == 0 && threadIdx.x == 0) __hip_atomic_store(barctr, 0u, __ATOMIC_RELAXED, __HIP_MEMORY_SCOPE_AGENT);
    for (int rep0_ = (PROBE_PHASE == 8 ? 0 : 1); rep0_ < 2; ++rep0_) prologue(p0, (long)c * 512 + threadIdx.x, (long)G * 512);
    grid.sync();

#pragma unroll 1
    for (int layer = 0; layer < DEPTH; ++layer) {
        Params p = p0;
        { size_t zoff = 0; asm volatile("" : "+s"(zoff)); p.ws = p0.ws + zoff; }
        bf16_t* H = (bf16_t*)(p.ws + WS_H);
        {
for (int rep_ = (PROBE_PHASE == 1 ? 0 : 1); rep_ < 2; ++rep_) { const bool dry = (PROBE_PHASE == 1) && (rep_ == 0) && (p.pos[0] == 0);
            EpiIn e; e.H = H; e.side = (float*)(p.ws + WS_SIDE); e.rope = (const float*)(p.ws + WS_ROPE); e.VT = (bf16_t*)(p.ws + WS_VT); e.KF = (bf16_t*)(p.ws + WS_KF); e.kmax = (unsigned*)(p.ws + WS_KMAX); e.dry = dry;
            const bf16_t* A = (const bf16_t*)(p.ws + WS_XB);
            const bf16_t* Bt = (const bf16_t*)(p.ws + WS_WIN) + (long)layer * NPAD * 1024;
#pragma unroll 1
            for (int L = c; L < 128 * 17; L += G) { int pm, pn; tile_of(L, 128, 17, pm, pn); gemm_tile((LAS unsigned char*)lds, A, 1024, Bt, 1024, pm, pn, e, wid_s); }
}
        }
        gbar(barctr, (++bar_n) * (unsigned)G); if (PROBE_PHASE == 9) gbar(barctr, (++bar_n) * (unsigned)G);
        {
for (int rep_ = (PROBE_PHASE == 2 ? 0 : 1); rep_ < 2; ++rep_) { const bool dry = (PROBE_PHASE == 2) && (rep_ == 0) && (p.pos[0] == 0);
            const int tid = otid(wid_s), lane = tid & 63, w = tid >> 6;
#pragma unroll 1
            for (int g = c; g < 256; g += G) gla_local_item(p, layer, g * 8 + w, lane, dry);
}
        }
for (int rep_ = (PROBE_PHASE == 3 ? 0 : 1); rep_ < 2; ++rep_) { const bool dry = (PROBE_PHASE == 3) && (rep_ == 0) && (p.pos[0] == 0);
#pragma unroll 1
        for (int tile = c; tile < 512; tile += G) conformer_tile(p, layer, lds, tile, dry, wid_s);
}
        gbar(barctr, (++bar_n) * (unsigned)G); if (PROBE_PHASE == 9) gbar(barctr, (++bar_n) * (unsigned)G);
        {
            const int tid = otid(wid_s);
#pragma unroll 1
            for (int g = c; g < 64; g += G) gla_scan(p, g * 512 + tid);
        }
for (int rep_ = (PROBE_PHASE == 4 ? 0 : 1); rep_ < 2; ++rep_) { const bool dry = (PROBE_PHASE == 4) && (rep_ == 0) && (p.pos[0] == 0);
#pragma unroll 1
        for (int it = c; it < 512; it += G) {
            const int pr = it >> 1, second = it & 1;
            const int xcd = pr & 7, j = pr >> 3, b = xcd >> 1, par = xcd & 1;
            const int qblk = second ? (2 * j + par) : 127 - (2 * j + par);
            dsa_item(p, lds, b, qblk, dry, wid_s);
        }
}
        gbar(barctr, (++bar_n) * (unsigned)G); if (PROBE_PHASE == 9) gbar(barctr, (++bar_n) * (unsigned)G);
        {
for (int rep_ = (PROBE_PHASE == 5 ? 0 : 1); rep_ < 2; ++rep_) { const bool dry = (PROBE_PHASE == 5) && (rep_ == 0) && (p.pos[0] == 0);
            const int tid = otid(wid_s), lane = tid & 63, w = tid >> 6;
#pragma unroll 1
            for (int g = c; g < 256; g += G) gla_out_item(p, layer, lds + w * 16384, g * 8 + w, lane, dry);
}
        }
        gbar(barctr, (++bar_n) * (unsigned)G); if (PROBE_PHASE == 9) gbar(barctr, (++bar_n) * (unsigned)G);
        {
for (int rep_ = (PROBE_PHASE == 6 ? 0 : 1); rep_ < 2; ++rep_) { const bool dry = (PROBE_PHASE == 6) && (rep_ == 0) && (p.pos[0] == 0);
            EpiOut e; e.xres = (layer == 0) ? p.x : p.out; e.out = p.out; e.dry = dry;
            const bf16_t* A = H + HAG;
            const bf16_t* Bt = (const bf16_t*)(p.ws + WS_WOUT) + (long)layer * 1024 * 1024;
#pragma unroll 1
            for (int L = c; L < 128 * 4; L += G) { int pm, pn; tile_of(L, 128, 4, pm, pn); gemm_tile((LAS unsigned char*)lds, A, HP, Bt, 1024, pm, pn, e, wid_s); }
}
        }
        gbar(barctr, (++bar_n) * (unsigned)G); if (PROBE_PHASE == 9) gbar(barctr, (++bar_n) * (unsigned)G);
        {
for (int rep_ = (PROBE_PHASE == 7 ? 0 : 1); rep_ < 2; ++rep_) { const bool dry = (PROBE_PHASE == 7) && (rep_ == 0) && (p.pos[0] == 0);
            const int tid = otid(wid_s), lane = tid & 63, w = tid >> 6;
            ln_phase(p, layer, c * 8 + w, G * 8, lane, dry);
            if (c == 0 && tid < 32) ((unsigned*)(p.ws + WS_KMAX))[tid] = 0u;
}
        }
        if (layer + 1 < DEPTH) { gbar(barctr, (++bar_n) * (unsigned)G); if (PROBE_PHASE == 9) gbar(barctr, (++bar_n) * (unsigned)G); }
    }
}

extern "C" void kernel_launch(void* const* d_in, const int* in_sizes, int n_in, void* d_out, int out_size, void* d_ws, size_t ws_size, hipStream_t stream) {
    static int grid_blocks = 0;
    if (grid_blocks == 0) {
        if (n_in != 15 || ws_size < WS_END) { fprintf(stderr, "kernel_launch: unexpected inputs (n_in %d, ws %zu < %zu)\n", n_in, ws_size, (size_t)WS_END); grid_blocks = -1; return; }
        int dev = 0, cus = 0, per_cu = 0;
        hipGetDevice(&dev);
        hipDeviceGetAttribute(&cus, hipDeviceAttributeMultiprocessorCount, dev);
        if (hipFuncSetAttribute((const void*)fwd_megakernel, hipFuncAttributeMaxDynamicSharedMemorySize, LDS_BYTES) != hipSuccess) { fprintf(stderr, "kernel_launch: hipFuncSetAttribute failed\n"); grid_blocks = -1; return; }
        hipOccupancyMaxActiveBlocksPerMultiprocessor(&per_cu, (const void*)fwd_megakernel, 512, LDS_BYTES);
        if (per_cu < 1) per_cu = 1;
        grid_blocks = cus * per_cu;
    }
    if (grid_blocks < 0) return;
    Params p{};
    p.x = (const float*)d_in[0]; p.pos = (const int*)d_in[1]; p.w_in = (const float*)d_in[2]; p.conv_w = (const float*)d_in[3]; p.conv_b = (const float*)d_in[4];
    p.cln_g = (const float*)d_in[5]; p.cln_b = (const float*)d_in[6]; p.pw_w = (const float*)d_in[7]; p.pw_b = (const float*)d_in[8];
    p.gate_w2 = (const float*)d_in[9]; p.gate_b = (const float*)d_in[10]; p.gnorm_g = (const float*)d_in[11]; p.w_out = (const float*)d_in[12];
    p.ln_g = (const float*)d_in[13]; p.ln_b = (const float*)d_in[14];
    p.out = (float*)d_out; p.ws = (unsigned char*)d_ws;
    for (int j = 0; j < 32; ++j) p.inv_freq[j] = (float)pow(10000.0, -(double)j / 32.0);
    void* args[] = {&p};
    hipError_t e = hipLaunchCooperativeKernel((const void*)fwd_megakernel, dim3(grid_blocks), dim3(512), args, LDS_BYTES, stream);
    if (e != hipSuccess) fprintf(stderr, "cooperative launch failed: %s (grid %d)\n", hipGetErrorString(e), grid_blocks);
}
```

```cpp
#include <hip/hip_runtime.h>
#include <hip/hip_cooperative_groups.h>
#include <cstdio>
#include <cmath>
namespace cg = cooperative_groups;

typedef unsigned short bf16_t;
typedef short bf16x8 __attribute__((ext_vector_type(8)));
typedef float f32x4 __attribute__((ext_vector_type(4)));
typedef float f32x16 __attribute__((ext_vector_type(16)));
typedef unsigned u32x4 __attribute__((ext_vector_type(4)));
typedef unsigned u32x2 __attribute__((ext_vector_type(2)));
typedef unsigned long long u64;

constexpr int NB = 4, T = 8192, NTOK = NB * T, DM = 1024, DIN = 4184, NPAD = 4352, HP = 4160, DEPTH = 4;
constexpr int HQ = 0, HK = 512, HV = 1024, HQI = 1536, HKI = 2048, HGLU = 2112, HCQ = 2624, HCK = 2752, HCV = 2880, HAG = 3136, HBG = 3648, HCG = 3904;
constexpr float EPS = 1e-5f;
constexpr float ALPHA = 1.6817928305074290f;
constexpr float QSCALE = 0.125f * 1.4426950408889634f;
constexpr float WI_SCALE = 0.04419417382415922f;
constexpr float SIG_UNIT = 5.66f;
constexpr int CAP = 128;

constexpr size_t WS_WIN = 0;
constexpr size_t WS_WOUT = WS_WIN + (size_t)DEPTH * NPAD * 1024 * 2;
constexpr size_t WS_PWT = WS_WOUT + (size_t)DEPTH * 1024 * 1024 * 2;
constexpr size_t WS_ROPE = WS_PWT + (size_t)DEPTH * 256 * 256 * 2;
constexpr size_t WS_XB = WS_ROPE + (size_t)NTOK * 32 * 8;
constexpr size_t WS_H = WS_XB + (size_t)NTOK * 1024 * 2;
constexpr size_t WS_SIDE = WS_H + (size_t)NTOK * HP * 2;
constexpr size_t WS_BCUM = WS_SIDE + (size_t)NTOK * 24 * 4;
constexpr size_t WS_U = WS_BCUM + (size_t)NTOK * 128 * 4;
constexpr size_t WS_DEC = WS_U + (size_t)2048 * 2048 * 4;
constexpr size_t WS_VT = WS_DEC + (size_t)2048 * 32 * 4;
constexpr size_t WS_KF = WS_VT + (size_t)NTOK * 512 * 2;
constexpr size_t WS_BAR = WS_KF + (size_t)NTOK * 512 * 2;
constexpr size_t WS_KMAX = WS_BAR + 256;
constexpr size_t WS_END = WS_KMAX + 256;

#ifndef PROBE_PHASE
#define PROBE_PHASE 0
#endif
constexpr int LDS_BYTES = 147456;

struct Params {
    const float* x; const int* pos; const float* w_in; const float* conv_w; const float* conv_b; const float* cln_g; const float* cln_b;
    const float* pw_w; const float* pw_b; const float* gate_w2; const float* gate_b; const float* gnorm_g; const float* w_out; const float* ln_g; const float* ln_b;
    float* out; unsigned char* ws;
    float inv_freq[32];
};

__device__ __forceinline__ unsigned f2bf(float f) { unsigned u = __float_as_uint(f); return (u + 0x7fffu + ((u >> 16) & 1u)) >> 16; }
__device__ __forceinline__ float bf2f(unsigned b) { return __uint_as_float(b << 16); }
typedef float f32x2_t __attribute__((ext_vector_type(2)));
typedef __bf16 bf16x2_t __attribute__((ext_vector_type(2)));
__device__ __forceinline__ unsigned pk2(float lo, float hi) { f32x2_t v = {lo, hi}; bf16x2_t b = __builtin_convertvector(v, bf16x2_t); return __builtin_bit_cast(unsigned, b); }
__device__ __forceinline__ float bflo(unsigned w) { return __uint_as_float(w << 16); }
__device__ __forceinline__ float bfhi(unsigned w) { return __uint_as_float(w & 0xffff0000u); }
__device__ __forceinline__ float silu_f(float v) { return v / (1.f + __expf(-v)); }
__device__ __forceinline__ float sigmoid_f(float v) { return 1.f / (1.f + __expf(-v)); }
__device__ __forceinline__ int bperm_i(int idx, int v) { return __builtin_amdgcn_ds_bpermute(idx << 2, v); }
__device__ __forceinline__ float sxor_f(float v, int lane, int m) { return __int_as_float(bperm_i(lane ^ m, __float_as_int(v))); }
__device__ __forceinline__ int sxor_i(int v, int lane, int m) { return bperm_i(lane ^ m, v); }
__device__ __forceinline__ float wave_sum(float v, int lane) {
#pragma unroll
    for (int o = 32; o >= 1; o >>= 1) v += sxor_f(v, lane, o);
    return v;
}
__device__ __forceinline__ int otid(int wid_s) { int l; asm volatile("v_mbcnt_lo_u32_b32 %0, -1, 0\n\tv_mbcnt_hi_u32_b32 %0, -1, %0" : "=v"(l)); return (wid_s << 6) | l; }
#define WAVE_SYNC() do { __builtin_amdgcn_fence(__ATOMIC_RELEASE, "wavefront"); __builtin_amdgcn_wave_barrier(); __builtin_amdgcn_fence(__ATOMIC_ACQUIRE, "wavefront"); } while (0)

__device__ __forceinline__ int l2orig(int l) {
    if (l < 1536) return l;
    if (l < 2048) return 2048 + (l - 1536);
    if (l < 2112) return 2560 + (l - 2048);
    if (l < 2624) return 2632 + (l - 2112);
    if (l < 2752) return 3400 + (l - 2624);
    if (l < 2880) return 3528 + (l - 2752);
    if (l < 3136) return 3656 + (l - 2880);
    if (l < 3648) return 1536 + (l - 3136);
    if (l < 3904) return 3144 + (l - 3648);
    if (l < 4160) return 3912 + (l - 3904);
    if (l < 4168) return 2624 + (l - 4160);
    if (l < 4184) return 4168 + (l - 4168);
    return -1;
}
__device__ __forceinline__ int npos2logical(int np) {
    const int hb = np & ~127, p = np & 127, wc = p >> 5, n = (p >> 4) & 1, fr = p & 15;
    return hb + (wc >> 1) * 64 + n * 32 + (wc & 1) * 16 + fr;
}

__device__ __forceinline__ void sincos_acc(float angf, float& c, float& s) {
    const double a = (double)angf;
    const double n = rint(a * 0.15915494309189535);
    double r = fma(-n, 6.283185307179586, a);
    r = fma(-n, 2.4492935982947064e-16, r);
    const double r2 = r * r;
    double ts = r, tc = 1.0, ss = r, cc = 1.0;
#pragma unroll
    for (int k = 1; k <= 14; ++k) {
        tc = -tc * r2 * (1.0 / (double)((2 * k - 1) * (2 * k)));
        ts = -ts * r2 * (1.0 / (double)((2 * k) * (2 * k + 1)));
        cc += tc; ss += ts;
    }
    c = (float)cc; s = (float)ss;
}

__device__ __forceinline__ void prologue(const Params& p, long gtid, long gthreads) {
    bf16_t* win = (bf16_t*)(p.ws + WS_WIN);
    for (long idx = gtid; idx < (long)DEPTH * 128 * NPAD; idx += gthreads) {
        const int np = (int)(idx % NPAD); const long r = idx / NPAD; const int kc = (int)(r % 128); const int l = (int)(r / 128);
        const int oc = l2orig(npos2logical(np));
        u32x4 w = {0u, 0u, 0u, 0u};
        if (oc >= 0) {
            const float* src = p.w_in + ((long)l * 1024 + kc * 8) * DIN + oc;
            float v[8];
#pragma unroll
            for (int i = 0; i < 8; ++i) v[i] = src[(long)i * DIN];
            w.x = pk2(v[0], v[1]); w.y = pk2(v[2], v[3]); w.z = pk2(v[4], v[5]); w.w = pk2(v[6], v[7]);
        }
        *(u32x4*)(win + ((long)l * NPAD + np) * 1024 + kc * 8) = w;
    }
    bf16_t* wout = (bf16_t*)(p.ws + WS_WOUT);
    for (long idx = gtid; idx < (long)DEPTH * 128 * 1024; idx += gthreads) {
        const int n = (int)(idx % 1024); const long r = idx / 1024; const int kc = (int)(r % 128); const int l = (int)(r / 128);
        const float* src = p.w_out + ((long)l * 1024 + kc * 8) * 1024 + n;
        float v[8];
#pragma unroll
        for (int i = 0; i < 8; ++i) v[i] = src[(long)i * 1024];
        u32x4 w; w.x = pk2(v[0], v[1]); w.y = pk2(v[2], v[3]); w.z = pk2(v[4], v[5]); w.w = pk2(v[6], v[7]);
        *(u32x4*)(wout + ((long)l * 1024 + n) * 1024 + kc * 8) = w;
    }
    bf16_t* pwt = (bf16_t*)(p.ws + WS_PWT);
    for (long idx = gtid; idx < (long)DEPTH * 32 * 256; idx += gthreads) {
        const int n = (int)(idx % 256); const long r = idx / 256; const int kc = (int)(r % 32); const int l = (int)(r / 32);
        const float* src = p.pw_w + ((long)l * 256 + kc * 8) * 256 + n;
        float v[8];
#pragma unroll
        for (int i = 0; i < 8; ++i) v[i] = src[(long)i * 256];
        u32x4 w; w.x = pk2(v[0], v[1]); w.y = pk2(v[2], v[3]); w.z = pk2(v[4], v[5]); w.w = pk2(v[6], v[7]);
        *(u32x4*)(pwt + ((long)l * 256 + n) * 256 + kc * 8) = w;
    }
    float2* rope = (float2*)(p.ws + WS_ROPE);
    for (long idx = gtid; idx < (long)NTOK * 32; idx += gthreads) {
        const int j = (int)(idx & 31); const long tok = idx >> 5;
        const float ang = (float)p.pos[tok] * p.inv_freq[j];
        float c, s; sincos_acc(ang, c, s);
        rope[idx] = make_float2(c, s);
    }
    if (gtid < 32) ((unsigned*)(p.ws + WS_KMAX))[gtid] = 0u;
    bf16_t* xb = (bf16_t*)(p.ws + WS_XB);
    for (long idx = gtid; idx < (long)NTOK * 128; idx += gthreads) {
        const f32x4 a = *(const f32x4*)(p.x + idx * 8), b = *(const f32x4*)(p.x + idx * 8 + 4);
        u32x4 w; w.x = pk2(a[0], a[1]); w.y = pk2(a[2], a[3]); w.z = pk2(b[0], b[1]); w.w = pk2(b[2], b[3]);
        *(u32x4*)(xb + idx * 8) = w;
    }
}

constexpr int BM = 256, BK = 64, HALF = 128, HT = HALF * BK;
__device__ __forceinline__ int lds_byte(int r, int c) {
    int st = (r >> 4) * 2 + (c >> 5), rr = r & 15, cc = c & 31, ob = rr * 64 + cc * 2;
    return st * 1024 + (ob ^ (((ob >> 9) & 1) << 5));
}
__device__ __forceinline__ void stage_rc(int b, int& R, int& C) {
    int st = b / 1024, sb = b % 1024, swz = sb ^ (((sb >> 9) & 1) << 5);
    R = (st >> 1) * 16 + swz / 64; C = (st & 1) * 32 + (swz % 64) / 2;
}
__device__ __forceinline__ void tile_of(int L, int nM, int nN, int& pm, int& pn) {
    const int nwg = nM * nN; int wgid = L;
    { const int q = nwg / 8, r = nwg % 8, xcd = wgid % 8, off = wgid / 8; wgid = (xcd < r ? xcd * (q + 1) : r * (q + 1) + (xcd - r) * q) + off; }
    const int nig = 8 * nN, gid = wgid / nig, fm = gid * 8, gsz = (nM - fm) < 8 ? (nM - fm) : 8;
    pm = fm + ((wgid % nig) % gsz); pn = (wgid % nig) / gsz;
}

#define LAS __attribute__((address_space(3)))
template <class Epi>
__device__ __forceinline__ void gemm_tile(LAS unsigned char* lds, const bf16_t* A, int lda, const bf16_t* Bt, int K, int pm, int pn, const Epi& epi, int wid_s) {
    const int tid = otid(wid_s), wid = __builtin_amdgcn_readfirstlane(tid >> 6), lane = tid & 63, wr = wid >> 2, wc = wid & 3, fr = lane & 15, fq = lane >> 4;
    const int nt = K / BK;
    unsigned voffA[2], voffB[2];
#pragma unroll
    for (int i = 0; i < 2; ++i) { int R, C; stage_rc(tid * 16 + i * 8192, R, C); voffA[i] = (unsigned)(R * lda + C) * 2u; voffB[i] = (unsigned)(R * K + C) * 2u; }
    const size_t kstep = (size_t)(BK * 2), hstepA = (size_t)HALF * lda * 2, hstepB = (size_t)HALF * K * 2;
    const unsigned ldsw = (unsigned)wid * 1024u;
    const int aoff = lds_byte(wr * 64 + fr, fq * 8), boff = lds_byte(wc * 32 + fr, fq * 8);
    const char* cA = (const char*)A + (size_t)pm * 2 * hstepA; const char* cB = (const char*)Bt + (size_t)pn * 2 * hstepB;
#define HTB (HALF * BK * 2)
#define SA(b, h) (((b) * 2 + (h)) * HTB)
#define SB(b, h) ((4 + (b) * 2 + (h)) * HTB)
#define STAGE(bufoff, gbase, voff) do { _Pragma("unroll") for (int _i = 0; _i < 2; ++_i) \
        __builtin_amdgcn_global_load_lds((const unsigned*)((const char*)(gbase) + (voff)[_i]), (LAS unsigned*)(lds + (bufoff) + ldsw + _i * 8192), 16, 0, 0); } while (0)
#define LDA(dst, b, h) do { _Pragma("unroll") for (int m = 0; m < 4; ++m) _Pragma("unroll") for (int k = 0; k < 2; ++k) dst[m][k] = *(const LAS bf16x8*)(lds + SA(b, h) + aoff + m * 2048 + k * 1024); } while (0)
#define LDB(dst, b, h) do { _Pragma("unroll") for (int n = 0; n < 2; ++n) _Pragma("unroll") for (int k = 0; k < 2; ++k) dst[n][k] = *(const LAS bf16x8*)(lds + SB(b, h) + boff + n * 2048 + k * 1024); } while (0)
#define MMA(ai, bj, At_, Bt_) do { __builtin_amdgcn_s_setprio(1); _Pragma("unroll") for (int m = 0; m < 4; ++m) _Pragma("unroll") for (int n = 0; n < 2; ++n) _Pragma("unroll") for (int k = 0; k < 2; ++k) \
        acc[ai][bj][m][n] = __builtin_amdgcn_mfma_f32_16x16x32_bf16(Bt_[n][k], At_[m][k], acc[ai][bj][m][n], 0, 0, 0); __builtin_amdgcn_s_setprio(0); } while (0)
#define WAIT_V(n) asm volatile("s_waitcnt vmcnt(" #n ")" ::: "memory")
#define WAIT_L(n) asm volatile("s_waitcnt lgkmcnt(" #n ")" ::: "memory")
#define BAR __builtin_amdgcn_s_barrier()
#define SCHED __builtin_amdgcn_sched_barrier(0)
    f32x4 acc[2][2][4][2];
#pragma unroll
    for (int a = 0; a < 2; ++a)
#pragma unroll
        for (int b = 0; b < 2; ++b)
#pragma unroll
            for (int m = 0; m < 4; ++m)
#pragma unroll
                for (int n = 0; n < 2; ++n) acc[a][b][m][n] = (f32x4){0.f, 0.f, 0.f, 0.f};
    bf16x8 At[4][2], B0[2][2], B1[2][2];
    STAGE(SB(0, 0), cB, voffB); STAGE(SA(0, 0), cA, voffA); STAGE(SB(0, 1), cB + hstepB, voffB); STAGE(SA(0, 1), cA + hstepA, voffA);
    if (wr == 1) BAR;
    WAIT_V(4); BAR;
    STAGE(SB(1, 0), cB + kstep, voffB); STAGE(SA(1, 0), cA + kstep, voffA); STAGE(SB(1, 1), cB + hstepB + kstep, voffB);
    WAIT_V(6); BAR;
    for (int t = 0; t < nt - 2; t += 2) {
        const char* a1 = cA + (size_t)(t + 1) * kstep; const char* a2 = cA + (size_t)(t + 2) * kstep; const char* b2 = cB + (size_t)(t + 2) * kstep;
        const char* a3 = a2 + kstep; const char* b3 = b2 + kstep;
        LDB(B0, 0, 0); SCHED; LDA(At, 0, 0); STAGE(SA(1, 1), a1 + hstepA, voffA);
        WAIT_L(8); BAR; WAIT_L(0); MMA(0, 0, At, B0); BAR; SCHED;
        LDB(B1, 0, 1); STAGE(SB(0, 0), b2, voffB);
        BAR; WAIT_L(0); MMA(0, 1, At, B1); BAR;
        LDA(At, 0, 1); STAGE(SA(0, 0), a2, voffA);
        BAR; WAIT_L(0); MMA(1, 0, At, B0); BAR; SCHED;
        STAGE(SB(0, 1), b2 + hstepB, voffB);
        WAIT_V(6); BAR; MMA(1, 1, At, B1); BAR;
        LDB(B0, 1, 0); SCHED; LDA(At, 1, 0); STAGE(SA(0, 1), a2 + hstepA, voffA);
        WAIT_L(8); BAR; WAIT_L(0); MMA(0, 0, At, B0); BAR; SCHED;
        LDB(B1, 1, 1); STAGE(SB(1, 0), b3, voffB);
        BAR; WAIT_L(0); MMA(0, 1, At, B1); BAR;
        LDA(At, 1, 1); STAGE(SA(1, 0), a3, voffA);
        BAR; WAIT_L(0); MMA(1, 0, At, B0); BAR; SCHED;
        STAGE(SB(1, 1), b3 + hstepB, voffB);
        WAIT_V(6); BAR; MMA(1, 1, At, B1); BAR;
    }
    { const char* a1 = cA + (size_t)(nt - 1) * kstep;
      LDB(B0, 0, 0); LDA(At, 0, 0); STAGE(SA(1, 1), a1 + hstepA, voffA);
      BAR; WAIT_L(0); MMA(0, 0, At, B0); BAR;
      LDB(B1, 0, 1); BAR; WAIT_L(0); MMA(0, 1, At, B1); BAR;
      LDA(At, 0, 1); WAIT_V(4); BAR; WAIT_L(0); MMA(1, 0, At, B0); MMA(1, 1, At, B1); BAR; }
    { LDB(B0, 1, 0); LDA(At, 1, 0); WAIT_V(2); BAR; WAIT_L(0); MMA(0, 0, At, B0); BAR;
      LDB(B1, 1, 1); WAIT_V(0); BAR; WAIT_L(0); MMA(0, 1, At, B1); BAR;
      LDA(At, 1, 1); BAR; WAIT_L(0); MMA(1, 0, At, B0); MMA(1, 1, At, B1); BAR; }
    if (wr == 0) BAR;
    epi(acc, pm * BM, pn * BM, wr, wc, fr, fq);
#undef SA
#undef SB
#undef STAGE
#undef LDA
#undef LDB
#undef MMA
}

struct EpiIn {
    bf16_t* H; float* side; const float* rope; bf16_t* VT; bf16_t* KF; unsigned* kmax; bool dry;
    __device__ __forceinline__ void operator()(f32x4 (&acc)[2][2][4][2], int brow, int bcol, int wr, int wc, int fr, int fq) const {
#pragma unroll
        for (int bj = 0; bj < 2; ++bj) {
            const int hb = bcol + bj * HALF;
            if (hb >= 4224 || dry) continue;
            const int gbase = hb + (wc >> 1) * 64, g64 = gbase >> 6, d0 = (wc & 1) * 16 + 4 * fq;
            const bool rp = (g64 < 16) || (g64 >= 24 && g64 <= 32);
            const float qs = (g64 < 8) ? QSCALE : 1.f;
            float kabs = 0.f;
#pragma unroll
            for (int ai = 0; ai < 2; ++ai)
#pragma unroll
                for (int m = 0; m < 4; ++m) {
                    const long row = brow + ai * HALF + wr * 64 + m * 16 + fr;
                    f32x4 o1 = acc[ai][bj][m][0], o2 = acc[ai][bj][m][1];
                    if (rp) {
                        const f32x4 c0 = *(const f32x4*)(rope + (row * 32 + d0) * 2), c1 = *(const f32x4*)(rope + (row * 32 + d0) * 2 + 4);
                        const f32x4 x1 = o1, x2 = o2;
                        o1[0] = (x1[0] * c0[0] - x2[0] * c0[1]) * qs; o2[0] = (x2[0] * c0[0] + x1[0] * c0[1]) * qs;
                        o1[1] = (x1[1] * c0[2] - x2[1] * c0[3]) * qs; o2[1] = (x2[1] * c0[2] + x1[1] * c0[3]) * qs;
                        o1[2] = (x1[2] * c1[0] - x2[2] * c1[1]) * qs; o2[2] = (x2[2] * c1[0] + x1[2] * c1[1]) * qs;
                        o1[3] = (x1[3] * c1[2] - x2[3] * c1[3]) * qs; o2[3] = (x2[3] * c1[2] + x1[3] * c1[3]) * qs;
                    }
                    if (g64 >= 8 && g64 < 24) {
                        const int bb = (int)(row >> 13), tt = (int)(row & (T - 1)), tile = tt >> 5, tk = tt & 31;
                        if (g64 < 16) {
                            kabs = fmaxf(kabs, fmaxf(fmaxf(fabsf(o1[0]), fabsf(o1[1])), fmaxf(fabsf(o1[2]), fabsf(o1[3]))));
                            kabs = fmaxf(kabs, fmaxf(fmaxf(fabsf(o2[0]), fabsf(o2[1])), fmaxf(fabsf(o2[2]), fabsf(o2[3]))));
                            const long base = ((long)(bb * 8 + (g64 - 8)) * 256 + tile) * 4;
                            const int ks = d0 >> 4, hk = (d0 >> 3) & 1, j0 = d0 & 7;
                            u32x2 w1, w2; w1.x = pk2(o1[0], o1[1]); w1.y = pk2(o1[2], o1[3]); w2.x = pk2(o2[0], o2[1]); w2.y = pk2(o2[2], o2[3]);
                            const auto sx = __builtin_amdgcn_permlane16_swap(w1.x, w2.x, false, false), sy = __builtin_amdgcn_permlane16_swap(w1.y, w2.y, false, false);
                            u32x4 wv; long slot;
                            if (fq & 1) { wv.x = sx[0]; wv.y = sy[0]; wv.z = w2.x; wv.w = w2.y; slot = (base + ks + 2) * 64 + hk * 32 + tk; }
                            else { wv.x = w1.x; wv.y = w1.y; wv.z = sx[1]; wv.w = sy[1]; slot = (base + ks) * 64 + hk * 32 + tk; }
                            *(u32x4*)(KF + slot * 8) = wv;
                        } else {
                            const int s = tk >> 4, u = tk & 15, hv = (u >> 2) & 1, jv = (u >> 3) * 4 + (u & 3);
                            const long base = (((long)(bb * 8 + (g64 - 16)) * 256 + tile) * 2) * 2 + s;
                            bf16_t* v0 = VT + ((base) * 64 + hv * 32 + d0) * 8 + jv;
                            bf16_t* v1 = VT + ((base + 2) * 64 + hv * 32 + d0) * 8 + jv;
#pragma unroll
                            for (int j = 0; j < 4; ++j) { v0[j * 8] = (bf16_t)f2bf(o1[j]); v1[j * 8] = (bf16_t)f2bf(o2[j]); }
                        }
                    } else if (gbase < 4160) {
                        bf16_t* hp = H + row * HP + gbase + d0;
                        u32x2 w1, w2; w1.x = pk2(o1[0], o1[1]); w1.y = pk2(o1[2], o1[3]); w2.x = pk2(o2[0], o2[1]); w2.y = pk2(o2[2], o2[3]);
                        const auto sx = __builtin_amdgcn_permlane16_swap(w1.x, w2.x, false, false), sy = __builtin_amdgcn_permlane16_swap(w1.y, w2.y, false, false);
                        u32x4 wv;
                        if (fq & 1) { wv.x = sx[0]; wv.y = sy[0]; wv.z = w2.x; wv.w = w2.y; hp += 32 - 4; }
                        else { wv.x = w1.x; wv.y = w1.y; wv.z = sx[1]; wv.w = sy[1]; }
                        *(u32x4*)hp = wv;
                    } else if (d0 < 8) { *(f32x4*)(side + row * 24 + d0) = o1 * WI_SCALE; }
                    else if (d0 < 24) { *(f32x4*)(side + row * 24 + d0) = o1; }
                }
            if (g64 >= 8 && g64 < 16) {
#pragma unroll
                for (int o = 32; o >= 1; o >>= 1) kabs = fmaxf(kabs, sxor_f(kabs, fq * 16 + fr, o));
                if ((threadIdx.x & 63) == 0) atomicMax(kmax + (brow >> 13) * 8 + (g64 - 8), __float_as_uint(kabs));
            }
        }
    }
};
struct EpiOut {
    const float* xres; float* out; bool dry;
    __device__ __forceinline__ void operator()(f32x4 (&acc)[2][2][4][2], int brow, int bcol, int wr, int wc, int fr, int fq) const {
#pragma unroll
        for (int ai = 0; ai < 2; ++ai)
#pragma unroll
            for (int m = 0; m < 4; ++m)
#pragma unroll
                for (int bj = 0; bj < 2; ++bj)
#pragma unroll
                    for (int n = 0; n < 2; ++n) {
                        const long idx = (long)(brow + ai * HALF + wr * 64 + m * 16 + fr) * DM + (bcol + bj * HALF + wc * 32 + n * 16 + 4 * fq);
                        const f32x4 xr = *(const f32x4*)(xres + idx);
                        if (!dry) *(f32x4*)(out + idx) = xr * ALPHA + acc[ai][bj][m][n];
                    }
    }
};

__device__ __forceinline__ void ln_phase(const Params& p, int layer, int wave_g, int nwaves, int lane, bool dry) {
    bf16_t* xb = (bf16_t*)(p.ws + WS_XB);
    const float* g = p.ln_g + layer * DM; const float* bb = p.ln_b + layer * DM;
    for (int row = wave_g; row < NTOK; row += nwaves) {
        float* zr = p.out + (long)row * DM;
        f32x4 v[4]; float s = 0.f;
#pragma unroll
        for (int r = 0; r < 4; ++r) { v[r] = *(const f32x4*)(zr + r * 256 + lane * 4); s += v[r][0] + v[r][1] + v[r][2] + v[r][3]; }
        const float mu = wave_sum(s, lane) * (1.f / DM);
        float q = 0.f;
#pragma unroll
        for (int r = 0; r < 4; ++r)
#pragma unroll
            for (int e = 0; e < 4; ++e) { const float d = v[r][e] - mu; q += d * d; }
        const float rstd = rsqrtf(wave_sum(q, lane) * (1.f / DM) + EPS);
#pragma unroll
        for (int r = 0; r < 4; ++r) {
            const f32x4 gg = *(const f32x4*)(g + r * 256 + lane * 4), bv = *(const f32x4*)(bb + r * 256 + lane * 4);
            f32x4 y;
#pragma unroll
            for (int e = 0; e < 4; ++e) y[e] = (v[r][e] - mu) * rstd * gg[e] + bv[e];
            if (dry) continue;
            *(f32x4*)(zr + r * 256 + lane * 4) = y;
            u32x2 w; w.x = pk2(y[0], y[1]); w.y = pk2(y[2], y[3]);
            *(u32x2*)(xb + (long)row * DM + r * 256 + lane * 4) = w;
        }
    }
}

__device__ __forceinline__ void conformer_tile(const Params& p, int layer, unsigned char* lds, int tile, bool dry, int wid_s) {
    bf16_t* H = (bf16_t*)(p.ws + WS_H);
    const int tid = otid(wid_s), lane = tid & 63, w = tid >> 6;
    const int tok0 = tile * 64, b = tok0 / T, tl0 = tok0 % T;
    bf16_t* hg = (bf16_t*)lds;
    float* cv = (float*)(lds + 49152);
    for (int idx = tid; idx < 94 * 32; idx += 512) {
        const int r = idx >> 5, cc = (idx & 31) * 8, tl = tl0 - 30 + r;
        u32x4 o = {0u, 0u, 0u, 0u};
        if (tl >= 0) {
            const bf16_t* src = H + ((long)b * T + tl) * HP + HGLU + cc;
            const u32x4 va = *(const u32x4*)src, ga = *(const u32x4*)(src + 256);
            o.x = pk2(bflo(va.x) * sigmoid_f(bflo(ga.x)), bfhi(va.x) * sigmoid_f(bfhi(ga.x)));
            o.y = pk2(bflo(va.y) * sigmoid_f(bflo(ga.y)), bfhi(va.y) * sigmoid_f(bfhi(ga.y)));
            o.z = pk2(bflo(va.z) * sigmoid_f(bflo(ga.z)), bfhi(va.z) * sigmoid_f(bfhi(ga.z)));
            o.w = pk2(bflo(va.w) * sigmoid_f(bflo(ga.w)), bfhi(va.w) * sigmoid_f(bfhi(ga.w)));
        }
        *(u32x4*)(hg + r * 256 + cc) = o;
    }
    __syncthreads();
    {
        const int c = tid & 255, half = tid >> 8;
        const float* cw = p.conv_w + (long)layer * 31 * 256 + c;
        float wj[31];
#pragma unroll
        for (int j = 0; j < 31; ++j) wj[j] = cw[j * 256];
        const float cb = p.conv_b[layer * 256 + c];
        float win[62];
#pragma unroll
        for (int r = 0; r < 62; ++r) win[r] = bf2f(hg[(half * 32 + r) * 256 + c]);
#pragma unroll
        for (int tt = 0; tt < 32; ++tt) {
            float a = cb;
#pragma unroll
            for (int j = 0; j < 31; ++j) a = fmaf(win[tt + j], wj[j], a);
            cv[(half * 32 + tt) * 256 + c] = a;
        }
    }
    __syncthreads();
    bf16_t* at = (bf16_t*)lds;
    {
        const f32x4 gg = *(const f32x4*)(p.cln_g + layer * 256 + lane * 4), bv = *(const f32x4*)(p.cln_b + layer * 256 + lane * 4);
#pragma unroll
        for (int tt = 0; tt < 8; ++tt) {
            const int t = w * 8 + tt;
            const f32x4 v = *(const f32x4*)(cv + t * 256 + lane * 4);
            const float mu = wave_sum(v[0] + v[1] + v[2] + v[3], lane) * (1.f / 256.f);
            float q = 0.f;
#pragma unroll
            for (int e = 0; e < 4; ++e) { const float d = v[e] - mu; q += d * d; }
            const float rstd = rsqrtf(wave_sum(q, lane) * (1.f / 256.f) + EPS);
            float y[4];
#pragma unroll
            for (int e = 0; e < 4; ++e) y[e] = silu_f((v[e] - mu) * rstd * gg[e] + bv[e]);
            u32x2 o; o.x = pk2(y[0], y[1]); o.y = pk2(y[2], y[3]);
            *(u32x2*)(at + t * 264 + lane * 4) = o;
        }
    }
    __syncthreads();
    {
        f32x16 acc0 = {}, acc1 = {};
        const bf16_t* pwt = (const bf16_t*)(p.ws + WS_PWT) + (long)layer * 65536 + (w * 32 + (lane & 31)) * 256 + 8 * (lane >> 5);
        const bf16_t* ap = at + (lane & 31) * 264 + 8 * (lane >> 5);
#pragma unroll 4
        for (int ks = 0; ks < 16; ++ks) {
            const bf16x8 bfr = *(const bf16x8*)(pwt + ks * 16);
            const bf16x8 a0 = *(const bf16x8*)(ap + ks * 16), a1 = *(const bf16x8*)(ap + 32 * 264 + ks * 16);
            acc0 = __builtin_amdgcn_mfma_f32_32x32x16_bf16(a0, bfr, acc0, 0, 0, 0);
            acc1 = __builtin_amdgcn_mfma_f32_32x32x16_bf16(a1, bfr, acc1, 0, 0, 0);
        }
        const int ch = w * 32 + (lane & 31);
        const float pb = p.pw_b[layer * 256 + ch];
#pragma unroll
        for (int i = 0; i < 16; ++i) {
            const int row = (i & 3) + 8 * (i >> 2) + 4 * (lane >> 5);
            bf16_t* g0 = H + (long)(tok0 + row) * HP + HBG + ch;
            bf16_t* g1 = H + (long)(tok0 + 32 + row) * HP + HBG + ch;
            const unsigned r0 = f2bf((acc0[i] + pb) * silu_f(bf2f(*g0))), r1 = f2bf((acc1[i] + pb) * silu_f(bf2f(*g1)));
            if (!dry) { *g0 = (bf16_t)r0; *g1 = (bf16_t)r1; }
        }
    }
    __syncthreads();
}

__device__ __forceinline__ float rdlane(float v, int l) { return __uint_as_float(__builtin_amdgcn_readlane(__float_as_uint(v), l)); }

__device__ __forceinline__ void gla_local_item(const Params& p, int layer, int item_, int lane, bool dry) {
    const int item = __builtin_amdgcn_readfirstlane(item_);
    bf16_t* H = (bf16_t*)(p.ws + WS_H);
    const float* side = (const float*)(p.ws + WS_SIDE);
    float* bcum = (float*)(p.ws + WS_BCUM); float* U = (float*)(p.ws + WS_U); float* DEC = (float*)(p.ws + WS_DEC);
    const int bh = item >> 7, c = item & 127, b = bh >> 2, h = bh & 3;
    const long tok0 = (long)b * T + c * 64, tok = tok0 + lane;
    float clr[16];
#pragma unroll
    for (int r = 0; r < 4; ++r) { const f32x4 v = *(const f32x4*)(side + tok * 24 + 8 + r * 4); clr[r * 4] = v[0]; clr[r * 4 + 1] = v[1]; clr[r * 4 + 2] = v[2]; clr[r * 4 + 3] = v[3]; }
    const float* gw = p.gate_w2 + (long)layer * 16 * 128 + h * 32; const float* gb = p.gate_b + layer * 128 + h * 32;
    float* bcp = bcum + tok * 128 + h * 32;
#pragma unroll 1
    for (int d = 0; d < 32; ++d) {
        float z = gb[d];
#pragma unroll
        for (int r = 0; r < 16; ++r) z = fmaf(clr[r], gw[r * 128 + d], z);
        float g = (fminf(z, 0.f) - __logf(1.f + __expf(-fabsf(z)))) * (1.f / 16.f);
#pragma unroll
        for (int o = 1; o < 64; o <<= 1) { const float up = __int_as_float(bperm_i((lane - o) & 63, __float_as_int(g))); if (lane >= o) g += up; }
        bcp[d] = g;
    }
    float bc[32];
#pragma unroll
    for (int r = 0; r < 8; ++r) { const f32x4 v = *(const f32x4*)(bcp + r * 4); bc[r * 4] = v[0]; bc[r * 4 + 1] = v[1]; bc[r * 4 + 2] = v[2]; bc[r * 4 + 3] = v[3]; }
    float kk[32];
    {
        const bf16_t* kp = H + tok * HP + HCK + h * 32;
#pragma unroll
        for (int r = 0; r < 4; ++r) {
            const u32x4 kv = *(const u32x4*)(kp + r * 8);
            kk[r * 8 + 0] = bflo(kv.x); kk[r * 8 + 1] = bfhi(kv.x); kk[r * 8 + 2] = bflo(kv.y); kk[r * 8 + 3] = bfhi(kv.y);
            kk[r * 8 + 4] = bflo(kv.z); kk[r * 8 + 5] = bfhi(kv.z); kk[r * 8 + 6] = bflo(kv.w); kk[r * 8 + 7] = bfhi(kv.w);
        }
#pragma unroll
        for (int d = 0; d < 32; ++d) { const float bl = rdlane(bc[d], 63); kk[d] *= __expf(bl - bc[d]); }
    }
    float acc[32];
#pragma unroll
    for (int d = 0; d < 32; ++d) acc[d] = 0.f;
    const bf16_t* vp = H + tok0 * HP + HCV + h * 64 + lane;
#pragma unroll 1
    for (int t8 = 0; t8 < 64; t8 += 8) {
        float vv[8];
#pragma unroll
        for (int u = 0; u < 8; ++u) vv[u] = bf2f(vp[(long)(t8 + u) * HP]);
#pragma unroll
        for (int u = 0; u < 8; ++u)
#pragma unroll
            for (int d = 0; d < 32; ++d) acc[d] = fmaf(rdlane(kk[d], t8 + u), vv[u], acc[d]);
    }
#pragma unroll
    for (int d = 0; d < 32; ++d) if (!dry) U[(long)item * 2048 + d * 64 + lane] = acc[d];
    if (lane == 63) {
#pragma unroll
        for (int r = 0; r < 8; ++r) { f32x4 v = {__expf(bc[r * 4]), __expf(bc[r * 4 + 1]), __expf(bc[r * 4 + 2]), __expf(bc[r * 4 + 3])}; *(f32x4*)(DEC + item * 32 + r * 4) = v; }
    }
}

__device__ __forceinline__ void gla_scan(const Params& p, int gt) {
    float* U = (float*)(p.ws + WS_U); const float* DEC = (const float*)(p.ws + WS_DEC);
    const int bh = gt >> 11, de = gt & 2047, d = de >> 6;
    float s = 0.f;
    for (int c0 = 0; c0 < 128; c0 += 32) {
        float u[32], dc[32];
#pragma unroll
        for (int i = 0; i < 32; ++i) { u[i] = U[(long)(bh * 128 + c0 + i) * 2048 + de]; dc[i] = DEC[(bh * 128 + c0 + i) * 32 + d]; }
#pragma unroll
        for (int i = 0; i < 32; ++i) { U[(long)(bh * 128 + c0 + i) * 2048 + de] = s; s = fmaf(dc[i], s, u[i]); }
    }
}

__device__ __forceinline__ void gla_out_item(const Params& p, int layer, unsigned char* ldsw, int item_, int lane, bool dry) {
    const int item = __builtin_amdgcn_readfirstlane(item_);
    bf16_t* H = (bf16_t*)(p.ws + WS_H);
    const float* bcum = (const float*)(p.ws + WS_BCUM); const float* U = (const float*)(p.ws + WS_U);
    float* sA = (float*)ldsw; bf16_t* sV = (bf16_t*)(ldsw + 8192);
    const int bh = item >> 7, c = item & 127, b = bh >> 2, h = bh & 3;
    const long tok = (long)b * T + c * 64 + lane;
#pragma unroll
    for (int r = 0; r < 8; ++r) *(f32x4*)(sA + r * 256 + lane * 4) = *(const f32x4*)(U + (long)item * 2048 + r * 256 + lane * 4);
#pragma unroll
    for (int r = 0; r < 8; ++r) *(u32x4*)(sV + lane * 64 + r * 8) = *(const u32x4*)(H + tok * HP + HCV + h * 64 + r * 8);
    WAVE_SYNC();
    float o[64];
#pragma unroll
    for (int e = 0; e < 64; ++e) o[e] = 0.f;
    {
        const bf16_t* qp = H + tok * HP + HCQ + h * 32; const float* bp = bcum + tok * 128 + h * 32;
#pragma unroll 1
        for (int d = 0; d < 32; ++d) {
            const float qd = bf2f(qp[d]) * 0.17677669529663687f * __expf(bp[d]);
#pragma unroll
            for (int e4 = 0; e4 < 16; ++e4) {
                const f32x4 s4 = *(const f32x4*)(sA + d * 64 + e4 * 4);
                o[e4 * 4] = fmaf(qd, s4[0], o[e4 * 4]); o[e4 * 4 + 1] = fmaf(qd, s4[1], o[e4 * 4 + 1]);
                o[e4 * 4 + 2] = fmaf(qd, s4[2], o[e4 * 4 + 2]); o[e4 * 4 + 3] = fmaf(qd, s4[3], o[e4 * 4 + 3]);
            }
        }
    }
    WAVE_SYNC();
    {
        const bf16_t* kp = H + tok * HP + HCK + h * 32;
#pragma unroll
        for (int r = 0; r < 4; ++r) {
            const u32x4 kv = *(const u32x4*)(kp + r * 8);
            const f32x4 b0 = *(const f32x4*)(bcum + tok * 128 + h * 32 + r * 8), b1 = *(const f32x4*)(bcum + tok * 128 + h * 32 + r * 8 + 4);
            f32x4 k0 = {bflo(kv.x) * __expf(-b0[0]), bfhi(kv.x) * __expf(-b0[1]), bflo(kv.y) * __expf(-b0[2]), bfhi(kv.y) * __expf(-b0[3])};
            f32x4 k1 = {bflo(kv.z) * __expf(-b1[0]), bfhi(kv.z) * __expf(-b1[1]), bflo(kv.w) * __expf(-b1[2]), bfhi(kv.w) * __expf(-b1[3])};
            *(f32x4*)(sA + lane * 32 + r * 8) = k0; *(f32x4*)(sA + lane * 32 + r * 8 + 4) = k1;
        }
    }
    float qe[32];
    {
        const bf16_t* qp = H + tok * HP + HCQ + h * 32;
#pragma unroll
        for (int r = 0; r < 4; ++r) {
            const u32x4 qv = *(const u32x4*)(qp + r * 8);
            const f32x4 b0 = *(const f32x4*)(bcum + tok * 128 + h * 32 + r * 8), b1 = *(const f32x4*)(bcum + tok * 128 + h * 32 + r * 8 + 4);
            const float qq[8] = {bflo(qv.x), bfhi(qv.x), bflo(qv.y), bfhi(qv.y), bflo(qv.z), bfhi(qv.z), bflo(qv.w), bfhi(qv.w)};
            const float bb[8] = {b0[0], b0[1], b0[2], b0[3], b1[0], b1[1], b1[2], b1[3]};
#pragma unroll
            for (int e = 0; e < 8; ++e) qe[r * 8 + e] = qq[e] * 0.17677669529663687f * __expf(bb[e]);
        }
    }
    WAVE_SYNC();
#pragma unroll 1
    for (int j = 0; j < 64; ++j) {
        float a = 0.f;
#pragma unroll
        for (int d4 = 0; d4 < 8; ++d4) {
            const f32x4 k4 = *(const f32x4*)(sA + j * 32 + d4 * 4);
            a = fmaf(qe[d4 * 4], k4[0], a); a = fmaf(qe[d4 * 4 + 1], k4[1], a); a = fmaf(qe[d4 * 4 + 2], k4[2], a); a = fmaf(qe[d4 * 4 + 3], k4[3], a);
        }
        if (j > lane) a = 0.f;
#pragma unroll
        for (int e8 = 0; e8 < 8; ++e8) {
            const u32x4 v8 = *(const u32x4*)(sV + j * 64 + e8 * 8);
            o[e8 * 8 + 0] = fmaf(a, bflo(v8.x), o[e8 * 8 + 0]); o[e8 * 8 + 1] = fmaf(a, bfhi(v8.x), o[e8 * 8 + 1]);
            o[e8 * 8 + 2] = fmaf(a, bflo(v8.y), o[e8 * 8 + 2]); o[e8 * 8 + 3] = fmaf(a, bfhi(v8.y), o[e8 * 8 + 3]);
            o[e8 * 8 + 4] = fmaf(a, bflo(v8.z), o[e8 * 8 + 4]); o[e8 * 8 + 5] = fmaf(a, bfhi(v8.z), o[e8 * 8 + 5]);
            o[e8 * 8 + 6] = fmaf(a, bflo(v8.w), o[e8 * 8 + 6]); o[e8 * 8 + 7] = fmaf(a, bfhi(v8.w), o[e8 * 8 + 7]);
        }
    }
    float ss = 0.f;
#pragma unroll
    for (int e = 0; e < 64; ++e) ss = fmaf(o[e], o[e], ss);
    const float rms = rsqrtf(ss * (1.f / 64.f) + EPS);
    const float* gn = p.gnorm_g + layer * 256 + h * 64;
    bf16_t* cg_p = H + tok * HP + HCG + h * 64;
#pragma unroll
    for (int r = 0; r < 8; ++r) {
        const u32x4 gv = *(const u32x4*)(cg_p + r * 8);
        const float gq[8] = {bflo(gv.x), bfhi(gv.x), bflo(gv.y), bfhi(gv.y), bflo(gv.z), bfhi(gv.z), bflo(gv.w), bfhi(gv.w)};
        float y[8];
#pragma unroll
        for (int e = 0; e < 8; ++e) y[e] = o[r * 8 + e] * rms * gn[r * 8 + e] * silu_f(gq[e]);
        u32x4 w; w.x = pk2(y[0], y[1]); w.y = pk2(y[2], y[3]); w.z = pk2(y[4], y[5]); w.w = pk2(y[6], y[7]);
        if (!dry) *(u32x4*)(cg_p + r * 8) = w;
    }
    WAVE_SYNC();
}

constexpr int MPITCH = 260;
constexpr int HPITCH = 516;
constexpr int L_HIST = 0;
constexpr int L_CAND = 66560;
constexpr int L_CCNT = L_CAND + 65536;
constexpr int L_QINF = L_CCNT + 2048;
constexpr int L_MTAB = L_QINF + 1024 + 64;
static_assert(L_MTAB + 8192 <= LDS_BYTES, "dsa lds");
__device__ __forceinline__ int mpos(int rr) { return 16 * ((rr >> 2) & 1) + (rr & 3) + 4 * (rr >> 3); }
constexpr int SUBCAP = 32;

__device__ __forceinline__ unsigned mono_bits(float f) { const unsigned u = __float_as_uint(f); return u ^ ((u >> 31) ? 0xffffffffu : 0x80000000u); }
__device__ __forceinline__ void idx_loadk(const bf16_t* Hb, int s0, int lane, bf16x8 (&kf)[2][2]) {
    const bf16_t* kp = Hb + (long)(s0 + (lane & 15)) * HP + HKI + 8 * (lane >> 4);
#pragma unroll
    for (int kb = 0; kb < 2; ++kb)
#pragma unroll
        for (int ks = 0; ks < 2; ++ks) kf[kb][ks] = *(const bf16x8*)(kp + (long)kb * 16 * HP + ks * 32);
}
__device__ __forceinline__ void idx_scores(const bf16x8 (&kf)[2][2], const bf16x8 (&qf)[8][2], const bf16x8 (&ql)[2][2], const float (&wh)[8], float (&score)[8]) {
    f32x4 lin[2];
#pragma unroll
    for (int kb = 0; kb < 2; ++kb) {
        lin[kb] = (f32x4){0.f, 0.f, 0.f, 0.f};
#pragma unroll
        for (int ks = 0; ks < 2; ++ks) {
            lin[kb] = __builtin_amdgcn_mfma_f32_16x16x32_bf16(kf[kb][ks], ql[0][ks], lin[kb], 0, 0, 0);
            lin[kb] = __builtin_amdgcn_mfma_f32_16x16x32_bf16(kf[kb][ks], ql[1][ks], lin[kb], 0, 0, 0);
        }
    }
#pragma unroll
    for (int i = 0; i < 8; ++i) score[i] = lin[i >> 2][i & 3];
#pragma unroll
    for (int hd = 0; hd < 8; ++hd) {
        f32x4 acc[2];
#pragma unroll
        for (int kb = 0; kb < 2; ++kb) {
            acc[kb] = (f32x4){0.f, 0.f, 0.f, 0.f};
#pragma unroll
            for (int ks = 0; ks < 2; ++ks) acc[kb] = __builtin_amdgcn_mfma_f32_16x16x32_bf16(kf[kb][ks], qf[hd][ks], acc[kb], 0, 0, 0);
        }
#pragma unroll
        for (int kb = 0; kb < 2; ++kb)
#pragma unroll
            for (int i = 0; i < 4; ++i) score[kb * 4 + i] = fmaf(fabsf(acc[kb][i]), wh[hd], score[kb * 4 + i]);
        if ((hd & 3) == 3) __builtin_amdgcn_sched_barrier(0);
    }
}

template <bool FAST>
__device__ __forceinline__ void attn_tile(const bf16x8 (&kf)[4], const bf16x8 (&vf)[4], const bf16x8 (&qfr)[2][4], f32x16 (&O)[2][2], float (&mrun)[2], float (&lrun)[2],
                                          const unsigned* hist, const float* mtab, int r32, int hh, int tile) {
#pragma unroll
    for (int qb = 0; qb < 2; ++qb) {
        f32x16 S;
        const unsigned mw = hist[(qb * 32 + r32) * MPITCH + tile] >> (16 * hh);
#pragma unroll
        for (int g8 = 0; g8 < 2; ++g8) {
            const float* mt = mtab + ((mw >> (8 * g8)) & 255u) * 8;
            const f32x4 ma = *(const f32x4*)mt, mb = *(const f32x4*)(mt + 4);
            S[8 * g8] = ma[0]; S[8 * g8 + 1] = ma[1]; S[8 * g8 + 2] = ma[2]; S[8 * g8 + 3] = ma[3];
            S[8 * g8 + 4] = mb[0]; S[8 * g8 + 5] = mb[1]; S[8 * g8 + 6] = mb[2]; S[8 * g8 + 7] = mb[3];
        }
#pragma unroll
        for (int ks = 0; ks < 4; ++ks) S = __builtin_amdgcn_mfma_f32_32x32x16_bf16(kf[ks], qfr[qb][ks], S, 0, 0, 0);
        float pr[16]; float ps = 0.f;
        if (FAST) {
#pragma unroll
            for (int i = 0; i < 16; ++i) { pr[i] = __builtin_amdgcn_exp2f(S[i]); ps += pr[i]; }
        } else {
            float mx = fmaxf(fmaxf(S[0], S[1]), S[2]);
#pragma unroll
            for (int i = 3; i < 15; i += 2) mx = fmaxf(fmaxf(mx, S[i]), S[i + 1]);
            mx = fmaxf(mx, S[15]);
            { const auto sw = __builtin_amdgcn_permlane32_swap(__float_as_uint(mx), __float_as_uint(mx), false, false); mx = fmaxf(__uint_as_float(sw[0]), __uint_as_float(sw[1])); }
            if (__any(mx > mrun[qb])) {
                const float mnew = fmaxf(mx, mrun[qb]);
                const float alpha = __builtin_amdgcn_exp2f(mrun[qb] - mnew);
                mrun[qb] = mnew; lrun[qb] *= alpha;
#pragma unroll
                for (int db = 0; db < 2; ++db)
#pragma unroll
                    for (int i = 0; i < 16; ++i) O[db][qb][i] *= alpha;
            }
            const float mref = fmaxf(mrun[qb], -1000.f);
#pragma unroll
            for (int i = 0; i < 16; ++i) { pr[i] = __builtin_amdgcn_exp2f(S[i] - mref); ps += pr[i]; }
        }
        lrun[qb] += ps;
        bf16x8 pf[2];
#pragma unroll
        for (int s = 0; s < 2; ++s) {
            u32x4 pw; pw.x = pk2(pr[8 * s], pr[8 * s + 1]); pw.y = pk2(pr[8 * s + 2], pr[8 * s + 3]); pw.z = pk2(pr[8 * s + 4], pr[8 * s + 5]); pw.w = pk2(pr[8 * s + 6], pr[8 * s + 7]);
            pf[s] = __builtin_bit_cast(bf16x8, pw);
        }
#pragma unroll
        for (int db = 0; db < 2; ++db)
#pragma unroll
            for (int s = 0; s < 2; ++s) O[db][qb] = __builtin_amdgcn_mfma_f32_32x32x16_bf16(vf[db * 2 + s], pf[s], O[db][qb], 0, 0, 0);
    }
}
template <bool FAST>
__device__ __forceinline__ void attn_loop(const bf16_t* Kp, const bf16_t* Vp, const bf16x8 (&qfr)[2][4], f32x16 (&O)[2][2], float (&mrun)[2], float (&lrun)[2],
                                          const unsigned* hist, const float* mtab, int r32, int hh, int nt32, bool dry2) {
    bf16x8 kf[4], vf[4], kg[4], vg[4];
#pragma unroll
    for (int ks = 0; ks < 4; ++ks) { kf[ks] = *(const bf16x8*)(Kp + ks * 512); vf[ks] = *(const bf16x8*)(Vp + ks * 512); }
#pragma unroll 1
    for (int tile = 0; tile < nt32; tile += 2) {
        {
            const int tn = dry2 ? 0 : tile + 1;
#pragma unroll
            for (int ks = 0; ks < 4; ++ks) { kg[ks] = *(const bf16x8*)(Kp + (long)tn * 2048 + ks * 512); vg[ks] = *(const bf16x8*)(Vp + (long)tn * 2048 + ks * 512); }
        }
        attn_tile<FAST>(kf, vf, qfr, O, mrun, lrun, hist, mtab, r32, hh, tile);
        {
            const int tn = dry2 ? 0 : ((tile + 2 < nt32) ? tile + 2 : tile);
#pragma unroll
            for (int ks = 0; ks < 4; ++ks) { kf[ks] = *(const bf16x8*)(Kp + (long)tn * 2048 + ks * 512); vf[ks] = *(const bf16x8*)(Vp + (long)tn * 2048 + ks * 512); }
        }
        attn_tile<FAST>(kg, vg, qfr, O, mrun, lrun, hist, mtab, r32, hh, tile + 1);
    }
}

__device__ __forceinline__ void dsa_item(const Params& p, unsigned char* lds, int b, int qblk, bool dry, int wid_s) {
    bf16_t* H = (bf16_t*)(p.ws + WS_H);
    const float* side = (const float*)(p.ws + WS_SIDE);
    const bf16_t* Hb = H + (long)b * T * HP;
    const int tid = otid(wid_s), lane = tid & 63, w = tid >> 6, hq = lane >> 4;
    const int qg = w & 3, kh = w >> 2;
    const int t0 = qblk * 64, qloc = qg * 16 + (lane & 15), t = t0 + qloc;
    unsigned* hist = (unsigned*)(lds + L_HIST);
    unsigned* cand = (unsigned*)(lds + L_CAND);
    unsigned* ccnt = (unsigned*)(lds + L_CCNT);
    int* qinf = (int*)(lds + L_QINF);

    for (int i = tid; i < 64 * MPITCH; i += 512) hist[i] = 0u;
    for (int i = tid; i < 2048; i += 512) ((float*)(lds + L_MTAB))[i] = ((i >> 3) >> (i & 7)) & 1 ? 0.f : -1e30f;
    bf16x8 qf[8][2]; bf16x8 ql[2][2]; float wi[8]; float inv, fb0c;
    {
        const bf16_t* qp = Hb + (long)t * HP + HQI + 8 * hq;
#pragma unroll
        for (int hd = 0; hd < 8; ++hd)
#pragma unroll
            for (int ks = 0; ks < 2; ++ks) qf[hd][ks] = *(const bf16x8*)(qp + hd * 64 + ks * 32);
        const float* sp = side + ((long)b * T + t) * 24;
        const f32x4 w0 = *(const f32x4*)sp, w1 = *(const f32x4*)(sp + 4);
        wi[0] = w0[0]; wi[1] = w0[1]; wi[2] = w0[2]; wi[3] = w0[3]; wi[4] = w1[0]; wi[5] = w1[1]; wi[6] = w1[2]; wi[7] = w1[3];
        float n2 = 0.f;
#pragma unroll
        for (int i = 0; i < 8; ++i) n2 = fmaf(wi[i], wi[i], n2);
        const float nrm = fmaxf(SIG_UNIT * sqrtf(n2), 1e-30f);
        inv = 64.f / nrm;
        fb0c = 256.f - 64.f * 3.19f * (wi[0] + wi[1] + wi[2] + wi[3] + wi[4] + wi[5] + wi[6] + wi[7]) / nrm;
#pragma unroll
        for (int i = 0; i < 8; ++i) wi[i] *= 0.5f;
#pragma unroll
        for (int ks = 0; ks < 2; ++ks) {
            float ql_f[8];
#pragma unroll
            for (int j = 0; j < 8; ++j) ql_f[j] = 0.f;
#pragma unroll
            for (int hd = 0; hd < 8; ++hd) {
                const u32x4 qv = __builtin_bit_cast(u32x4, qf[hd][ks]);
                ql_f[0] = fmaf(wi[hd], bflo(qv.x), ql_f[0]); ql_f[1] = fmaf(wi[hd], bfhi(qv.x), ql_f[1]); ql_f[2] = fmaf(wi[hd], bflo(qv.y), ql_f[2]); ql_f[3] = fmaf(wi[hd], bfhi(qv.y), ql_f[3]);
                ql_f[4] = fmaf(wi[hd], bflo(qv.z), ql_f[4]); ql_f[5] = fmaf(wi[hd], bfhi(qv.z), ql_f[5]); ql_f[6] = fmaf(wi[hd], bflo(qv.w), ql_f[6]); ql_f[7] = fmaf(wi[hd], bfhi(qv.w), ql_f[7]);
            }
            u32x4 hi4; hi4.x = pk2(ql_f[0], ql_f[1]); hi4.y = pk2(ql_f[2], ql_f[3]); hi4.z = pk2(ql_f[4], ql_f[5]); hi4.w = pk2(ql_f[6], ql_f[7]);
            u32x4 lo4;
            lo4.x = pk2(ql_f[0] - bflo(hi4.x), ql_f[1] - bfhi(hi4.x)); lo4.y = pk2(ql_f[2] - bflo(hi4.y), ql_f[3] - bfhi(hi4.y));
            lo4.z = pk2(ql_f[4] - bflo(hi4.z), ql_f[5] - bfhi(hi4.z)); lo4.w = pk2(ql_f[6] - bflo(hi4.w), ql_f[7] - bfhi(hi4.w));
            ql[0][ks] = __builtin_bit_cast(bf16x8, hi4); ql[1][ks] = __builtin_bit_cast(bf16x8, lo4);
        }
    }
    const int ntile = (t0 + 64 + 127) >> 7;
    const int tmaxw = t0 + qg * 16 + 15;
    __syncthreads();
    int nit = 0;
    { const int v = tmaxw - kh * 64; if (v >= 0) nit = 2 * (v >> 7) + (((v & 127) >= 32) ? 2 : 1); }
    float fa = inv, fbias = fb0c;
    bool active = true;
#pragma unroll 1
    for (int level = 0; level < 2; ++level) {
        unsigned* hbase = level ? cand : hist;
        const bool wave_on = __any(active);
        if (wave_on) {
            const unsigned incv = 1u << ((qloc & 1) * 16);
            unsigned* hrow = hbase + (qloc >> 1) * HPITCH;
            bf16x8 kf[2][2];
            idx_loadk(Hb, kh * 64, lane, kf);
#pragma unroll 1
            for (int it = 0; it < nit; ++it) {
                const int s0 = (it >> 1) * 128 + kh * 64 + (it & 1) * 32;
                const int itn = (it + 1 < nit) ? it + 1 : it;
                bf16x8 kn[2][2];
                idx_loadk(Hb, (itn >> 1) * 128 + kh * 64 + (itn & 1) * 32, lane, kn);
                float score[8];
                idx_scores(kf, qf, ql, wi, score);
                if (s0 + 31 <= t0 + qg * 16) {
#pragma unroll
                    for (int i = 0; i < 8; ++i) { const unsigned bin = (unsigned)__builtin_amdgcn_fmed3f(fmaf(score[i], fa, fbias), 0.f, 511.5f); atomicAdd(hrow + bin, incv); }
                } else {
#pragma unroll
                    for (int i = 0; i < 8; ++i) {
                        const int s = s0 + (i >> 2) * 16 + hq * 4 + (i & 3);
                        if (s <= t) { const unsigned bin = (unsigned)__builtin_amdgcn_fmed3f(fmaf(score[i], fa, fbias), 0.f, 511.5f); atomicAdd(hrow + bin, incv); }
                    }
                }
#pragma unroll
                for (int kb = 0; kb < 2; ++kb)
#pragma unroll
                    for (int ks = 0; ks < 2; ++ks) kf[kb][ks] = kn[kb][ks];
            }
        }
        __syncthreads();
#pragma unroll 1
        for (int qq = 0; qq < 8; ++qq) {
            const int q = w * 8 + qq;
            if (level && !qinf[q * 4 + 3]) continue;
            const u32x4 wa = *(const u32x4*)(hbase + (q >> 1) * HPITCH + 8 * lane), wb = *(const u32x4*)(hbase + (q >> 1) * HPITCH + 8 * lane + 4);
            const int sh = (q & 1) * 16;
            const unsigned c[8] = {(wa.x >> sh) & 0xffffu, (wa.y >> sh) & 0xffffu, (wa.z >> sh) & 0xffffu, (wa.w >> sh) & 0xffffu, (wb.x >> sh) & 0xffffu, (wb.y >> sh) & 0xffffu, (wb.z >> sh) & 0xffffu, (wb.w >> sh) & 0xffffu};
            const unsigned tot = c[0] + c[1] + c[2] + c[3] + c[4] + c[5] + c[6] + c[7];
            unsigned S = tot;
#pragma unroll
            for (int o = 1; o < 64; o <<= 1) { const unsigned dn = (unsigned)bperm_i((lane + o) & 63, (int)S); if (lane + o < 64) S += dn; }
            const unsigned total = (unsigned)__builtin_amdgcn_readfirstlane((int)S);
            const u64 bal = __ballot(S >= 256u);
            int b1 = -1, r1 = 0, n1 = 0;
            if (total >= 256u) {
                const int Ls = 63 - __clzll(bal);
                unsigned cum = S - tot; bool found = false; int lb = -1, lr = 0, ln = 0;
#pragma unroll
                for (int j = 7; j >= 0; --j) { const bool hit = !found && (cum + c[j] >= 256u); if (hit) { lb = 8 * lane + j; lr = 256 - (int)cum; ln = (int)c[j]; found = true; } cum += c[j]; }
                b1 = bperm_i(Ls, lb); r1 = bperm_i(Ls, lr); n1 = bperm_i(Ls, ln);
            }
            if (lane == 0) { qinf[q * 4] = b1; qinf[q * 4 + 1] = r1; qinf[q * 4 + 2] = n1; }
        }
        __syncthreads();
        if (level == 0) { for (int i = tid; i < 64 * MPITCH; i += 512) hist[i] = 0u; }
        if (tid == 0) qinf[256] = 0;
        __syncthreads();
        if (wave_on) {
            const int b1 = qinf[qloc * 4];
            const float fsel = !active ? __builtin_inff() : ((b1 < 0) ? -__builtin_inff() : ((b1 >= 511) ? __builtin_inff() : (float)(b1 + 1)));
            const float fcand = !active ? __builtin_inff() : ((b1 <= 0) ? -__builtin_inff() : (float)b1);
            const float fb1 = (float)(b1 < 0 ? 0 : b1);
            unsigned* cslot = cand + (qloc * 8 + kh * 4 + hq) * SUBCAP; int ncand = 0;
            bf16x8 kf[2][2];
            idx_loadk(Hb, kh * 64, lane, kf);
#pragma unroll 1
            for (int it = 0; it < nit; ++it) {
                const int s0 = (it >> 1) * 128 + kh * 64 + (it & 1) * 32;
                const int itn = (it + 1 < nit) ? it + 1 : it;
                bf16x8 kn[2][2];
                idx_loadk(Hb, (itn >> 1) * 128 + kh * 64 + (itn & 1) * 32, lane, kn);
                float score[8];
                idx_scores(kf, qf, ql, wi, score);
                unsigned m0 = 0u;
                if (s0 + 31 <= t0 + qg * 16) {
#pragma unroll
                    for (int i = 0; i < 8; ++i) {
                        const int rr = (i >> 2) * 16 + hq * 4 + (i & 3), s = s0 + rr;
                        const float fb = fmaf(score[i], fa, fbias);
                        if (fb >= fcand) {
                            if (fb >= fsel) m0 |= 1u << (16 * (hq & 1) + 4 * (hq >> 1) + (i & 3) + 8 * (i >> 2));
                            else {
                                const unsigned q19 = (unsigned)__builtin_amdgcn_fmed3f((fb - fb1) * 524288.f, 0.f, 524287.f);
                                if (ncand < SUBCAP) cslot[ncand] = (q19 << 13) | (unsigned)(8191 - s);
                                ++ncand;
                            }
                        }
                    }
                } else {
#pragma unroll
                    for (int i = 0; i < 8; ++i) {
                        const int rr = (i >> 2) * 16 + hq * 4 + (i & 3), s = s0 + rr;
                        const float fb = fmaf(score[i], fa, fbias);
                        if (fb >= fcand && s <= t) {
                            if (fb >= fsel) m0 |= 1u << (16 * (hq & 1) + 4 * (hq >> 1) + (i & 3) + 8 * (i >> 2));
                            else {
                                const unsigned q19 = (unsigned)__builtin_amdgcn_fmed3f((fb - fb1) * 524288.f, 0.f, 524287.f);
                                if (ncand < SUBCAP) cslot[ncand] = (q19 << 13) | (unsigned)(8191 - s);
                                ++ncand;
                            }
                        }
                    }
                }
                if (m0) atomicOr(&hist[qloc * MPITCH + (s0 >> 5)], m0);
#pragma unroll
                for (int kb = 0; kb < 2; ++kb)
#pragma unroll
                    for (int ks = 0; ks < 2; ++ks) kf[kb][ks] = kn[kb][ks];
            }
            ccnt[qloc * 8 + kh * 4 + hq] = (unsigned)ncand;
        } else ccnt[qloc * 8 + kh * 4 + hq] = 0u;
        __syncthreads();
#pragma unroll 1
        for (int qq = 0; qq < 8; ++qq) {
            const int q = w * 8 + qq;
            if (level && !qinf[q * 4 + 3]) continue;
            const int r1 = qinf[q * 4 + 1];
            const int wr_ = lane >> 3, sl0 = (lane & 7) * 4;
            int cw = (int)ccnt[q * 8 + wr_];
            const bool ovf = __any(cw > SUBCAP) && (level == 0);
            if (lane == 0) { qinf[q * 4 + 3] = ovf ? 1 : 0; if (ovf) qinf[256] = 1; }
            if (ovf || r1 <= 0) continue;
            if (cw > SUBCAP) cw = SUBCAP;
            const u32x4 mine = *(const u32x4*)(cand + (q * 8 + wr_) * SUBCAP + sl0);
            int rk0 = 0, rk1 = 0, rk2 = 0, rk3 = 0;
#pragma unroll 1
            for (int ww = 0; ww < 8; ++ww) {
                int cn = (int)ccnt[q * 8 + ww]; if (cn > SUBCAP) cn = SUBCAP;
                const unsigned* cl = cand + (q * 8 + ww) * SUBCAP;
#pragma unroll 1
                for (int j = 0; j < cn; ++j) { const unsigned cv = cl[j]; rk0 += (cv > mine.x); rk1 += (cv > mine.y); rk2 += (cv > mine.z); rk3 += (cv > mine.w); }
            }
            if (sl0 + 0 < cw && rk0 < r1) { const int s = 8191 - (int)(mine.x & 8191u); atomicOr(&hist[q * MPITCH + (s >> 5)], 1u << mpos(s & 31)); }
            if (sl0 + 1 < cw && rk1 < r1) { const int s = 8191 - (int)(mine.y & 8191u); atomicOr(&hist[q * MPITCH + (s >> 5)], 1u << mpos(s & 31)); }
            if (sl0 + 2 < cw && rk2 < r1) { const int s = 8191 - (int)(mine.z & 8191u); atomicOr(&hist[q * MPITCH + (s >> 5)], 1u << mpos(s & 31)); }
            if (sl0 + 3 < cw && rk3 < r1) { const int s = 8191 - (int)(mine.w & 8191u); atomicOr(&hist[q * MPITCH + (s >> 5)], 1u << mpos(s & 31)); }
        }
        __syncthreads();
        if (level == 1 || qinf[256] == 0) break;
        {
            const bool mine_ovf = qinf[qloc * 4 + 3] != 0;
            const int b1 = qinf[qloc * 4];
            active = mine_ovf;
            fa = mine_ovf ? inv * 510.f : 0.f;
            fbias = mine_ovf ? fmaf(fb0c - (float)b1, 510.f, 1.f) : -1.f;
        }
        for (int i = tid; i < 32 * HPITCH; i += 512) cand[i] = 0u;
        __syncthreads();
    }
    for (int rep2_ = ((PROBE_PHASE == 41) ? 0 : 1); rep2_ < 2; ++rep2_) {
        const bool dry2 = dry || ((PROBE_PHASE == 41) && (rep2_ == 0) && (p.pos[0] == 0));
        const int head = w, r32 = lane & 31, hh = lane >> 5;
        bf16x8 qfr[2][4];
        float q1 = 0.f;
#pragma unroll
        for (int qb = 0; qb < 2; ++qb) {
            float qa = 0.f;
#pragma unroll
            for (int ks = 0; ks < 4; ++ks) {
                qfr[qb][ks] = *(const bf16x8*)(Hb + (long)(t0 + qb * 32 + r32) * HP + HQ + head * 64 + ks * 16 + 8 * hh);
                const u32x4 qv = __builtin_bit_cast(u32x4, qfr[qb][ks]);
                qa += fabsf(bflo(qv.x)) + fabsf(bfhi(qv.x)) + fabsf(bflo(qv.y)) + fabsf(bfhi(qv.y)) + fabsf(bflo(qv.z)) + fabsf(bfhi(qv.z)) + fabsf(bflo(qv.w)) + fabsf(bfhi(qv.w));
            }
            q1 = fmaxf(q1, qa);
        }
        q1 += sxor_f(q1, lane, 32);
#pragma unroll
        for (int o = 16; o >= 1; o >>= 1) q1 = fmaxf(q1, sxor_f(q1, lane, o));
        const float kmx = __uint_as_float(((const unsigned*)(p.ws + WS_KMAX))[b * 8 + head]);
        const bool fast = (q1 * kmx * 1.02f) < 100.f;
        f32x16 O[2][2];
#pragma unroll
        for (int a = 0; a < 2; ++a)
#pragma unroll
            for (int c2 = 0; c2 < 2; ++c2)
#pragma unroll
                for (int i = 0; i < 16; ++i) O[a][c2][i] = 0.f;
        float mrun[2] = {-1e30f, -1e30f}, lrun[2] = {0.f, 0.f};
        const bf16_t* Kp = (const bf16_t*)(p.ws + WS_KF) + ((long)(b * 8 + head) * 256 * 4 * 64 + lane) * 8;
        const bf16_t* Vp = (const bf16_t*)(p.ws + WS_VT) + ((long)(b * 8 + head) * 256 * 4 * 64 + lane) * 8;
        const int nt32 = (t0 + 64) >> 5;
        if (fast) attn_loop<true>(Kp, Vp, qfr, O, mrun, lrun, hist, (const float*)(lds + L_MTAB), r32, hh, nt32, dry2);
        else attn_loop<false>(Kp, Vp, qfr, O, mrun, lrun, hist, (const float*)(lds + L_MTAB), r32, hh, nt32, dry2);
#pragma unroll
        for (int qb = 0; qb < 2; ++qb) {
            const float lt = lrun[qb] + sxor_f(lrun[qb], lane, 32);
            const float il = 1.f / lt;
            bf16_t* gp = H + ((long)b * T + t0 + qb * 32 + r32) * HP + HAG + head * 64 + 4 * hh;
#pragma unroll
            for (int db = 0; db < 2; ++db)
#pragma unroll
                for (int g4 = 0; g4 < 4; ++g4) {
                    bf16_t* gq = gp + db * 32 + 8 * g4;
                    const u32x2 gv = *(const u32x2*)gq;
                    u32x2 wv;
                    wv.x = pk2(O[db][qb][4 * g4] * il * silu_f(bflo(gv.x)), O[db][qb][4 * g4 + 1] * il * silu_f(bfhi(gv.x)));
                    wv.y = pk2(O[db][qb][4 * g4 + 2] * il * silu_f(bflo(gv.y)), O[db][qb][4 * g4 + 3] * il * silu_f(bfhi(gv.y)));
                    if (!dry2) *(u32x2*)gq = wv;
                }
        }
    }
    __syncthreads();
}

__device__ __forceinline__ void gbar(unsigned* ctr, unsigned target) {
    __syncthreads();
    if (threadIdx.x == 0) {
        __builtin_amdgcn_fence(__ATOMIC_RELEASE, "agent");
        __hip_atomic_fetch_add(ctr, 1u, __ATOMIC_RELAXED, __HIP_MEMORY_SCOPE_AGENT);
        while (__hip_atomic_load(ctr, __ATOMIC_RELAXED, __HIP_MEMORY_SCOPE_AGENT) < target) __builtin_amdgcn_s_sleep(2);
        __builtin_amdgcn_fence(__ATOMIC_ACQUIRE, "agent");
    }
    __syncthreads();
}

__device__ __forceinline__ void ho_arrive(unsigned* ctr) {
    __syncthreads();
    if (threadIdx.x == 0) { __builtin_amdgcn_fence(__ATOMIC_RELEASE, "agent"); __hip_atomic_fetch_add(ctr, 1u, __ATOMIC_RELAXED, __HIP_MEMORY_SCOPE_AGENT); }
}
__device__ __forceinline__ void ho_wait(unsigned* ctr, unsigned target) {
    if (threadIdx.x == 0) {
        while (__hip_atomic_load(ctr, __ATOMIC_RELAXED, __HIP_MEMORY_SCOPE_AGENT) < target) __builtin_amdgcn_s_sleep(2);
        __builtin_amdgcn_fence(__ATOMIC_ACQUIRE, "agent");
    }
    __syncthreads();
}

__global__ void __launch_bounds__(512) fwd_megakernel(Params p0) {
    extern __shared__ __attribute__((aligned(16))) unsigned char lds[];
    cg::grid_group grid = cg::this_grid();
    const int G = gridDim.x, c = blockIdx.x;
    const int wid_s = __builtin_amdgcn_readfirstlane((int)(threadIdx.x >> 6));

    unsigned* barctr = (unsigned*)(p0.ws + WS_BAR); unsigned bar_n = 0;
    if (c == 0 && threadIdx.x < 3) __hip_atomic_store(barctr + 16 * threadIdx.x, 0u, __ATOMIC_RELAXED, __HIP_MEMORY_SCOPE_AGENT);
    for (int rep0_ = (PROBE_PHASE == 8 ? 0 : 1); rep0_ < 2; ++rep0_) prologue(p0, (long)c * 512 + threadIdx.x, (long)G * 512);
    grid.sync();

#pragma unroll 1
    for (int layer = 0; layer < DEPTH; ++layer) {
        Params p = p0;
        { size_t zoff = 0; asm volatile("" : "+s"(zoff)); p.ws = p0.ws + zoff; }
        bf16_t* H = (bf16_t*)(p.ws + WS_H);
        {
for (int rep_ = (PROBE_PHASE == 1 ? 0 : 1); rep_ < 2; ++rep_) { const bool dry = (PROBE_PHASE == 1) && (rep_ == 0) && (p.pos[0] == 0);
            EpiIn e; e.H = H; e.side = (float*)(p.ws + WS_SIDE); e.rope = (const float*)(p.ws + WS_ROPE); e.VT = (bf16_t*)(p.ws + WS_VT); e.KF = (bf16_t*)(p.ws + WS_KF); e.kmax = (unsigned*)(p.ws + WS_KMAX); e.dry = dry;
            const bf16_t* A = (const bf16_t*)(p.ws + WS_XB);
            const bf16_t* Bt = (const bf16_t*)(p.ws + WS_WIN) + (long)layer * NPAD * 1024;
#pragma unroll 1
            for (int L = c; L < 128 * 17; L += G) { int pm, pn; tile_of(L, 128, 17, pm, pn); gemm_tile((LAS unsigned char*)lds, A, 1024, Bt, 1024, pm, pn, e, wid_s); }
}
        }
        gbar(barctr, (++bar_n) * (unsigned)G); if (PROBE_PHASE == 9) gbar(barctr, (++bar_n) * (unsigned)G);
        {
for (int rep_ = (PROBE_PHASE == 2 ? 0 : 1); rep_ < 2; ++rep_) { const bool dry = (PROBE_PHASE == 2) && (rep_ == 0) && (p.pos[0] == 0);
            const int tid = otid(wid_s), lane = tid & 63, w = tid >> 6;
#pragma unroll 1
            for (int g = c; g < 256; g += G) gla_local_item(p, layer, g * 8 + w, lane, dry);
}
        }
        ho_arrive(barctr + 16);
        if (c < 64) {
            ho_wait(barctr + 16, (unsigned)(layer + 1) * (unsigned)G);
            const int tid = otid(wid_s);
#pragma unroll 1
            for (int g = c; g < 64; g += G) gla_scan(p, g * 512 + tid);
            ho_arrive(barctr + 32);
        }
for (int rep_ = (PROBE_PHASE == 3 ? 0 : 1); rep_ < 2; ++rep_) { const bool dry = (PROBE_PHASE == 3) && (rep_ == 0) && (p.pos[0] == 0);
#pragma unroll 1
        for (int tile = c; tile < 512; tile += G) conformer_tile(p, layer, lds, tile, dry, wid_s);
}
for (int rep_ = (PROBE_PHASE == 4 ? 0 : 1); rep_ < 2; ++rep_) { const bool dry = (PROBE_PHASE == 4) && (rep_ == 0) && (p.pos[0] == 0);
#pragma unroll 1
        for (int it = c; it < 512; it += G) {
            const int pr = it >> 1, second = it & 1;
            const int xcd = pr & 7, j = pr >> 3, b = xcd >> 1, par = xcd & 1;
            const int qblk = second ? (2 * j + par) : 127 - (2 * j + par);
            dsa_item(p, lds, b, qblk, dry, wid_s);
        }
}
        ho_wait(barctr + 32, (unsigned)(layer + 1) * (unsigned)(G < 64 ? G : 64));
        {
for (int rep_ = (PROBE_PHASE == 5 ? 0 : 1); rep_ < 2; ++rep_) { const bool dry = (PROBE_PHASE == 5) && (rep_ == 0) && (p.pos[0] == 0);
            const int tid = otid(wid_s), lane = tid & 63, w = tid >> 6;
#pragma unroll 1
            for (int g = c; g < 256; g += G) gla_out_item(p, layer, lds + w * 16384, g * 8 + w, lane, dry);
}
        }
        gbar(barctr, (++bar_n) * (unsigned)G); if (PROBE_PHASE == 9) gbar(barctr, (++bar_n) * (unsigned)G);
        {
for (int rep_ = (PROBE_PHASE == 6 ? 0 : 1); rep_ < 2; ++rep_) { const bool dry = (PROBE_PHASE == 6) && (rep_ == 0) && (p.pos[0] == 0);
            EpiOut e; e.xres = (layer == 0) ? p.x : p.out; e.out = p.out; e.dry = dry;
            const bf16_t* A = H + HAG;
            const bf16_t* Bt = (const bf16_t*)(p.ws + WS_WOUT) + (long)layer * 1024 * 1024;
#pragma unroll 1
            for (int L = c; L < 128 * 4; L += G) { int pm, pn; tile_of(L, 128, 4, pm, pn); gemm_tile((LAS unsigned char*)lds, A, HP, Bt, 1024, pm, pn, e, wid_s); }
}
        }
        gbar(barctr, (++bar_n) * (unsigned)G); if (PROBE_PHASE == 9) gbar(barctr, (++bar_n) * (unsigned)G);
        {
for (int rep_ = (PROBE_PHASE == 7 ? 0 : 1); rep_ < 2; ++rep_) { const bool dry = (PROBE_PHASE == 7) && (rep_ == 0) && (p.pos[0] == 0);
            const int tid = otid(wid_s), lane = tid & 63, w = tid >> 6;
            ln_phase(p, layer, c * 8 + w, G * 8, lane, dry);
            if (c == 0 && tid < 32) ((unsigned*)(p.ws + WS_KMAX))[tid] = 0u;
}
        }
        if (layer + 1 < DEPTH) { gbar(barctr, (++bar_n) * (unsigned)G); if (PROBE_PHASE == 9) gbar(barctr, (++bar_n) * (unsigned)G); }
    }
}

extern "C" void kernel_launch(void* const* d_in, const int* in_sizes, int n_in, void* d_out, int out_size, void* d_ws, size_t ws_size, hipStream_t stream) {
    static int grid_blocks = 0;
    if (grid_blocks == 0) {
        if (n_in != 15 || ws_size < WS_END) { fprintf(stderr, "kernel_launch: unexpected inputs (n_in %d, ws %zu < %zu)\n", n_in, ws_size, (size_t)WS_END); grid_blocks = -1; return; }
        int dev = 0, cus = 0, per_cu = 0;
        hipGetDevice(&dev);
        hipDeviceGetAttribute(&cus, hipDeviceAttributeMultiprocessorCount, dev);
        if (hipFuncSetAttribute((const void*)fwd_megakernel, hipFuncAttributeMaxDynamicSharedMemorySize, LDS_BYTES) != hipSuccess) { fprintf(stderr, "kernel_launch: hipFuncSetAttribute failed\n"); grid_blocks = -1; return; }
        hipOccupancyMaxActiveBlocksPerMultiprocessor(&per_cu, (const void*)fwd_megakernel, 512, LDS_BYTES);
        if (per_cu < 1) per_cu = 1;
        grid_blocks = cus * per_cu;
    }
    if (grid_blocks < 0) return;
    Params p{};
    p.x = (const float*)d_in[0]; p.pos = (const int*)d_in[1]; p.w_in = (const float*)d_in[2]; p.conv_w = (const float*)d_in[3]; p.conv_b = (const float*)d_in[4];
    p.cln_g = (const float*)d_in[5]; p.cln_b = (const float*)d_in[6]; p.pw_w = (const float*)d_in[7]; p.pw_b = (const float*)d_in[8];
    p.gate_w2 = (const float*)d_in[9]; p.gate_b = (const float*)d_in[10]; p.gnorm_g = (const float*)d_in[11]; p.w_out = (const float*)d_in[12];
    p.ln_g = (const float*)d_in[13]; p.ln_b = (const float*)d_in[14];
    p.out = (float*)d_out; p.ws = (unsigned char*)d_ws;
    for (int j = 0; j < 32; ++j) p.inv_freq[j] = (float)pow(10000.0, -(double)j / 32.0);
    void* args[] = {&p};
    hipError_t e = hipLaunchCooperativeKernel((const void*)fwd_megakernel, dim3(grid_blocks), dim3(512), args, LDS_BYTES, stream);
    if (e != hipSuccess) fprintf(stderr, "cooperative launch failed: %s (grid %d)\n", hipGetErrorString(e), grid_blocks);
}
```

```cpp
#include <hip/hip_runtime.h>
#include <hip/hip_cooperative_groups.h>
#include <cstdio>
#include <cmath>
namespace cg = cooperative_groups;

typedef unsigned short bf16_t;
typedef short bf16x8 __attribute__((ext_vector_type(8)));
typedef float f32x4 __attribute__((ext_vector_type(4)));
typedef float f32x16 __attribute__((ext_vector_type(16)));
typedef unsigned u32x4 __attribute__((ext_vector_type(4)));
typedef unsigned u32x2 __attribute__((ext_vector_type(2)));
typedef unsigned long long u64;

constexpr int NB = 4, T = 8192, NTOK = NB * T, DM = 1024, DIN = 4184, NPAD = 4352, HP = 4160, DEPTH = 4;
constexpr int HQ = 0, HK = 512, HV = 1024, HQI = 1536, HKI = 2048, HGLU = 2112, HCQ = 2624, HCK = 2752, HCV = 2880, HAG = 3136, HBG = 3648, HCG = 3904;
constexpr float EPS = 1e-5f;
constexpr float ALPHA = 1.6817928305074290f;
constexpr float QSCALE = 0.125f * 1.4426950408889634f;
constexpr float WI_SCALE = 0.04419417382415922f;
constexpr float SIG_UNIT = 5.66f;
constexpr int CAP = 128;

constexpr size_t WS_WIN = 0;
constexpr size_t WS_WOUT = WS_WIN + (size_t)DEPTH * NPAD * 1024 * 2;
constexpr size_t WS_PWT = WS_WOUT + (size_t)DEPTH * 1024 * 1024 * 2;
constexpr size_t WS_ROPE = WS_PWT + (size_t)DEPTH * 256 * 256 * 2;
constexpr size_t WS_XB = WS_ROPE + (size_t)NTOK * 32 * 8;
constexpr size_t WS_H = WS_XB + (size_t)NTOK * 1024 * 2;
constexpr size_t WS_SIDE = WS_H + (size_t)NTOK * HP * 2;
constexpr size_t WS_BCUM = WS_SIDE + (size_t)NTOK * 24 * 4;
constexpr size_t WS_U = WS_BCUM + (size_t)NTOK * 128 * 4;
constexpr size_t WS_DEC = WS_U + (size_t)2048 * 2048 * 4;
constexpr size_t WS_VT = WS_DEC + (size_t)2048 * 32 * 4;
constexpr size_t WS_KF = WS_VT + (size_t)NTOK * 512 * 2;
constexpr size_t WS_BAR = WS_KF + (size_t)NTOK * 512 * 2;
constexpr size_t WS_KMAX = WS_BAR + 256;
constexpr size_t WS_PCNT = WS_KMAX + 256;
constexpr size_t WS_END = WS_PCNT + 128 * 64;

#ifndef PROBE_PHASE
#define PROBE_PHASE 0
#endif
constexpr int LDS_BYTES = 147456;

struct Params {
    const float* x; const int* pos; const float* w_in; const float* conv_w; const float* conv_b; const float* cln_g; const float* cln_b;
    const float* pw_w; const float* pw_b; const float* gate_w2; const float* gate_b; const float* gnorm_g; const float* w_out; const float* ln_g; const float* ln_b;
    float* out; unsigned char* ws;
    float inv_freq[32];
};

__device__ __forceinline__ unsigned f2bf(float f) { unsigned u = __float_as_uint(f); return (u + 0x7fffu + ((u >> 16) & 1u)) >> 16; }
__device__ __forceinline__ float bf2f(unsigned b) { return __uint_as_float(b << 16); }
typedef float f32x2_t __attribute__((ext_vector_type(2)));
typedef __bf16 bf16x2_t __attribute__((ext_vector_type(2)));
__device__ __forceinline__ unsigned pk2(float lo, float hi) { f32x2_t v = {lo, hi}; bf16x2_t b = __builtin_convertvector(v, bf16x2_t); return __builtin_bit_cast(unsigned, b); }
__device__ __forceinline__ float bflo(unsigned w) { return __uint_as_float(w << 16); }
__device__ __forceinline__ float bfhi(unsigned w) { return __uint_as_float(w & 0xffff0000u); }
__device__ __forceinline__ float silu_f(float v) { return v / (1.f + __expf(-v)); }
__device__ __forceinline__ float sigmoid_f(float v) { return 1.f / (1.f + __expf(-v)); }
__device__ __forceinline__ int bperm_i(int idx, int v) { return __builtin_amdgcn_ds_bpermute(idx << 2, v); }
__device__ __forceinline__ float sxor_f(float v, int lane, int m) { return __int_as_float(bperm_i(lane ^ m, __float_as_int(v))); }
__device__ __forceinline__ int sxor_i(int v, int lane, int m) { return bperm_i(lane ^ m, v); }
__device__ __forceinline__ float wave_sum(float v, int lane) {
#pragma unroll
    for (int o = 32; o >= 1; o >>= 1) v += sxor_f(v, lane, o);
    return v;
}
__device__ __forceinline__ int otid(int wid_s) { int l; asm volatile("v_mbcnt_lo_u32_b32 %0, -1, 0\n\tv_mbcnt_hi_u32_b32 %0, -1, %0" : "=v"(l)); return (wid_s << 6) | l; }
#define WAVE_SYNC() do { __builtin_amdgcn_fence(__ATOMIC_RELEASE, "wavefront"); __builtin_amdgcn_wave_barrier(); __builtin_amdgcn_fence(__ATOMIC_ACQUIRE, "wavefront"); } while (0)

__device__ __forceinline__ int l2orig(int l) {
    if (l < 1536) return l;
    if (l < 2048) return 2048 + (l - 1536);
    if (l < 2112) return 2560 + (l - 2048);
    if (l < 2624) return 2632 + (l - 2112);
    if (l < 2752) return 3400 + (l - 2624);
    if (l < 2880) return 3528 + (l - 2752);
    if (l < 3136) return 3656 + (l - 2880);
    if (l < 3648) return 1536 + (l - 3136);
    if (l < 3904) return 3144 + (l - 3648);
    if (l < 4160) return 3912 + (l - 3904);
    if (l < 4168) return 2624 + (l - 4160);
    if (l < 4184) return 4168 + (l - 4168);
    return -1;
}
__device__ __forceinline__ int npos2logical(int np) {
    const int hb = np & ~127, p = np & 127, wc = p >> 5, n = (p >> 4) & 1, fr = p & 15;
    return hb + (wc >> 1) * 64 + n * 32 + (wc & 1) * 16 + fr;
}

__device__ __forceinline__ void sincos_acc(float angf, float& c, float& s) {
    const double a = (double)angf;
    const double n = rint(a * 0.15915494309189535);
    double r = fma(-n, 6.283185307179586, a);
    r = fma(-n, 2.4492935982947064e-16, r);
    const double r2 = r * r;
    double ts = r, tc = 1.0, ss = r, cc = 1.0;
#pragma unroll
    for (int k = 1; k <= 14; ++k) {
        tc = -tc * r2 * (1.0 / (double)((2 * k - 1) * (2 * k)));
        ts = -ts * r2 * (1.0 / (double)((2 * k) * (2 * k + 1)));
        cc += tc; ss += ts;
    }
    c = (float)cc; s = (float)ss;
}

__device__ __forceinline__ void prologue(const Params& p, long gtid, long gthreads) {
    bf16_t* win = (bf16_t*)(p.ws + WS_WIN);
    for (long idx = gtid; idx < (long)DEPTH * 128 * NPAD; idx += gthreads) {
        const int np = (int)(idx % NPAD); const long r = idx / NPAD; const int kc = (int)(r % 128); const int l = (int)(r / 128);
        const int oc = l2orig(npos2logical(np));
        u32x4 w = {0u, 0u, 0u, 0u};
        if (oc >= 0) {
            const float* src = p.w_in + ((long)l * 1024 + kc * 8) * DIN + oc;
            float v[8];
#pragma unroll
            for (int i = 0; i < 8; ++i) v[i] = src[(long)i * DIN];
            w.x = pk2(v[0], v[1]); w.y = pk2(v[2], v[3]); w.z = pk2(v[4], v[5]); w.w = pk2(v[6], v[7]);
        }
        *(u32x4*)(win + ((long)l * NPAD + np) * 1024 + kc * 8) = w;
    }
    bf16_t* wout = (bf16_t*)(p.ws + WS_WOUT);
    for (long idx = gtid; idx < (long)DEPTH * 128 * 1024; idx += gthreads) {
        const int n = (int)(idx % 1024); const long r = idx / 1024; const int kc = (int)(r % 128); const int l = (int)(r / 128);
        const float* src = p.w_out + ((long)l * 1024 + kc * 8) * 1024 + n;
        float v[8];
#pragma unroll
        for (int i = 0; i < 8; ++i) v[i] = src[(long)i * 1024];
        u32x4 w; w.x = pk2(v[0], v[1]); w.y = pk2(v[2], v[3]); w.z = pk2(v[4], v[5]); w.w = pk2(v[6], v[7]);
        *(u32x4*)(wout + ((long)l * 1024 + n) * 1024 + kc * 8) = w;
    }
    bf16_t* pwt = (bf16_t*)(p.ws + WS_PWT);
    for (long idx = gtid; idx < (long)DEPTH * 32 * 256; idx += gthreads) {
        const int n = (int)(idx % 256); const long r = idx / 256; const int kc = (int)(r % 32); const int l = (int)(r / 32);
        const float* src = p.pw_w + ((long)l * 256 + kc * 8) * 256 + n;
        float v[8];
#pragma unroll
        for (int i = 0; i < 8; ++i) v[i] = src[(long)i * 256];
        u32x4 w; w.x = pk2(v[0], v[1]); w.y = pk2(v[2], v[3]); w.z = pk2(v[4], v[5]); w.w = pk2(v[6], v[7]);
        *(u32x4*)(pwt + ((long)l * 256 + n) * 256 + kc * 8) = w;
    }
    float2* rope = (float2*)(p.ws + WS_ROPE);
    for (long idx = gtid; idx < (long)NTOK * 32; idx += gthreads) {
        const int j = (int)(idx & 31); const long tok = idx >> 5;
        const float ang = (float)p.pos[tok] * p.inv_freq[j];
        float c, s; sincos_acc(ang, c, s);
        rope[idx] = make_float2(c, s);
    }
    if (gtid < 32) ((unsigned*)(p.ws + WS_KMAX))[gtid] = 0u;
    if (gtid < 128) ((unsigned*)(p.ws + WS_PCNT))[gtid * 16] = 0u;
    bf16_t* xb = (bf16_t*)(p.ws + WS_XB);
    for (long idx = gtid; idx < (long)NTOK * 128; idx += gthreads) {
        const f32x4 a = *(const f32x4*)(p.x + idx * 8), b = *(const f32x4*)(p.x + idx * 8 + 4);
        u32x4 w; w.x = pk2(a[0], a[1]); w.y = pk2(a[2], a[3]); w.z = pk2(b[0], b[1]); w.w = pk2(b[2], b[3]);
        *(u32x4*)(xb + idx * 8) = w;
    }
}

constexpr int BM = 256, BK = 64, HALF = 128, HT = HALF * BK;
__device__ __forceinline__ int lds_byte(int r, int c) {
    int st = (r >> 4) * 2 + (c >> 5), rr = r & 15, cc = c & 31, ob = rr * 64 + cc * 2;
    return st * 1024 + (ob ^ (((ob >> 9) & 1) << 5));
}
__device__ __forceinline__ void stage_rc(int b, int& R, int& C) {
    int st = b / 1024, sb = b % 1024, swz = sb ^ (((sb >> 9) & 1) << 5);
    R = (st >> 1) * 16 + swz / 64; C = (st & 1) * 32 + (swz % 64) / 2;
}
__device__ __forceinline__ void tile_of(int L, int nM, int nN, int& pm, int& pn) {
    const int nwg = nM * nN; int wgid = L;
    { const int q = nwg / 8, r = nwg % 8, xcd = wgid % 8, off = wgid / 8; wgid = (xcd < r ? xcd * (q + 1) : r * (q + 1) + (xcd - r) * q) + off; }
    const int nig = 8 * nN, gid = wgid / nig, fm = gid * 8, gsz = (nM - fm) < 8 ? (nM - fm) : 8;
    pm = fm + ((wgid % nig) % gsz); pn = (wgid % nig) / gsz;
}

#define LAS __attribute__((address_space(3)))
template <class Epi>
__device__ __forceinline__ void gemm_tile(LAS unsigned char* lds, const bf16_t* A, int lda, const bf16_t* Bt, int K, int pm, int pn, const Epi& epi, int wid_s) {
    const int tid = otid(wid_s), wid = __builtin_amdgcn_readfirstlane(tid >> 6), lane = tid & 63, wr = wid >> 2, wc = wid & 3, fr = lane & 15, fq = lane >> 4;
    const int nt = K / BK;
    unsigned voffA[2], voffB[2];
#pragma unroll
    for (int i = 0; i < 2; ++i) { int R, C; stage_rc(tid * 16 + i * 8192, R, C); voffA[i] = (unsigned)(R * lda + C) * 2u; voffB[i] = (unsigned)(R * K + C) * 2u; }
    const size_t kstep = (size_t)(BK * 2), hstepA = (size_t)HALF * lda * 2, hstepB = (size_t)HALF * K * 2;
    const unsigned ldsw = (unsigned)wid * 1024u;
    const int aoff = lds_byte(wr * 64 + fr, fq * 8), boff = lds_byte(wc * 32 + fr, fq * 8);
    const char* cA = (const char*)A + (size_t)pm * 2 * hstepA; const char* cB = (const char*)Bt + (size_t)pn * 2 * hstepB;
#define HTB (HALF * BK * 2)
#define SA(b, h) (((b) * 2 + (h)) * HTB)
#define SB(b, h) ((4 + (b) * 2 + (h)) * HTB)
#define STAGE(bufoff, gbase, voff) do { _Pragma("unroll") for (int _i = 0; _i < 2; ++_i) \
        __builtin_amdgcn_global_load_lds((const unsigned*)((const char*)(gbase) + (voff)[_i]), (LAS unsigned*)(lds + (bufoff) + ldsw + _i * 8192), 16, 0, 0); } while (0)
#define LDA(dst, b, h) do { _Pragma("unroll") for (int m = 0; m < 4; ++m) _Pragma("unroll") for (int k = 0; k < 2; ++k) dst[m][k] = *(const LAS bf16x8*)(lds + SA(b, h) + aoff + m * 2048 + k * 1024); } while (0)
#define LDB(dst, b, h) do { _Pragma("unroll") for (int n = 0; n < 2; ++n) _Pragma("unroll") for (int k = 0; k < 2; ++k) dst[n][k] = *(const LAS bf16x8*)(lds + SB(b, h) + boff + n * 2048 + k * 1024); } while (0)
#define MMA(ai, bj, At_, Bt_) do { __builtin_amdgcn_s_setprio(1); _Pragma("unroll") for (int m = 0; m < 4; ++m) _Pragma("unroll") for (int n = 0; n < 2; ++n) _Pragma("unroll") for (int k = 0; k < 2; ++k) \
        acc[ai][bj][m][n] = __builtin_amdgcn_mfma_f32_16x16x32_bf16(Bt_[n][k], At_[m][k], acc[ai][bj][m][n], 0, 0, 0); __builtin_amdgcn_s_setprio(0); } while (0)
#define WAIT_V(n) asm volatile("s_waitcnt vmcnt(" #n ")" ::: "memory")
#define WAIT_L(n) asm volatile("s_waitcnt lgkmcnt(" #n ")" ::: "memory")
#define BAR __builtin_amdgcn_s_barrier()
#define SCHED __builtin_amdgcn_sched_barrier(0)
    f32x4 acc[2][2][4][2];
#pragma unroll
    for (int a = 0; a < 2; ++a)
#pragma unroll
        for (int b = 0; b < 2; ++b)
#pragma unroll
            for (int m = 0; m < 4; ++m)
#pragma unroll
                for (int n = 0; n < 2; ++n) acc[a][b][m][n] = (f32x4){0.f, 0.f, 0.f, 0.f};
    bf16x8 At[4][2], B0[2][2], B1[2][2];
    STAGE(SB(0, 0), cB, voffB); STAGE(SA(0, 0), cA, voffA); STAGE(SB(0, 1), cB + hstepB, voffB); STAGE(SA(0, 1), cA + hstepA, voffA);
    if (wr == 1) BAR;
    WAIT_V(4); BAR;
    STAGE(SB(1, 0), cB + kstep, voffB); STAGE(SA(1, 0), cA + kstep, voffA); STAGE(SB(1, 1), cB + hstepB + kstep, voffB);
    WAIT_V(6); BAR;
    for (int t = 0; t < nt - 2; t += 2) {
        const char* a1 = cA + (size_t)(t + 1) * kstep; const char* a2 = cA + (size_t)(t + 2) * kstep; const char* b2 = cB + (size_t)(t + 2) * kstep;
        const char* a3 = a2 + kstep; const char* b3 = b2 + kstep;
        LDB(B0, 0, 0); SCHED; LDA(At, 0, 0); STAGE(SA(1, 1), a1 + hstepA, voffA);
        WAIT_L(8); BAR; WAIT_L(0); MMA(0, 0, At, B0); BAR; SCHED;
        LDB(B1, 0, 1); STAGE(SB(0, 0), b2, voffB);
        BAR; WAIT_L(0); MMA(0, 1, At, B1); BAR;
        LDA(At, 0, 1); STAGE(SA(0, 0), a2, voffA);
        BAR; WAIT_L(0); MMA(1, 0, At, B0); BAR; SCHED;
        STAGE(SB(0, 1), b2 + hstepB, voffB);
        WAIT_V(6); BAR; MMA(1, 1, At, B1); BAR;
        LDB(B0, 1, 0); SCHED; LDA(At, 1, 0); STAGE(SA(0, 1), a2 + hstepA, voffA);
        WAIT_L(8); BAR; WAIT_L(0); MMA(0, 0, At, B0); BAR; SCHED;
        LDB(B1, 1, 1); STAGE(SB(1, 0), b3, voffB);
        BAR; WAIT_L(0); MMA(0, 1, At, B1); BAR;
        LDA(At, 1, 1); STAGE(SA(1, 0), a3, voffA);
        BAR; WAIT_L(0); MMA(1, 0, At, B0); BAR; SCHED;
        STAGE(SB(1, 1), b3 + hstepB, voffB);
        WAIT_V(6); BAR; MMA(1, 1, At, B1); BAR;
    }
    { const char* a1 = cA + (size_t)(nt - 1) * kstep;
      LDB(B0, 0, 0); LDA(At, 0, 0); STAGE(SA(1, 1), a1 + hstepA, voffA);
      BAR; WAIT_L(0); MMA(0, 0, At, B0); BAR;
      LDB(B1, 0, 1); BAR; WAIT_L(0); MMA(0, 1, At, B1); BAR;
      LDA(At, 0, 1); WAIT_V(4); BAR; WAIT_L(0); MMA(1, 0, At, B0); MMA(1, 1, At, B1); BAR; }
    { LDB(B0, 1, 0); LDA(At, 1, 0); WAIT_V(2); BAR; WAIT_L(0); MMA(0, 0, At, B0); BAR;
      LDB(B1, 1, 1); WAIT_V(0); BAR; WAIT_L(0); MMA(0, 1, At, B1); BAR;
      LDA(At, 1, 1); BAR; WAIT_L(0); MMA(1, 0, At, B0); MMA(1, 1, At, B1); BAR; }
    if (wr == 0) BAR;
    epi(acc, pm * BM, pn * BM, wr, wc, fr, fq);
#undef SA
#undef SB
#undef STAGE
#undef LDA
#undef LDB
#undef MMA
}

struct EpiIn {
    bf16_t* H; float* side; const float* rope; bf16_t* VT; bf16_t* KF; unsigned* kmax; bool dry;
    __device__ __forceinline__ void operator()(f32x4 (&acc)[2][2][4][2], int brow, int bcol, int wr, int wc, int fr, int fq) const {
#pragma unroll
        for (int bj = 0; bj < 2; ++bj) {
            const int hb = bcol + bj * HALF;
            if (hb >= 4224 || dry) continue;
            const int gbase = hb + (wc >> 1) * 64, g64 = gbase >> 6, d0 = (wc & 1) * 16 + 4 * fq;
            const bool rp = (g64 < 16) || (g64 >= 24 && g64 <= 32);
            const float qs = (g64 < 8) ? QSCALE : 1.f;
            float kabs = 0.f;
#pragma unroll
            for (int ai = 0; ai < 2; ++ai)
#pragma unroll
                for (int m = 0; m < 4; ++m) {
                    const long row = brow + ai * HALF + wr * 64 + m * 16 + fr;
                    f32x4 o1 = acc[ai][bj][m][0], o2 = acc[ai][bj][m][1];
                    if (rp) {
                        const f32x4 c0 = *(const f32x4*)(rope + (row * 32 + d0) * 2), c1 = *(const f32x4*)(rope + (row * 32 + d0) * 2 + 4);
                        const f32x4 x1 = o1, x2 = o2;
                        o1[0] = (x1[0] * c0[0] - x2[0] * c0[1]) * qs; o2[0] = (x2[0] * c0[0] + x1[0] * c0[1]) * qs;
                        o1[1] = (x1[1] * c0[2] - x2[1] * c0[3]) * qs; o2[1] = (x2[1] * c0[2] + x1[1] * c0[3]) * qs;
                        o1[2] = (x1[2] * c1[0] - x2[2] * c1[1]) * qs; o2[2] = (x2[2] * c1[0] + x1[2] * c1[1]) * qs;
                        o1[3] = (x1[3] * c1[2] - x2[3] * c1[3]) * qs; o2[3] = (x2[3] * c1[2] + x1[3] * c1[3]) * qs;
                    }
                    if (g64 >= 8 && g64 < 24) {
                        const int bb = (int)(row >> 13), tt = (int)(row & (T - 1)), tile = tt >> 5, tk = tt & 31;
                        if (g64 < 16) {
                            kabs = fmaxf(kabs, fmaxf(fmaxf(fabsf(o1[0]), fabsf(o1[1])), fmaxf(fabsf(o1[2]), fabsf(o1[3]))));
                            kabs = fmaxf(kabs, fmaxf(fmaxf(fabsf(o2[0]), fabsf(o2[1])), fmaxf(fabsf(o2[2]), fabsf(o2[3]))));
                            const long base = ((long)(bb * 8 + (g64 - 8)) * 256 + tile) * 4;
                            const int ks = d0 >> 4, hk = (d0 >> 3) & 1, j0 = d0 & 7;
                            u32x2 w1, w2; w1.x = pk2(o1[0], o1[1]); w1.y = pk2(o1[2], o1[3]); w2.x = pk2(o2[0], o2[1]); w2.y = pk2(o2[2], o2[3]);
                            const auto sx = __builtin_amdgcn_permlane16_swap(w1.x, w2.x, false, false), sy = __builtin_amdgcn_permlane16_swap(w1.y, w2.y, false, false);
                            u32x4 wv; long slot;
                            if (fq & 1) { wv.x = sx[0]; wv.y = sy[0]; wv.z = w2.x; wv.w = w2.y; slot = (base + ks + 2) * 64 + hk * 32 + tk; }
                            else { wv.x = w1.x; wv.y = w1.y; wv.z = sx[1]; wv.w = sy[1]; slot = (base + ks) * 64 + hk * 32 + tk; }
                            *(u32x4*)(KF + slot * 8) = wv;
                        } else {
                            const int s = tk >> 4, u = tk & 15, hv = (u >> 2) & 1, jv = (u >> 3) * 4 + (u & 3);
                            const long base = (((long)(bb * 8 + (g64 - 16)) * 256 + tile) * 2) * 2 + s;
                            bf16_t* v0 = VT + ((base) * 64 + hv * 32 + d0) * 8 + jv;
                            bf16_t* v1 = VT + ((base + 2) * 64 + hv * 32 + d0) * 8 + jv;
#pragma unroll
                            for (int j = 0; j < 4; ++j) { v0[j * 8] = (bf16_t)f2bf(o1[j]); v1[j * 8] = (bf16_t)f2bf(o2[j]); }
                        }
                    } else if (gbase < 4160) {
                        bf16_t* hp = H + row * HP + gbase + d0;
                        u32x2 w1, w2; w1.x = pk2(o1[0], o1[1]); w1.y = pk2(o1[2], o1[3]); w2.x = pk2(o2[0], o2[1]); w2.y = pk2(o2[2], o2[3]);
                        const auto sx = __builtin_amdgcn_permlane16_swap(w1.x, w2.x, false, false), sy = __builtin_amdgcn_permlane16_swap(w1.y, w2.y, false, false);
                        u32x4 wv;
                        if (fq & 1) { wv.x = sx[0]; wv.y = sy[0]; wv.z = w2.x; wv.w = w2.y; hp += 32 - 4; }
                        else { wv.x = w1.x; wv.y = w1.y; wv.z = sx[1]; wv.w = sy[1]; }
                        *(u32x4*)hp = wv;
                    } else if (d0 < 8) { *(f32x4*)(side + row * 24 + d0) = o1 * WI_SCALE; }
                    else if (d0 < 24) { *(f32x4*)(side + row * 24 + d0) = o1; }
                }
            if (g64 >= 8 && g64 < 16) {
#pragma unroll
                for (int o = 32; o >= 1; o >>= 1) kabs = fmaxf(kabs, sxor_f(kabs, fq * 16 + fr, o));
                if ((threadIdx.x & 63) == 0) atomicMax(kmax + (brow >> 13) * 8 + (g64 - 8), __float_as_uint(kabs));
            }
        }
    }
};
struct EpiOut {
    const float* xres; float* out; bool dry;
    __device__ __forceinline__ void operator()(f32x4 (&acc)[2][2][4][2], int brow, int bcol, int wr, int wc, int fr, int fq) const {
#pragma unroll
        for (int ai = 0; ai < 2; ++ai)
#pragma unroll
            for (int m = 0; m < 4; ++m)
#pragma unroll
                for (int bj = 0; bj < 2; ++bj)
#pragma unroll
                    for (int n = 0; n < 2; ++n) {
                        const long idx = (long)(brow + ai * HALF + wr * 64 + m * 16 + fr) * DM + (bcol + bj * HALF + wc * 32 + n * 16 + 4 * fq);
                        const f32x4 xr = *(const f32x4*)(xres + idx);
                        if (!dry) *(f32x4*)(out + idx) = xr * ALPHA + acc[ai][bj][m][n];
                    }
    }
};

__device__ __forceinline__ void ln_phase(const Params& p, int layer, int row_begin, int row_end, int row_step, int lane, bool dry) {
    bf16_t* xb = (bf16_t*)(p.ws + WS_XB);
    const float* g = p.ln_g + layer * DM; const float* bb = p.ln_b + layer * DM;
    for (int row = row_begin; row < row_end; row += row_step) {
        float* zr = p.out + (long)row * DM;
        f32x4 v[4]; float s = 0.f;
#pragma unroll
        for (int r = 0; r < 4; ++r) { v[r] = *(const f32x4*)(zr + r * 256 + lane * 4); s += v[r][0] + v[r][1] + v[r][2] + v[r][3]; }
        const float mu = wave_sum(s, lane) * (1.f / DM);
        float q = 0.f;
#pragma unroll
        for (int r = 0; r < 4; ++r)
#pragma unroll
            for (int e = 0; e < 4; ++e) { const float d = v[r][e] - mu; q += d * d; }
        const float rstd = rsqrtf(wave_sum(q, lane) * (1.f / DM) + EPS);
#pragma unroll
        for (int r = 0; r < 4; ++r) {
            const f32x4 gg = *(const f32x4*)(g + r * 256 + lane * 4), bv = *(const f32x4*)(bb + r * 256 + lane * 4);
            f32x4 y;
#pragma unroll
            for (int e = 0; e < 4; ++e) y[e] = (v[r][e] - mu) * rstd * gg[e] + bv[e];
            if (dry) continue;
            *(f32x4*)(zr + r * 256 + lane * 4) = y;
            u32x2 w; w.x = pk2(y[0], y[1]); w.y = pk2(y[2], y[3]);
            *(u32x2*)(xb + (long)row * DM + r * 256 + lane * 4) = w;
        }
    }
}

__device__ __forceinline__ void conformer_tile(const Params& p, int layer, unsigned char* lds, int tile, bool dry, int wid_s) {
    bf16_t* H = (bf16_t*)(p.ws + WS_H);
    const int tid = otid(wid_s), lane = tid & 63, w = tid >> 6;
    const int tok0 = tile * 64, b = tok0 / T, tl0 = tok0 % T;
    bf16_t* hg = (bf16_t*)lds;
    float* cv = (float*)(lds + 49152);
    for (int idx = tid; idx < 94 * 32; idx += 512) {
        const int r = idx >> 5, cc = (idx & 31) * 8, tl = tl0 - 30 + r;
        u32x4 o = {0u, 0u, 0u, 0u};
        if (tl >= 0) {
            const bf16_t* src = H + ((long)b * T + tl) * HP + HGLU + cc;
            const u32x4 va = *(const u32x4*)src, ga = *(const u32x4*)(src + 256);
            o.x = pk2(bflo(va.x) * sigmoid_f(bflo(ga.x)), bfhi(va.x) * sigmoid_f(bfhi(ga.x)));
            o.y = pk2(bflo(va.y) * sigmoid_f(bflo(ga.y)), bfhi(va.y) * sigmoid_f(bfhi(ga.y)));
            o.z = pk2(bflo(va.z) * sigmoid_f(bflo(ga.z)), bfhi(va.z) * sigmoid_f(bfhi(ga.z)));
            o.w = pk2(bflo(va.w) * sigmoid_f(bflo(ga.w)), bfhi(va.w) * sigmoid_f(bfhi(ga.w)));
        }
        *(u32x4*)(hg + r * 256 + cc) = o;
    }
    __syncthreads();
    {
        const int c = tid & 255, half = tid >> 8;
        const float* cw = p.conv_w + (long)layer * 31 * 256 + c;
        float wj[31];
#pragma unroll
        for (int j = 0; j < 31; ++j) wj[j] = cw[j * 256];
        const float cb = p.conv_b[layer * 256 + c];
        float win[62];
#pragma unroll
        for (int r = 0; r < 62; ++r) win[r] = bf2f(hg[(half * 32 + r) * 256 + c]);
#pragma unroll
        for (int tt = 0; tt < 32; ++tt) {
            float a = cb;
#pragma unroll
            for (int j = 0; j < 31; ++j) a = fmaf(win[tt + j], wj[j], a);
            cv[(half * 32 + tt) * 256 + c] = a;
        }
    }
    __syncthreads();
    bf16_t* at = (bf16_t*)lds;
    {
        const f32x4 gg = *(const f32x4*)(p.cln_g + layer * 256 + lane * 4), bv = *(const f32x4*)(p.cln_b + layer * 256 + lane * 4);
#pragma unroll
        for (int tt = 0; tt < 8; ++tt) {
            const int t = w * 8 + tt;
            const f32x4 v = *(const f32x4*)(cv + t * 256 + lane * 4);
            const float mu = wave_sum(v[0] + v[1] + v[2] + v[3], lane) * (1.f / 256.f);
            float q = 0.f;
#pragma unroll
            for (int e = 0; e < 4; ++e) { const float d = v[e] - mu; q += d * d; }
            const float rstd = rsqrtf(wave_sum(q, lane) * (1.f / 256.f) + EPS);
            float y[4];
#pragma unroll
            for (int e = 0; e < 4; ++e) y[e] = silu_f((v[e] - mu) * rstd * gg[e] + bv[e]);
            u32x2 o; o.x = pk2(y[0], y[1]); o.y = pk2(y[2], y[3]);
            *(u32x2*)(at + t * 264 + lane * 4) = o;
        }
    }
    __syncthreads();
    {
        f32x16 acc0 = {}, acc1 = {};
        const bf16_t* pwt = (const bf16_t*)(p.ws + WS_PWT) + (long)layer * 65536 + (w * 32 + (lane & 31)) * 256 + 8 * (lane >> 5);
        const bf16_t* ap = at + (lane & 31) * 264 + 8 * (lane >> 5);
#pragma unroll 4
        for (int ks = 0; ks < 16; ++ks) {
            const bf16x8 bfr = *(const bf16x8*)(pwt + ks * 16);
            const bf16x8 a0 = *(const bf16x8*)(ap + ks * 16), a1 = *(const bf16x8*)(ap + 32 * 264 + ks * 16);
            acc0 = __builtin_amdgcn_mfma_f32_32x32x16_bf16(a0, bfr, acc0, 0, 0, 0);
            acc1 = __builtin_amdgcn_mfma_f32_32x32x16_bf16(a1, bfr, acc1, 0, 0, 0);
        }
        const int ch = w * 32 + (lane & 31);
        const float pb = p.pw_b[layer * 256 + ch];
#pragma unroll
        for (int i = 0; i < 16; ++i) {
            const int row = (i & 3) + 8 * (i >> 2) + 4 * (lane >> 5);
            bf16_t* g0 = H + (long)(tok0 + row) * HP + HBG + ch;
            bf16_t* g1 = H + (long)(tok0 + 32 + row) * HP + HBG + ch;
            const unsigned r0 = f2bf((acc0[i] + pb) * silu_f(bf2f(*g0))), r1 = f2bf((acc1[i] + pb) * silu_f(bf2f(*g1)));
            if (!dry) { *g0 = (bf16_t)r0; *g1 = (bf16_t)r1; }
        }
    }
    __syncthreads();
}

__device__ __forceinline__ float rdlane(float v, int l) { return __uint_as_float(__builtin_amdgcn_readlane(__float_as_uint(v), l)); }

__device__ __forceinline__ void gla_local_item(const Params& p, int layer, int item_, int lane, bool dry) {
    const int item = __builtin_amdgcn_readfirstlane(item_);
    bf16_t* H = (bf16_t*)(p.ws + WS_H);
    const float* side = (const float*)(p.ws + WS_SIDE);
    float* bcum = (float*)(p.ws + WS_BCUM); float* U = (float*)(p.ws + WS_U); float* DEC = (float*)(p.ws + WS_DEC);
    const int bh = item >> 7, c = item & 127, b = bh >> 2, h = bh & 3;
    const long tok0 = (long)b * T + c * 64, tok = tok0 + lane;
    float clr[16];
#pragma unroll
    for (int r = 0; r < 4; ++r) { const f32x4 v = *(const f32x4*)(side + tok * 24 + 8 + r * 4); clr[r * 4] = v[0]; clr[r * 4 + 1] = v[1]; clr[r * 4 + 2] = v[2]; clr[r * 4 + 3] = v[3]; }
    const float* gw = p.gate_w2 + (long)layer * 16 * 128 + h * 32; const float* gb = p.gate_b + layer * 128 + h * 32;
    float* bcp = bcum + tok * 128 + h * 32;
#pragma unroll 1
    for (int d = 0; d < 32; ++d) {
        float z = gb[d];
#pragma unroll
        for (int r = 0; r < 16; ++r) z = fmaf(clr[r], gw[r * 128 + d], z);
        float g = (fminf(z, 0.f) - __logf(1.f + __expf(-fabsf(z)))) * (1.f / 16.f);
#pragma unroll
        for (int o = 1; o < 64; o <<= 1) { const float up = __int_as_float(bperm_i((lane - o) & 63, __float_as_int(g))); if (lane >= o) g += up; }
        bcp[d] = g;
    }
    float bc[32];
#pragma unroll
    for (int r = 0; r < 8; ++r) { const f32x4 v = *(const f32x4*)(bcp + r * 4); bc[r * 4] = v[0]; bc[r * 4 + 1] = v[1]; bc[r * 4 + 2] = v[2]; bc[r * 4 + 3] = v[3]; }
    float kk[32];
    {
        const bf16_t* kp = H + tok * HP + HCK + h * 32;
#pragma unroll
        for (int r = 0; r < 4; ++r) {
            const u32x4 kv = *(const u32x4*)(kp + r * 8);
            kk[r * 8 + 0] = bflo(kv.x); kk[r * 8 + 1] = bfhi(kv.x); kk[r * 8 + 2] = bflo(kv.y); kk[r * 8 + 3] = bfhi(kv.y);
            kk[r * 8 + 4] = bflo(kv.z); kk[r * 8 + 5] = bfhi(kv.z); kk[r * 8 + 6] = bflo(kv.w); kk[r * 8 + 7] = bfhi(kv.w);
        }
#pragma unroll
        for (int d = 0; d < 32; ++d) { const float bl = rdlane(bc[d], 63); kk[d] *= __expf(bl - bc[d]); }
    }
    float acc[32];
#pragma unroll
    for (int d = 0; d < 32; ++d) acc[d] = 0.f;
    const bf16_t* vp = H + tok0 * HP + HCV + h * 64 + lane;
#pragma unroll 1
    for (int t8 = 0; t8 < 64; t8 += 8) {
        float vv[8];
#pragma unroll
        for (int u = 0; u < 8; ++u) vv[u] = bf2f(vp[(long)(t8 + u) * HP]);
#pragma unroll
        for (int u = 0; u < 8; ++u)
#pragma unroll
            for (int d = 0; d < 32; ++d) acc[d] = fmaf(rdlane(kk[d], t8 + u), vv[u], acc[d]);
    }
#pragma unroll
    for (int d = 0; d < 32; ++d) if (!dry) U[(long)item * 2048 + d * 64 + lane] = acc[d];
    if (lane == 63) {
#pragma unroll
        for (int r = 0; r < 8; ++r) { f32x4 v = {__expf(bc[r * 4]), __expf(bc[r * 4 + 1]), __expf(bc[r * 4 + 2]), __expf(bc[r * 4 + 3])}; *(f32x4*)(DEC + item * 32 + r * 4) = v; }
    }
}

__device__ __forceinline__ void gla_scan(const Params& p, int gt) {
    float* U = (float*)(p.ws + WS_U); const float* DEC = (const float*)(p.ws + WS_DEC);
    const int bh = gt >> 11, de = gt & 2047, d = de >> 6;
    float s = 0.f;
    for (int c0 = 0; c0 < 128; c0 += 32) {
        float u[32], dc[32];
#pragma unroll
        for (int i = 0; i < 32; ++i) { u[i] = U[(long)(bh * 128 + c0 + i) * 2048 + de]; dc[i] = DEC[(bh * 128 + c0 + i) * 32 + d]; }
#pragma unroll
        for (int i = 0; i < 32; ++i) { U[(long)(bh * 128 + c0 + i) * 2048 + de] = s; s = fmaf(dc[i], s, u[i]); }
    }
}

__device__ __forceinline__ void gla_out_item(const Params& p, int layer, unsigned char* ldsw, int item_, int lane, bool dry) {
    const int item = __builtin_amdgcn_readfirstlane(item_);
    bf16_t* H = (bf16_t*)(p.ws + WS_H);
    const float* bcum = (const float*)(p.ws + WS_BCUM); const float* U = (const float*)(p.ws + WS_U);
    float* sA = (float*)ldsw; bf16_t* sV = (bf16_t*)(ldsw + 8192);
    const int bh = item >> 7, c = item & 127, b = bh >> 2, h = bh & 3;
    const long tok = (long)b * T + c * 64 + lane;
#pragma unroll
    for (int r = 0; r < 8; ++r) *(f32x4*)(sA + r * 256 + lane * 4) = *(const f32x4*)(U + (long)item * 2048 + r * 256 + lane * 4);
#pragma unroll
    for (int r = 0; r < 8; ++r) *(u32x4*)(sV + lane * 64 + r * 8) = *(const u32x4*)(H + tok * HP + HCV + h * 64 + r * 8);
    WAVE_SYNC();
    float o[64];
#pragma unroll
    for (int e = 0; e < 64; ++e) o[e] = 0.f;
    {
        const bf16_t* qp = H + tok * HP + HCQ + h * 32; const float* bp = bcum + tok * 128 + h * 32;
#pragma unroll 1
        for (int d = 0; d < 32; ++d) {
            const float qd = bf2f(qp[d]) * 0.17677669529663687f * __expf(bp[d]);
#pragma unroll
            for (int e4 = 0; e4 < 16; ++e4) {
                const f32x4 s4 = *(const f32x4*)(sA + d * 64 + e4 * 4);
                o[e4 * 4] = fmaf(qd, s4[0], o[e4 * 4]); o[e4 * 4 + 1] = fmaf(qd, s4[1], o[e4 * 4 + 1]);
                o[e4 * 4 + 2] = fmaf(qd, s4[2], o[e4 * 4 + 2]); o[e4 * 4 + 3] = fmaf(qd, s4[3], o[e4 * 4 + 3]);
            }
        }
    }
    WAVE_SYNC();
    {
        const bf16_t* kp = H + tok * HP + HCK + h * 32;
#pragma unroll
        for (int r = 0; r < 4; ++r) {
            const u32x4 kv = *(const u32x4*)(kp + r * 8);
            const f32x4 b0 = *(const f32x4*)(bcum + tok * 128 + h * 32 + r * 8), b1 = *(const f32x4*)(bcum + tok * 128 + h * 32 + r * 8 + 4);
            f32x4 k0 = {bflo(kv.x) * __expf(-b0[0]), bfhi(kv.x) * __expf(-b0[1]), bflo(kv.y) * __expf(-b0[2]), bfhi(kv.y) * __expf(-b0[3])};
            f32x4 k1 = {bflo(kv.z) * __expf(-b1[0]), bfhi(kv.z) * __expf(-b1[1]), bflo(kv.w) * __expf(-b1[2]), bfhi(kv.w) * __expf(-b1[3])};
            *(f32x4*)(sA + lane * 32 + r * 8) = k0; *(f32x4*)(sA + lane * 32 + r * 8 + 4) = k1;
        }
    }
    float qe[32];
    {
        const bf16_t* qp = H + tok * HP + HCQ + h * 32;
#pragma unroll
        for (int r = 0; r < 4; ++r) {
            const u32x4 qv = *(const u32x4*)(qp + r * 8);
            const f32x4 b0 = *(const f32x4*)(bcum + tok * 128 + h * 32 + r * 8), b1 = *(const f32x4*)(bcum + tok * 128 + h * 32 + r * 8 + 4);
            const float qq[8] = {bflo(qv.x), bfhi(qv.x), bflo(qv.y), bfhi(qv.y), bflo(qv.z), bfhi(qv.z), bflo(qv.w), bfhi(qv.w)};
            const float bb[8] = {b0[0], b0[1], b0[2], b0[3], b1[0], b1[1], b1[2], b1[3]};
#pragma unroll
            for (int e = 0; e < 8; ++e) qe[r * 8 + e] = qq[e] * 0.17677669529663687f * __expf(bb[e]);
        }
    }
    WAVE_SYNC();
#pragma unroll 1
    for (int j = 0; j < 64; ++j) {
        float a = 0.f;
#pragma unroll
        for (int d4 = 0; d4 < 8; ++d4) {
            const f32x4 k4 = *(const f32x4*)(sA + j * 32 + d4 * 4);
            a = fmaf(qe[d4 * 4], k4[0], a); a = fmaf(qe[d4 * 4 + 1], k4[1], a); a = fmaf(qe[d4 * 4 + 2], k4[2], a); a = fmaf(qe[d4 * 4 + 3], k4[3], a);
        }
        if (j > lane) a = 0.f;
#pragma unroll
        for (int e8 = 0; e8 < 8; ++e8) {
            const u32x4 v8 = *(const u32x4*)(sV + j * 64 + e8 * 8);
            o[e8 * 8 + 0] = fmaf(a, bflo(v8.x), o[e8 * 8 + 0]); o[e8 * 8 + 1] = fmaf(a, bfhi(v8.x), o[e8 * 8 + 1]);
            o[e8 * 8 + 2] = fmaf(a, bflo(v8.y), o[e8 * 8 + 2]); o[e8 * 8 + 3] = fmaf(a, bfhi(v8.y), o[e8 * 8 + 3]);
            o[e8 * 8 + 4] = fmaf(a, bflo(v8.z), o[e8 * 8 + 4]); o[e8 * 8 + 5] = fmaf(a, bfhi(v8.z), o[e8 * 8 + 5]);
            o[e8 * 8 + 6] = fmaf(a, bflo(v8.w), o[e8 * 8 + 6]); o[e8 * 8 + 7] = fmaf(a, bfhi(v8.w), o[e8 * 8 + 7]);
        }
    }
    float ss = 0.f;
#pragma unroll
    for (int e = 0; e < 64; ++e) ss = fmaf(o[e], o[e], ss);
    const float rms = rsqrtf(ss * (1.f / 64.f) + EPS);
    const float* gn = p.gnorm_g + layer * 256 + h * 64;
    bf16_t* cg_p = H + tok * HP + HCG + h * 64;
#pragma unroll
    for (int r = 0; r < 8; ++r) {
        const u32x4 gv = *(const u32x4*)(cg_p + r * 8);
        const float gq[8] = {bflo(gv.x), bfhi(gv.x), bflo(gv.y), bfhi(gv.y), bflo(gv.z), bfhi(gv.z), bflo(gv.w), bfhi(gv.w)};
        float y[8];
#pragma unroll
        for (int e = 0; e < 8; ++e) y[e] = o[r * 8 + e] * rms * gn[r * 8 + e] * silu_f(gq[e]);
        u32x4 w; w.x = pk2(y[0], y[1]); w.y = pk2(y[2], y[3]); w.z = pk2(y[4], y[5]); w.w = pk2(y[6], y[7]);
        if (!dry) *(u32x4*)(cg_p + r * 8) = w;
    }
    WAVE_SYNC();
}

constexpr int MPITCH = 260;
constexpr int HPITCH = 516;
constexpr int L_HIST = 0;
constexpr int L_CAND = 66560;
constexpr int L_CCNT = L_CAND + 65536;
constexpr int L_QINF = L_CCNT + 2048;
constexpr int L_MTAB = L_QINF + 1024 + 64;
static_assert(L_MTAB + 8192 <= LDS_BYTES, "dsa lds");
__device__ __forceinline__ int mpos(int rr) { return 16 * ((rr >> 2) & 1) + (rr & 3) + 4 * (rr >> 3); }
constexpr int SUBCAP = 32;

__device__ __forceinline__ unsigned mono_bits(float f) { const unsigned u = __float_as_uint(f); return u ^ ((u >> 31) ? 0xffffffffu : 0x80000000u); }
__device__ __forceinline__ void idx_loadk(const bf16_t* Hb, int s0, int lane, bf16x8 (&kf)[2][2]) {
    const bf16_t* kp = Hb + (long)(s0 + (lane & 15)) * HP + HKI + 8 * (lane >> 4);
#pragma unroll
    for (int kb = 0; kb < 2; ++kb)
#pragma unroll
        for (int ks = 0; ks < 2; ++ks) kf[kb][ks] = *(const bf16x8*)(kp + (long)kb * 16 * HP + ks * 32);
}
__device__ __forceinline__ void idx_scores(const bf16x8 (&kf)[2][2], const bf16x8 (&qf)[8][2], const bf16x8 (&ql)[2][2], const float (&wh)[8], float (&score)[8]) {
    f32x4 lin[2];
#pragma unroll
    for (int kb = 0; kb < 2; ++kb) {
        lin[kb] = (f32x4){0.f, 0.f, 0.f, 0.f};
#pragma unroll
        for (int ks = 0; ks < 2; ++ks) {
            lin[kb] = __builtin_amdgcn_mfma_f32_16x16x32_bf16(kf[kb][ks], ql[0][ks], lin[kb], 0, 0, 0);
            lin[kb] = __builtin_amdgcn_mfma_f32_16x16x32_bf16(kf[kb][ks], ql[1][ks], lin[kb], 0, 0, 0);
        }
    }
#pragma unroll
    for (int i = 0; i < 8; ++i) score[i] = lin[i >> 2][i & 3];
#pragma unroll
    for (int hd = 0; hd < 8; ++hd) {
        f32x4 acc[2];
#pragma unroll
        for (int kb = 0; kb < 2; ++kb) {
            acc[kb] = (f32x4){0.f, 0.f, 0.f, 0.f};
#pragma unroll
            for (int ks = 0; ks < 2; ++ks) acc[kb] = __builtin_amdgcn_mfma_f32_16x16x32_bf16(kf[kb][ks], qf[hd][ks], acc[kb], 0, 0, 0);
        }
#pragma unroll
        for (int kb = 0; kb < 2; ++kb)
#pragma unroll
            for (int i = 0; i < 4; ++i) score[kb * 4 + i] = fmaf(fabsf(acc[kb][i]), wh[hd], score[kb * 4 + i]);
        if ((hd & 3) == 3) __builtin_amdgcn_sched_barrier(0);
    }
}

template <bool FAST>
__device__ __forceinline__ void attn_tile(const bf16x8 (&kf)[4], const bf16x8 (&vf)[4], const bf16x8 (&qfr)[2][4], f32x16 (&O)[2][2], float (&mrun)[2], float (&lrun)[2],
                                          const unsigned* hist, const float* mtab, int r32, int hh, int tile) {
#pragma unroll
    for (int qb = 0; qb < 2; ++qb) {
        f32x16 S;
        const unsigned mw = hist[(qb * 32 + r32) * MPITCH + tile] >> (16 * hh);
#pragma unroll
        for (int g8 = 0; g8 < 2; ++g8) {
            const float* mt = mtab + ((mw >> (8 * g8)) & 255u) * 8;
            const f32x4 ma = *(const f32x4*)mt, mb = *(const f32x4*)(mt + 4);
            S[8 * g8] = ma[0]; S[8 * g8 + 1] = ma[1]; S[8 * g8 + 2] = ma[2]; S[8 * g8 + 3] = ma[3];
            S[8 * g8 + 4] = mb[0]; S[8 * g8 + 5] = mb[1]; S[8 * g8 + 6] = mb[2]; S[8 * g8 + 7] = mb[3];
        }
#pragma unroll
        for (int ks = 0; ks < 4; ++ks) S = __builtin_amdgcn_mfma_f32_32x32x16_bf16(kf[ks], qfr[qb][ks], S, 0, 0, 0);
        float pr[16]; float ps = 0.f;
        if (FAST) {
#pragma unroll
            for (int i = 0; i < 16; ++i) { pr[i] = __builtin_amdgcn_exp2f(S[i]); ps += pr[i]; }
        } else {
            float mx = fmaxf(fmaxf(S[0], S[1]), S[2]);
#pragma unroll
            for (int i = 3; i < 15; i += 2) mx = fmaxf(fmaxf(mx, S[i]), S[i + 1]);
            mx = fmaxf(mx, S[15]);
            { const auto sw = __builtin_amdgcn_permlane32_swap(__float_as_uint(mx), __float_as_uint(mx), false, false); mx = fmaxf(__uint_as_float(sw[0]), __uint_as_float(sw[1])); }
            if (__any(mx > mrun[qb])) {
                const float mnew = fmaxf(mx, mrun[qb]);
                const float alpha = __builtin_amdgcn_exp2f(mrun[qb] - mnew);
                mrun[qb] = mnew; lrun[qb] *= alpha;
#pragma unroll
                for (int db = 0; db < 2; ++db)
#pragma unroll
                    for (int i = 0; i < 16; ++i) O[db][qb][i] *= alpha;
            }
            const float mref = fmaxf(mrun[qb], -1000.f);
#pragma unroll
            for (int i = 0; i < 16; ++i) { pr[i] = __builtin_amdgcn_exp2f(S[i] - mref); ps += pr[i]; }
        }
        lrun[qb] += ps;
        bf16x8 pf[2];
#pragma unroll
        for (int s = 0; s < 2; ++s) {
            u32x4 pw; pw.x = pk2(pr[8 * s], pr[8 * s + 1]); pw.y = pk2(pr[8 * s + 2], pr[8 * s + 3]); pw.z = pk2(pr[8 * s + 4], pr[8 * s + 5]); pw.w = pk2(pr[8 * s + 6], pr[8 * s + 7]);
            pf[s] = __builtin_bit_cast(bf16x8, pw);
        }
#pragma unroll
        for (int db = 0; db < 2; ++db)
#pragma unroll
            for (int s = 0; s < 2; ++s) O[db][qb] = __builtin_amdgcn_mfma_f32_32x32x16_bf16(vf[db * 2 + s], pf[s], O[db][qb], 0, 0, 0);
    }
}
template <bool FAST>
__device__ __forceinline__ void attn_loop(const bf16_t* Kp, const bf16_t* Vp, const bf16x8 (&qfr)[2][4], f32x16 (&O)[2][2], float (&mrun)[2], float (&lrun)[2],
                                          const unsigned* hist, const float* mtab, int r32, int hh, int nt32, bool dry2) {
    bf16x8 kf[4], vf[4], kg[4], vg[4];
#pragma unroll
    for (int ks = 0; ks < 4; ++ks) { kf[ks] = *(const bf16x8*)(Kp + ks * 512); vf[ks] = *(const bf16x8*)(Vp + ks * 512); }
#pragma unroll 1
    for (int tile = 0; tile < nt32; tile += 2) {
        {
            const int tn = dry2 ? 0 : tile + 1;
#pragma unroll
            for (int ks = 0; ks < 4; ++ks) { kg[ks] = *(const bf16x8*)(Kp + (long)tn * 2048 + ks * 512); vg[ks] = *(const bf16x8*)(Vp + (long)tn * 2048 + ks * 512); }
        }
        attn_tile<FAST>(kf, vf, qfr, O, mrun, lrun, hist, mtab, r32, hh, tile);
        {
            const int tn = dry2 ? 0 : ((tile + 2 < nt32) ? tile + 2 : tile);
#pragma unroll
            for (int ks = 0; ks < 4; ++ks) { kf[ks] = *(const bf16x8*)(Kp + (long)tn * 2048 + ks * 512); vf[ks] = *(const bf16x8*)(Vp + (long)tn * 2048 + ks * 512); }
        }
        attn_tile<FAST>(kg, vg, qfr, O, mrun, lrun, hist, mtab, r32, hh, tile + 1);
    }
}

__device__ __forceinline__ void dsa_item(const Params& p, unsigned char* lds, int b, int qblk, bool dry, int wid_s) {
    bf16_t* H = (bf16_t*)(p.ws + WS_H);
    const float* side = (const float*)(p.ws + WS_SIDE);
    const bf16_t* Hb = H + (long)b * T * HP;
    const int tid = otid(wid_s), lane = tid & 63, w = tid >> 6, hq = lane >> 4;
    const int qg = w & 3, kh = w >> 2;
    const int t0 = qblk * 64, qloc = qg * 16 + (lane & 15), t = t0 + qloc;
    unsigned* hist = (unsigned*)(lds + L_HIST);
    unsigned* cand = (unsigned*)(lds + L_CAND);
    unsigned* ccnt = (unsigned*)(lds + L_CCNT);
    int* qinf = (int*)(lds + L_QINF);

    for (int i = tid; i < 64 * MPITCH; i += 512) hist[i] = 0u;
    for (int i = tid; i < 2048; i += 512) ((float*)(lds + L_MTAB))[i] = ((i >> 3) >> (i & 7)) & 1 ? 0.f : -1e30f;
    bf16x8 qf[8][2]; bf16x8 ql[2][2]; float wi[8]; float inv, fb0c;
    {
        const bf16_t* qp = Hb + (long)t * HP + HQI + 8 * hq;
#pragma unroll
        for (int hd = 0; hd < 8; ++hd)
#pragma unroll
            for (int ks = 0; ks < 2; ++ks) qf[hd][ks] = *(const bf16x8*)(qp + hd * 64 + ks * 32);
        const float* sp = side + ((long)b * T + t) * 24;
        const f32x4 w0 = *(const f32x4*)sp, w1 = *(const f32x4*)(sp + 4);
        wi[0] = w0[0]; wi[1] = w0[1]; wi[2] = w0[2]; wi[3] = w0[3]; wi[4] = w1[0]; wi[5] = w1[1]; wi[6] = w1[2]; wi[7] = w1[3];
        float n2 = 0.f;
#pragma unroll
        for (int i = 0; i < 8; ++i) n2 = fmaf(wi[i], wi[i], n2);
        const float nrm = fmaxf(SIG_UNIT * sqrtf(n2), 1e-30f);
        inv = 64.f / nrm;
        fb0c = 256.f - 64.f * 3.19f * (wi[0] + wi[1] + wi[2] + wi[3] + wi[4] + wi[5] + wi[6] + wi[7]) / nrm;
#pragma unroll
        for (int i = 0; i < 8; ++i) wi[i] *= 0.5f;
#pragma unroll
        for (int ks = 0; ks < 2; ++ks) {
            float ql_f[8];
#pragma unroll
            for (int j = 0; j < 8; ++j) ql_f[j] = 0.f;
#pragma unroll
            for (int hd = 0; hd < 8; ++hd) {
                const u32x4 qv = __builtin_bit_cast(u32x4, qf[hd][ks]);
                ql_f[0] = fmaf(wi[hd], bflo(qv.x), ql_f[0]); ql_f[1] = fmaf(wi[hd], bfhi(qv.x), ql_f[1]); ql_f[2] = fmaf(wi[hd], bflo(qv.y), ql_f[2]); ql_f[3] = fmaf(wi[hd], bfhi(qv.y), ql_f[3]);
                ql_f[4] = fmaf(wi[hd], bflo(qv.z), ql_f[4]); ql_f[5] = fmaf(wi[hd], bfhi(qv.z), ql_f[5]); ql_f[6] = fmaf(wi[hd], bflo(qv.w), ql_f[6]); ql_f[7] = fmaf(wi[hd], bfhi(qv.w), ql_f[7]);
            }
            u32x4 hi4; hi4.x = pk2(ql_f[0], ql_f[1]); hi4.y = pk2(ql_f[2], ql_f[3]); hi4.z = pk2(ql_f[4], ql_f[5]); hi4.w = pk2(ql_f[6], ql_f[7]);
            u32x4 lo4;
            lo4.x = pk2(ql_f[0] - bflo(hi4.x), ql_f[1] - bfhi(hi4.x)); lo4.y = pk2(ql_f[2] - bflo(hi4.y), ql_f[3] - bfhi(hi4.y));
            lo4.z = pk2(ql_f[4] - bflo(hi4.z), ql_f[5] - bfhi(hi4.z)); lo4.w = pk2(ql_f[6] - bflo(hi4.w), ql_f[7] - bfhi(hi4.w));
            ql[0][ks] = __builtin_bit_cast(bf16x8, hi4); ql[1][ks] = __builtin_bit_cast(bf16x8, lo4);
        }
    }
    const int ntile = (t0 + 64 + 127) >> 7;
    const int tmaxw = t0 + qg * 16 + 15;
    __syncthreads();
    int nit = 0;
    { const int v = tmaxw - kh * 64; if (v >= 0) nit = 2 * (v >> 7) + (((v & 127) >= 32) ? 2 : 1); }
    float fa = inv, fbias = fb0c;
    bool active = true;
#pragma unroll 1
    for (int level = 0; level < 2; ++level) {
        unsigned* hbase = level ? cand : hist;
        const bool wave_on = __any(active);
        if (wave_on) {
            const unsigned incv = 1u << ((qloc & 1) * 16);
            unsigned* hrow = hbase + (qloc >> 1) * HPITCH;
            bf16x8 kf[2][2];
            idx_loadk(Hb, kh * 64, lane, kf);
#pragma unroll 1
            for (int it = 0; it < nit; ++it) {
                const int s0 = (it >> 1) * 128 + kh * 64 + (it & 1) * 32;
                const int itn = (it + 1 < nit) ? it + 1 : it;
                bf16x8 kn[2][2];
                idx_loadk(Hb, (itn >> 1) * 128 + kh * 64 + (itn & 1) * 32, lane, kn);
                float score[8];
                idx_scores(kf, qf, ql, wi, score);
                if (s0 + 31 <= t0 + qg * 16) {
#pragma unroll
                    for (int i = 0; i < 8; ++i) { const unsigned bin = (unsigned)__builtin_amdgcn_fmed3f(fmaf(score[i], fa, fbias), 0.f, 511.5f); atomicAdd(hrow + bin, incv); }
                } else {
#pragma unroll
                    for (int i = 0; i < 8; ++i) {
                        const int s = s0 + (i >> 2) * 16 + hq * 4 + (i & 3);
                        if (s <= t) { const unsigned bin = (unsigned)__builtin_amdgcn_fmed3f(fmaf(score[i], fa, fbias), 0.f, 511.5f); atomicAdd(hrow + bin, incv); }
                    }
                }
#pragma unroll
                for (int kb = 0; kb < 2; ++kb)
#pragma unroll
                    for (int ks = 0; ks < 2; ++ks) kf[kb][ks] = kn[kb][ks];
            }
        }
        __syncthreads();
#pragma unroll 1
        for (int qq = 0; qq < 8; ++qq) {
            const int q = w * 8 + qq;
            if (level && !qinf[q * 4 + 3]) continue;
            const u32x4 wa = *(const u32x4*)(hbase + (q >> 1) * HPITCH + 8 * lane), wb = *(const u32x4*)(hbase + (q >> 1) * HPITCH + 8 * lane + 4);
            const int sh = (q & 1) * 16;
            const unsigned c[8] = {(wa.x >> sh) & 0xffffu, (wa.y >> sh) & 0xffffu, (wa.z >> sh) & 0xffffu, (wa.w >> sh) & 0xffffu, (wb.x >> sh) & 0xffffu, (wb.y >> sh) & 0xffffu, (wb.z >> sh) & 0xffffu, (wb.w >> sh) & 0xffffu};
            const unsigned tot = c[0] + c[1] + c[2] + c[3] + c[4] + c[5] + c[6] + c[7];
            unsigned S = tot;
#pragma unroll
            for (int o = 1; o < 64; o <<= 1) { const unsigned dn = (unsigned)bperm_i((lane + o) & 63, (int)S); if (lane + o < 64) S += dn; }
            const unsigned total = (unsigned)__builtin_amdgcn_readfirstlane((int)S);
            const u64 bal = __ballot(S >= 256u);
            int b1 = -1, r1 = 0, n1 = 0;
            if (total >= 256u) {
                const int Ls = 63 - __clzll(bal);
                unsigned cum = S - tot; bool found = false; int lb = -1, lr = 0, ln = 0;
#pragma unroll
                for (int j = 7; j >= 0; --j) { const bool hit = !found && (cum + c[j] >= 256u); if (hit) { lb = 8 * lane + j; lr = 256 - (int)cum; ln = (int)c[j]; found = true; } cum += c[j]; }
                b1 = bperm_i(Ls, lb); r1 = bperm_i(Ls, lr); n1 = bperm_i(Ls, ln);
            }
            if (lane == 0) { qinf[q * 4] = b1; qinf[q * 4 + 1] = r1; qinf[q * 4 + 2] = n1; }
        }
        __syncthreads();
        if (level == 0) { for (int i = tid; i < 64 * MPITCH; i += 512) hist[i] = 0u; }
        if (tid == 0) qinf[256] = 0;
        __syncthreads();
        if (wave_on) {
            const int b1 = qinf[qloc * 4];
            const float fsel = !active ? __builtin_inff() : ((b1 < 0) ? -__builtin_inff() : ((b1 >= 511) ? __builtin_inff() : (float)(b1 + 1)));
            const float fcand = !active ? __builtin_inff() : ((b1 <= 0) ? -__builtin_inff() : (float)b1);
            const float fb1 = (float)(b1 < 0 ? 0 : b1);
            unsigned* cslot = cand + (qloc * 8 + kh * 4 + hq) * SUBCAP; int ncand = 0;
            bf16x8 kf[2][2];
            idx_loadk(Hb, kh * 64, lane, kf);
#pragma unroll 1
            for (int it = 0; it < nit; ++it) {
                const int s0 = (it >> 1) * 128 + kh * 64 + (it & 1) * 32;
                const int itn = (it + 1 < nit) ? it + 1 : it;
                bf16x8 kn[2][2];
                idx_loadk(Hb, (itn >> 1) * 128 + kh * 64 + (itn & 1) * 32, lane, kn);
                float score[8];
                idx_scores(kf, qf, ql, wi, score);
                unsigned m0 = 0u;
                if (s0 + 31 <= t0 + qg * 16) {
#pragma unroll
                    for (int i = 0; i < 8; ++i) {
                        const int rr = (i >> 2) * 16 + hq * 4 + (i & 3), s = s0 + rr;
                        const float fb = fmaf(score[i], fa, fbias);
                        if (fb >= fcand) {
                            if (fb >= fsel) m0 |= 1u << (16 * (hq & 1) + 4 * (hq >> 1) + (i & 3) + 8 * (i >> 2));
                            else {
                                const unsigned q19 = (unsigned)__builtin_amdgcn_fmed3f((fb - fb1) * 524288.f, 0.f, 524287.f);
                                if (ncand < SUBCAP) cslot[ncand] = (q19 << 13) | (unsigned)(8191 - s);
                                ++ncand;
                            }
                        }
                    }
                } else {
#pragma unroll
                    for (int i = 0; i < 8; ++i) {
                        const int rr = (i >> 2) * 16 + hq * 4 + (i & 3), s = s0 + rr;
                        const float fb = fmaf(score[i], fa, fbias);
                        if (fb >= fcand && s <= t) {
                            if (fb >= fsel) m0 |= 1u << (16 * (hq & 1) + 4 * (hq >> 1) + (i & 3) + 8 * (i >> 2));
                            else {
                                const unsigned q19 = (unsigned)__builtin_amdgcn_fmed3f((fb - fb1) * 524288.f, 0.f, 524287.f);
                                if (ncand < SUBCAP) cslot[ncand] = (q19 << 13) | (unsigned)(8191 - s);
                                ++ncand;
                            }
                        }
                    }
                }
                if (m0) atomicOr(&hist[qloc * MPITCH + (s0 >> 5)], m0);
#pragma unroll
                for (int kb = 0; kb < 2; ++kb)
#pragma unroll
                    for (int ks = 0; ks < 2; ++ks) kf[kb][ks] = kn[kb][ks];
            }
            ccnt[qloc * 8 + kh * 4 + hq] = (unsigned)ncand;
        } else ccnt[qloc * 8 + kh * 4 + hq] = 0u;
        __syncthreads();
#pragma unroll 1
        for (int qq = 0; qq < 8; ++qq) {
            const int q = w * 8 + qq;
            if (level && !qinf[q * 4 + 3]) continue;
            const int r1 = qinf[q * 4 + 1];
            const int wr_ = lane >> 3, sl0 = (lane & 7) * 4;
            int cw = (int)ccnt[q * 8 + wr_];
            const bool ovf = __any(cw > SUBCAP) && (level == 0);
            if (lane == 0) { qinf[q * 4 + 3] = ovf ? 1 : 0; if (ovf) qinf[256] = 1; }
            if (ovf || r1 <= 0) continue;
            if (cw > SUBCAP) cw = SUBCAP;
            const u32x4 mine = *(const u32x4*)(cand + (q * 8 + wr_) * SUBCAP + sl0);
            int rk0 = 0, rk1 = 0, rk2 = 0, rk3 = 0;
#pragma unroll 1
            for (int ww = 0; ww < 8; ++ww) {
                int cn = (int)ccnt[q * 8 + ww]; if (cn > SUBCAP) cn = SUBCAP;
                const unsigned* cl = cand + (q * 8 + ww) * SUBCAP;
#pragma unroll 1
                for (int j = 0; j < cn; ++j) { const unsigned cv = cl[j]; rk0 += (cv > mine.x); rk1 += (cv > mine.y); rk2 += (cv > mine.z); rk3 += (cv > mine.w); }
            }
            if (sl0 + 0 < cw && rk0 < r1) { const int s = 8191 - (int)(mine.x & 8191u); atomicOr(&hist[q * MPITCH + (s >> 5)], 1u << mpos(s & 31)); }
            if (sl0 + 1 < cw && rk1 < r1) { const int s = 8191 - (int)(mine.y & 8191u); atomicOr(&hist[q * MPITCH + (s >> 5)], 1u << mpos(s & 31)); }
            if (sl0 + 2 < cw && rk2 < r1) { const int s = 8191 - (int)(mine.z & 8191u); atomicOr(&hist[q * MPITCH + (s >> 5)], 1u << mpos(s & 31)); }
            if (sl0 + 3 < cw && rk3 < r1) { const int s = 8191 - (int)(mine.w & 8191u); atomicOr(&hist[q * MPITCH + (s >> 5)], 1u << mpos(s & 31)); }
        }
        __syncthreads();
        if (level == 1 || qinf[256] == 0) break;
        {
            const bool mine_ovf = qinf[qloc * 4 + 3] != 0;
            const int b1 = qinf[qloc * 4];
            active = mine_ovf;
            fa = mine_ovf ? inv * 510.f : 0.f;
            fbias = mine_ovf ? fmaf(fb0c - (float)b1, 510.f, 1.f) : -1.f;
        }
        for (int i = tid; i < 32 * HPITCH; i += 512) cand[i] = 0u;
        __syncthreads();
    }
    for (int rep2_ = ((PROBE_PHASE == 41) ? 0 : 1); rep2_ < 2; ++rep2_) {
        const bool dry2 = dry || ((PROBE_PHASE == 41) && (rep2_ == 0) && (p.pos[0] == 0));
        const int head = w, r32 = lane & 31, hh = lane >> 5;
        bf16x8 qfr[2][4];
        float q1 = 0.f;
#pragma unroll
        for (int qb = 0; qb < 2; ++qb) {
            float qa = 0.f;
#pragma unroll
            for (int ks = 0; ks < 4; ++ks) {
                qfr[qb][ks] = *(const bf16x8*)(Hb + (long)(t0 + qb * 32 + r32) * HP + HQ + head * 64 + ks * 16 + 8 * hh);
                const u32x4 qv = __builtin_bit_cast(u32x4, qfr[qb][ks]);
                qa += fabsf(bflo(qv.x)) + fabsf(bfhi(qv.x)) + fabsf(bflo(qv.y)) + fabsf(bfhi(qv.y)) + fabsf(bflo(qv.z)) + fabsf(bfhi(qv.z)) + fabsf(bflo(qv.w)) + fabsf(bfhi(qv.w));
            }
            q1 = fmaxf(q1, qa);
        }
        q1 += sxor_f(q1, lane, 32);
#pragma unroll
        for (int o = 16; o >= 1; o >>= 1) q1 = fmaxf(q1, sxor_f(q1, lane, o));
        const float kmx = __uint_as_float(((const unsigned*)(p.ws + WS_KMAX))[b * 8 + head]);
        const bool fast = (q1 * kmx * 1.02f) < 100.f;
        f32x16 O[2][2];
#pragma unroll
        for (int a = 0; a < 2; ++a)
#pragma unroll
            for (int c2 = 0; c2 < 2; ++c2)
#pragma unroll
                for (int i = 0; i < 16; ++i) O[a][c2][i] = 0.f;
        float mrun[2] = {-1e30f, -1e30f}, lrun[2] = {0.f, 0.f};
        const bf16_t* Kp = (const bf16_t*)(p.ws + WS_KF) + ((long)(b * 8 + head) * 256 * 4 * 64 + lane) * 8;
        const bf16_t* Vp = (const bf16_t*)(p.ws + WS_VT) + ((long)(b * 8 + head) * 256 * 4 * 64 + lane) * 8;
        const int nt32 = (t0 + 64) >> 5;
        if (fast) attn_loop<true>(Kp, Vp, qfr, O, mrun, lrun, hist, (const float*)(lds + L_MTAB), r32, hh, nt32, dry2);
        else attn_loop<false>(Kp, Vp, qfr, O, mrun, lrun, hist, (const float*)(lds + L_MTAB), r32, hh, nt32, dry2);
#pragma unroll
        for (int qb = 0; qb < 2; ++qb) {
            const float lt = lrun[qb] + sxor_f(lrun[qb], lane, 32);
            const float il = 1.f / lt;
            bf16_t* gp = H + ((long)b * T + t0 + qb * 32 + r32) * HP + HAG + head * 64 + 4 * hh;
#pragma unroll
            for (int db = 0; db < 2; ++db)
#pragma unroll
                for (int g4 = 0; g4 < 4; ++g4) {
                    bf16_t* gq = gp + db * 32 + 8 * g4;
                    const u32x2 gv = *(const u32x2*)gq;
                    u32x2 wv;
                    wv.x = pk2(O[db][qb][4 * g4] * il * silu_f(bflo(gv.x)), O[db][qb][4 * g4 + 1] * il * silu_f(bfhi(gv.x)));
                    wv.y = pk2(O[db][qb][4 * g4 + 2] * il * silu_f(bflo(gv.y)), O[db][qb][4 * g4 + 3] * il * silu_f(bfhi(gv.y)));
                    if (!dry2) *(u32x2*)gq = wv;
                }
        }
    }
    __syncthreads();
}

__device__ __forceinline__ void gbar(unsigned* ctr, unsigned target) {
    __syncthreads();
    if (threadIdx.x == 0) {
        __builtin_amdgcn_fence(__ATOMIC_RELEASE, "agent");
        __hip_atomic_fetch_add(ctr, 1u, __ATOMIC_RELAXED, __HIP_MEMORY_SCOPE_AGENT);
        while (__hip_atomic_load(ctr, __ATOMIC_RELAXED, __HIP_MEMORY_SCOPE_AGENT) < target) __builtin_amdgcn_s_sleep(2);
        __builtin_amdgcn_fence(__ATOMIC_ACQUIRE, "agent");
    }
    __syncthreads();
}

__device__ __forceinline__ void ho_arrive(unsigned* ctr) {
    __syncthreads();
    if (threadIdx.x == 0) { __builtin_amdgcn_fence(__ATOMIC_RELEASE, "agent"); __hip_atomic_fetch_add(ctr, 1u, __ATOMIC_RELAXED, __HIP_MEMORY_SCOPE_AGENT); }
}
__device__ __forceinline__ void ho_wait(unsigned* ctr, unsigned target) {
    if (threadIdx.x == 0) {
        while (__hip_atomic_load(ctr, __ATOMIC_RELAXED, __HIP_MEMORY_SCOPE_AGENT) < target) __builtin_amdgcn_s_sleep(2);
        __builtin_amdgcn_fence(__ATOMIC_ACQUIRE, "agent");
    }
    __syncthreads();
}

__global__ void __launch_bounds__(512) fwd_megakernel(Params p0) {
    extern __shared__ __attribute__((aligned(16))) unsigned char lds[];
    cg::grid_group grid = cg::this_grid();
    const int G = gridDim.x, c = blockIdx.x;
    const int wid_s = __builtin_amdgcn_readfirstlane((int)(threadIdx.x >> 6));

    unsigned* barctr = (unsigned*)(p0.ws + WS_BAR); unsigned bar_n = 0;
    if (c == 0 && threadIdx.x < 3) __hip_atomic_store(barctr + 16 * threadIdx.x, 0u, __ATOMIC_RELAXED, __HIP_MEMORY_SCOPE_AGENT);
    for (int rep0_ = (PROBE_PHASE == 8 ? 0 : 1); rep0_ < 2; ++rep0_) prologue(p0, (long)c * 512 + threadIdx.x, (long)G * 512);
    grid.sync();

#pragma unroll 1
    for (int layer = 0; layer < DEPTH; ++layer) {
        Params p = p0;
        { size_t zoff = 0; asm volatile("" : "+s"(zoff)); p.ws = p0.ws + zoff; }
        bf16_t* H = (bf16_t*)(p.ws + WS_H);
        {
for (int rep_ = (PROBE_PHASE == 1 ? 0 : 1); rep_ < 2; ++rep_) { const bool dry = (PROBE_PHASE == 1) && (rep_ == 0) && (p.pos[0] == 0);
            EpiIn e; e.H = H; e.side = (float*)(p.ws + WS_SIDE); e.rope = (const float*)(p.ws + WS_ROPE); e.VT = (bf16_t*)(p.ws + WS_VT); e.KF = (bf16_t*)(p.ws + WS_KF); e.kmax = (unsigned*)(p.ws + WS_KMAX); e.dry = dry;
            const bf16_t* A = (const bf16_t*)(p.ws + WS_XB);
            const bf16_t* Bt = (const bf16_t*)(p.ws + WS_WIN) + (long)layer * NPAD * 1024;
#pragma unroll 1
            for (int L = c; L < 128 * 17; L += G) { int pm, pn; tile_of(L, 128, 17, pm, pn); gemm_tile((LAS unsigned char*)lds, A, 1024, Bt, 1024, pm, pn, e, wid_s); }
}
        }
        gbar(barctr, (++bar_n) * (unsigned)G); if (PROBE_PHASE == 9) gbar(barctr, (++bar_n) * (unsigned)G);
        {
for (int rep_ = (PROBE_PHASE == 2 ? 0 : 1); rep_ < 2; ++rep_) { const bool dry = (PROBE_PHASE == 2) && (rep_ == 0) && (p.pos[0] == 0);
            const int tid = otid(wid_s), lane = tid & 63, w = tid >> 6;
#pragma unroll 1
            for (int g = c; g < 256; g += G) gla_local_item(p, layer, g * 8 + w, lane, dry);
}
        }
        ho_arrive(barctr + 16);
        if (c < 64) {
            ho_wait(barctr + 16, (unsigned)(layer + 1) * (unsigned)G);
            const int tid = otid(wid_s);
#pragma unroll 1
            for (int g = c; g < 64; g += G) gla_scan(p, g * 512 + tid);
            ho_arrive(barctr + 32);
        }
for (int rep_ = (PROBE_PHASE == 3 ? 0 : 1); rep_ < 2; ++rep_) { const bool dry = (PROBE_PHASE == 3) && (rep_ == 0) && (p.pos[0] == 0);
#pragma unroll 1
        for (int tile = c; tile < 512; tile += G) conformer_tile(p, layer, lds, tile, dry, wid_s);
}
for (int rep_ = (PROBE_PHASE == 4 ? 0 : 1); rep_ < 2; ++rep_) { const bool dry = (PROBE_PHASE == 4) && (rep_ == 0) && (p.pos[0] == 0);
#pragma unroll 1
        for (int it = c; it < 512; it += G) {
            const int pr = it >> 1, second = it & 1;
            const int xcd = pr & 7, j = pr >> 3, b = xcd >> 1, par = xcd & 1;
            const int qblk = second ? (2 * j + par) : 127 - (2 * j + par);
            dsa_item(p, lds, b, qblk, dry, wid_s);
        }
}
        ho_wait(barctr + 32, (unsigned)(layer + 1) * (unsigned)(G < 64 ? G : 64));
        {
for (int rep_ = (PROBE_PHASE == 5 ? 0 : 1); rep_ < 2; ++rep_) { const bool dry = (PROBE_PHASE == 5) && (rep_ == 0) && (p.pos[0] == 0);
            const int tid = otid(wid_s), lane = tid & 63, w = tid >> 6;
#pragma unroll 1
            for (int g = c; g < 256; g += G) gla_out_item(p, layer, lds + w * 16384, g * 8 + w, lane, dry);
}
        }
        gbar(barctr, (++bar_n) * (unsigned)G); if (PROBE_PHASE == 9) gbar(barctr, (++bar_n) * (unsigned)G);
        {
for (int rep_ = (PROBE_PHASE == 6 ? 0 : 1); rep_ < 2; ++rep_) { const bool dry = (PROBE_PHASE == 6) && (rep_ == 0) && (p.pos[0] == 0);
            EpiOut e; e.xres = (layer == 0) ? p.x : p.out; e.out = p.out; e.dry = dry;
            const bf16_t* A = H + HAG;
            const bf16_t* Bt = (const bf16_t*)(p.ws + WS_WOUT) + (long)layer * 1024 * 1024;
#pragma unroll 1
            for (int L = c; L < 128 * 4; L += G) { int pm, pn; tile_of(L, 128, 4, pm, pn); gemm_tile((LAS unsigned char*)lds, A, HP, Bt, 1024, pm, pn, e, wid_s); ho_arrive((unsigned*)(p.ws + WS_PCNT) + pm * 16); }
}
        }
        {
for (int rep_ = (PROBE_PHASE == 7 ? 0 : 1); rep_ < 2; ++rep_) { const bool dry = (PROBE_PHASE == 7) && (rep_ == 0) && (p.pos[0] == 0);
            const int tid = otid(wid_s), lane = tid & 63, w = tid >> 6;
#pragma unroll 1
            for (int hp = c; hp < 256; hp += G) {
                ho_wait((unsigned*)(p.ws + WS_PCNT) + (hp >> 1) * 16, 4u * (unsigned)(layer + 1));
                const int base = (hp >> 1) * 256 + (hp & 1) * 128;
                ln_phase(p, layer, base + w, base + 128, 8, lane, dry);
            }
            if (c == 0 && tid < 32) ((unsigned*)(p.ws + WS_KMAX))[tid] = 0u;
}
        }
        if (layer + 1 < DEPTH) { gbar(barctr, (++bar_n) * (unsigned)G); if (PROBE_PHASE == 9) gbar(barctr, (++bar_n) * (unsigned)G); }
    }
}

extern "C" void kernel_launch(void* const* d_in, const int* in_sizes, int n_in, void* d_out, int out_size, void* d_ws, size_t ws_size, hipStream_t stream) {
    static int grid_blocks = 0;
    if (grid_blocks == 0) {
        if (n_in != 15 || ws_size < WS_END) { fprintf(stderr, "kernel_launch: unexpected inputs (n_in %d, ws %zu < %zu)\n", n_in, ws_size, (size_t)WS_END); grid_blocks = -1; return; }
        int dev = 0, cus = 0, per_cu = 0;
        hipGetDevice(&dev);
        hipDeviceGetAttribute(&cus, hipDeviceAttributeMultiprocessorCount, dev);
        if (hipFuncSetAttribute((const void*)fwd_megakernel, hipFuncAttributeMaxDynamicSharedMemorySize, LDS_BYTES) != hipSuccess) { fprintf(stderr, "kernel_launch: hipFuncSetAttribute failed\n"); grid_blocks = -1; return; }
        hipOccupancyMaxActiveBlocksPerMultiprocessor(&per_cu, (const void*)fwd_megakernel, 512, LDS_BYTES);
        if (per_cu < 1) per_cu = 1;
        grid_blocks = cus * per_cu;
    }
    if (grid_blocks < 0) return;
    Params p{};
    p.x = (const float*)d_in[0]; p.pos = (const int*)d_in[1]; p.w_in = (const float*)d_in[2]; p.conv_w = (const float*)d_in[3]; p.conv_b = (const float*)d_in[4];
    p.cln_g = (const float*)d_in[5]; p.cln_b = (const float*)d_in[6]; p.pw_w = (const float*)d_in[7]; p.pw_b = (const float*)d_in[8];
    p.gate_w2 = (const float*)d_in[9]; p.gate_b = (const float*)d_in[10]; p.gnorm_g = (const float*)d_in[11]; p.w_out = (const float*)d_in[12];
    p.ln_g = (const float*)d_in[13]; p.ln_b = (const float*)d_in[14];
    p.out = (float*)d_out; p.ws = (unsigned char*)d_ws;
    for (int j = 0; j < 32; ++j) p.inv_freq[j] = (float)pow(10000.0, -(double)j / 32.0);
    void* args[] = {&p};
    hipError_t e = hipLaunchCooperativeKernel((const void*)fwd_megakernel, dim3(grid_blocks), dim3(512), args, LDS_BYTES, stream);
    if (e != hipSuccess) fprintf(stderr, "cooperative launch failed: %s (grid %d)\n", hipGetErrorString(e), grid_blocks);
}
```

```cpp
#include <hip/hip_runtime.h>
#include <hip/hip_cooperative_groups.h>
#include <cstdio>
#include <cmath>
namespace cg = cooperative_groups;

typedef unsigned short bf16_t;
typedef short bf16x8 __attribute__((ext_vector_type(8)));
typedef float f32x4 __attribute__((ext_vector_type(4)));
typedef float f32x16 __attribute__((ext_vector_type(16)));
typedef unsigned u32x4 __attribute__((ext_vector_type(4)));
typedef unsigned u32x2 __attribute__((ext_vector_type(2)));
typedef unsigned long long u64;

constexpr int NB = 4, T = 8192, NTOK = NB * T, DM = 1024, DIN = 4184, NPAD = 4352, HP = 4160, DEPTH = 4;
constexpr int HQ = 0, HK = 512, HV = 1024, HQI = 1536, HKI = 2048, HGLU = 2112, HCQ = 2624, HCK = 2752, HCV = 2880, HAG = 3136, HBG = 3648, HCG = 3904;
constexpr float EPS = 1e-5f;
constexpr float ALPHA = 1.6817928305074290f;
constexpr float QSCALE = 0.125f * 1.4426950408889634f;
constexpr float WI_SCALE = 0.04419417382415922f;
constexpr float SIG_UNIT = 5.66f;
constexpr int CAP = 128;

constexpr size_t WS_WIN = 0;
constexpr size_t WS_WOUT = WS_WIN + (size_t)DEPTH * NPAD * 1024 * 2;
constexpr size_t WS_PWT = WS_WOUT + (size_t)DEPTH * 1024 * 1024 * 2;
constexpr size_t WS_ROPE = WS_PWT + (size_t)DEPTH * 256 * 256 * 2;
constexpr size_t WS_XB = WS_ROPE + (size_t)NTOK * 32 * 8;
constexpr size_t WS_H = WS_XB + (size_t)NTOK * 1024 * 2;
constexpr size_t WS_SIDE = WS_H + (size_t)NTOK * HP * 2;
constexpr size_t WS_BCUM = WS_SIDE + (size_t)NTOK * 24 * 4;
constexpr size_t WS_U = WS_BCUM + (size_t)NTOK * 128 * 4;
constexpr size_t WS_DEC = WS_U + (size_t)2048 * 2048 * 4;
constexpr size_t WS_VT = WS_DEC + (size_t)2048 * 32 * 4;
constexpr size_t WS_KF = WS_VT + (size_t)NTOK * 512 * 2;
constexpr size_t WS_BAR = WS_KF + (size_t)NTOK * 512 * 2;
constexpr size_t WS_KMAX = WS_BAR + 256;
constexpr size_t WS_PCNT = WS_KMAX + 512;
constexpr size_t WS_LCNT = WS_PCNT + 128 * 64;
constexpr size_t WS_END = WS_LCNT + 128 * 64;

#ifndef PROBE_PHASE
#define PROBE_PHASE 0
#endif
constexpr int LDS_BYTES = 147456;

struct Params {
    const float* x; const int* pos; const float* w_in; const float* conv_w; const float* conv_b; const float* cln_g; const float* cln_b;
    const float* pw_w; const float* pw_b; const float* gate_w2; const float* gate_b; const float* gnorm_g; const float* w_out; const float* ln_g; const float* ln_b;
    float* out; unsigned char* ws;
    float inv_freq[32];
};

__device__ __forceinline__ unsigned f2bf(float f) { unsigned u = __float_as_uint(f); return (u + 0x7fffu + ((u >> 16) & 1u)) >> 16; }
__device__ __forceinline__ float bf2f(unsigned b) { return __uint_as_float(b << 16); }
typedef float f32x2_t __attribute__((ext_vector_type(2)));
typedef __bf16 bf16x2_t __attribute__((ext_vector_type(2)));
__device__ __forceinline__ unsigned pk2(float lo, float hi) { f32x2_t v = {lo, hi}; bf16x2_t b = __builtin_convertvector(v, bf16x2_t); return __builtin_bit_cast(unsigned, b); }
__device__ __forceinline__ float bflo(unsigned w) { return __uint_as_float(w << 16); }
__device__ __forceinline__ float bfhi(unsigned w) { return __uint_as_float(w & 0xffff0000u); }
__device__ __forceinline__ float silu_f(float v) { return v / (1.f + __expf(-v)); }
__device__ __forceinline__ float sigmoid_f(float v) { return 1.f / (1.f + __expf(-v)); }
__device__ __forceinline__ int bperm_i(int idx, int v) { return __builtin_amdgcn_ds_bpermute(idx << 2, v); }
__device__ __forceinline__ float sxor_f(float v, int lane, int m) { return __int_as_float(bperm_i(lane ^ m, __float_as_int(v))); }
__device__ __forceinline__ int sxor_i(int v, int lane, int m) { return bperm_i(lane ^ m, v); }
__device__ __forceinline__ float wave_sum(float v, int lane) {
#pragma unroll
    for (int o = 32; o >= 1; o >>= 1) v += sxor_f(v, lane, o);
    return v;
}
__device__ __forceinline__ int otid(int wid_s) { int l; asm volatile("v_mbcnt_lo_u32_b32 %0, -1, 0\n\tv_mbcnt_hi_u32_b32 %0, -1, %0" : "=v"(l)); return (wid_s << 6) | l; }
#define WAVE_SYNC() do { __builtin_amdgcn_fence(__ATOMIC_RELEASE, "wavefront"); __builtin_amdgcn_wave_barrier(); __builtin_amdgcn_fence(__ATOMIC_ACQUIRE, "wavefront"); } while (0)

__device__ __forceinline__ int l2orig(int l) {
    if (l < 1536) return l;
    if (l < 2048) return 2048 + (l - 1536);
    if (l < 2112) return 2560 + (l - 2048);
    if (l < 2624) return 2632 + (l - 2112);
    if (l < 2752) return 3400 + (l - 2624);
    if (l < 2880) return 3528 + (l - 2752);
    if (l < 3136) return 3656 + (l - 2880);
    if (l < 3648) return 1536 + (l - 3136);
    if (l < 3904) return 3144 + (l - 3648);
    if (l < 4160) return 3912 + (l - 3904);
    if (l < 4168) return 2624 + (l - 4160);
    if (l < 4184) return 4168 + (l - 4168);
    return -1;
}
__device__ __forceinline__ int npos2logical(int np) {
    const int hb = np & ~127, p = np & 127, wc = p >> 5, n = (p >> 4) & 1, fr = p & 15;
    return hb + (wc >> 1) * 64 + n * 32 + (wc & 1) * 16 + fr;
}

__device__ __forceinline__ void sincos_acc(float angf, float& c, float& s) {
    const double a = (double)angf;
    const double n = rint(a * 0.15915494309189535);
    double r = fma(-n, 6.283185307179586, a);
    r = fma(-n, 2.4492935982947064e-16, r);
    const double r2 = r * r;
    double ts = r, tc = 1.0, ss = r, cc = 1.0;
#pragma unroll
    for (int k = 1; k <= 14; ++k) {
        tc = -tc * r2 * (1.0 / (double)((2 * k - 1) * (2 * k)));
        ts = -ts * r2 * (1.0 / (double)((2 * k) * (2 * k + 1)));
        cc += tc; ss += ts;
    }
    c = (float)cc; s = (float)ss;
}

__device__ __forceinline__ void prologue(const Params& p, long gtid, long gthreads) {
    bf16_t* win = (bf16_t*)(p.ws + WS_WIN);
    for (long idx = gtid; idx < (long)DEPTH * 128 * NPAD; idx += gthreads) {
        const int np = (int)(idx % NPAD); const long r = idx / NPAD; const int kc = (int)(r % 128); const int l = (int)(r / 128);
        const int oc = l2orig(npos2logical(np));
        u32x4 w = {0u, 0u, 0u, 0u};
        if (oc >= 0) {
            const float* src = p.w_in + ((long)l * 1024 + kc * 8) * DIN + oc;
            float v[8];
#pragma unroll
            for (int i = 0; i < 8; ++i) v[i] = src[(long)i * DIN];
            w.x = pk2(v[0], v[1]); w.y = pk2(v[2], v[3]); w.z = pk2(v[4], v[5]); w.w = pk2(v[6], v[7]);
        }
        *(u32x4*)(win + ((long)l * NPAD + np) * 1024 + kc * 8) = w;
    }
    bf16_t* wout = (bf16_t*)(p.ws + WS_WOUT);
    for (long idx = gtid; idx < (long)DEPTH * 128 * 1024; idx += gthreads) {
        const int n = (int)(idx % 1024); const long r = idx / 1024; const int kc = (int)(r % 128); const int l = (int)(r / 128);
        const float* src = p.w_out + ((long)l * 1024 + kc * 8) * 1024 + n;
        float v[8];
#pragma unroll
        for (int i = 0; i < 8; ++i) v[i] = src[(long)i * 1024];
        u32x4 w; w.x = pk2(v[0], v[1]); w.y = pk2(v[2], v[3]); w.z = pk2(v[4], v[5]); w.w = pk2(v[6], v[7]);
        *(u32x4*)(wout + ((long)l * 1024 + n) * 1024 + kc * 8) = w;
    }
    bf16_t* pwt = (bf16_t*)(p.ws + WS_PWT);
    for (long idx = gtid; idx < (long)DEPTH * 32 * 256; idx += gthreads) {
        const int n = (int)(idx % 256); const long r = idx / 256; const int kc = (int)(r % 32); const int l = (int)(r / 32);
        const float* src = p.pw_w + ((long)l * 256 + kc * 8) * 256 + n;
        float v[8];
#pragma unroll
        for (int i = 0; i < 8; ++i) v[i] = src[(long)i * 256];
        u32x4 w; w.x = pk2(v[0], v[1]); w.y = pk2(v[2], v[3]); w.z = pk2(v[4], v[5]); w.w = pk2(v[6], v[7]);
        *(u32x4*)(pwt + ((long)l * 256 + n) * 256 + kc * 8) = w;
    }
    float2* rope = (float2*)(p.ws + WS_ROPE);
    for (long idx = gtid; idx < (long)NTOK * 32; idx += gthreads) {
        const int j = (int)(idx & 31); const long tok = idx >> 5;
        const float ang = (float)p.pos[tok] * p.inv_freq[j];
        float c, s; sincos_acc(ang, c, s);
        rope[idx] = make_float2(c, s);
    }
    if (gtid < 128) { ((unsigned*)(p.ws + WS_KMAX))[gtid] = 0u; ((unsigned*)(p.ws + WS_PCNT))[gtid * 16] = 0u; ((unsigned*)(p.ws + WS_LCNT))[gtid * 16] = 0u; }
    bf16_t* xb = (bf16_t*)(p.ws + WS_XB);
    for (long idx = gtid; idx < (long)NTOK * 128; idx += gthreads) {
        const f32x4 a = *(const f32x4*)(p.x + idx * 8), b = *(const f32x4*)(p.x + idx * 8 + 4);
        u32x4 w; w.x = pk2(a[0], a[1]); w.y = pk2(a[2], a[3]); w.z = pk2(b[0], b[1]); w.w = pk2(b[2], b[3]);
        *(u32x4*)(xb + idx * 8) = w;
    }
}

constexpr int BM = 256, BK = 64, HALF = 128, HT = HALF * BK;
__device__ __forceinline__ int lds_byte(int r, int c) {
    int st = (r >> 4) * 2 + (c >> 5), rr = r & 15, cc = c & 31, ob = rr * 64 + cc * 2;
    return st * 1024 + (ob ^ (((ob >> 9) & 1) << 5));
}
__device__ __forceinline__ void stage_rc(int b, int& R, int& C) {
    int st = b / 1024, sb = b % 1024, swz = sb ^ (((sb >> 9) & 1) << 5);
    R = (st >> 1) * 16 + swz / 64; C = (st & 1) * 32 + (swz % 64) / 2;
}
__device__ __forceinline__ void tile_of(int L, int nM, int nN, int& pm, int& pn) {
    const int nwg = nM * nN; int wgid = L;
    { const int q = nwg / 8, r = nwg % 8, xcd = wgid % 8, off = wgid / 8; wgid = (xcd < r ? xcd * (q + 1) : r * (q + 1) + (xcd - r) * q) + off; }
    const int nig = 8 * nN, gid = wgid / nig, fm = gid * 8, gsz = (nM - fm) < 8 ? (nM - fm) : 8;
    pm = fm + ((wgid % nig) % gsz); pn = (wgid % nig) / gsz;
}

#define LAS __attribute__((address_space(3)))
template <class Epi>
__device__ __forceinline__ void gemm_tile(LAS unsigned char* lds, const bf16_t* A, int lda, const bf16_t* Bt, int K, int pm, int pn, const Epi& epi, int wid_s) {
    const int tid = otid(wid_s), wid = __builtin_amdgcn_readfirstlane(tid >> 6), lane = tid & 63, wr = wid >> 2, wc = wid & 3, fr = lane & 15, fq = lane >> 4;
    const int nt = K / BK;
    unsigned voffA[2], voffB[2];
#pragma unroll
    for (int i = 0; i < 2; ++i) { int R, C; stage_rc(tid * 16 + i * 8192, R, C); voffA[i] = (unsigned)(R * lda + C) * 2u; voffB[i] = (unsigned)(R * K + C) * 2u; }
    const size_t kstep = (size_t)(BK * 2), hstepA = (size_t)HALF * lda * 2, hstepB = (size_t)HALF * K * 2;
    const unsigned ldsw = (unsigned)wid * 1024u;
    const int aoff = lds_byte(wr * 64 + fr, fq * 8), boff = lds_byte(wc * 32 + fr, fq * 8);
    const char* cA = (const char*)A + (size_t)pm * 2 * hstepA; const char* cB = (const char*)Bt + (size_t)pn * 2 * hstepB;
#define HTB (HALF * BK * 2)
#define SA(b, h) (((b) * 2 + (h)) * HTB)
#define SB(b, h) ((4 + (b) * 2 + (h)) * HTB)
#define STAGE(bufoff, gbase, voff) do { _Pragma("unroll") for (int _i = 0; _i < 2; ++_i) \
        __builtin_amdgcn_global_load_lds((const unsigned*)((const char*)(gbase) + (voff)[_i]), (LAS unsigned*)(lds + (bufoff) + ldsw + _i * 8192), 16, 0, 0); } while (0)
#define LDA(dst, b, h) do { _Pragma("unroll") for (int m = 0; m < 4; ++m) _Pragma("unroll") for (int k = 0; k < 2; ++k) dst[m][k] = *(const LAS bf16x8*)(lds + SA(b, h) + aoff + m * 2048 + k * 1024); } while (0)
#define LDB(dst, b, h) do { _Pragma("unroll") for (int n = 0; n < 2; ++n) _Pragma("unroll") for (int k = 0; k < 2; ++k) dst[n][k] = *(const LAS bf16x8*)(lds + SB(b, h) + boff + n * 2048 + k * 1024); } while (0)
#define MMA(ai, bj, At_, Bt_) do { __builtin_amdgcn_s_setprio(1); _Pragma("unroll") for (int m = 0; m < 4; ++m) _Pragma("unroll") for (int n = 0; n < 2; ++n) _Pragma("unroll") for (int k = 0; k < 2; ++k) \
        acc[ai][bj][m][n] = __builtin_amdgcn_mfma_f32_16x16x32_bf16(Bt_[n][k], At_[m][k], acc[ai][bj][m][n], 0, 0, 0); __builtin_amdgcn_s_setprio(0); } while (0)
#define WAIT_V(n) asm volatile("s_waitcnt vmcnt(" #n ")" ::: "memory")
#define WAIT_L(n) asm volatile("s_waitcnt lgkmcnt(" #n ")" ::: "memory")
#define BAR __builtin_amdgcn_s_barrier()
#define SCHED __builtin_amdgcn_sched_barrier(0)
    f32x4 acc[2][2][4][2];
#pragma unroll
    for (int a = 0; a < 2; ++a)
#pragma unroll
        for (int b = 0; b < 2; ++b)
#pragma unroll
            for (int m = 0; m < 4; ++m)
#pragma unroll
                for (int n = 0; n < 2; ++n) acc[a][b][m][n] = (f32x4){0.f, 0.f, 0.f, 0.f};
    bf16x8 At[4][2], B0[2][2], B1[2][2];
    STAGE(SB(0, 0), cB, voffB); STAGE(SA(0, 0), cA, voffA); STAGE(SB(0, 1), cB + hstepB, voffB); STAGE(SA(0, 1), cA + hstepA, voffA);
    if (wr == 1) BAR;
    WAIT_V(4); BAR;
    STAGE(SB(1, 0), cB + kstep, voffB); STAGE(SA(1, 0), cA + kstep, voffA); STAGE(SB(1, 1), cB + hstepB + kstep, voffB);
    WAIT_V(6); BAR;
    for (int t = 0; t < nt - 2; t += 2) {
        const char* a1 = cA + (size_t)(t + 1) * kstep; const char* a2 = cA + (size_t)(t + 2) * kstep; const char* b2 = cB + (size_t)(t + 2) * kstep;
        const char* a3 = a2 + kstep; const char* b3 = b2 + kstep;
        LDB(B0, 0, 0); SCHED; LDA(At, 0, 0); STAGE(SA(1, 1), a1 + hstepA, voffA);
        WAIT_L(8); BAR; WAIT_L(0); MMA(0, 0, At, B0); BAR; SCHED;
        LDB(B1, 0, 1); STAGE(SB(0, 0), b2, voffB);
        BAR; WAIT_L(0); MMA(0, 1, At, B1); BAR;
        LDA(At, 0, 1); STAGE(SA(0, 0), a2, voffA);
        BAR; WAIT_L(0); MMA(1, 0, At, B0); BAR; SCHED;
        STAGE(SB(0, 1), b2 + hstepB, voffB);
        WAIT_V(6); BAR; MMA(1, 1, At, B1); BAR;
        LDB(B0, 1, 0); SCHED; LDA(At, 1, 0); STAGE(SA(0, 1), a2 + hstepA, voffA);
        WAIT_L(8); BAR; WAIT_L(0); MMA(0, 0, At, B0); BAR; SCHED;
        LDB(B1, 1, 1); STAGE(SB(1, 0), b3, voffB);
        BAR; WAIT_L(0); MMA(0, 1, At, B1); BAR;
        LDA(At, 1, 1); STAGE(SA(1, 0), a3, voffA);
        BAR; WAIT_L(0); MMA(1, 0, At, B0); BAR; SCHED;
        STAGE(SB(1, 1), b3 + hstepB, voffB);
        WAIT_V(6); BAR; MMA(1, 1, At, B1); BAR;
    }
    { const char* a1 = cA + (size_t)(nt - 1) * kstep;
      LDB(B0, 0, 0); LDA(At, 0, 0); STAGE(SA(1, 1), a1 + hstepA, voffA);
      BAR; WAIT_L(0); MMA(0, 0, At, B0); BAR;
      LDB(B1, 0, 1); BAR; WAIT_L(0); MMA(0, 1, At, B1); BAR;
      LDA(At, 0, 1); WAIT_V(4); BAR; WAIT_L(0); MMA(1, 0, At, B0); MMA(1, 1, At, B1); BAR; }
    { LDB(B0, 1, 0); LDA(At, 1, 0); WAIT_V(2); BAR; WAIT_L(0); MMA(0, 0, At, B0); BAR;
      LDB(B1, 1, 1); WAIT_V(0); BAR; WAIT_L(0); MMA(0, 1, At, B1); BAR;
      LDA(At, 1, 1); BAR; WAIT_L(0); MMA(1, 0, At, B0); MMA(1, 1, At, B1); BAR; }
    if (wr == 0) BAR;
    epi(acc, pm * BM, pn * BM, wr, wc, fr, fq);
#undef SA
#undef SB
#undef STAGE
#undef LDA
#undef LDB
#undef MMA
}

struct EpiIn {
    bf16_t* H; float* side; const float* rope; bf16_t* VT; bf16_t* KF; unsigned* kmax; bool dry;
    __device__ __forceinline__ void operator()(f32x4 (&acc)[2][2][4][2], int brow, int bcol, int wr, int wc, int fr, int fq) const {
#pragma unroll
        for (int bj = 0; bj < 2; ++bj) {
            const int hb = bcol + bj * HALF;
            if (hb >= 4224 || dry) continue;
            const int gbase = hb + (wc >> 1) * 64, g64 = gbase >> 6, d0 = (wc & 1) * 16 + 4 * fq;
            const bool rp = (g64 < 16) || (g64 >= 24 && g64 <= 32);
            const float qs = (g64 < 8) ? QSCALE : 1.f;
            float kabs = 0.f;
#pragma unroll
            for (int ai = 0; ai < 2; ++ai)
#pragma unroll
                for (int m = 0; m < 4; ++m) {
                    const long row = brow + ai * HALF + wr * 64 + m * 16 + fr;
                    f32x4 o1 = acc[ai][bj][m][0], o2 = acc[ai][bj][m][1];
                    if (rp) {
                        const f32x4 c0 = *(const f32x4*)(rope + (row * 32 + d0) * 2), c1 = *(const f32x4*)(rope + (row * 32 + d0) * 2 + 4);
                        const f32x4 x1 = o1, x2 = o2;
                        o1[0] = (x1[0] * c0[0] - x2[0] * c0[1]) * qs; o2[0] = (x2[0] * c0[0] + x1[0] * c0[1]) * qs;
                        o1[1] = (x1[1] * c0[2] - x2[1] * c0[3]) * qs; o2[1] = (x2[1] * c0[2] + x1[1] * c0[3]) * qs;
                        o1[2] = (x1[2] * c1[0] - x2[2] * c1[1]) * qs; o2[2] = (x2[2] * c1[0] + x1[2] * c1[1]) * qs;
                        o1[3] = (x1[3] * c1[2] - x2[3] * c1[3]) * qs; o2[3] = (x2[3] * c1[2] + x1[3] * c1[3]) * qs;
                    }
                    if (g64 >= 8 && g64 < 24) {
                        const int bb = (int)(row >> 13), tt = (int)(row & (T - 1)), tile = tt >> 5, tk = tt & 31;
                        if (g64 < 16) {
                            kabs = fmaxf(kabs, fmaxf(fmaxf(fabsf(o1[0]), fabsf(o1[1])), fmaxf(fabsf(o1[2]), fabsf(o1[3]))));
                            kabs = fmaxf(kabs, fmaxf(fmaxf(fabsf(o2[0]), fabsf(o2[1])), fmaxf(fabsf(o2[2]), fabsf(o2[3]))));
                            const long base = ((long)(bb * 8 + (g64 - 8)) * 256 + tile) * 4;
                            const int ks = d0 >> 4, hk = (d0 >> 3) & 1, j0 = d0 & 7;
                            u32x2 w1, w2; w1.x = pk2(o1[0], o1[1]); w1.y = pk2(o1[2], o1[3]); w2.x = pk2(o2[0], o2[1]); w2.y = pk2(o2[2], o2[3]);
                            const auto sx = __builtin_amdgcn_permlane16_swap(w1.x, w2.x, false, false), sy = __builtin_amdgcn_permlane16_swap(w1.y, w2.y, false, false);
                            u32x4 wv; long slot;
                            if (fq & 1) { wv.x = sx[0]; wv.y = sy[0]; wv.z = w2.x; wv.w = w2.y; slot = (base + ks + 2) * 64 + hk * 32 + tk; }
                            else { wv.x = w1.x; wv.y = w1.y; wv.z = sx[1]; wv.w = sy[1]; slot = (base + ks) * 64 + hk * 32 + tk; }
                            *(u32x4*)(KF + slot * 8) = wv;
                        } else {
                            const int s = tk >> 4, u = tk & 15, hv = (u >> 2) & 1, jv = (u >> 3) * 4 + (u & 3);
                            const long base = (((long)(bb * 8 + (g64 - 16)) * 256 + tile) * 2) * 2 + s;
                            bf16_t* v0 = VT + ((base) * 64 + hv * 32 + d0) * 8 + jv;
                            bf16_t* v1 = VT + ((base + 2) * 64 + hv * 32 + d0) * 8 + jv;
#pragma unroll
                            for (int j = 0; j < 4; ++j) { v0[j * 8] = (bf16_t)f2bf(o1[j]); v1[j * 8] = (bf16_t)f2bf(o2[j]); }
                        }
                    } else if (gbase < 4160) {
                        bf16_t* hp = H + row * HP + gbase + d0;
                        u32x2 w1, w2; w1.x = pk2(o1[0], o1[1]); w1.y = pk2(o1[2], o1[3]); w2.x = pk2(o2[0], o2[1]); w2.y = pk2(o2[2], o2[3]);
                        const auto sx = __builtin_amdgcn_permlane16_swap(w1.x, w2.x, false, false), sy = __builtin_amdgcn_permlane16_swap(w1.y, w2.y, false, false);
                        u32x4 wv;
                        if (fq & 1) { wv.x = sx[0]; wv.y = sy[0]; wv.z = w2.x; wv.w = w2.y; hp += 32 - 4; }
                        else { wv.x = w1.x; wv.y = w1.y; wv.z = sx[1]; wv.w = sy[1]; }
                        *(u32x4*)hp = wv;
                    } else if (d0 < 8) { *(f32x4*)(side + row * 24 + d0) = o1 * WI_SCALE; }
                    else if (d0 < 24) { *(f32x4*)(side + row * 24 + d0) = o1; }
                }
            if (g64 >= 8 && g64 < 16) {
#pragma unroll
                for (int o = 32; o >= 1; o >>= 1) kabs = fmaxf(kabs, sxor_f(kabs, fq * 16 + fr, o));
                if ((threadIdx.x & 63) == 0) atomicMax(kmax + (brow >> 13) * 8 + (g64 - 8), __float_as_uint(kabs));
            }
        }
    }
};
struct EpiOut {
    const float* xres; float* out; bool dry;
    __device__ __forceinline__ void operator()(f32x4 (&acc)[2][2][4][2], int brow, int bcol, int wr, int wc, int fr, int fq) const {
#pragma unroll
        for (int ai = 0; ai < 2; ++ai)
#pragma unroll
            for (int m = 0; m < 4; ++m)
#pragma unroll
                for (int bj = 0; bj < 2; ++bj)
#pragma unroll
                    for (int n = 0; n < 2; ++n) {
                        const long idx = (long)(brow + ai * HALF + wr * 64 + m * 16 + fr) * DM + (bcol + bj * HALF + wc * 32 + n * 16 + 4 * fq);
                        const f32x4 xr = *(const f32x4*)(xres + idx);
                        if (!dry) *(f32x4*)(out + idx) = xr * ALPHA + acc[ai][bj][m][n];
                    }
    }
};

__device__ __forceinline__ void ln_phase(const Params& p, int layer, int row_begin, int row_end, int row_step, int lane, bool dry) {
    bf16_t* xb = (bf16_t*)(p.ws + WS_XB);
    const float* g = p.ln_g + layer * DM; const float* bb = p.ln_b + layer * DM;
    for (int row = row_begin; row < row_end; row += row_step) {
        float* zr = p.out + (long)row * DM;
        f32x4 v[4]; float s = 0.f;
#pragma unroll
        for (int r = 0; r < 4; ++r) { v[r] = *(const f32x4*)(zr + r * 256 + lane * 4); s += v[r][0] + v[r][1] + v[r][2] + v[r][3]; }
        const float mu = wave_sum(s, lane) * (1.f / DM);
        float q = 0.f;
#pragma unroll
        for (int r = 0; r < 4; ++r)
#pragma unroll
            for (int e = 0; e < 4; ++e) { const float d = v[r][e] - mu; q += d * d; }
        const float rstd = rsqrtf(wave_sum(q, lane) * (1.f / DM) + EPS);
#pragma unroll
        for (int r = 0; r < 4; ++r) {
            const f32x4 gg = *(const f32x4*)(g + r * 256 + lane * 4), bv = *(const f32x4*)(bb + r * 256 + lane * 4);
            f32x4 y;
#pragma unroll
            for (int e = 0; e < 4; ++e) y[e] = (v[r][e] - mu) * rstd * gg[e] + bv[e];
            if (dry) continue;
            *(f32x4*)(zr + r * 256 + lane * 4) = y;
            u32x2 w; w.x = pk2(y[0], y[1]); w.y = pk2(y[2], y[3]);
            *(u32x2*)(xb + (long)row * DM + r * 256 + lane * 4) = w;
        }
    }
}

__device__ __forceinline__ void conformer_tile(const Params& p, int layer, unsigned char* lds, int tile, bool dry, int wid_s) {
    bf16_t* H = (bf16_t*)(p.ws + WS_H);
    const int tid = otid(wid_s), lane = tid & 63, w = tid >> 6;
    const int tok0 = tile * 64, b = tok0 / T, tl0 = tok0 % T;
    bf16_t* hg = (bf16_t*)lds;
    float* cv = (float*)(lds + 49152);
    for (int idx = tid; idx < 94 * 32; idx += 512) {
        const int r = idx >> 5, cc = (idx & 31) * 8, tl = tl0 - 30 + r;
        u32x4 o = {0u, 0u, 0u, 0u};
        if (tl >= 0) {
            const bf16_t* src = H + ((long)b * T + tl) * HP + HGLU + cc;
            const u32x4 va = *(const u32x4*)src, ga = *(const u32x4*)(src + 256);
            o.x = pk2(bflo(va.x) * sigmoid_f(bflo(ga.x)), bfhi(va.x) * sigmoid_f(bfhi(ga.x)));
            o.y = pk2(bflo(va.y) * sigmoid_f(bflo(ga.y)), bfhi(va.y) * sigmoid_f(bfhi(ga.y)));
            o.z = pk2(bflo(va.z) * sigmoid_f(bflo(ga.z)), bfhi(va.z) * sigmoid_f(bfhi(ga.z)));
            o.w = pk2(bflo(va.w) * sigmoid_f(bflo(ga.w)), bfhi(va.w) * sigmoid_f(bfhi(ga.w)));
        }
        *(u32x4*)(hg + r * 256 + cc) = o;
    }
    __syncthreads();
    {
        const int c = tid & 255, half = tid >> 8;
        const float* cw = p.conv_w + (long)layer * 31 * 256 + c;
        float wj[31];
#pragma unroll
        for (int j = 0; j < 31; ++j) wj[j] = cw[j * 256];
        const float cb = p.conv_b[layer * 256 + c];
        float win[62];
#pragma unroll
        for (int r = 0; r < 62; ++r) win[r] = bf2f(hg[(half * 32 + r) * 256 + c]);
#pragma unroll
        for (int tt = 0; tt < 32; ++tt) {
            float a = cb;
#pragma unroll
            for (int j = 0; j < 31; ++j) a = fmaf(win[tt + j], wj[j], a);
            cv[(half * 32 + tt) * 256 + c] = a;
        }
    }
    __syncthreads();
    bf16_t* at = (bf16_t*)lds;
    {
        const f32x4 gg = *(const f32x4*)(p.cln_g + layer * 256 + lane * 4), bv = *(const f32x4*)(p.cln_b + layer * 256 + lane * 4);
#pragma unroll
        for (int tt = 0; tt < 8; ++tt) {
            const int t = w * 8 + tt;
            const f32x4 v = *(const f32x4*)(cv + t * 256 + lane * 4);
            const float mu = wave_sum(v[0] + v[1] + v[2] + v[3], lane) * (1.f / 256.f);
            float q = 0.f;
#pragma unroll
            for (int e = 0; e < 4; ++e) { const float d = v[e] - mu; q += d * d; }
            const float rstd = rsqrtf(wave_sum(q, lane) * (1.f / 256.f) + EPS);
            float y[4];
#pragma unroll
            for (int e = 0; e < 4; ++e) y[e] = silu_f((v[e] - mu) * rstd * gg[e] + bv[e]);
            u32x2 o; o.x = pk2(y[0], y[1]); o.y = pk2(y[2], y[3]);
            *(u32x2*)(at + t * 264 + lane * 4) = o;
        }
    }
    __syncthreads();
    {
        f32x16 acc0 = {}, acc1 = {};
        const bf16_t* pwt = (const bf16_t*)(p.ws + WS_PWT) + (long)layer * 65536 + (w * 32 + (lane & 31)) * 256 + 8 * (lane >> 5);
        const bf16_t* ap = at + (lane & 31) * 264 + 8 * (lane >> 5);
#pragma unroll 4
        for (int ks = 0; ks < 16; ++ks) {
            const bf16x8 bfr = *(const bf16x8*)(pwt + ks * 16);
            const bf16x8 a0 = *(const bf16x8*)(ap + ks * 16), a1 = *(const bf16x8*)(ap + 32 * 264 + ks * 16);
            acc0 = __builtin_amdgcn_mfma_f32_32x32x16_bf16(a0, bfr, acc0, 0, 0, 0);
            acc1 = __builtin_amdgcn_mfma_f32_32x32x16_bf16(a1, bfr, acc1, 0, 0, 0);
        }
        const int ch = w * 32 + (lane & 31);
        const float pb = p.pw_b[layer * 256 + ch];
#pragma unroll
        for (int i = 0; i < 16; ++i) {
            const int row = (i & 3) + 8 * (i >> 2) + 4 * (lane >> 5);
            bf16_t* g0 = H + (long)(tok0 + row) * HP + HBG + ch;
            bf16_t* g1 = H + (long)(tok0 + 32 + row) * HP + HBG + ch;
            const unsigned r0 = f2bf((acc0[i] + pb) * silu_f(bf2f(*g0))), r1 = f2bf((acc1[i] + pb) * silu_f(bf2f(*g1)));
            if (!dry) { *g0 = (bf16_t)r0; *g1 = (bf16_t)r1; }
        }
    }
    __syncthreads();
}

__device__ __forceinline__ float rdlane(float v, int l) { return __uint_as_float(__builtin_amdgcn_readlane(__float_as_uint(v), l)); }

__device__ __forceinline__ void gla_local_item(const Params& p, int layer, int item_, int lane, bool dry) {
    const int item = __builtin_amdgcn_readfirstlane(item_);
    bf16_t* H = (bf16_t*)(p.ws + WS_H);
    const float* side = (const float*)(p.ws + WS_SIDE);
    float* bcum = (float*)(p.ws + WS_BCUM); float* U = (float*)(p.ws + WS_U); float* DEC = (float*)(p.ws + WS_DEC);
    const int bh = item >> 7, c = item & 127, b = bh >> 2, h = bh & 3;
    const long tok0 = (long)b * T + c * 64, tok = tok0 + lane;
    float clr[16];
#pragma unroll
    for (int r = 0; r < 4; ++r) { const f32x4 v = *(const f32x4*)(side + tok * 24 + 8 + r * 4); clr[r * 4] = v[0]; clr[r * 4 + 1] = v[1]; clr[r * 4 + 2] = v[2]; clr[r * 4 + 3] = v[3]; }
    const float* gw = p.gate_w2 + (long)layer * 16 * 128 + h * 32; const float* gb = p.gate_b + layer * 128 + h * 32;
    float* bcp = bcum + tok * 128 + h * 32;
#pragma unroll 1
    for (int d = 0; d < 32; ++d) {
        float z = gb[d];
#pragma unroll
        for (int r = 0; r < 16; ++r) z = fmaf(clr[r], gw[r * 128 + d], z);
        float g = (fminf(z, 0.f) - __logf(1.f + __expf(-fabsf(z)))) * (1.f / 16.f);
#pragma unroll
        for (int o = 1; o < 64; o <<= 1) { const float up = __int_as_float(bperm_i((lane - o) & 63, __float_as_int(g))); if (lane >= o) g += up; }
        bcp[d] = g;
    }
    float bc[32];
#pragma unroll
    for (int r = 0; r < 8; ++r) { const f32x4 v = *(const f32x4*)(bcp + r * 4); bc[r * 4] = v[0]; bc[r * 4 + 1] = v[1]; bc[r * 4 + 2] = v[2]; bc[r * 4 + 3] = v[3]; }
    float kk[32];
    {
        const bf16_t* kp = H + tok * HP + HCK + h * 32;
#pragma unroll
        for (int r = 0; r < 4; ++r) {
            const u32x4 kv = *(const u32x4*)(kp + r * 8);
            kk[r * 8 + 0] = bflo(kv.x); kk[r * 8 + 1] = bfhi(kv.x); kk[r * 8 + 2] = bflo(kv.y); kk[r * 8 + 3] = bfhi(kv.y);
            kk[r * 8 + 4] = bflo(kv.z); kk[r * 8 + 5] = bfhi(kv.z); kk[r * 8 + 6] = bflo(kv.w); kk[r * 8 + 7] = bfhi(kv.w);
        }
#pragma unroll
        for (int d = 0; d < 32; ++d) { const float bl = rdlane(bc[d], 63); kk[d] *= __expf(bl - bc[d]); }
    }
    float acc[32];
#pragma unroll
    for (int d = 0; d < 32; ++d) acc[d] = 0.f;
    const bf16_t* vp = H + tok0 * HP + HCV + h * 64 + lane;
#pragma unroll 1
    for (int t8 = 0; t8 < 64; t8 += 8) {
        float vv[8];
#pragma unroll
        for (int u = 0; u < 8; ++u) vv[u] = bf2f(vp[(long)(t8 + u) * HP]);
#pragma unroll
        for (int u = 0; u < 8; ++u)
#pragma unroll
            for (int d = 0; d < 32; ++d) acc[d] = fmaf(rdlane(kk[d], t8 + u), vv[u], acc[d]);
    }
#pragma unroll
    for (int d = 0; d < 32; ++d) if (!dry) U[(long)item * 2048 + d * 64 + lane] = acc[d];
    if (lane == 63) {
#pragma unroll
        for (int r = 0; r < 8; ++r) { f32x4 v = {__expf(bc[r * 4]), __expf(bc[r * 4 + 1]), __expf(bc[r * 4 + 2]), __expf(bc[r * 4 + 3])}; *(f32x4*)(DEC + item * 32 + r * 4) = v; }
    }
}

__device__ __forceinline__ void gla_scan(const Params& p, int gt) {
    float* U = (float*)(p.ws + WS_U); const float* DEC = (const float*)(p.ws + WS_DEC);
    const int bh = gt >> 11, de = gt & 2047, d = de >> 6;
    float s = 0.f;
    for (int c0 = 0; c0 < 128; c0 += 32) {
        float u[32], dc[32];
#pragma unroll
        for (int i = 0; i < 32; ++i) { u[i] = U[(long)(bh * 128 + c0 + i) * 2048 + de]; dc[i] = DEC[(bh * 128 + c0 + i) * 32 + d]; }
#pragma unroll
        for (int i = 0; i < 32; ++i) { U[(long)(bh * 128 + c0 + i) * 2048 + de] = s; s = fmaf(dc[i], s, u[i]); }
    }
}

__device__ __forceinline__ void gla_out_item(const Params& p, int layer, unsigned char* ldsw, int item_, int lane, bool dry) {
    const int item = __builtin_amdgcn_readfirstlane(item_);
    bf16_t* H = (bf16_t*)(p.ws + WS_H);
    const float* bcum = (const float*)(p.ws + WS_BCUM); const float* U = (const float*)(p.ws + WS_U);
    float* sA = (float*)ldsw; bf16_t* sV = (bf16_t*)(ldsw + 8192);
    const int bh = item >> 7, c = item & 127, b = bh >> 2, h = bh & 3;
    const long tok = (long)b * T + c * 64 + lane;
#pragma unroll
    for (int r = 0; r < 8; ++r) *(f32x4*)(sA + r * 256 + lane * 4) = *(const f32x4*)(U + (long)item * 2048 + r * 256 + lane * 4);
#pragma unroll
    for (int r = 0; r < 8; ++r) *(u32x4*)(sV + lane * 64 + r * 8) = *(const u32x4*)(H + tok * HP + HCV + h * 64 + r * 8);
    WAVE_SYNC();
    float o[64];
#pragma unroll
    for (int e = 0; e < 64; ++e) o[e] = 0.f;
    {
        const bf16_t* qp = H + tok * HP + HCQ + h * 32; const float* bp = bcum + tok * 128 + h * 32;
#pragma unroll 1
        for (int d = 0; d < 32; ++d) {
            const float qd = bf2f(qp[d]) * 0.17677669529663687f * __expf(bp[d]);
#pragma unroll
            for (int e4 = 0; e4 < 16; ++e4) {
                const f32x4 s4 = *(const f32x4*)(sA + d * 64 + e4 * 4);
                o[e4 * 4] = fmaf(qd, s4[0], o[e4 * 4]); o[e4 * 4 + 1] = fmaf(qd, s4[1], o[e4 * 4 + 1]);
                o[e4 * 4 + 2] = fmaf(qd, s4[2], o[e4 * 4 + 2]); o[e4 * 4 + 3] = fmaf(qd, s4[3], o[e4 * 4 + 3]);
            }
        }
    }
    WAVE_SYNC();
    {
        const bf16_t* kp = H + tok * HP + HCK + h * 32;
#pragma unroll
        for (int r = 0; r < 4; ++r) {
            const u32x4 kv = *(const u32x4*)(kp + r * 8);
            const f32x4 b0 = *(const f32x4*)(bcum + tok * 128 + h * 32 + r * 8), b1 = *(const f32x4*)(bcum + tok * 128 + h * 32 + r * 8 + 4);
            f32x4 k0 = {bflo(kv.x) * __expf(-b0[0]), bfhi(kv.x) * __expf(-b0[1]), bflo(kv.y) * __expf(-b0[2]), bfhi(kv.y) * __expf(-b0[3])};
            f32x4 k1 = {bflo(kv.z) * __expf(-b1[0]), bfhi(kv.z) * __expf(-b1[1]), bflo(kv.w) * __expf(-b1[2]), bfhi(kv.w) * __expf(-b1[3])};
            *(f32x4*)(sA + lane * 32 + r * 8) = k0; *(f32x4*)(sA + lane * 32 + r * 8 + 4) = k1;
        }
    }
    float qe[32];
    {
        const bf16_t* qp = H + tok * HP + HCQ + h * 32;
#pragma unroll
        for (int r = 0; r < 4; ++r) {
            const u32x4 qv = *(const u32x4*)(qp + r * 8);
            const f32x4 b0 = *(const f32x4*)(bcum + tok * 128 + h * 32 + r * 8), b1 = *(const f32x4*)(bcum + tok * 128 + h * 32 + r * 8 + 4);
            const float qq[8] = {bflo(qv.x), bfhi(qv.x), bflo(qv.y), bfhi(qv.y), bflo(qv.z), bfhi(qv.z), bflo(qv.w), bfhi(qv.w)};
            const float bb[8] = {b0[0], b0[1], b0[2], b0[3], b1[0], b1[1], b1[2], b1[3]};
#pragma unroll
            for (int e = 0; e < 8; ++e) qe[r * 8 + e] = qq[e] * 0.17677669529663687f * __expf(bb[e]);
        }
    }
    WAVE_SYNC();
#pragma unroll 1
    for (int j = 0; j < 64; ++j) {
        float a = 0.f;
#pragma unroll
        for (int d4 = 0; d4 < 8; ++d4) {
            const f32x4 k4 = *(const f32x4*)(sA + j * 32 + d4 * 4);
            a = fmaf(qe[d4 * 4], k4[0], a); a = fmaf(qe[d4 * 4 + 1], k4[1], a); a = fmaf(qe[d4 * 4 + 2], k4[2], a); a = fmaf(qe[d4 * 4 + 3], k4[3], a);
        }
        if (j > lane) a = 0.f;
#pragma unroll
        for (int e8 = 0; e8 < 8; ++e8) {
            const u32x4 v8 = *(const u32x4*)(sV + j * 64 + e8 * 8);
            o[e8 * 8 + 0] = fmaf(a, bflo(v8.x), o[e8 * 8 + 0]); o[e8 * 8 + 1] = fmaf(a, bfhi(v8.x), o[e8 * 8 + 1]);
            o[e8 * 8 + 2] = fmaf(a, bflo(v8.y), o[e8 * 8 + 2]); o[e8 * 8 + 3] = fmaf(a, bfhi(v8.y), o[e8 * 8 + 3]);
            o[e8 * 8 + 4] = fmaf(a, bflo(v8.z), o[e8 * 8 + 4]); o[e8 * 8 + 5] = fmaf(a, bfhi(v8.z), o[e8 * 8 + 5]);
            o[e8 * 8 + 6] = fmaf(a, bflo(v8.w), o[e8 * 8 + 6]); o[e8 * 8 + 7] = fmaf(a, bfhi(v8.w), o[e8 * 8 + 7]);
        }
    }
    float ss = 0.f;
#pragma unroll
    for (int e = 0; e < 64; ++e) ss = fmaf(o[e], o[e], ss);
    const float rms = rsqrtf(ss * (1.f / 64.f) + EPS);
    const float* gn = p.gnorm_g + layer * 256 + h * 64;
    bf16_t* cg_p = H + tok * HP + HCG + h * 64;
#pragma unroll
    for (int r = 0; r < 8; ++r) {
        const u32x4 gv = *(const u32x4*)(cg_p + r * 8);
        const float gq[8] = {bflo(gv.x), bfhi(gv.x), bflo(gv.y), bfhi(gv.y), bflo(gv.z), bfhi(gv.z), bflo(gv.w), bfhi(gv.w)};
        float y[8];
#pragma unroll
        for (int e = 0; e < 8; ++e) y[e] = o[r * 8 + e] * rms * gn[r * 8 + e] * silu_f(gq[e]);
        u32x4 w; w.x = pk2(y[0], y[1]); w.y = pk2(y[2], y[3]); w.z = pk2(y[4], y[5]); w.w = pk2(y[6], y[7]);
        if (!dry) *(u32x4*)(cg_p + r * 8) = w;
    }
    WAVE_SYNC();
}

constexpr int MPITCH = 260;
constexpr int HPITCH = 516;
constexpr int L_HIST = 0;
constexpr int L_CAND = 66560;
constexpr int L_CCNT = L_CAND + 65536;
constexpr int L_QINF = L_CCNT + 2048;
constexpr int L_MTAB = L_QINF + 1024 + 64;
static_assert(L_MTAB + 8192 <= LDS_BYTES, "dsa lds");
__device__ __forceinline__ int mpos(int rr) { return 16 * ((rr >> 2) & 1) + (rr & 3) + 4 * (rr >> 3); }
constexpr int SUBCAP = 32;

__device__ __forceinline__ unsigned mono_bits(float f) { const unsigned u = __float_as_uint(f); return u ^ ((u >> 31) ? 0xffffffffu : 0x80000000u); }
__device__ __forceinline__ void idx_loadk(const bf16_t* Hb, int s0, int lane, bf16x8 (&kf)[2][2]) {
    const bf16_t* kp = Hb + (long)(s0 + (lane & 15)) * HP + HKI + 8 * (lane >> 4);
#pragma unroll
    for (int kb = 0; kb < 2; ++kb)
#pragma unroll
        for (int ks = 0; ks < 2; ++ks) kf[kb][ks] = *(const bf16x8*)(kp + (long)kb * 16 * HP + ks * 32);
}
__device__ __forceinline__ void idx_scores(const bf16x8 (&kf)[2][2], const bf16x8 (&qf)[8][2], const bf16x8 (&ql)[2][2], const float (&wh)[8], float (&score)[8]) {
    f32x4 lin[2];
#pragma unroll
    for (int kb = 0; kb < 2; ++kb) {
        lin[kb] = (f32x4){0.f, 0.f, 0.f, 0.f};
#pragma unroll
        for (int ks = 0; ks < 2; ++ks) {
            lin[kb] = __builtin_amdgcn_mfma_f32_16x16x32_bf16(kf[kb][ks], ql[0][ks], lin[kb], 0, 0, 0);
            lin[kb] = __builtin_amdgcn_mfma_f32_16x16x32_bf16(kf[kb][ks], ql[1][ks], lin[kb], 0, 0, 0);
        }
    }
#pragma unroll
    for (int i = 0; i < 8; ++i) score[i] = lin[i >> 2][i & 3];
#pragma unroll
    for (int hd = 0; hd < 8; ++hd) {
        f32x4 acc[2];
#pragma unroll
        for (int kb = 0; kb < 2; ++kb) {
            acc[kb] = (f32x4){0.f, 0.f, 0.f, 0.f};
#pragma unroll
            for (int ks = 0; ks < 2; ++ks) acc[kb] = __builtin_amdgcn_mfma_f32_16x16x32_bf16(kf[kb][ks], qf[hd][ks], acc[kb], 0, 0, 0);
        }
#pragma unroll
        for (int kb = 0; kb < 2; ++kb)
#pragma unroll
            for (int i = 0; i < 4; ++i) score[kb * 4 + i] = fmaf(fabsf(acc[kb][i]), wh[hd], score[kb * 4 + i]);
        if ((hd & 3) == 3) __builtin_amdgcn_sched_barrier(0);
    }
}

template <bool FAST>
__device__ __forceinline__ void attn_tile(const bf16x8 (&kf)[4], const bf16x8 (&vf)[4], const bf16x8 (&qfr)[2][4], f32x16 (&O)[2][2], float (&mrun)[2], float (&lrun)[2],
                                          const unsigned* hist, const float* mtab, int r32, int hh, int tile) {
#pragma unroll
    for (int qb = 0; qb < 2; ++qb) {
        f32x16 S;
        const unsigned mw = hist[(qb * 32 + r32) * MPITCH + tile] >> (16 * hh);
#pragma unroll
        for (int g8 = 0; g8 < 2; ++g8) {
            const float* mt = mtab + ((mw >> (8 * g8)) & 255u) * 8;
            const f32x4 ma = *(const f32x4*)mt, mb = *(const f32x4*)(mt + 4);
            S[8 * g8] = ma[0]; S[8 * g8 + 1] = ma[1]; S[8 * g8 + 2] = ma[2]; S[8 * g8 + 3] = ma[3];
            S[8 * g8 + 4] = mb[0]; S[8 * g8 + 5] = mb[1]; S[8 * g8 + 6] = mb[2]; S[8 * g8 + 7] = mb[3];
        }
#pragma unroll
        for (int ks = 0; ks < 4; ++ks) S = __builtin_amdgcn_mfma_f32_32x32x16_bf16(kf[ks], qfr[qb][ks], S, 0, 0, 0);
        float pr[16]; float ps = 0.f;
        if (FAST) {
#pragma unroll
            for (int i = 0; i < 16; ++i) { pr[i] = __builtin_amdgcn_exp2f(S[i]); ps += pr[i]; }
        } else {
            float mx = fmaxf(fmaxf(S[0], S[1]), S[2]);
#pragma unroll
            for (int i = 3; i < 15; i += 2) mx = fmaxf(fmaxf(mx, S[i]), S[i + 1]);
            mx = fmaxf(mx, S[15]);
            { const auto sw = __builtin_amdgcn_permlane32_swap(__float_as_uint(mx), __float_as_uint(mx), false, false); mx = fmaxf(__uint_as_float(sw[0]), __uint_as_float(sw[1])); }
            if (__any(mx > mrun[qb])) {
                const float mnew = fmaxf(mx, mrun[qb]);
                const float alpha = __builtin_amdgcn_exp2f(mrun[qb] - mnew);
                mrun[qb] = mnew; lrun[qb] *= alpha;
#pragma unroll
                for (int db = 0; db < 2; ++db)
#pragma unroll
                    for (int i = 0; i < 16; ++i) O[db][qb][i] *= alpha;
            }
            const float mref = fmaxf(mrun[qb], -1000.f);
#pragma unroll
            for (int i = 0; i < 16; ++i) { pr[i] = __builtin_amdgcn_exp2f(S[i] - mref); ps += pr[i]; }
        }
        lrun[qb] += ps;
        bf16x8 pf[2];
#pragma unroll
        for (int s = 0; s < 2; ++s) {
            u32x4 pw; pw.x = pk2(pr[8 * s], pr[8 * s + 1]); pw.y = pk2(pr[8 * s + 2], pr[8 * s + 3]); pw.z = pk2(pr[8 * s + 4], pr[8 * s + 5]); pw.w = pk2(pr[8 * s + 6], pr[8 * s + 7]);
            pf[s] = __builtin_bit_cast(bf16x8, pw);
        }
#pragma unroll
        for (int db = 0; db < 2; ++db)
#pragma unroll
            for (int s = 0; s < 2; ++s) O[db][qb] = __builtin_amdgcn_mfma_f32_32x32x16_bf16(vf[db * 2 + s], pf[s], O[db][qb], 0, 0, 0);
    }
}
template <bool FAST>
__device__ __forceinline__ void attn_loop(const bf16_t* Kp, const bf16_t* Vp, const bf16x8 (&qfr)[2][4], f32x16 (&O)[2][2], float (&mrun)[2], float (&lrun)[2],
                                          const unsigned* hist, const float* mtab, int r32, int hh, int nt32, bool dry2) {
    bf16x8 kf[4], vf[4], kg[4], vg[4];
#pragma unroll
    for (int ks = 0; ks < 4; ++ks) { kf[ks] = *(const bf16x8*)(Kp + ks * 512); vf[ks] = *(const bf16x8*)(Vp + ks * 512); }
#pragma unroll 1
    for (int tile = 0; tile < nt32; tile += 2) {
        {
            const int tn = dry2 ? 0 : tile + 1;
#pragma unroll
            for (int ks = 0; ks < 4; ++ks) { kg[ks] = *(const bf16x8*)(Kp + (long)tn * 2048 + ks * 512); vg[ks] = *(const bf16x8*)(Vp + (long)tn * 2048 + ks * 512); }
        }
        attn_tile<FAST>(kf, vf, qfr, O, mrun, lrun, hist, mtab, r32, hh, tile);
        {
            const int tn = dry2 ? 0 : ((tile + 2 < nt32) ? tile + 2 : tile);
#pragma unroll
            for (int ks = 0; ks < 4; ++ks) { kf[ks] = *(const bf16x8*)(Kp + (long)tn * 2048 + ks * 512); vf[ks] = *(const bf16x8*)(Vp + (long)tn * 2048 + ks * 512); }
        }
        attn_tile<FAST>(kg, vg, qfr, O, mrun, lrun, hist, mtab, r32, hh, tile + 1);
    }
}

__device__ __forceinline__ void dsa_item(const Params& p, unsigned char* lds, int b, int qblk, bool dry, int wid_s, const unsigned* kmaxL) {
    bf16_t* H = (bf16_t*)(p.ws + WS_H);
    const float* side = (const float*)(p.ws + WS_SIDE);
    const bf16_t* Hb = H + (long)b * T * HP;
    const int tid = otid(wid_s), lane = tid & 63, w = tid >> 6, hq = lane >> 4;
    const int qg = w & 3, kh = w >> 2;
    const int t0 = qblk * 64, qloc = qg * 16 + (lane & 15), t = t0 + qloc;
    unsigned* hist = (unsigned*)(lds + L_HIST);
    unsigned* cand = (unsigned*)(lds + L_CAND);
    unsigned* ccnt = (unsigned*)(lds + L_CCNT);
    int* qinf = (int*)(lds + L_QINF);

    for (int i = tid; i < 64 * MPITCH; i += 512) hist[i] = 0u;
    for (int i = tid; i < 2048; i += 512) ((float*)(lds + L_MTAB))[i] = ((i >> 3) >> (i & 7)) & 1 ? 0.f : -1e30f;
    bf16x8 qf[8][2]; bf16x8 ql[2][2]; float wi[8]; float inv, fb0c;
    {
        const bf16_t* qp = Hb + (long)t * HP + HQI + 8 * hq;
#pragma unroll
        for (int hd = 0; hd < 8; ++hd)
#pragma unroll
            for (int ks = 0; ks < 2; ++ks) qf[hd][ks] = *(const bf16x8*)(qp + hd * 64 + ks * 32);
        const float* sp = side + ((long)b * T + t) * 24;
        const f32x4 w0 = *(const f32x4*)sp, w1 = *(const f32x4*)(sp + 4);
        wi[0] = w0[0]; wi[1] = w0[1]; wi[2] = w0[2]; wi[3] = w0[3]; wi[4] = w1[0]; wi[5] = w1[1]; wi[6] = w1[2]; wi[7] = w1[3];
        float n2 = 0.f;
#pragma unroll
        for (int i = 0; i < 8; ++i) n2 = fmaf(wi[i], wi[i], n2);
        const float nrm = fmaxf(SIG_UNIT * sqrtf(n2), 1e-30f);
        inv = 64.f / nrm;
        fb0c = 256.f - 64.f * 3.19f * (wi[0] + wi[1] + wi[2] + wi[3] + wi[4] + wi[5] + wi[6] + wi[7]) / nrm;
#pragma unroll
        for (int i = 0; i < 8; ++i) wi[i] *= 0.5f;
#pragma unroll
        for (int ks = 0; ks < 2; ++ks) {
            float ql_f[8];
#pragma unroll
            for (int j = 0; j < 8; ++j) ql_f[j] = 0.f;
#pragma unroll
            for (int hd = 0; hd < 8; ++hd) {
                const u32x4 qv = __builtin_bit_cast(u32x4, qf[hd][ks]);
                ql_f[0] = fmaf(wi[hd], bflo(qv.x), ql_f[0]); ql_f[1] = fmaf(wi[hd], bfhi(qv.x), ql_f[1]); ql_f[2] = fmaf(wi[hd], bflo(qv.y), ql_f[2]); ql_f[3] = fmaf(wi[hd], bfhi(qv.y), ql_f[3]);
                ql_f[4] = fmaf(wi[hd], bflo(qv.z), ql_f[4]); ql_f[5] = fmaf(wi[hd], bfhi(qv.z), ql_f[5]); ql_f[6] = fmaf(wi[hd], bflo(qv.w), ql_f[6]); ql_f[7] = fmaf(wi[hd], bfhi(qv.w), ql_f[7]);
            }
            u32x4 hi4; hi4.x = pk2(ql_f[0], ql_f[1]); hi4.y = pk2(ql_f[2], ql_f[3]); hi4.z = pk2(ql_f[4], ql_f[5]); hi4.w = pk2(ql_f[6], ql_f[7]);
            u32x4 lo4;
            lo4.x = pk2(ql_f[0] - bflo(hi4.x), ql_f[1] - bfhi(hi4.x)); lo4.y = pk2(ql_f[2] - bflo(hi4.y), ql_f[3] - bfhi(hi4.y));
            lo4.z = pk2(ql_f[4] - bflo(hi4.z), ql_f[5] - bfhi(hi4.z)); lo4.w = pk2(ql_f[6] - bflo(hi4.w), ql_f[7] - bfhi(hi4.w));
            ql[0][ks] = __builtin_bit_cast(bf16x8, hi4); ql[1][ks] = __builtin_bit_cast(bf16x8, lo4);
        }
    }
    const int ntile = (t0 + 64 + 127) >> 7;
    const int tmaxw = t0 + qg * 16 + 15;
    __syncthreads();
    int nit = 0;
    { const int v = tmaxw - kh * 64; if (v >= 0) nit = 2 * (v >> 7) + (((v & 127) >= 32) ? 2 : 1); }
    float fa = inv, fbias = fb0c;
    bool active = true;
#pragma unroll 1
    for (int level = 0; level < 2; ++level) {
        unsigned* hbase = level ? cand : hist;
        const bool wave_on = __any(active);
        if (wave_on) {
            const unsigned incv = 1u << ((qloc & 1) * 16);
            unsigned* hrow = hbase + (qloc >> 1) * HPITCH;
            bf16x8 kf[2][2];
            idx_loadk(Hb, kh * 64, lane, kf);
#pragma unroll 1
            for (int it = 0; it < nit; ++it) {
                const int s0 = (it >> 1) * 128 + kh * 64 + (it & 1) * 32;
                const int itn = (it + 1 < nit) ? it + 1 : it;
                bf16x8 kn[2][2];
                idx_loadk(Hb, (itn >> 1) * 128 + kh * 64 + (itn & 1) * 32, lane, kn);
                float score[8];
                idx_scores(kf, qf, ql, wi, score);
                if (s0 + 31 <= t0 + qg * 16) {
#pragma unroll
                    for (int i = 0; i < 8; ++i) { const unsigned bin = (unsigned)__builtin_amdgcn_fmed3f(fmaf(score[i], fa, fbias), 0.f, 511.5f); atomicAdd(hrow + bin, incv); }
                } else {
#pragma unroll
                    for (int i = 0; i < 8; ++i) {
                        const int s = s0 + (i >> 2) * 16 + hq * 4 + (i & 3);
                        if (s <= t) { const unsigned bin = (unsigned)__builtin_amdgcn_fmed3f(fmaf(score[i], fa, fbias), 0.f, 511.5f); atomicAdd(hrow + bin, incv); }
                    }
                }
#pragma unroll
                for (int kb = 0; kb < 2; ++kb)
#pragma unroll
                    for (int ks = 0; ks < 2; ++ks) kf[kb][ks] = kn[kb][ks];
            }
        }
        __syncthreads();
#pragma unroll 1
        for (int qq = 0; qq < 8; ++qq) {
            const int q = w * 8 + qq;
            if (level && !qinf[q * 4 + 3]) continue;
            const u32x4 wa = *(const u32x4*)(hbase + (q >> 1) * HPITCH + 8 * lane), wb = *(const u32x4*)(hbase + (q >> 1) * HPITCH + 8 * lane + 4);
            const int sh = (q & 1) * 16;
            const unsigned c[8] = {(wa.x >> sh) & 0xffffu, (wa.y >> sh) & 0xffffu, (wa.z >> sh) & 0xffffu, (wa.w >> sh) & 0xffffu, (wb.x >> sh) & 0xffffu, (wb.y >> sh) & 0xffffu, (wb.z >> sh) & 0xffffu, (wb.w >> sh) & 0xffffu};
            const unsigned tot = c[0] + c[1] + c[2] + c[3] + c[4] + c[5] + c[6] + c[7];
            unsigned S = tot;
#pragma unroll
            for (int o = 1; o < 64; o <<= 1) { const unsigned dn = (unsigned)bperm_i((lane + o) & 63, (int)S); if (lane + o < 64) S += dn; }
            const unsigned total = (unsigned)__builtin_amdgcn_readfirstlane((int)S);
            const u64 bal = __ballot(S >= 256u);
            int b1 = -1, r1 = 0, n1 = 0;
            if (total >= 256u) {
                const int Ls = 63 - __clzll(bal);
                unsigned cum = S - tot; bool found = false; int lb = -1, lr = 0, ln = 0;
#pragma unroll
                for (int j = 7; j >= 0; --j) { const bool hit = !found && (cum + c[j] >= 256u); if (hit) { lb = 8 * lane + j; lr = 256 - (int)cum; ln = (int)c[j]; found = true; } cum += c[j]; }
                b1 = bperm_i(Ls, lb); r1 = bperm_i(Ls, lr); n1 = bperm_i(Ls, ln);
            }
            if (lane == 0) { qinf[q * 4] = b1; qinf[q * 4 + 1] = r1; qinf[q * 4 + 2] = n1; }
        }
        __syncthreads();
        if (level == 0) { for (int i = tid; i < 64 * MPITCH; i += 512) hist[i] = 0u; }
        if (tid == 0) qinf[256] = 0;
        __syncthreads();
        if (wave_on) {
            const int b1 = qinf[qloc * 4];
            const float fsel = !active ? __builtin_inff() : ((b1 < 0) ? -__builtin_inff() : ((b1 >= 511) ? __builtin_inff() : (float)(b1 + 1)));
            const float fcand = !active ? __builtin_inff() : ((b1 <= 0) ? -__builtin_inff() : (float)b1);
            const float fb1 = (float)(b1 < 0 ? 0 : b1);
            unsigned* cslot = cand + (qloc * 8 + kh * 4 + hq) * SUBCAP; int ncand = 0;
            bf16x8 kf[2][2];
            idx_loadk(Hb, kh * 64, lane, kf);
#pragma unroll 1
            for (int it = 0; it < nit; ++it) {
                const int s0 = (it >> 1) * 128 + kh * 64 + (it & 1) * 32;
                const int itn = (it + 1 < nit) ? it + 1 : it;
                bf16x8 kn[2][2];
                idx_loadk(Hb, (itn >> 1) * 128 + kh * 64 + (itn & 1) * 32, lane, kn);
                float score[8];
                idx_scores(kf, qf, ql, wi, score);
                unsigned m0 = 0u;
                if (s0 + 31 <= t0 + qg * 16) {
#pragma unroll
                    for (int i = 0; i < 8; ++i) {
                        const int rr = (i >> 2) * 16 + hq * 4 + (i & 3), s = s0 + rr;
                        const float fb = fmaf(score[i], fa, fbias);
                        if (fb >= fcand) {
                            if (fb >= fsel) m0 |= 1u << (16 * (hq & 1) + 4 * (hq >> 1) + (i & 3) + 8 * (i >> 2));
                            else {
                                const unsigned q19 = (unsigned)__builtin_amdgcn_fmed3f((fb - fb1) * 524288.f, 0.f, 524287.f);
                                if (ncand < SUBCAP) cslot[ncand] = (q19 << 13) | (unsigned)(8191 - s);
                                ++ncand;
                            }
                        }
                    }
                } else {
#pragma unroll
                    for (int i = 0; i < 8; ++i) {
                        const int rr = (i >> 2) * 16 + hq * 4 + (i & 3), s = s0 + rr;
                        const float fb = fmaf(score[i], fa, fbias);
                        if (fb >= fcand && s <= t) {
                            if (fb >= fsel) m0 |= 1u << (16 * (hq & 1) + 4 * (hq >> 1) + (i & 3) + 8 * (i >> 2));
                            else {
                                const unsigned q19 = (unsigned)__builtin_amdgcn_fmed3f((fb - fb1) * 524288.f, 0.f, 524287.f);
                                if (ncand < SUBCAP) cslot[ncand] = (q19 << 13) | (unsigned)(8191 - s);
                                ++ncand;
                            }
                        }
                    }
                }
                if (m0) atomicOr(&hist[qloc * MPITCH + (s0 >> 5)], m0);
#pragma unroll
                for (int kb = 0; kb < 2; ++kb)
#pragma unroll
                    for (int ks = 0; ks < 2; ++ks) kf[kb][ks] = kn[kb][ks];
            }
            ccnt[qloc * 8 + kh * 4 + hq] = (unsigned)ncand;
        } else ccnt[qloc * 8 + kh * 4 + hq] = 0u;
        __syncthreads();
#pragma unroll 1
        for (int qq = 0; qq < 8; ++qq) {
            const int q = w * 8 + qq;
            if (level && !qinf[q * 4 + 3]) continue;
            const int r1 = qinf[q * 4 + 1];
            const int wr_ = lane >> 3, sl0 = (lane & 7) * 4;
            int cw = (int)ccnt[q * 8 + wr_];
            const bool ovf = __any(cw > SUBCAP) && (level == 0);
            if (lane == 0) { qinf[q * 4 + 3] = ovf ? 1 : 0; if (ovf) qinf[256] = 1; }
            if (ovf || r1 <= 0) continue;
            if (cw > SUBCAP) cw = SUBCAP;
            const u32x4 mine = *(const u32x4*)(cand + (q * 8 + wr_) * SUBCAP + sl0);
            int rk0 = 0, rk1 = 0, rk2 = 0, rk3 = 0;
#pragma unroll 1
            for (int ww = 0; ww < 8; ++ww) {
                int cn = (int)ccnt[q * 8 + ww]; if (cn > SUBCAP) cn = SUBCAP;
                const unsigned* cl = cand + (q * 8 + ww) * SUBCAP;
#pragma unroll 1
                for (int j = 0; j < cn; ++j) { const unsigned cv = cl[j]; rk0 += (cv > mine.x); rk1 += (cv > mine.y); rk2 += (cv > mine.z); rk3 += (cv > mine.w); }
            }
            if (sl0 + 0 < cw && rk0 < r1) { const int s = 8191 - (int)(mine.x & 8191u); atomicOr(&hist[q * MPITCH + (s >> 5)], 1u << mpos(s & 31)); }
            if (sl0 + 1 < cw && rk1 < r1) { const int s = 8191 - (int)(mine.y & 8191u); atomicOr(&hist[q * MPITCH + (s >> 5)], 1u << mpos(s & 31)); }
            if (sl0 + 2 < cw && rk2 < r1) { const int s = 8191 - (int)(mine.z & 8191u); atomicOr(&hist[q * MPITCH + (s >> 5)], 1u << mpos(s & 31)); }
            if (sl0 + 3 < cw && rk3 < r1) { const int s = 8191 - (int)(mine.w & 8191u); atomicOr(&hist[q * MPITCH + (s >> 5)], 1u << mpos(s & 31)); }
        }
        __syncthreads();
        if (level == 1 || qinf[256] == 0) break;
        {
            const bool mine_ovf = qinf[qloc * 4 + 3] != 0;
            const int b1 = qinf[qloc * 4];
            active = mine_ovf;
            fa = mine_ovf ? inv * 510.f : 0.f;
            fbias = mine_ovf ? fmaf(fb0c - (float)b1, 510.f, 1.f) : -1.f;
        }
        for (int i = tid; i < 32 * HPITCH; i += 512) cand[i] = 0u;
        __syncthreads();
    }
    for (int rep2_ = ((PROBE_PHASE == 41) ? 0 : 1); rep2_ < 2; ++rep2_) {
        const bool dry2 = dry || ((PROBE_PHASE == 41) && (rep2_ == 0) && (p.pos[0] == 0));
        const int head = w, r32 = lane & 31, hh = lane >> 5;
        bf16x8 qfr[2][4];
        float q1 = 0.f;
#pragma unroll
        for (int qb = 0; qb < 2; ++qb) {
            float qa = 0.f;
#pragma unroll
            for (int ks = 0; ks < 4; ++ks) {
                qfr[qb][ks] = *(const bf16x8*)(Hb + (long)(t0 + qb * 32 + r32) * HP + HQ + head * 64 + ks * 16 + 8 * hh);
                const u32x4 qv = __builtin_bit_cast(u32x4, qfr[qb][ks]);
                qa += fabsf(bflo(qv.x)) + fabsf(bfhi(qv.x)) + fabsf(bflo(qv.y)) + fabsf(bfhi(qv.y)) + fabsf(bflo(qv.z)) + fabsf(bfhi(qv.z)) + fabsf(bflo(qv.w)) + fabsf(bfhi(qv.w));
            }
            q1 = fmaxf(q1, qa);
        }
        q1 += sxor_f(q1, lane, 32);
#pragma unroll
        for (int o = 16; o >= 1; o >>= 1) q1 = fmaxf(q1, sxor_f(q1, lane, o));
        const float kmx = __uint_as_float(kmaxL[b * 8 + head]);
        const bool fast = (q1 * kmx * 1.02f) < 100.f;
        f32x16 O[2][2];
#pragma unroll
        for (int a = 0; a < 2; ++a)
#pragma unroll
            for (int c2 = 0; c2 < 2; ++c2)
#pragma unroll
                for (int i = 0; i < 16; ++i) O[a][c2][i] = 0.f;
        float mrun[2] = {-1e30f, -1e30f}, lrun[2] = {0.f, 0.f};
        const bf16_t* Kp = (const bf16_t*)(p.ws + WS_KF) + ((long)(b * 8 + head) * 256 * 4 * 64 + lane) * 8;
        const bf16_t* Vp = (const bf16_t*)(p.ws + WS_VT) + ((long)(b * 8 + head) * 256 * 4 * 64 + lane) * 8;
        const int nt32 = (t0 + 64) >> 5;
        if (fast) attn_loop<true>(Kp, Vp, qfr, O, mrun, lrun, hist, (const float*)(lds + L_MTAB), r32, hh, nt32, dry2);
        else attn_loop<false>(Kp, Vp, qfr, O, mrun, lrun, hist, (const float*)(lds + L_MTAB), r32, hh, nt32, dry2);
#pragma unroll
        for (int qb = 0; qb < 2; ++qb) {
            const float lt = lrun[qb] + sxor_f(lrun[qb], lane, 32);
            const float il = 1.f / lt;
            bf16_t* gp = H + ((long)b * T + t0 + qb * 32 + r32) * HP + HAG + head * 64 + 4 * hh;
#pragma unroll
            for (int db = 0; db < 2; ++db)
#pragma unroll
                for (int g4 = 0; g4 < 4; ++g4) {
                    bf16_t* gq = gp + db * 32 + 8 * g4;
                    const u32x2 gv = *(const u32x2*)gq;
                    u32x2 wv;
                    wv.x = pk2(O[db][qb][4 * g4] * il * silu_f(bflo(gv.x)), O[db][qb][4 * g4 + 1] * il * silu_f(bfhi(gv.x)));
                    wv.y = pk2(O[db][qb][4 * g4 + 2] * il * silu_f(bflo(gv.y)), O[db][qb][4 * g4 + 3] * il * silu_f(bfhi(gv.y)));
                    if (!dry2) *(u32x2*)gq = wv;
                }
        }
    }
    __syncthreads();
}

__device__ __forceinline__ void gbar(unsigned* ctr, unsigned target) {
    __syncthreads();
    if (threadIdx.x == 0) {
        __builtin_amdgcn_fence(__ATOMIC_RELEASE, "agent");
        __hip_atomic_fetch_add(ctr, 1u, __ATOMIC_RELAXED, __HIP_MEMORY_SCOPE_AGENT);
        while (__hip_atomic_load(ctr, __ATOMIC_RELAXED, __HIP_MEMORY_SCOPE_AGENT) < target) __builtin_amdgcn_s_sleep(2);
        __builtin_amdgcn_fence(__ATOMIC_ACQUIRE, "agent");
    }
    __syncthreads();
}

__device__ __forceinline__ void ho_arrive(unsigned* ctr) {
    __syncthreads();
    if (threadIdx.x == 0) { __builtin_amdgcn_fence(__ATOMIC_RELEASE, "agent"); __hip_atomic_fetch_add(ctr, 1u, __ATOMIC_RELAXED, __HIP_MEMORY_SCOPE_AGENT); }
}
__device__ __forceinline__ void ho_wait(unsigned* ctr, unsigned target) {
    if (threadIdx.x == 0) {
        while (__hip_atomic_load(ctr, __ATOMIC_RELAXED, __HIP_MEMORY_SCOPE_AGENT) < target) __builtin_amdgcn_s_sleep(2);
        __builtin_amdgcn_fence(__ATOMIC_ACQUIRE, "agent");
    }
    __syncthreads();
}

__global__ void __launch_bounds__(512) fwd_megakernel(Params p0) {
    extern __shared__ __attribute__((aligned(16))) unsigned char lds[];
    cg::grid_group grid = cg::this_grid();
    const int G = gridDim.x, c = blockIdx.x;
    const int wid_s = __builtin_amdgcn_readfirstlane((int)(threadIdx.x >> 6));

    unsigned* barctr = (unsigned*)(p0.ws + WS_BAR); unsigned bar_n = 0;
    if (c == 0 && threadIdx.x < 3) __hip_atomic_store(barctr + 16 * threadIdx.x, 0u, __ATOMIC_RELAXED, __HIP_MEMORY_SCOPE_AGENT);
    for (int rep0_ = (PROBE_PHASE == 8 ? 0 : 1); rep0_ < 2; ++rep0_) prologue(p0, (long)c * 512 + threadIdx.x, (long)G * 512);
    grid.sync();

#pragma unroll 1
    for (int layer = 0; layer < DEPTH; ++layer) {
        Params p = p0;
        { size_t zoff = 0; asm volatile("" : "+s"(zoff)); p.ws = p0.ws + zoff; }
        bf16_t* H = (bf16_t*)(p.ws + WS_H);
        {
for (int rep_ = (PROBE_PHASE == 1 ? 0 : 1); rep_ < 2; ++rep_) { const bool dry = (PROBE_PHASE == 1) && (rep_ == 0) && (p.pos[0] == 0);
            EpiIn e; e.H = H; e.side = (float*)(p.ws + WS_SIDE); e.rope = (const float*)(p.ws + WS_ROPE); e.VT = (bf16_t*)(p.ws + WS_VT); e.KF = (bf16_t*)(p.ws + WS_KF); e.kmax = (unsigned*)(p.ws + WS_KMAX) + layer * 32; e.dry = dry;
            const bf16_t* A = (const bf16_t*)(p.ws + WS_XB);
            const bf16_t* Bt = (const bf16_t*)(p.ws + WS_WIN) + (long)layer * NPAD * 1024;
#pragma unroll 1
            for (int L = c; L < 128 * 17; L += G) { int pm, pn; tile_of(L, 128, 17, pm, pn); if (layer) ho_wait((unsigned*)(p.ws + WS_LCNT) + pm * 16, 2u * (unsigned)layer); gemm_tile((LAS unsigned char*)lds, A, 1024, Bt, 1024, pm, pn, e, wid_s); }
}
        }
        gbar(barctr, (++bar_n) * (unsigned)G); if (PROBE_PHASE == 9) gbar(barctr, (++bar_n) * (unsigned)G);
        {
for (int rep_ = (PROBE_PHASE == 2 ? 0 : 1); rep_ < 2; ++rep_) { const bool dry = (PROBE_PHASE == 2) && (rep_ == 0) && (p.pos[0] == 0);
            const int tid = otid(wid_s), lane = tid & 63, w = tid >> 6;
#pragma unroll 1
            for (int g = c; g < 256; g += G) gla_local_item(p, layer, g * 8 + w, lane, dry);
}
        }
        ho_arrive(barctr + 16);
        if (c < 64) {
            ho_wait(barctr + 16, (unsigned)(layer + 1) * (unsigned)G);
            const int tid = otid(wid_s);
#pragma unroll 1
            for (int g = c; g < 64; g += G) gla_scan(p, g * 512 + tid);
            ho_arrive(barctr + 32);
        }
for (int rep_ = (PROBE_PHASE == 3 ? 0 : 1); rep_ < 2; ++rep_) { const bool dry = (PROBE_PHASE == 3) && (rep_ == 0) && (p.pos[0] == 0);
#pragma unroll 1
        for (int tile = c; tile < 512; tile += G) conformer_tile(p, layer, lds, tile, dry, wid_s);
}
for (int rep_ = (PROBE_PHASE == 4 ? 0 : 1); rep_ < 2; ++rep_) { const bool dry = (PROBE_PHASE == 4) && (rep_ == 0) && (p.pos[0] == 0);
#pragma unroll 1
        for (int it = c; it < 512; it += G) {
            const int pr = it >> 1, second = it & 1;
            const int xcd = pr & 7, j = pr >> 3, b = xcd >> 1, par = xcd & 1;
            const int qblk = second ? (2 * j + par) : 127 - (2 * j + par);
            dsa_item(p, lds, b, qblk, dry, wid_s, (const unsigned*)(p.ws + WS_KMAX) + layer * 32);
        }
}
        ho_wait(barctr + 32, (unsigned)(layer + 1) * (unsigned)(G < 64 ? G : 64));
        {
for (int rep_ = (PROBE_PHASE == 5 ? 0 : 1); rep_ < 2; ++rep_) { const bool dry = (PROBE_PHASE == 5) && (rep_ == 0) && (p.pos[0] == 0);
            const int tid = otid(wid_s), lane = tid & 63, w = tid >> 6;
#pragma unroll 1
            for (int g = c; g < 256; g += G) gla_out_item(p, layer, lds + w * 16384, g * 8 + w, lane, dry);
}
        }
        gbar(barctr, (++bar_n) * (unsigned)G); if (PROBE_PHASE == 9) gbar(barctr, (++bar_n) * (unsigned)G);
        {
for (int rep_ = (PROBE_PHASE == 6 ? 0 : 1); rep_ < 2; ++rep_) { const bool dry = (PROBE_PHASE == 6) && (rep_ == 0) && (p.pos[0] == 0);
            EpiOut e; e.xres = (layer == 0) ? p.x : p.out; e.out = p.out; e.dry = dry;
            const bf16_t* A = H + HAG;
            const bf16_t* Bt = (const bf16_t*)(p.ws + WS_WOUT) + (long)layer * 1024 * 1024;
#pragma unroll 1
            for (int L = c; L < 128 * 4; L += G) { int pm, pn; tile_of(L, 128, 4, pm, pn); gemm_tile((LAS unsigned char*)lds, A, HP, Bt, 1024, pm, pn, e, wid_s); ho_arrive((unsigned*)(p.ws + WS_PCNT) + pm * 16); }
}
        }
        {
for (int rep_ = (PROBE_PHASE == 7 ? 0 : 1); rep_ < 2; ++rep_) { const bool dry = (PROBE_PHASE == 7) && (rep_ == 0) && (p.pos[0] == 0);
            const int tid = otid(wid_s), lane = tid & 63, w = tid >> 6;
#pragma unroll 1
            for (int hp = c; hp < 256; hp += G) {
                ho_wait((unsigned*)(p.ws + WS_PCNT) + (hp >> 1) * 16, 4u * (unsigned)(layer + 1));
                const int base = (hp >> 1) * 256 + (hp & 1) * 128;
                ln_phase(p, layer, base + w, base + 128, 8, lane, dry);
                ho_arrive((unsigned*)(p.ws + WS_LCNT) + (hp >> 1) * 16);
            }
}
        }
    }
}

extern "C" void kernel_launch(void* const* d_in, const int* in_sizes, int n_in, void* d_out, int out_size, void* d_ws, size_t ws_size, hipStream_t stream) {
    static int grid_blocks = 0;
    if (grid_blocks == 0) {
        if (n_in != 15 || ws_size < WS_END) { fprintf(stderr, "kernel_launch: unexpected inputs (n_in %d, ws %zu < %zu)\n", n_in, ws_size, (size_t)WS_END); grid_blocks = -1; return; }
        int dev = 0, cus = 0, per_cu = 0;
        hipGetDevice(&dev);
        hipDeviceGetAttribute(&cus, hipDeviceAttributeMultiprocessorCount, dev);
        if (hipFuncSetAttribute((const void*)fwd_megakernel, hipFuncAttributeMaxDynamicSharedMemorySize, LDS_BYTES) != hipSuccess) { fprintf(stderr, "kernel_launch: hipFuncSetAttribute failed\n"); grid_blocks = -1; return; }
        hipOccupancyMaxActiveBlocksPerMultiprocessor(&per_cu, (const void*)fwd_megakernel, 512, LDS_BYTES);
        if (per_cu < 1) per_cu = 1;
        grid_blocks = cus * per_cu;
    }
    if (grid_blocks < 0) return;
    Params p{};
    p.x = (const float*)d_in[0]; p.pos = (const int*)d_in[1]; p.w_in = (const float*)d_in[2]; p.conv_w = (const float*)d_in[3]; p.conv_b = (const float*)d_in[4];
    p.cln_g = (const float*)d_in[5]; p.cln_b = (const float*)d_in[6]; p.pw_w = (const float*)d_in[7]; p.pw_b = (const float*)d_in[8];
    p.gate_w2 = (const float*)d_in[9]; p.gate_b = (const float*)d_in[10]; p.gnorm_g = (const float*)d_in[11]; p.w_out = (const float*)d_in[12];
    p.ln_g = (const float*)d_in[13]; p.ln_b = (const float*)d_in[14];
    p.out = (float*)d_out; p.ws = (unsigned char*)d_ws;
    for (int j = 0; j < 32; ++j) p.inv_freq[j] = (float)pow(10000.0, -(double)j / 32.0);
    void* args[] = {&p};
    hipError_t e = hipLaunchCooperativeKernel((const void*)fwd_megakernel, dim3(grid_blocks), dim3(512), args, LDS_BYTES, stream);
    if (e != hipSuccess) fprintf(stderr, "cooperative launch failed: %s (grid %d)\n", hipGetErrorString(e), grid_blocks);
}
```

```cpp
#include <hip/hip_runtime.h>
#include <hip/hip_cooperative_groups.h>
#include <cstdio>
#include <cmath>
namespace cg = cooperative_groups;

typedef unsigned short bf16_t;
typedef short bf16x8 __attribute__((ext_vector_type(8)));
typedef float f32x4 __attribute__((ext_vector_type(4)));
typedef float f32x16 __attribute__((ext_vector_type(16)));
typedef unsigned u32x4 __attribute__((ext_vector_type(4)));
typedef unsigned u32x2 __attribute__((ext_vector_type(2)));
typedef unsigned long long u64;

constexpr int NB = 4, T = 8192, NTOK = NB * T, DM = 1024, DIN = 4184, NPAD = 4352, HP = 4160, DEPTH = 4;
constexpr int HQ = 0, HK = 512, HV = 1024, HQI = 1536, HKI = 2048, HGLU = 2112, HCQ = 2624, HCK = 2752, HCV = 2880, HAG = 3136, HBG = 3648, HCG = 3904;
constexpr float EPS = 1e-5f;
constexpr float ALPHA = 1.6817928305074290f;
constexpr float QSCALE = 0.125f * 1.4426950408889634f;
constexpr float WI_SCALE = 0.04419417382415922f;
constexpr float SIG_UNIT = 5.66f;
constexpr int CAP = 128;

constexpr size_t WS_WIN = 0;
constexpr size_t WS_WOUT = WS_WIN + (size_t)DEPTH * NPAD * 1024 * 2;
constexpr size_t WS_PWT = WS_WOUT + (size_t)DEPTH * 1024 * 1024 * 2;
constexpr size_t WS_ROPE = WS_PWT + (size_t)DEPTH * 256 * 256 * 2;
constexpr size_t WS_XB = WS_ROPE + (size_t)NTOK * 32 * 8;
constexpr size_t WS_H = WS_XB + (size_t)NTOK * 1024 * 2;
constexpr size_t WS_SIDE = WS_H + (size_t)NTOK * HP * 2;
constexpr size_t WS_BCUM = WS_SIDE + (size_t)NTOK * 24 * 4;
constexpr size_t WS_U = WS_BCUM + (size_t)NTOK * 128 * 4;
constexpr size_t WS_DEC = WS_U + (size_t)2048 * 2048 * 4;
constexpr size_t WS_VT = WS_DEC + (size_t)2048 * 32 * 4;
constexpr size_t WS_KF = WS_VT + (size_t)NTOK * 512 * 2;
constexpr size_t WS_BAR = WS_KF + (size_t)NTOK * 512 * 2;
constexpr size_t WS_KMAX = WS_BAR + 256;
constexpr size_t WS_PCNT = WS_KMAX + 512;
constexpr size_t WS_LCNT = WS_PCNT + 128 * 64;
constexpr size_t WS_END = WS_LCNT + 128 * 64;

#ifndef PROBE_PHASE
#define PROBE_PHASE 0
#endif
constexpr int LDS_BYTES = 147456;

struct Params {
    const float* x; const int* pos; const float* w_in; const float* conv_w; const float* conv_b; const float* cln_g; const float* cln_b;
    const float* pw_w; const float* pw_b; const float* gate_w2; const float* gate_b; const float* gnorm_g; const float* w_out; const float* ln_g; const float* ln_b;
    float* out; unsigned char* ws;
    float inv_freq[32];
};

__device__ __forceinline__ unsigned f2bf(float f) { unsigned u = __float_as_uint(f); return (u + 0x7fffu + ((u >> 16) & 1u)) >> 16; }
__device__ __forceinline__ float bf2f(unsigned b) { return __uint_as_float(b << 16); }
typedef float f32x2_t __attribute__((ext_vector_type(2)));
typedef __bf16 bf16x2_t __attribute__((ext_vector_type(2)));
__device__ __forceinline__ unsigned pk2(float lo, float hi) { f32x2_t v = {lo, hi}; bf16x2_t b = __builtin_convertvector(v, bf16x2_t); return __builtin_bit_cast(unsigned, b); }
__device__ __forceinline__ float bflo(unsigned w) { return __uint_as_float(w << 16); }
__device__ __forceinline__ float bfhi(unsigned w) { return __uint_as_float(w & 0xffff0000u); }
__device__ __forceinline__ float silu_f(float v) { return v / (1.f + __expf(-v)); }
__device__ __forceinline__ float sigmoid_f(float v) { return 1.f / (1.f + __expf(-v)); }
__device__ __forceinline__ int bperm_i(int idx, int v) { return __builtin_amdgcn_ds_bpermute(idx << 2, v); }
__device__ __forceinline__ float sxor_f(float v, int lane, int m) { return __int_as_float(bperm_i(lane ^ m, __float_as_int(v))); }
__device__ __forceinline__ int sxor_i(int v, int lane, int m) { return bperm_i(lane ^ m, v); }
__device__ __forceinline__ float wave_sum(float v, int lane) {
#pragma unroll
    for (int o = 32; o >= 1; o >>= 1) v += sxor_f(v, lane, o);
    return v;
}
__device__ __forceinline__ int otid(int wid_s) { int l; asm volatile("v_mbcnt_lo_u32_b32 %0, -1, 0\n\tv_mbcnt_hi_u32_b32 %0, -1, %0" : "=v"(l)); return (wid_s << 6) | l; }
#define WAVE_SYNC() do { __builtin_amdgcn_fence(__ATOMIC_RELEASE, "wavefront"); __builtin_amdgcn_wave_barrier(); __builtin_amdgcn_fence(__ATOMIC_ACQUIRE, "wavefront"); } while (0)

__device__ __forceinline__ int l2orig(int l) {
    if (l < 1536) return l;
    if (l < 2048) return 2048 + (l - 1536);
    if (l < 2112) return 2560 + (l - 2048);
    if (l < 2624) return 2632 + (l - 2112);
    if (l < 2752) return 3400 + (l - 2624);
    if (l < 2880) return 3528 + (l - 2752);
    if (l < 3136) return 3656 + (l - 2880);
    if (l < 3648) return 1536 + (l - 3136);
    if (l < 3904) return 3144 + (l - 3648);
    if (l < 4160) return 3912 + (l - 3904);
    if (l < 4168) return 2624 + (l - 4160);
    if (l < 4184) return 4168 + (l - 4168);
    return -1;
}
__device__ __forceinline__ int npos2logical(int np) {
    const int hb = np & ~127, p = np & 127, wc = p >> 5, n = (p >> 4) & 1, fr = p & 15;
    return hb + (wc >> 1) * 64 + n * 32 + (wc & 1) * 16 + fr;
}

__device__ __forceinline__ void sincos_acc(float angf, float& c, float& s) {
    const double a = (double)angf;
    const double n = rint(a * 0.15915494309189535);
    double r = fma(-n, 6.283185307179586, a);
    r = fma(-n, 2.4492935982947064e-16, r);
    const double r2 = r * r;
    double ts = r, tc = 1.0, ss = r, cc = 1.0;
#pragma unroll
    for (int k = 1; k <= 14; ++k) {
        tc = -tc * r2 * (1.0 / (double)((2 * k - 1) * (2 * k)));
        ts = -ts * r2 * (1.0 / (double)((2 * k) * (2 * k + 1)));
        cc += tc; ss += ts;
    }
    c = (float)cc; s = (float)ss;
}

__device__ __forceinline__ void convert_weights(const Params& p, int l0, int l1, long gtid, long gthreads) {
    bf16_t* win = (bf16_t*)(p.ws + WS_WIN);
    for (long idx = gtid; idx < (long)(l1 - l0) * 128 * NPAD; idx += gthreads) {
        const int np = (int)(idx % NPAD); const long r = idx / NPAD; const int kc = (int)(r % 128); const int l = l0 + (int)(r / 128);
        const int oc = l2orig(npos2logical(np));
        u32x4 w = {0u, 0u, 0u, 0u};
        if (oc >= 0) {
            const float* src = p.w_in + ((long)l * 1024 + kc * 8) * DIN + oc;
            float v[8];
#pragma unroll
            for (int i = 0; i < 8; ++i) v[i] = src[(long)i * DIN];
            w.x = pk2(v[0], v[1]); w.y = pk2(v[2], v[3]); w.z = pk2(v[4], v[5]); w.w = pk2(v[6], v[7]);
        }
        *(u32x4*)(win + ((long)l * NPAD + np) * 1024 + kc * 8) = w;
    }
    bf16_t* wout = (bf16_t*)(p.ws + WS_WOUT);
    for (long idx = gtid; idx < (long)(l1 - l0) * 128 * 1024; idx += gthreads) {
        const int n = (int)(idx % 1024); const long r = idx / 1024; const int kc = (int)(r % 128); const int l = l0 + (int)(r / 128);
        const float* src = p.w_out + ((long)l * 1024 + kc * 8) * 1024 + n;
        float v[8];
#pragma unroll
        for (int i = 0; i < 8; ++i) v[i] = src[(long)i * 1024];
        u32x4 w; w.x = pk2(v[0], v[1]); w.y = pk2(v[2], v[3]); w.z = pk2(v[4], v[5]); w.w = pk2(v[6], v[7]);
        *(u32x4*)(wout + ((long)l * 1024 + n) * 1024 + kc * 8) = w;
    }
    bf16_t* pwt = (bf16_t*)(p.ws + WS_PWT);
    for (long idx = gtid; idx < (long)(l1 - l0) * 32 * 256; idx += gthreads) {
        const int n = (int)(idx % 256); const long r = idx / 256; const int kc = (int)(r % 32); const int l = l0 + (int)(r / 32);
        const float* src = p.pw_w + ((long)l * 256 + kc * 8) * 256 + n;
        float v[8];
#pragma unroll
        for (int i = 0; i < 8; ++i) v[i] = src[(long)i * 256];
        u32x4 w; w.x = pk2(v[0], v[1]); w.y = pk2(v[2], v[3]); w.z = pk2(v[4], v[5]); w.w = pk2(v[6], v[7]);
        *(u32x4*)(pwt + ((long)l * 256 + n) * 256 + kc * 8) = w;
    }
}

__device__ __forceinline__ void prologue(const Params& p, long gtid, long gthreads) {
    convert_weights(p, 0, 1, gtid, gthreads);
    float2* rope = (float2*)(p.ws + WS_ROPE);
    for (long idx = gtid; idx < (long)NTOK * 32; idx += gthreads) {
        const int j = (int)(idx & 31); const long tok = idx >> 5;
        const float ang = (float)p.pos[tok] * p.inv_freq[j];
        float c, s; sincos_acc(ang, c, s);
        rope[idx] = make_float2(c, s);
    }
    if (gtid < 128) { ((unsigned*)(p.ws + WS_KMAX))[gtid] = 0u; ((unsigned*)(p.ws + WS_PCNT))[gtid * 16] = 0u; ((unsigned*)(p.ws + WS_LCNT))[gtid * 16] = 0u; }
    bf16_t* xb = (bf16_t*)(p.ws + WS_XB);
    for (long idx = gtid; idx < (long)NTOK * 128; idx += gthreads) {
        const f32x4 a = *(const f32x4*)(p.x + idx * 8), b = *(const f32x4*)(p.x + idx * 8 + 4);
        u32x4 w; w.x = pk2(a[0], a[1]); w.y = pk2(a[2], a[3]); w.z = pk2(b[0], b[1]); w.w = pk2(b[2], b[3]);
        *(u32x4*)(xb + idx * 8) = w;
    }
}

constexpr int BM = 256, BK = 64, HALF = 128, HT = HALF * BK;
__device__ __forceinline__ int lds_byte(int r, int c) {
    int st = (r >> 4) * 2 + (c >> 5), rr = r & 15, cc = c & 31, ob = rr * 64 + cc * 2;
    return st * 1024 + (ob ^ (((ob >> 9) & 1) << 5));
}
__device__ __forceinline__ void stage_rc(int b, int& R, int& C) {
    int st = b / 1024, sb = b % 1024, swz = sb ^ (((sb >> 9) & 1) << 5);
    R = (st >> 1) * 16 + swz / 64; C = (st & 1) * 32 + (swz % 64) / 2;
}
__device__ __forceinline__ void tile_of(int L, int nM, int nN, int& pm, int& pn) {
    const int nwg = nM * nN; int wgid = L;
    { const int q = nwg / 8, r = nwg % 8, xcd = wgid % 8, off = wgid / 8; wgid = (xcd < r ? xcd * (q + 1) : r * (q + 1) + (xcd - r) * q) + off; }
    const int nig = 8 * nN, gid = wgid / nig, fm = gid * 8, gsz = (nM - fm) < 8 ? (nM - fm) : 8;
    pm = fm + ((wgid % nig) % gsz); pn = (wgid % nig) / gsz;
}

#define LAS __attribute__((address_space(3)))
template <class Epi>
__device__ __forceinline__ void gemm_tile(LAS unsigned char* lds, const bf16_t* A, int lda, const bf16_t* Bt, int K, int pm, int pn, const Epi& epi, int wid_s) {
    const int tid = otid(wid_s), wid = __builtin_amdgcn_readfirstlane(tid >> 6), lane = tid & 63, wr = wid >> 2, wc = wid & 3, fr = lane & 15, fq = lane >> 4;
    const int nt = K / BK;
    unsigned voffA[2], voffB[2];
#pragma unroll
    for (int i = 0; i < 2; ++i) { int R, C; stage_rc(tid * 16 + i * 8192, R, C); voffA[i] = (unsigned)(R * lda + C) * 2u; voffB[i] = (unsigned)(R * K + C) * 2u; }
    const size_t kstep = (size_t)(BK * 2), hstepA = (size_t)HALF * lda * 2, hstepB = (size_t)HALF * K * 2;
    const unsigned ldsw = (unsigned)wid * 1024u;
    const int aoff = lds_byte(wr * 64 + fr, fq * 8), boff = lds_byte(wc * 32 + fr, fq * 8);
    const char* cA = (const char*)A + (size_t)pm * 2 * hstepA; const char* cB = (const char*)Bt + (size_t)pn * 2 * hstepB;
#define HTB (HALF * BK * 2)
#define SA(b, h) (((b) * 2 + (h)) * HTB)
#define SB(b, h) ((4 + (b) * 2 + (h)) * HTB)
#define STAGE(bufoff, gbase, voff) do { _Pragma("unroll") for (int _i = 0; _i < 2; ++_i) \
        __builtin_amdgcn_global_load_lds((const unsigned*)((const char*)(gbase) + (voff)[_i]), (LAS unsigned*)(lds + (bufoff) + ldsw + _i * 8192), 16, 0, 0); } while (0)
#define LDA(dst, b, h) do { _Pragma("unroll") for (int m = 0; m < 4; ++m) _Pragma("unroll") for (int k = 0; k < 2; ++k) dst[m][k] = *(const LAS bf16x8*)(lds + SA(b, h) + aoff + m * 2048 + k * 1024); } while (0)
#define LDB(dst, b, h) do { _Pragma("unroll") for (int n = 0; n < 2; ++n) _Pragma("unroll") for (int k = 0; k < 2; ++k) dst[n][k] = *(const LAS bf16x8*)(lds + SB(b, h) + boff + n * 2048 + k * 1024); } while (0)
#define MMA(ai, bj, At_, Bt_) do { __builtin_amdgcn_s_setprio(1); _Pragma("unroll") for (int m = 0; m < 4; ++m) _Pragma("unroll") for (int n = 0; n < 2; ++n) _Pragma("unroll") for (int k = 0; k < 2; ++k) \
        acc[ai][bj][m][n] = __builtin_amdgcn_mfma_f32_16x16x32_bf16(Bt_[n][k], At_[m][k], acc[ai][bj][m][n], 0, 0, 0); __builtin_amdgcn_s_setprio(0); } while (0)
#define WAIT_V(n) asm volatile("s_waitcnt vmcnt(" #n ")" ::: "memory")
#define WAIT_L(n) asm volatile("s_waitcnt lgkmcnt(" #n ")" ::: "memory")
#define BAR __builtin_amdgcn_s_barrier()
#define SCHED __builtin_amdgcn_sched_barrier(0)
    f32x4 acc[2][2][4][2];
#pragma unroll
    for (int a = 0; a < 2; ++a)
#pragma unroll
        for (int b = 0; b < 2; ++b)
#pragma unroll
            for (int m = 0; m < 4; ++m)
#pragma unroll
                for (int n = 0; n < 2; ++n) acc[a][b][m][n] = (f32x4){0.f, 0.f, 0.f, 0.f};
    bf16x8 At[4][2], B0[2][2], B1[2][2];
    STAGE(SB(0, 0), cB, voffB); STAGE(SA(0, 0), cA, voffA); STAGE(SB(0, 1), cB + hstepB, voffB); STAGE(SA(0, 1), cA + hstepA, voffA);
    if (wr == 1) BAR;
    WAIT_V(4); BAR;
    STAGE(SB(1, 0), cB + kstep, voffB); STAGE(SA(1, 0), cA + kstep, voffA); STAGE(SB(1, 1), cB + hstepB + kstep, voffB);
    WAIT_V(6); BAR;
    for (int t = 0; t < nt - 2; t += 2) {
        const char* a1 = cA + (size_t)(t + 1) * kstep; const char* a2 = cA + (size_t)(t + 2) * kstep; const char* b2 = cB + (size_t)(t + 2) * kstep;
        const char* a3 = a2 + kstep; const char* b3 = b2 + kstep;
        LDB(B0, 0, 0); SCHED; LDA(At, 0, 0); STAGE(SA(1, 1), a1 + hstepA, voffA);
        WAIT_L(8); BAR; WAIT_L(0); MMA(0, 0, At, B0); BAR; SCHED;
        LDB(B1, 0, 1); STAGE(SB(0, 0), b2, voffB);
        BAR; WAIT_L(0); MMA(0, 1, At, B1); BAR;
        LDA(At, 0, 1); STAGE(SA(0, 0), a2, voffA);
        BAR; WAIT_L(0); MMA(1, 0, At, B0); BAR; SCHED;
        STAGE(SB(0, 1), b2 + hstepB, voffB);
        WAIT_V(6); BAR; MMA(1, 1, At, B1); BAR;
        LDB(B0, 1, 0); SCHED; LDA(At, 1, 0); STAGE(SA(0, 1), a2 + hstepA, voffA);
        WAIT_L(8); BAR; WAIT_L(0); MMA(0, 0, At, B0); BAR; SCHED;
        LDB(B1, 1, 1); STAGE(SB(1, 0), b3, voffB);
        BAR; WAIT_L(0); MMA(0, 1, At, B1); BAR;
        LDA(At, 1, 1); STAGE(SA(1, 0), a3, voffA);
        BAR; WAIT_L(0); MMA(1, 0, At, B0); BAR; SCHED;
        STAGE(SB(1, 1), b3 + hstepB, voffB);
        WAIT_V(6); BAR; MMA(1, 1, At, B1); BAR;
    }
    { const char* a1 = cA + (size_t)(nt - 1) * kstep;
      LDB(B0, 0, 0); LDA(At, 0, 0); STAGE(SA(1, 1), a1 + hstepA, voffA);
      BAR; WAIT_L(0); MMA(0, 0, At, B0); BAR;
      LDB(B1, 0, 1); BAR; WAIT_L(0); MMA(0, 1, At, B1); BAR;
      LDA(At, 0, 1); WAIT_V(4); BAR; WAIT_L(0); MMA(1, 0, At, B0); MMA(1, 1, At, B1); BAR; }
    { LDB(B0, 1, 0); LDA(At, 1, 0); WAIT_V(2); BAR; WAIT_L(0); MMA(0, 0, At, B0); BAR;
      LDB(B1, 1, 1); WAIT_V(0); BAR; WAIT_L(0); MMA(0, 1, At, B1); BAR;
      LDA(At, 1, 1); BAR; WAIT_L(0); MMA(1, 0, At, B0); MMA(1, 1, At, B1); BAR; }
    if (wr == 0) BAR;
    epi(acc, pm * BM, pn * BM, wr, wc, fr, fq);
#undef SA
#undef SB
#undef STAGE
#undef LDA
#undef LDB
#undef MMA
}

struct EpiIn {
    bf16_t* H; float* side; const float* rope; bf16_t* VT; bf16_t* KF; unsigned* kmax; bool dry;
    __device__ __forceinline__ void operator()(f32x4 (&acc)[2][2][4][2], int brow, int bcol, int wr, int wc, int fr, int fq) const {
#pragma unroll
        for (int bj = 0; bj < 2; ++bj) {
            const int hb = bcol + bj * HALF;
            if (hb >= 4224 || dry) continue;
            const int gbase = hb + (wc >> 1) * 64, g64 = gbase >> 6, d0 = (wc & 1) * 16 + 4 * fq;
            const bool rp = (g64 < 16) || (g64 >= 24 && g64 <= 32);
            const float qs = (g64 < 8) ? QSCALE : 1.f;
            float kabs = 0.f;
#pragma unroll
            for (int ai = 0; ai < 2; ++ai)
#pragma unroll
                for (int m = 0; m < 4; ++m) {
                    const long row = brow + ai * HALF + wr * 64 + m * 16 + fr;
                    f32x4 o1 = acc[ai][bj][m][0], o2 = acc[ai][bj][m][1];
                    if (rp) {
                        const f32x4 c0 = *(const f32x4*)(rope + (row * 32 + d0) * 2), c1 = *(const f32x4*)(rope + (row * 32 + d0) * 2 + 4);
                        const f32x4 x1 = o1, x2 = o2;
                        o1[0] = (x1[0] * c0[0] - x2[0] * c0[1]) * qs; o2[0] = (x2[0] * c0[0] + x1[0] * c0[1]) * qs;
                        o1[1] = (x1[1] * c0[2] - x2[1] * c0[3]) * qs; o2[1] = (x2[1] * c0[2] + x1[1] * c0[3]) * qs;
                        o1[2] = (x1[2] * c1[0] - x2[2] * c1[1]) * qs; o2[2] = (x2[2] * c1[0] + x1[2] * c1[1]) * qs;
                        o1[3] = (x1[3] * c1[2] - x2[3] * c1[3]) * qs; o2[3] = (x2[3] * c1[2] + x1[3] * c1[3]) * qs;
                    }
                    if (g64 >= 8 && g64 < 24) {
                        const int bb = (int)(row >> 13), tt = (int)(row & (T - 1)), tile = tt >> 5, tk = tt & 31;
                        if (g64 < 16) {
                            kabs = fmaxf(kabs, fmaxf(fmaxf(fabsf(o1[0]), fabsf(o1[1])), fmaxf(fabsf(o1[2]), fabsf(o1[3]))));
                            kabs = fmaxf(kabs, fmaxf(fmaxf(fabsf(o2[0]), fabsf(o2[1])), fmaxf(fabsf(o2[2]), fabsf(o2[3]))));
                            const long base = ((long)(bb * 8 + (g64 - 8)) * 256 + tile) * 4;
                            const int ks = d0 >> 4, hk = (d0 >> 3) & 1, j0 = d0 & 7;
                            u32x2 w1, w2; w1.x = pk2(o1[0], o1[1]); w1.y = pk2(o1[2], o1[3]); w2.x = pk2(o2[0], o2[1]); w2.y = pk2(o2[2], o2[3]);
                            const auto sx = __builtin_amdgcn_permlane16_swap(w1.x, w2.x, false, false), sy = __builtin_amdgcn_permlane16_swap(w1.y, w2.y, false, false);
                            u32x4 wv; long slot;
                            if (fq & 1) { wv.x = sx[0]; wv.y = sy[0]; wv.z = w2.x; wv.w = w2.y; slot = (base + ks + 2) * 64 + hk * 32 + tk; }
                            else { wv.x = w1.x; wv.y = w1.y; wv.z = sx[1]; wv.w = sy[1]; slot = (base + ks) * 64 + hk * 32 + tk; }
                            *(u32x4*)(KF + slot * 8) = wv;
                        } else {
                            const int s = tk >> 4, u = tk & 15, hv = (u >> 2) & 1, jv = (u >> 3) * 4 + (u & 3);
                            const long base = (((long)(bb * 8 + (g64 - 16)) * 256 + tile) * 2) * 2 + s;
                            bf16_t* v0 = VT + ((base) * 64 + hv * 32 + d0) * 8 + jv;
                            bf16_t* v1 = VT + ((base + 2) * 64 + hv * 32 + d0) * 8 + jv;
#pragma unroll
                            for (int j = 0; j < 4; ++j) { v0[j * 8] = (bf16_t)f2bf(o1[j]); v1[j * 8] = (bf16_t)f2bf(o2[j]); }
                        }
                    } else if (gbase < 4160) {
                        bf16_t* hp = H + row * HP + gbase + d0;
                        u32x2 w1, w2; w1.x = pk2(o1[0], o1[1]); w1.y = pk2(o1[2], o1[3]); w2.x = pk2(o2[0], o2[1]); w2.y = pk2(o2[2], o2[3]);
                        const auto sx = __builtin_amdgcn_permlane16_swap(w1.x, w2.x, false, false), sy = __builtin_amdgcn_permlane16_swap(w1.y, w2.y, false, false);
                        u32x4 wv;
                        if (fq & 1) { wv.x = sx[0]; wv.y = sy[0]; wv.z = w2.x; wv.w = w2.y; hp += 32 - 4; }
                        else { wv.x = w1.x; wv.y = w1.y; wv.z = sx[1]; wv.w = sy[1]; }
                        *(u32x4*)hp = wv;
                    } else if (d0 < 8) { *(f32x4*)(side + row * 24 + d0) = o1 * WI_SCALE; }
                    else if (d0 < 24) { *(f32x4*)(side + row * 24 + d0) = o1; }
                }
            if (g64 >= 8 && g64 < 16) {
#pragma unroll
                for (int o = 32; o >= 1; o >>= 1) kabs = fmaxf(kabs, sxor_f(kabs, fq * 16 + fr, o));
                if ((threadIdx.x & 63) == 0) atomicMax(kmax + (brow >> 13) * 8 + (g64 - 8), __float_as_uint(kabs));
            }
        }
    }
};
struct EpiOut {
    const float* xres; float* out; bool dry;
    __device__ __forceinline__ void operator()(f32x4 (&acc)[2][2][4][2], int brow, int bcol, int wr, int wc, int fr, int fq) const {
#pragma unroll
        for (int ai = 0; ai < 2; ++ai)
#pragma unroll
            for (int m = 0; m < 4; ++m)
#pragma unroll
                for (int bj = 0; bj < 2; ++bj)
#pragma unroll
                    for (int n = 0; n < 2; ++n) {
                        const long idx = (long)(brow + ai * HALF + wr * 64 + m * 16 + fr) * DM + (bcol + bj * HALF + wc * 32 + n * 16 + 4 * fq);
                        const f32x4 xr = *(const f32x4*)(xres + idx);
                        if (!dry) *(f32x4*)(out + idx) = xr * ALPHA + acc[ai][bj][m][n];
                    }
    }
};

__device__ __forceinline__ void ln_phase(const Params& p, int layer, int row_begin, int row_end, int row_step, int lane, bool dry) {
    bf16_t* xb = (bf16_t*)(p.ws + WS_XB);
    const float* g = p.ln_g + layer * DM; const float* bb = p.ln_b + layer * DM;
    for (int row = row_begin; row < row_end; row += row_step) {
        float* zr = p.out + (long)row * DM;
        f32x4 v[4]; float s = 0.f;
#pragma unroll
        for (int r = 0; r < 4; ++r) { v[r] = *(const f32x4*)(zr + r * 256 + lane * 4); s += v[r][0] + v[r][1] + v[r][2] + v[r][3]; }
        const float mu = wave_sum(s, lane) * (1.f / DM);
        float q = 0.f;
#pragma unroll
        for (int r = 0; r < 4; ++r)
#pragma unroll
            for (int e = 0; e < 4; ++e) { const float d = v[r][e] - mu; q += d * d; }
        const float rstd = rsqrtf(wave_sum(q, lane) * (1.f / DM) + EPS);
#pragma unroll
        for (int r = 0; r < 4; ++r) {
            const f32x4 gg = *(const f32x4*)(g + r * 256 + lane * 4), bv = *(const f32x4*)(bb + r * 256 + lane * 4);
            f32x4 y;
#pragma unroll
            for (int e = 0; e < 4; ++e) y[e] = (v[r][e] - mu) * rstd * gg[e] + bv[e];
            if (dry) continue;
            *(f32x4*)(zr + r * 256 + lane * 4) = y;
            u32x2 w; w.x = pk2(y[0], y[1]); w.y = pk2(y[2], y[3]);
            *(u32x2*)(xb + (long)row * DM + r * 256 + lane * 4) = w;
        }
    }
}

__device__ __forceinline__ void conformer_tile(const Params& p, int layer, unsigned char* lds, int tile, bool dry, int wid_s) {
    bf16_t* H = (bf16_t*)(p.ws + WS_H);
    const int tid = otid(wid_s), lane = tid & 63, w = tid >> 6;
    const int tok0 = tile * 64, b = tok0 / T, tl0 = tok0 % T;
    bf16_t* hg = (bf16_t*)lds;
    float* cv = (float*)(lds + 49152);
    for (int idx = tid; idx < 94 * 32; idx += 512) {
        const int r = idx >> 5, cc = (idx & 31) * 8, tl = tl0 - 30 + r;
        u32x4 o = {0u, 0u, 0u, 0u};
        if (tl >= 0) {
            const bf16_t* src = H + ((long)b * T + tl) * HP + HGLU + cc;
            const u32x4 va = *(const u32x4*)src, ga = *(const u32x4*)(src + 256);
            o.x = pk2(bflo(va.x) * sigmoid_f(bflo(ga.x)), bfhi(va.x) * sigmoid_f(bfhi(ga.x)));
            o.y = pk2(bflo(va.y) * sigmoid_f(bflo(ga.y)), bfhi(va.y) * sigmoid_f(bfhi(ga.y)));
            o.z = pk2(bflo(va.z) * sigmoid_f(bflo(ga.z)), bfhi(va.z) * sigmoid_f(bfhi(ga.z)));
            o.w = pk2(bflo(va.w) * sigmoid_f(bflo(ga.w)), bfhi(va.w) * sigmoid_f(bfhi(ga.w)));
        }
        *(u32x4*)(hg + r * 256 + cc) = o;
    }
    __syncthreads();
    {
        const int c = tid & 255, half = tid >> 8;
        const float* cw = p.conv_w + (long)layer * 31 * 256 + c;
        float wj[31];
#pragma unroll
        for (int j = 0; j < 31; ++j) wj[j] = cw[j * 256];
        const float cb = p.conv_b[layer * 256 + c];
        float win[62];
#pragma unroll
        for (int r = 0; r < 62; ++r) win[r] = bf2f(hg[(half * 32 + r) * 256 + c]);
#pragma unroll
        for (int tt = 0; tt < 32; ++tt) {
            float a = cb;
#pragma unroll
            for (int j = 0; j < 31; ++j) a = fmaf(win[tt + j], wj[j], a);
            cv[(half * 32 + tt) * 256 + c] = a;
        }
    }
    __syncthreads();
    bf16_t* at = (bf16_t*)lds;
    {
        const f32x4 gg = *(const f32x4*)(p.cln_g + layer * 256 + lane * 4), bv = *(const f32x4*)(p.cln_b + layer * 256 + lane * 4);
#pragma unroll
        for (int tt = 0; tt < 8; ++tt) {
            const int t = w * 8 + tt;
            const f32x4 v = *(const f32x4*)(cv + t * 256 + lane * 4);
            const float mu = wave_sum(v[0] + v[1] + v[2] + v[3], lane) * (1.f / 256.f);
            float q = 0.f;
#pragma unroll
            for (int e = 0; e < 4; ++e) { const float d = v[e] - mu; q += d * d; }
            const float rstd = rsqrtf(wave_sum(q, lane) * (1.f / 256.f) + EPS);
            float y[4];
#pragma unroll
            for (int e = 0; e < 4; ++e) y[e] = silu_f((v[e] - mu) * rstd * gg[e] + bv[e]);
            u32x2 o; o.x = pk2(y[0], y[1]); o.y = pk2(y[2], y[3]);
            *(u32x2*)(at + t * 264 + lane * 4) = o;
        }
    }
    __syncthreads();
    {
        f32x16 acc0 = {}, acc1 = {};
        const bf16_t* pwt = (const bf16_t*)(p.ws + WS_PWT) + (long)layer * 65536 + (w * 32 + (lane & 31)) * 256 + 8 * (lane >> 5);
        const bf16_t* ap = at + (lane & 31) * 264 + 8 * (lane >> 5);
#pragma unroll 4
        for (int ks = 0; ks < 16; ++ks) {
            const bf16x8 bfr = *(const bf16x8*)(pwt + ks * 16);
            const bf16x8 a0 = *(const bf16x8*)(ap + ks * 16), a1 = *(const bf16x8*)(ap + 32 * 264 + ks * 16);
            acc0 = __builtin_amdgcn_mfma_f32_32x32x16_bf16(a0, bfr, acc0, 0, 0, 0);
            acc1 = __builtin_amdgcn_mfma_f32_32x32x16_bf16(a1, bfr, acc1, 0, 0, 0);
        }
        const int ch = w * 32 + (lane & 31);
        const float pb = p.pw_b[layer * 256 + ch];
#pragma unroll
        for (int i = 0; i < 16; ++i) {
            const int row = (i & 3) + 8 * (i >> 2) + 4 * (lane >> 5);
            bf16_t* g0 = H + (long)(tok0 + row) * HP + HBG + ch;
            bf16_t* g1 = H + (long)(tok0 + 32 + row) * HP + HBG + ch;
            const unsigned r0 = f2bf((acc0[i] + pb) * silu_f(bf2f(*g0))), r1 = f2bf((acc1[i] + pb) * silu_f(bf2f(*g1)));
            if (!dry) { *g0 = (bf16_t)r0; *g1 = (bf16_t)r1; }
        }
    }
    __syncthreads();
}

__device__ __forceinline__ float rdlane(float v, int l) { return __uint_as_float(__builtin_amdgcn_readlane(__float_as_uint(v), l)); }

__device__ __forceinline__ void gla_local_item(const Params& p, int layer, int item_, int lane, bool dry) {
    const int item = __builtin_amdgcn_readfirstlane(item_);
    bf16_t* H = (bf16_t*)(p.ws + WS_H);
    const float* side = (const float*)(p.ws + WS_SIDE);
    float* bcum = (float*)(p.ws + WS_BCUM); float* U = (float*)(p.ws + WS_U); float* DEC = (float*)(p.ws + WS_DEC);
    const int bh = item >> 7, c = item & 127, b = bh >> 2, h = bh & 3;
    const long tok0 = (long)b * T + c * 64, tok = tok0 + lane;
    float clr[16];
#pragma unroll
    for (int r = 0; r < 4; ++r) { const f32x4 v = *(const f32x4*)(side + tok * 24 + 8 + r * 4); clr[r * 4] = v[0]; clr[r * 4 + 1] = v[1]; clr[r * 4 + 2] = v[2]; clr[r * 4 + 3] = v[3]; }
    const float* gw = p.gate_w2 + (long)layer * 16 * 128 + h * 32; const float* gb = p.gate_b + layer * 128 + h * 32;
    float* bcp = bcum + tok * 128 + h * 32;
#pragma unroll 1
    for (int d = 0; d < 32; ++d) {
        float z = gb[d];
#pragma unroll
        for (int r = 0; r < 16; ++r) z = fmaf(clr[r], gw[r * 128 + d], z);
        float g = (fminf(z, 0.f) - __logf(1.f + __expf(-fabsf(z)))) * (1.f / 16.f);
#pragma unroll
        for (int o = 1; o < 64; o <<= 1) { const float up = __int_as_float(bperm_i((lane - o) & 63, __float_as_int(g))); if (lane >= o) g += up; }
        bcp[d] = g;
    }
    float bc[32];
#pragma unroll
    for (int r = 0; r < 8; ++r) { const f32x4 v = *(const f32x4*)(bcp + r * 4); bc[r * 4] = v[0]; bc[r * 4 + 1] = v[1]; bc[r * 4 + 2] = v[2]; bc[r * 4 + 3] = v[3]; }
    float kk[32];
    {
        const bf16_t* kp = H + tok * HP + HCK + h * 32;
#pragma unroll
        for (int r = 0; r < 4; ++r) {
            const u32x4 kv = *(const u32x4*)(kp + r * 8);
            kk[r * 8 + 0] = bflo(kv.x); kk[r * 8 + 1] = bfhi(kv.x); kk[r * 8 + 2] = bflo(kv.y); kk[r * 8 + 3] = bfhi(kv.y);
            kk[r * 8 + 4] = bflo(kv.z); kk[r * 8 + 5] = bfhi(kv.z); kk[r * 8 + 6] = bflo(kv.w); kk[r * 8 + 7] = bfhi(kv.w);
        }
#pragma unroll
        for (int d = 0; d < 32; ++d) { const float bl = rdlane(bc[d], 63); kk[d] *= __expf(bl - bc[d]); }
    }
    float acc[32];
#pragma unroll
    for (int d = 0; d < 32; ++d) acc[d] = 0.f;
    const bf16_t* vp = H + tok0 * HP + HCV + h * 64 + lane;
#pragma unroll 1
    for (int t8 = 0; t8 < 64; t8 += 8) {
        float vv[8];
#pragma unroll
        for (int u = 0; u < 8; ++u) vv[u] = bf2f(vp[(long)(t8 + u) * HP]);
#pragma unroll
        for (int u = 0; u < 8; ++u)
#pragma unroll
            for (int d = 0; d < 32; ++d) acc[d] = fmaf(rdlane(kk[d], t8 + u), vv[u], acc[d]);
    }
#pragma unroll
    for (int d = 0; d < 32; ++d) if (!dry) U[(long)item * 2048 + d * 64 + lane] = acc[d];
    if (lane == 63) {
#pragma unroll
        for (int r = 0; r < 8; ++r) { f32x4 v = {__expf(bc[r * 4]), __expf(bc[r * 4 + 1]), __expf(bc[r * 4 + 2]), __expf(bc[r * 4 + 3])}; *(f32x4*)(DEC + item * 32 + r * 4) = v; }
    }
}

__device__ __forceinline__ void gla_scan(const Params& p, int gt) {
    float* U = (float*)(p.ws + WS_U); const float* DEC = (const float*)(p.ws + WS_DEC);
    const int bh = gt >> 11, de = gt & 2047, d = de >> 6;
    float s = 0.f;
    for (int c0 = 0; c0 < 128; c0 += 32) {
        float u[32], dc[32];
#pragma unroll
        for (int i = 0; i < 32; ++i) { u[i] = U[(long)(bh * 128 + c0 + i) * 2048 + de]; dc[i] = DEC[(bh * 128 + c0 + i) * 32 + d]; }
#pragma unroll
        for (int i = 0; i < 32; ++i) { U[(long)(bh * 128 + c0 + i) * 2048 + de] = s; s = fmaf(dc[i], s, u[i]); }
    }
}

__device__ __forceinline__ void gla_out_item(const Params& p, int layer, unsigned char* ldsw, int item_, int lane, bool dry) {
    const int item = __builtin_amdgcn_readfirstlane(item_);
    bf16_t* H = (bf16_t*)(p.ws + WS_H);
    const float* bcum = (const float*)(p.ws + WS_BCUM); const float* U = (const float*)(p.ws + WS_U);
    float* sA = (float*)ldsw; bf16_t* sV = (bf16_t*)(ldsw + 8192);
    const int bh = item >> 7, c = item & 127, b = bh >> 2, h = bh & 3;
    const long tok = (long)b * T + c * 64 + lane;
#pragma unroll
    for (int r = 0; r < 8; ++r) *(f32x4*)(sA + r * 256 + lane * 4) = *(const f32x4*)(U + (long)item * 2048 + r * 256 + lane * 4);
#pragma unroll
    for (int r = 0; r < 8; ++r) *(u32x4*)(sV + lane * 64 + r * 8) = *(const u32x4*)(H + tok * HP + HCV + h * 64 + r * 8);
    WAVE_SYNC();
    float o[64];
#pragma unroll
    for (int e = 0; e < 64; ++e) o[e] = 0.f;
    {
        const bf16_t* qp = H + tok * HP + HCQ + h * 32; const float* bp = bcum + tok * 128 + h * 32;
#pragma unroll 1
        for (int d = 0; d < 32; ++d) {
            const float qd = bf2f(qp[d]) * 0.17677669529663687f * __expf(bp[d]);
#pragma unroll
            for (int e4 = 0; e4 < 16; ++e4) {
                const f32x4 s4 = *(const f32x4*)(sA + d * 64 + e4 * 4);
                o[e4 * 4] = fmaf(qd, s4[0], o[e4 * 4]); o[e4 * 4 + 1] = fmaf(qd, s4[1], o[e4 * 4 + 1]);
                o[e4 * 4 + 2] = fmaf(qd, s4[2], o[e4 * 4 + 2]); o[e4 * 4 + 3] = fmaf(qd, s4[3], o[e4 * 4 + 3]);
            }
        }
    }
    WAVE_SYNC();
    {
        const bf16_t* kp = H + tok * HP + HCK + h * 32;
#pragma unroll
        for (int r = 0; r < 4; ++r) {
            const u32x4 kv = *(const u32x4*)(kp + r * 8);
            const f32x4 b0 = *(const f32x4*)(bcum + tok * 128 + h * 32 + r * 8), b1 = *(const f32x4*)(bcum + tok * 128 + h * 32 + r * 8 + 4);
            f32x4 k0 = {bflo(kv.x) * __expf(-b0[0]), bfhi(kv.x) * __expf(-b0[1]), bflo(kv.y) * __expf(-b0[2]), bfhi(kv.y) * __expf(-b0[3])};
            f32x4 k1 = {bflo(kv.z) * __expf(-b1[0]), bfhi(kv.z) * __expf(-b1[1]), bflo(kv.w) * __expf(-b1[2]), bfhi(kv.w) * __expf(-b1[3])};
            *(f32x4*)(sA + lane * 32 + r * 8) = k0; *(f32x4*)(sA + lane * 32 + r * 8 + 4) = k1;
        }
    }
    float qe[32];
    {
        const bf16_t* qp = H + tok * HP + HCQ + h * 32;
#pragma unroll
        for (int r = 0; r < 4; ++r) {
            const u32x4 qv = *(const u32x4*)(qp + r * 8);
            const f32x4 b0 = *(const f32x4*)(bcum + tok * 128 + h * 32 + r * 8), b1 = *(const f32x4*)(bcum + tok * 128 + h * 32 + r * 8 + 4);
            const float qq[8] = {bflo(qv.x), bfhi(qv.x), bflo(qv.y), bfhi(qv.y), bflo(qv.z), bfhi(qv.z), bflo(qv.w), bfhi(qv.w)};
            const float bb[8] = {b0[0], b0[1], b0[2], b0[3], b1[0], b1[1], b1[2], b1[3]};
#pragma unroll
            for (int e = 0; e < 8; ++e) qe[r * 8 + e] = qq[e] * 0.17677669529663687f * __expf(bb[e]);
        }
    }
    WAVE_SYNC();
#pragma unroll 1
    for (int j = 0; j < 64; ++j) {
        float a = 0.f;
#pragma unroll
        for (int d4 = 0; d4 < 8; ++d4) {
            const f32x4 k4 = *(const f32x4*)(sA + j * 32 + d4 * 4);
            a = fmaf(qe[d4 * 4], k4[0], a); a = fmaf(qe[d4 * 4 + 1], k4[1], a); a = fmaf(qe[d4 * 4 + 2], k4[2], a); a = fmaf(qe[d4 * 4 + 3], k4[3], a);
        }
        if (j > lane) a = 0.f;
#pragma unroll
        for (int e8 = 0; e8 < 8; ++e8) {
            const u32x4 v8 = *(const u32x4*)(sV + j * 64 + e8 * 8);
            o[e8 * 8 + 0] = fmaf(a, bflo(v8.x), o[e8 * 8 + 0]); o[e8 * 8 + 1] = fmaf(a, bfhi(v8.x), o[e8 * 8 + 1]);
            o[e8 * 8 + 2] = fmaf(a, bflo(v8.y), o[e8 * 8 + 2]); o[e8 * 8 + 3] = fmaf(a, bfhi(v8.y), o[e8 * 8 + 3]);
            o[e8 * 8 + 4] = fmaf(a, bflo(v8.z), o[e8 * 8 + 4]); o[e8 * 8 + 5] = fmaf(a, bfhi(v8.z), o[e8 * 8 + 5]);
            o[e8 * 8 + 6] = fmaf(a, bflo(v8.w), o[e8 * 8 + 6]); o[e8 * 8 + 7] = fmaf(a, bfhi(v8.w), o[e8 * 8 + 7]);
        }
    }
    float ss = 0.f;
#pragma unroll
    for (int e = 0; e < 64; ++e) ss = fmaf(o[e], o[e], ss);
    const float rms = rsqrtf(ss * (1.f / 64.f) + EPS);
    const float* gn = p.gnorm_g + layer * 256 + h * 64;
    bf16_t* cg_p = H + tok * HP + HCG + h * 64;
#pragma unroll
    for (int r = 0; r < 8; ++r) {
        const u32x4 gv = *(const u32x4*)(cg_p + r * 8);
        const float gq[8] = {bflo(gv.x), bfhi(gv.x), bflo(gv.y), bfhi(gv.y), bflo(gv.z), bfhi(gv.z), bflo(gv.w), bfhi(gv.w)};
        float y[8];
#pragma unroll
        for (int e = 0; e < 8; ++e) y[e] = o[r * 8 + e] * rms * gn[r * 8 + e] * silu_f(gq[e]);
        u32x4 w; w.x = pk2(y[0], y[1]); w.y = pk2(y[2], y[3]); w.z = pk2(y[4], y[5]); w.w = pk2(y[6], y[7]);
        if (!dry) *(u32x4*)(cg_p + r * 8) = w;
    }
    WAVE_SYNC();
}

constexpr int MPITCH = 260;
constexpr int HPITCH = 516;
constexpr int L_HIST = 0;
constexpr int L_CAND = 66560;
constexpr int L_CCNT = L_CAND + 65536;
constexpr int L_QINF = L_CCNT + 2048;
constexpr int L_MTAB = L_QINF + 1024 + 64;
static_assert(L_MTAB + 8192 <= LDS_BYTES, "dsa lds");
__device__ __forceinline__ int mpos(int rr) { return 16 * ((rr >> 2) & 1) + (rr & 3) + 4 * (rr >> 3); }
constexpr int SUBCAP = 32;

__device__ __forceinline__ unsigned mono_bits(float f) { const unsigned u = __float_as_uint(f); return u ^ ((u >> 31) ? 0xffffffffu : 0x80000000u); }
__device__ __forceinline__ void idx_loadk(const bf16_t* Hb, int s0, int lane, bf16x8 (&kf)[2][2]) {
    const bf16_t* kp = Hb + (long)(s0 + (lane & 15)) * HP + HKI + 8 * (lane >> 4);
#pragma unroll
    for (int kb = 0; kb < 2; ++kb)
#pragma unroll
        for (int ks = 0; ks < 2; ++ks) kf[kb][ks] = *(const bf16x8*)(kp + (long)kb * 16 * HP + ks * 32);
}
__device__ __forceinline__ void idx_scores(const bf16x8 (&kf)[2][2], const bf16x8 (&qf)[8][2], const bf16x8 (&ql)[2][2], const float (&wh)[8], float (&score)[8]) {
    f32x4 lin[2];
#pragma unroll
    for (int kb = 0; kb < 2; ++kb) {
        lin[kb] = (f32x4){0.f, 0.f, 0.f, 0.f};
#pragma unroll
        for (int ks = 0; ks < 2; ++ks) {
            lin[kb] = __builtin_amdgcn_mfma_f32_16x16x32_bf16(kf[kb][ks], ql[0][ks], lin[kb], 0, 0, 0);
            lin[kb] = __builtin_amdgcn_mfma_f32_16x16x32_bf16(kf[kb][ks], ql[1][ks], lin[kb], 0, 0, 0);
        }
    }
#pragma unroll
    for (int i = 0; i < 8; ++i) score[i] = lin[i >> 2][i & 3];
#pragma unroll
    for (int hd = 0; hd < 8; ++hd) {
        f32x4 acc[2];
#pragma unroll
        for (int kb = 0; kb < 2; ++kb) {
            acc[kb] = (f32x4){0.f, 0.f, 0.f, 0.f};
#pragma unroll
            for (int ks = 0; ks < 2; ++ks) acc[kb] = __builtin_amdgcn_mfma_f32_16x16x32_bf16(kf[kb][ks], qf[hd][ks], acc[kb], 0, 0, 0);
        }
#pragma unroll
        for (int kb = 0; kb < 2; ++kb)
#pragma unroll
            for (int i = 0; i < 4; ++i) score[kb * 4 + i] = fmaf(fabsf(acc[kb][i]), wh[hd], score[kb * 4 + i]);
        if ((hd & 3) == 3) __builtin_amdgcn_sched_barrier(0);
    }
}

template <bool FAST>
__device__ __forceinline__ void attn_tile(const bf16x8 (&kf)[4], const bf16x8 (&vf)[4], const bf16x8 (&qfr)[2][4], f32x16 (&O)[2][2], float (&mrun)[2], float (&lrun)[2],
                                          const unsigned* hist, const float* mtab, int r32, int hh, int tile) {
#pragma unroll
    for (int qb = 0; qb < 2; ++qb) {
        f32x16 S;
        const unsigned mw = hist[(qb * 32 + r32) * MPITCH + tile] >> (16 * hh);
#pragma unroll
        for (int g8 = 0; g8 < 2; ++g8) {
            const float* mt = mtab + ((mw >> (8 * g8)) & 255u) * 8;
            const f32x4 ma = *(const f32x4*)mt, mb = *(const f32x4*)(mt + 4);
            S[8 * g8] = ma[0]; S[8 * g8 + 1] = ma[1]; S[8 * g8 + 2] = ma[2]; S[8 * g8 + 3] = ma[3];
            S[8 * g8 + 4] = mb[0]; S[8 * g8 + 5] = mb[1]; S[8 * g8 + 6] = mb[2]; S[8 * g8 + 7] = mb[3];
        }
#pragma unroll
        for (int ks = 0; ks < 4; ++ks) S = __builtin_amdgcn_mfma_f32_32x32x16_bf16(kf[ks], qfr[qb][ks], S, 0, 0, 0);
        float pr[16]; float ps = 0.f;
        if (FAST) {
#pragma unroll
            for (int i = 0; i < 16; ++i) { pr[i] = __builtin_amdgcn_exp2f(S[i]); ps += pr[i]; }
        } else {
            float mx = fmaxf(fmaxf(S[0], S[1]), S[2]);
#pragma unroll
            for (int i = 3; i < 15; i += 2) mx = fmaxf(fmaxf(mx, S[i]), S[i + 1]);
            mx = fmaxf(mx, S[15]);
            { const auto sw = __builtin_amdgcn_permlane32_swap(__float_as_uint(mx), __float_as_uint(mx), false, false); mx = fmaxf(__uint_as_float(sw[0]), __uint_as_float(sw[1])); }
            if (__any(mx > mrun[qb])) {
                const float mnew = fmaxf(mx, mrun[qb]);
                const float alpha = __builtin_amdgcn_exp2f(mrun[qb] - mnew);
                mrun[qb] = mnew; lrun[qb] *= alpha;
#pragma unroll
                for (int db = 0; db < 2; ++db)
#pragma unroll
                    for (int i = 0; i < 16; ++i) O[db][qb][i] *= alpha;
            }
            const float mref = fmaxf(mrun[qb], -1000.f);
#pragma unroll
            for (int i = 0; i < 16; ++i) { pr[i] = __builtin_amdgcn_exp2f(S[i] - mref); ps += pr[i]; }
        }
        lrun[qb] += ps;
        bf16x8 pf[2];
#pragma unroll
        for (int s = 0; s < 2; ++s) {
            u32x4 pw; pw.x = pk2(pr[8 * s], pr[8 * s + 1]); pw.y = pk2(pr[8 * s + 2], pr[8 * s + 3]); pw.z = pk2(pr[8 * s + 4], pr[8 * s + 5]); pw.w = pk2(pr[8 * s + 6], pr[8 * s + 7]);
            pf[s] = __builtin_bit_cast(bf16x8, pw);
        }
#pragma unroll
        for (int db = 0; db < 2; ++db)
#pragma unroll
            for (int s = 0; s < 2; ++s) O[db][qb] = __builtin_amdgcn_mfma_f32_32x32x16_bf16(vf[db * 2 + s], pf[s], O[db][qb], 0, 0, 0);
    }
}
template <bool FAST>
__device__ __forceinline__ void attn_loop(const bf16_t* Kp, const bf16_t* Vp, const bf16x8 (&qfr)[2][4], f32x16 (&O)[2][2], float (&mrun)[2], float (&lrun)[2],
                                          const unsigned* hist, const float* mtab, int r32, int hh, int nt32, bool dry2) {
    bf16x8 kf[4], vf[4], kg[4], vg[4];
#pragma unroll
    for (int ks = 0; ks < 4; ++ks) { kf[ks] = *(const bf16x8*)(Kp + ks * 512); vf[ks] = *(const bf16x8*)(Vp + ks * 512); }
#pragma unroll 1
    for (int tile = 0; tile < nt32; tile += 2) {
        {
            const int tn = dry2 ? 0 : tile + 1;
#pragma unroll
            for (int ks = 0; ks < 4; ++ks) { kg[ks] = *(const bf16x8*)(Kp + (long)tn * 2048 + ks * 512); vg[ks] = *(const bf16x8*)(Vp + (long)tn * 2048 + ks * 512); }
        }
        attn_tile<FAST>(kf, vf, qfr, O, mrun, lrun, hist, mtab, r32, hh, tile);
        {
            const int tn = dry2 ? 0 : ((tile + 2 < nt32) ? tile + 2 : tile);
#pragma unroll
            for (int ks = 0; ks < 4; ++ks) { kf[ks] = *(const bf16x8*)(Kp + (long)tn * 2048 + ks * 512); vf[ks] = *(const bf16x8*)(Vp + (long)tn * 2048 + ks * 512); }
        }
        attn_tile<FAST>(kg, vg, qfr, O, mrun, lrun, hist, mtab, r32, hh, tile + 1);
    }
}

__device__ __forceinline__ void dsa_item(const Params& p, unsigned char* lds, int b, int qblk, bool dry, int wid_s, const unsigned* kmaxL) {
    bf16_t* H = (bf16_t*)(p.ws + WS_H);
    const float* side = (const float*)(p.ws + WS_SIDE);
    const bf16_t* Hb = H + (long)b * T * HP;
    const int tid = otid(wid_s), lane = tid & 63, w = tid >> 6, hq = lane >> 4;
    const int qg = w & 3, kh = w >> 2;
    const int t0 = qblk * 64, qloc = qg * 16 + (lane & 15), t = t0 + qloc;
    unsigned* hist = (unsigned*)(lds + L_HIST);
    unsigned* cand = (unsigned*)(lds + L_CAND);
    unsigned* ccnt = (unsigned*)(lds + L_CCNT);
    int* qinf = (int*)(lds + L_QINF);

    for (int i = tid; i < 64 * MPITCH; i += 512) hist[i] = 0u;
    for (int i = tid; i < 2048; i += 512) ((float*)(lds + L_MTAB))[i] = ((i >> 3) >> (i & 7)) & 1 ? 0.f : -1e30f;
    bf16x8 qf[8][2]; bf16x8 ql[2][2]; float wi[8]; float inv, fb0c;
    {
        const bf16_t* qp = Hb + (long)t * HP + HQI + 8 * hq;
#pragma unroll
        for (int hd = 0; hd < 8; ++hd)
#pragma unroll
            for (int ks = 0; ks < 2; ++ks) qf[hd][ks] = *(const bf16x8*)(qp + hd * 64 + ks * 32);
        const float* sp = side + ((long)b * T + t) * 24;
        const f32x4 w0 = *(const f32x4*)sp, w1 = *(const f32x4*)(sp + 4);
        wi[0] = w0[0]; wi[1] = w0[1]; wi[2] = w0[2]; wi[3] = w0[3]; wi[4] = w1[0]; wi[5] = w1[1]; wi[6] = w1[2]; wi[7] = w1[3];
        float n2 = 0.f;
#pragma unroll
        for (int i = 0; i < 8; ++i) n2 = fmaf(wi[i], wi[i], n2);
        const float nrm = fmaxf(SIG_UNIT * sqrtf(n2), 1e-30f);
        inv = 64.f / nrm;
        fb0c = 256.f - 64.f * 3.19f * (wi[0] + wi[1] + wi[2] + wi[3] + wi[4] + wi[5] + wi[6] + wi[7]) / nrm;
#pragma unroll
        for (int i = 0; i < 8; ++i) wi[i] *= 0.5f;
#pragma unroll
        for (int ks = 0; ks < 2; ++ks) {
            float ql_f[8];
#pragma unroll
            for (int j = 0; j < 8; ++j) ql_f[j] = 0.f;
#pragma unroll
            for (int hd = 0; hd < 8; ++hd) {
                const u32x4 qv = __builtin_bit_cast(u32x4, qf[hd][ks]);
                ql_f[0] = fmaf(wi[hd], bflo(qv.x), ql_f[0]); ql_f[1] = fmaf(wi[hd], bfhi(qv.x), ql_f[1]); ql_f[2] = fmaf(wi[hd], bflo(qv.y), ql_f[2]); ql_f[3] = fmaf(wi[hd], bfhi(qv.y), ql_f[3]);
                ql_f[4] = fmaf(wi[hd], bflo(qv.z), ql_f[4]); ql_f[5] = fmaf(wi[hd], bfhi(qv.z), ql_f[5]); ql_f[6] = fmaf(wi[hd], bflo(qv.w), ql_f[6]); ql_f[7] = fmaf(wi[hd], bfhi(qv.w), ql_f[7]);
            }
            u32x4 hi4; hi4.x = pk2(ql_f[0], ql_f[1]); hi4.y = pk2(ql_f[2], ql_f[3]); hi4.z = pk2(ql_f[4], ql_f[5]); hi4.w = pk2(ql_f[6], ql_f[7]);
            u32x4 lo4;
            lo4.x = pk2(ql_f[0] - bflo(hi4.x), ql_f[1] - bfhi(hi4.x)); lo4.y = pk2(ql_f[2] - bflo(hi4.y), ql_f[3] - bfhi(hi4.y));
            lo4.z = pk2(ql_f[4] - bflo(hi4.z), ql_f[5] - bfhi(hi4.z)); lo4.w = pk2(ql_f[6] - bflo(hi4.w), ql_f[7] - bfhi(hi4.w));
            ql[0][ks] = __builtin_bit_cast(bf16x8, hi4); ql[1][ks] = __builtin_bit_cast(bf16x8, lo4);
        }
    }
    const int ntile = (t0 + 64 + 127) >> 7;
    const int tmaxw = t0 + qg * 16 + 15;
    __syncthreads();
    int nit = 0;
    { const int v = tmaxw - kh * 64; if (v >= 0) nit = 2 * (v >> 7) + (((v & 127) >= 32) ? 2 : 1); }
    float fa = inv, fbias = fb0c;
    bool active = true;
#pragma unroll 1
    for (int level = 0; level < 2; ++level) {
        unsigned* hbase = level ? cand : hist;
        const bool wave_on = __any(active);
        if (wave_on) {
            const unsigned incv = 1u << ((qloc & 1) * 16);
            unsigned* hrow = hbase + (qloc >> 1) * HPITCH;
            bf16x8 kf[2][2];
            idx_loadk(Hb, kh * 64, lane, kf);
#pragma unroll 1
            for (int it = 0; it < nit; ++it) {
                const int s0 = (it >> 1) * 128 + kh * 64 + (it & 1) * 32;
                const int itn = (it + 1 < nit) ? it + 1 : it;
                bf16x8 kn[2][2];
                idx_loadk(Hb, (itn >> 1) * 128 + kh * 64 + (itn & 1) * 32, lane, kn);
                float score[8];
                idx_scores(kf, qf, ql, wi, score);
                if (s0 + 31 <= t0 + qg * 16) {
#pragma unroll
                    for (int i = 0; i < 8; ++i) { const unsigned bin = (unsigned)__builtin_amdgcn_fmed3f(fmaf(score[i], fa, fbias), 0.f, 511.5f); atomicAdd(hrow + bin, incv); }
                } else {
#pragma unroll
                    for (int i = 0; i < 8; ++i) {
                        const int s = s0 + (i >> 2) * 16 + hq * 4 + (i & 3);
                        if (s <= t) { const unsigned bin = (unsigned)__builtin_amdgcn_fmed3f(fmaf(score[i], fa, fbias), 0.f, 511.5f); atomicAdd(hrow + bin, incv); }
                    }
                }
#pragma unroll
                for (int kb = 0; kb < 2; ++kb)
#pragma unroll
                    for (int ks = 0; ks < 2; ++ks) kf[kb][ks] = kn[kb][ks];
            }
        }
        __syncthreads();
#pragma unroll 1
        for (int qq = 0; qq < 8; ++qq) {
            const int q = w * 8 + qq;
            if (level && !qinf[q * 4 + 3]) continue;
            const u32x4 wa = *(const u32x4*)(hbase + (q >> 1) * HPITCH + 8 * lane), wb = *(const u32x4*)(hbase + (q >> 1) * HPITCH + 8 * lane + 4);
            const int sh = (q & 1) * 16;
            const unsigned c[8] = {(wa.x >> sh) & 0xffffu, (wa.y >> sh) & 0xffffu, (wa.z >> sh) & 0xffffu, (wa.w >> sh) & 0xffffu, (wb.x >> sh) & 0xffffu, (wb.y >> sh) & 0xffffu, (wb.z >> sh) & 0xffffu, (wb.w >> sh) & 0xffffu};
            const unsigned tot = c[0] + c[1] + c[2] + c[3] + c[4] + c[5] + c[6] + c[7];
            unsigned S = tot;
#pragma unroll
            for (int o = 1; o < 64; o <<= 1) { const unsigned dn = (unsigned)bperm_i((lane + o) & 63, (int)S); if (lane + o < 64) S += dn; }
            const unsigned total = (unsigned)__builtin_amdgcn_readfirstlane((int)S);
            const u64 bal = __ballot(S >= 256u);
            int b1 = -1, r1 = 0, n1 = 0;
            if (total >= 256u) {
                const int Ls = 63 - __clzll(bal);
                unsigned cum = S - tot; bool found = false; int lb = -1, lr = 0, ln = 0;
#pragma unroll
                for (int j = 7; j >= 0; --j) { const bool hit = !found && (cum + c[j] >= 256u); if (hit) { lb = 8 * lane + j; lr = 256 - (int)cum; ln = (int)c[j]; found = true; } cum += c[j]; }
                b1 = bperm_i(Ls, lb); r1 = bperm_i(Ls, lr); n1 = bperm_i(Ls, ln);
            }
            if (lane == 0) { qinf[q * 4] = b1; qinf[q * 4 + 1] = r1; qinf[q * 4 + 2] = n1; }
        }
        __syncthreads();
        if (level == 0) { for (int i = tid; i < 64 * MPITCH; i += 512) hist[i] = 0u; }
        if (tid == 0) qinf[256] = 0;
        __syncthreads();
        if (wave_on) {
            const int b1 = qinf[qloc * 4];
            const float fsel = !active ? __builtin_inff() : ((b1 < 0) ? -__builtin_inff() : ((b1 >= 511) ? __builtin_inff() : (float)(b1 + 1)));
            const float fcand = !active ? __builtin_inff() : ((b1 <= 0) ? -__builtin_inff() : (float)b1);
            const float fb1 = (float)(b1 < 0 ? 0 : b1);
            unsigned* cslot = cand + (qloc * 8 + kh * 4 + hq) * SUBCAP; int ncand = 0;
            bf16x8 kf[2][2];
            idx_loadk(Hb, kh * 64, lane, kf);
#pragma unroll 1
            for (int it = 0; it < nit; ++it) {
                const int s0 = (it >> 1) * 128 + kh * 64 + (it & 1) * 32;
                const int itn = (it + 1 < nit) ? it + 1 : it;
                bf16x8 kn[2][2];
                idx_loadk(Hb, (itn >> 1) * 128 + kh * 64 + (itn & 1) * 32, lane, kn);
                float score[8];
                idx_scores(kf, qf, ql, wi, score);
                unsigned m0 = 0u;
                if (s0 + 31 <= t0 + qg * 16) {
#pragma unroll
                    for (int i = 0; i < 8; ++i) {
                        const int rr = (i >> 2) * 16 + hq * 4 + (i & 3), s = s0 + rr;
                        const float fb = fmaf(score[i], fa, fbias);
                        if (fb >= fcand) {
                            if (fb >= fsel) m0 |= 1u << (16 * (hq & 1) + 4 * (hq >> 1) + (i & 3) + 8 * (i >> 2));
                            else {
                                const unsigned q19 = (unsigned)__builtin_amdgcn_fmed3f((fb - fb1) * 524288.f, 0.f, 524287.f);
                                if (ncand < SUBCAP) cslot[ncand] = (q19 << 13) | (unsigned)(8191 - s);
                                ++ncand;
                            }
                        }
                    }
                } else {
#pragma unroll
                    for (int i = 0; i < 8; ++i) {
                        const int rr = (i >> 2) * 16 + hq * 4 + (i & 3), s = s0 + rr;
                        const float fb = fmaf(score[i], fa, fbias);
                        if (fb >= fcand && s <= t) {
                            if (fb >= fsel) m0 |= 1u << (16 * (hq & 1) + 4 * (hq >> 1) + (i & 3) + 8 * (i >> 2));
                            else {
                                const unsigned q19 = (unsigned)__builtin_amdgcn_fmed3f((fb - fb1) * 524288.f, 0.f, 524287.f);
                                if (ncand < SUBCAP) cslot[ncand] = (q19 << 13) | (unsigned)(8191 - s);
                                ++ncand;
                            }
                        }
                    }
                }
                if (m0) atomicOr(&hist[qloc * MPITCH + (s0 >> 5)], m0);
#pragma unroll
                for (int kb = 0; kb < 2; ++kb)
#pragma unroll
                    for (int ks = 0; ks < 2; ++ks) kf[kb][ks] = kn[kb][ks];
            }
            ccnt[qloc * 8 + kh * 4 + hq] = (unsigned)ncand;
        } else ccnt[qloc * 8 + kh * 4 + hq] = 0u;
        __syncthreads();
#pragma unroll 1
        for (int qq = 0; qq < 8; ++qq) {
            const int q = w * 8 + qq;
            if (level && !qinf[q * 4 + 3]) continue;
            const int r1 = qinf[q * 4 + 1];
            const int wr_ = lane >> 3, sl0 = (lane & 7) * 4;
            int cw = (int)ccnt[q * 8 + wr_];
            const bool ovf = __any(cw > SUBCAP) && (level == 0);
            if (lane == 0) { qinf[q * 4 + 3] = ovf ? 1 : 0; if (ovf) qinf[256] = 1; }
            if (ovf || r1 <= 0) continue;
            if (cw > SUBCAP) cw = SUBCAP;
            const u32x4 mine = *(const u32x4*)(cand + (q * 8 + wr_) * SUBCAP + sl0);
            int rk0 = 0, rk1 = 0, rk2 = 0, rk3 = 0;
#pragma unroll 1
            for (int ww = 0; ww < 8; ++ww) {
                int cn = (int)ccnt[q * 8 + ww]; if (cn > SUBCAP) cn = SUBCAP;
                const unsigned* cl = cand + (q * 8 + ww) * SUBCAP;
#pragma unroll 1
                for (int j = 0; j < cn; ++j) { const unsigned cv = cl[j]; rk0 += (cv > mine.x); rk1 += (cv > mine.y); rk2 += (cv > mine.z); rk3 += (cv > mine.w); }
            }
            if (sl0 + 0 < cw && rk0 < r1) { const int s = 8191 - (int)(mine.x & 8191u); atomicOr(&hist[q * MPITCH + (s >> 5)], 1u << mpos(s & 31)); }
            if (sl0 + 1 < cw && rk1 < r1) { const int s = 8191 - (int)(mine.y & 8191u); atomicOr(&hist[q * MPITCH + (s >> 5)], 1u << mpos(s & 31)); }
            if (sl0 + 2 < cw && rk2 < r1) { const int s = 8191 - (int)(mine.z & 8191u); atomicOr(&hist[q * MPITCH + (s >> 5)], 1u << mpos(s & 31)); }
            if (sl0 + 3 < cw && rk3 < r1) { const int s = 8191 - (int)(mine.w & 8191u); atomicOr(&hist[q * MPITCH + (s >> 5)], 1u << mpos(s & 31)); }
        }
        __syncthreads();
        if (level == 1 || qinf[256] == 0) break;
        {
            const bool mine_ovf = qinf[qloc * 4 + 3] != 0;
            const int b1 = qinf[qloc * 4];
            active = mine_ovf;
            fa = mine_ovf ? inv * 510.f : 0.f;
            fbias = mine_ovf ? fmaf(fb0c - (float)b1, 510.f, 1.f) : -1.f;
        }
        for (int i = tid; i < 32 * HPITCH; i += 512) cand[i] = 0u;
        __syncthreads();
    }
    for (int rep2_ = ((PROBE_PHASE == 41) ? 0 : 1); rep2_ < 2; ++rep2_) {
        const bool dry2 = dry || ((PROBE_PHASE == 41) && (rep2_ == 0) && (p.pos[0] == 0));
        const int head = w, r32 = lane & 31, hh = lane >> 5;
        bf16x8 qfr[2][4];
        float q1 = 0.f;
#pragma unroll
        for (int qb = 0; qb < 2; ++qb) {
            float qa = 0.f;
#pragma unroll
            for (int ks = 0; ks < 4; ++ks) {
                qfr[qb][ks] = *(const bf16x8*)(Hb + (long)(t0 + qb * 32 + r32) * HP + HQ + head * 64 + ks * 16 + 8 * hh);
                const u32x4 qv = __builtin_bit_cast(u32x4, qfr[qb][ks]);
                qa += fabsf(bflo(qv.x)) + fabsf(bfhi(qv.x)) + fabsf(bflo(qv.y)) + fabsf(bfhi(qv.y)) + fabsf(bflo(qv.z)) + fabsf(bfhi(qv.z)) + fabsf(bflo(qv.w)) + fabsf(bfhi(qv.w));
            }
            q1 = fmaxf(q1, qa);
        }
        q1 += sxor_f(q1, lane, 32);
#pragma unroll
        for (int o = 16; o >= 1; o >>= 1) q1 = fmaxf(q1, sxor_f(q1, lane, o));
        const float kmx = __uint_as_float(kmaxL[b * 8 + head]);
        const bool fast = (q1 * kmx * 1.02f) < 100.f;
        f32x16 O[2][2];
#pragma unroll
        for (int a = 0; a < 2; ++a)
#pragma unroll
            for (int c2 = 0; c2 < 2; ++c2)
#pragma unroll
                for (int i = 0; i < 16; ++i) O[a][c2][i] = 0.f;
        float mrun[2] = {-1e30f, -1e30f}, lrun[2] = {0.f, 0.f};
        const bf16_t* Kp = (const bf16_t*)(p.ws + WS_KF) + ((long)(b * 8 + head) * 256 * 4 * 64 + lane) * 8;
        const bf16_t* Vp = (const bf16_t*)(p.ws + WS_VT) + ((long)(b * 8 + head) * 256 * 4 * 64 + lane) * 8;
        const int nt32 = (t0 + 64) >> 5;
        if (fast) attn_loop<true>(Kp, Vp, qfr, O, mrun, lrun, hist, (const float*)(lds + L_MTAB), r32, hh, nt32, dry2);
        else attn_loop<false>(Kp, Vp, qfr, O, mrun, lrun, hist, (const float*)(lds + L_MTAB), r32, hh, nt32, dry2);
#pragma unroll
        for (int qb = 0; qb < 2; ++qb) {
            const float lt = lrun[qb] + sxor_f(lrun[qb], lane, 32);
            const float il = 1.f / lt;
            bf16_t* gp = H + ((long)b * T + t0 + qb * 32 + r32) * HP + HAG + head * 64 + 4 * hh;
#pragma unroll
            for (int db = 0; db < 2; ++db)
#pragma unroll
                for (int g4 = 0; g4 < 4; ++g4) {
                    bf16_t* gq = gp + db * 32 + 8 * g4;
                    const u32x2 gv = *(const u32x2*)gq;
                    u32x2 wv;
                    wv.x = pk2(O[db][qb][4 * g4] * il * silu_f(bflo(gv.x)), O[db][qb][4 * g4 + 1] * il * silu_f(bfhi(gv.x)));
                    wv.y = pk2(O[db][qb][4 * g4 + 2] * il * silu_f(bflo(gv.y)), O[db][qb][4 * g4 + 3] * il * silu_f(bfhi(gv.y)));
                    if (!dry2) *(u32x2*)gq = wv;
                }
        }
    }
    __syncthreads();
}

__device__ __forceinline__ void gbar(unsigned* ctr, unsigned target) {
    __syncthreads();
    if (threadIdx.x == 0) {
        __builtin_amdgcn_fence(__ATOMIC_RELEASE, "agent");
        __hip_atomic_fetch_add(ctr, 1u, __ATOMIC_RELAXED, __HIP_MEMORY_SCOPE_AGENT);
        while (__hip_atomic_load(ctr, __ATOMIC_RELAXED, __HIP_MEMORY_SCOPE_AGENT) < target) __builtin_amdgcn_s_sleep(2);
        __builtin_amdgcn_fence(__ATOMIC_ACQUIRE, "agent");
    }
    __syncthreads();
}

__device__ __forceinline__ void ho_arrive(unsigned* ctr) {
    __syncthreads();
    if (threadIdx.x == 0) { __builtin_amdgcn_fence(__ATOMIC_RELEASE, "agent"); __hip_atomic_fetch_add(ctr, 1u, __ATOMIC_RELAXED, __HIP_MEMORY_SCOPE_AGENT); }
}
__device__ __forceinline__ void ho_wait(unsigned* ctr, unsigned target) {
    if (threadIdx.x == 0) {
        while (__hip_atomic_load(ctr, __ATOMIC_RELAXED, __HIP_MEMORY_SCOPE_AGENT) < target) __builtin_amdgcn_s_sleep(2);
        __builtin_amdgcn_fence(__ATOMIC_ACQUIRE, "agent");
    }
    __syncthreads();
}

__global__ void __launch_bounds__(512) fwd_megakernel(Params p0) {
    extern __shared__ __attribute__((aligned(16))) unsigned char lds[];
    cg::grid_group grid = cg::this_grid();
    const int G = gridDim.x, c = blockIdx.x;
    const int wid_s = __builtin_amdgcn_readfirstlane((int)(threadIdx.x >> 6));

    unsigned* barctr = (unsigned*)(p0.ws + WS_BAR); unsigned bar_n = 0;
    if (c == 0 && threadIdx.x < 3) __hip_atomic_store(barctr + 16 * threadIdx.x, 0u, __ATOMIC_RELAXED, __HIP_MEMORY_SCOPE_AGENT);
    for (int rep0_ = (PROBE_PHASE == 8 ? 0 : 1); rep0_ < 2; ++rep0_) prologue(p0, (long)c * 512 + threadIdx.x, (long)G * 512);
    grid.sync();

#pragma unroll 1
    for (int layer = 0; layer < DEPTH; ++layer) {
        Params p = p0;
        { size_t zoff = 0; asm volatile("" : "+s"(zoff)); p.ws = p0.ws + zoff; }
        bf16_t* H = (bf16_t*)(p.ws + WS_H);
        {
for (int rep_ = (PROBE_PHASE == 1 ? 0 : 1); rep_ < 2; ++rep_) { const bool dry = (PROBE_PHASE == 1) && (rep_ == 0) && (p.pos[0] == 0);
            EpiIn e; e.H = H; e.side = (float*)(p.ws + WS_SIDE); e.rope = (const float*)(p.ws + WS_ROPE); e.VT = (bf16_t*)(p.ws + WS_VT); e.KF = (bf16_t*)(p.ws + WS_KF); e.kmax = (unsigned*)(p.ws + WS_KMAX) + layer * 32; e.dry = dry;
            const bf16_t* A = (const bf16_t*)(p.ws + WS_XB);
            const bf16_t* Bt = (const bf16_t*)(p.ws + WS_WIN) + (long)layer * NPAD * 1024;
#pragma unroll 1
            for (int L = c; L < 128 * 17; L += G) { int pm, pn; tile_of(L, 128, 17, pm, pn); if (layer) ho_wait((unsigned*)(p.ws + WS_LCNT) + pm * 16, 2u * (unsigned)layer); gemm_tile((LAS unsigned char*)lds, A, 1024, Bt, 1024, pm, pn, e, wid_s); }
            {
                const int rem = (128 * 17) % G;
                if (layer + 1 < DEPTH && c >= rem) convert_weights(p, layer + 1, layer + 2, (long)(c - rem) * 512 + otid(wid_s), (long)(G - rem) * 512);
            }
}
        }
        gbar(barctr, (++bar_n) * (unsigned)G); if (PROBE_PHASE == 9) gbar(barctr, (++bar_n) * (unsigned)G);
        {
for (int rep_ = (PROBE_PHASE == 2 ? 0 : 1); rep_ < 2; ++rep_) { const bool dry = (PROBE_PHASE == 2) && (rep_ == 0) && (p.pos[0] == 0);
            const int tid = otid(wid_s), lane = tid & 63, w = tid >> 6;
#pragma unroll 1
            for (int g = c; g < 256; g += G) gla_local_item(p, layer, g * 8 + w, lane, dry);
}
        }
        ho_arrive(barctr + 16);
        if (c < 64) {
            ho_wait(barctr + 16, (unsigned)(layer + 1) * (unsigned)G);
            const int tid = otid(wid_s);
#pragma unroll 1
            for (int g = c; g < 64; g += G) gla_scan(p, g * 512 + tid);
            ho_arrive(barctr + 32);
        }
for (int rep_ = (PROBE_PHASE == 3 ? 0 : 1); rep_ < 2; ++rep_) { const bool dry = (PROBE_PHASE == 3) && (rep_ == 0) && (p.pos[0] == 0);
#pragma unroll 1
        for (int tile = c; tile < 512; tile += G) conformer_tile(p, layer, lds, tile, dry, wid_s);
}
for (int rep_ = (PROBE_PHASE == 4 ? 0 : 1); rep_ < 2; ++rep_) { const bool dry = (PROBE_PHASE == 4) && (rep_ == 0) && (p.pos[0] == 0);
#pragma unroll 1
        for (int it = c; it < 512; it += G) {
            const int pr = it >> 1, second = it & 1;
            const int xcd = pr & 7, j = pr >> 3, b = xcd >> 1, par = xcd & 1;
            const int qblk = second ? (2 * j + par) : 127 - (2 * j + par);
            dsa_item(p, lds, b, qblk, dry, wid_s, (const unsigned*)(p.ws + WS_KMAX) + layer * 32);
        }
}
        ho_wait(barctr + 32, (unsigned)(layer + 1) * (unsigned)(G < 64 ? G : 64));
        {
for (int rep_ = (PROBE_PHASE == 5 ? 0 : 1); rep_ < 2; ++rep_) { const bool dry = (PROBE_PHASE == 5) && (rep_ == 0) && (p.pos[0] == 0);
            const int tid = otid(wid_s), lane = tid & 63, w = tid >> 6;
#pragma unroll 1
            for (int g = c; g < 256; g += G) gla_out_item(p, layer, lds + w * 16384, g * 8 + w, lane, dry);
}
        }
        gbar(barctr, (++bar_n) * (unsigned)G); if (PROBE_PHASE == 9) gbar(barctr, (++bar_n) * (unsigned)G);
        {
for (int rep_ = (PROBE_PHASE == 6 ? 0 : 1); rep_ < 2; ++rep_) { const bool dry = (PROBE_PHASE == 6) && (rep_ == 0) && (p.pos[0] == 0);
            EpiOut e; e.xres = (layer == 0) ? p.x : p.out; e.out = p.out; e.dry = dry;
            const bf16_t* A = H + HAG;
            const bf16_t* Bt = (const bf16_t*)(p.ws + WS_WOUT) + (long)layer * 1024 * 1024;
#pragma unroll 1
            for (int L = c; L < 128 * 4; L += G) { int pm, pn; tile_of(L, 128, 4, pm, pn); gemm_tile((LAS unsigned char*)lds, A, HP, Bt, 1024, pm, pn, e, wid_s); ho_arrive((unsigned*)(p.ws + WS_PCNT) + pm * 16); }
}
        }
        {
for (int rep_ = (PROBE_PHASE == 7 ? 0 : 1); rep_ < 2; ++rep_) { const bool dry = (PROBE_PHASE == 7) && (rep_ == 0) && (p.pos[0] == 0);
            const int tid = otid(wid_s), lane = tid & 63, w = tid >> 6;
#pragma unroll 1
            for (int hp = c; hp < 256; hp += G) {
                ho_wait((unsigned*)(p.ws + WS_PCNT) + (hp >> 1) * 16, 4u * (unsigned)(layer + 1));
                const int base = (hp >> 1) * 256 + (hp & 1) * 128;
                ln_phase(p, layer, base + w, base + 128, 8, lane, dry);
                ho_arrive((unsigned*)(p.ws + WS_LCNT) + (hp >> 1) * 16);
            }
}
        }
    }
}

extern "C" void kernel_launch(void* const* d_in, const int* in_sizes, int n_in, void* d_out, int out_size, void* d_ws, size_t ws_size, hipStream_t stream) {
    static int grid_blocks = 0;
    if (grid_blocks == 0) {
        if (n_in != 15 || ws_size < WS_END) { fprintf(stderr, "kernel_launch: unexpected inputs (n_in %d, ws %zu < %zu)\n", n_in, ws_size, (size_t)WS_END); grid_blocks = -1; return; }
        int dev = 0, cus = 0, per_cu = 0;
        hipGetDevice(&dev);
        hipDeviceGetAttribute(&cus, hipDeviceAttributeMultiprocessorCount, dev);
        if (hipFuncSetAttribute((const void*)fwd_megakernel, hipFuncAttributeMaxDynamicSharedMemorySize, LDS_BYTES) != hipSuccess) { fprintf(stderr, "kernel_launch: hipFuncSetAttribute failed\n"); grid_blocks = -1; return; }
        hipOccupancyMaxActiveBlocksPerMultiprocessor(&per_cu, (const void*)fwd_megakernel, 512, LDS_BYTES);
        if (per_cu < 1) per_cu = 1;
        grid_blocks = cus * per_cu;
    }
    if (grid_blocks < 0) return;
    Params p{};
    p.x = (const float*)d_in[0]; p.pos = (const int*)d_in[1]; p.w_in = (const float*)d_in[2]; p.conv_w = (const float*)d_in[3]; p.conv_b = (const float*)d_in[4];
    p.cln_g = (const float*)d_in[5]; p.cln_b = (const float*)d_in[6]; p.pw_w = (const float*)d_in[7]; p.pw_b = (const float*)d_in[8];
    p.gate_w2 = (const float*)d_in[9]; p.gate_b = (const float*)d_in[10]; p.gnorm_g = (const float*)d_in[11]; p.w_out = (const float*)d_in[12];
    p.ln_g = (const float*)d_in[13]; p.ln_b = (const float*)d_in[14];
    p.out = (float*)d_out; p.ws = (unsigned char*)d_ws;
    for (int j = 0; j < 32; ++j) p.inv_freq[j] = (float)pow(10000.0, -(double)j / 32.0);
    void* args[] = {&p};
    hipError_t e = hipLaunchCooperativeKernel((const void*)fwd_megakernel, dim3(grid_blocks), dim3(512), args, LDS_BYTES, stream);
    if (e != hipSuccess) fprintf(stderr, "cooperative launch failed: %s (grid %d)\n", hipGetErrorString(e), grid_blocks);
}
```

```cpp
#include <hip/hip_runtime.h>
#include <hip/hip_cooperative_groups.h>
#include <cstdio>
#include <cmath>
namespace cg = cooperative_groups;

typedef unsigned short bf16_t;
typedef short bf16x8 __attribute__((ext_vector_type(8)));
typedef float f32x4 __attribute__((ext_vector_type(4)));
typedef float f32x16 __attribute__((ext_vector_type(16)));
typedef unsigned u32x4 __attribute__((ext_vector_type(4)));
typedef unsigned u32x2 __attribute__((ext_vector_type(2)));
typedef unsigned long long u64;

constexpr int NB = 4, T = 8192, NTOK = NB * T, DM = 1024, DIN = 4184, NPAD = 4352, HP = 4160, DEPTH = 4;
constexpr int HQ = 0, HK = 512, HV = 1024, HQI = 1536, HKI = 2048, HGLU = 2112, HCQ = 2624, HCK = 2752, HCV = 2880, HAG = 3136, HBG = 3648, HCG = 3904;
constexpr float EPS = 1e-5f;
constexpr float ALPHA = 1.6817928305074290f;
constexpr float QSCALE = 0.125f * 1.4426950408889634f;
constexpr float WI_SCALE = 0.04419417382415922f;
constexpr float SIG_UNIT = 5.66f;
constexpr int CAP = 128;

constexpr size_t WS_WIN = 0;
constexpr size_t WS_WOUT = WS_WIN + (size_t)DEPTH * NPAD * 1024 * 2;
constexpr size_t WS_PWT = WS_WOUT + (size_t)DEPTH * 1024 * 1024 * 2;
constexpr size_t WS_ROPE = WS_PWT + (size_t)DEPTH * 256 * 256 * 2;
constexpr size_t WS_XB = WS_ROPE + (size_t)NTOK * 32 * 8;
constexpr size_t WS_H = WS_XB + (size_t)NTOK * 1024 * 2;
constexpr size_t WS_SIDE = WS_H + (size_t)NTOK * HP * 2;
constexpr size_t WS_BCUM = WS_SIDE + (size_t)NTOK * 24 * 4;
constexpr size_t WS_U = WS_BCUM + (size_t)NTOK * 128 * 4;
constexpr size_t WS_DEC = WS_U + (size_t)2048 * 2048 * 4;
constexpr size_t WS_VT = WS_DEC + (size_t)2048 * 32 * 4;
constexpr size_t WS_KF = WS_VT + (size_t)NTOK * 512 * 2;
constexpr size_t WS_BAR = WS_KF + (size_t)NTOK * 512 * 2;
constexpr size_t WS_KMAX = WS_BAR + 256;
constexpr size_t WS_PCNT = WS_KMAX + 512;
constexpr size_t WS_LCNT = WS_PCNT + 128 * 64;
constexpr size_t WS_END = WS_LCNT + 128 * 64;

#ifndef PROBE_PHASE
#define PROBE_PHASE 0
#endif
constexpr int LDS_BYTES = 147456;

struct Params {
    const float* x; const int* pos; const float* w_in; const float* conv_w; const float* conv_b; const float* cln_g; const float* cln_b;
    const float* pw_w; const float* pw_b; const float* gate_w2; const float* gate_b; const float* gnorm_g; const float* w_out; const float* ln_g; const float* ln_b;
    float* out; unsigned char* ws;
    float inv_freq[32];
};

__device__ __forceinline__ unsigned f2bf(float f) { unsigned u = __float_as_uint(f); return (u + 0x7fffu + ((u >> 16) & 1u)) >> 16; }
__device__ __forceinline__ float bf2f(unsigned b) { return __uint_as_float(b << 16); }
typedef float f32x2_t __attribute__((ext_vector_type(2)));
typedef __bf16 bf16x2_t __attribute__((ext_vector_type(2)));
__device__ __forceinline__ unsigned pk2(float lo, float hi) { f32x2_t v = {lo, hi}; bf16x2_t b = __builtin_convertvector(v, bf16x2_t); return __builtin_bit_cast(unsigned, b); }
__device__ __forceinline__ float bflo(unsigned w) { return __uint_as_float(w << 16); }
__device__ __forceinline__ float bfhi(unsigned w) { return __uint_as_float(w & 0xffff0000u); }
__device__ __forceinline__ float silu_f(float v) { return v / (1.f + __expf(-v)); }
__device__ __forceinline__ float sigmoid_f(float v) { return 1.f / (1.f + __expf(-v)); }
__device__ __forceinline__ int bperm_i(int idx, int v) { return __builtin_amdgcn_ds_bpermute(idx << 2, v); }
__device__ __forceinline__ float sxor_f(float v, int lane, int m) { return __int_as_float(bperm_i(lane ^ m, __float_as_int(v))); }
__device__ __forceinline__ int sxor_i(int v, int lane, int m) { return bperm_i(lane ^ m, v); }
__device__ __forceinline__ float wave_sum(float v, int lane) {
#pragma unroll
    for (int o = 32; o >= 1; o >>= 1) v += sxor_f(v, lane, o);
    return v;
}
__device__ __forceinline__ int otid(int wid_s) { int l; asm volatile("v_mbcnt_lo_u32_b32 %0, -1, 0\n\tv_mbcnt_hi_u32_b32 %0, -1, %0" : "=v"(l)); return (wid_s << 6) | l; }
#define WAVE_SYNC() do { __builtin_amdgcn_fence(__ATOMIC_RELEASE, "wavefront"); __builtin_amdgcn_wave_barrier(); __builtin_amdgcn_fence(__ATOMIC_ACQUIRE, "wavefront"); } while (0)

__device__ __forceinline__ int l2orig(int l) {
    if (l < 1536) return l;
    if (l < 2048) return 2048 + (l - 1536);
    if (l < 2112) return 2560 + (l - 2048);
    if (l < 2624) return 2632 + (l - 2112);
    if (l < 2752) return 3400 + (l - 2624);
    if (l < 2880) return 3528 + (l - 2752);
    if (l < 3136) return 3656 + (l - 2880);
    if (l < 3648) return 1536 + (l - 3136);
    if (l < 3904) return 3144 + (l - 3648);
    if (l < 4160) return 3912 + (l - 3904);
    if (l < 4168) return 2624 + (l - 4160);
    if (l < 4184) return 4168 + (l - 4168);
    return -1;
}
__device__ __forceinline__ int npos2logical(int np) {
    const int hb = np & ~127, p = np & 127, wc = p >> 5, n = (p >> 4) & 1, fr = p & 15;
    return hb + (wc >> 1) * 64 + n * 32 + (wc & 1) * 16 + fr;
}

__device__ __forceinline__ void sincos_acc(float angf, float& c, float& s) {
    const double a = (double)angf;
    const double n = rint(a * 0.15915494309189535);
    double r = fma(-n, 6.283185307179586, a);
    r = fma(-n, 2.4492935982947064e-16, r);
    const double r2 = r * r;
    double ts = r, tc = 1.0, ss = r, cc = 1.0;
#pragma unroll
    for (int k = 1; k <= 14; ++k) {
        tc = -tc * r2 * (1.0 / (double)((2 * k - 1) * (2 * k)));
        ts = -ts * r2 * (1.0 / (double)((2 * k) * (2 * k + 1)));
        cc += tc; ss += ts;
    }
    c = (float)cc; s = (float)ss;
}

__device__ __forceinline__ void convert_weights(const Params& p, int l0, int l1, long gtid, long gthreads) {
    bf16_t* win = (bf16_t*)(p.ws + WS_WIN);
    for (long idx = gtid; idx < (long)(l1 - l0) * 128 * NPAD; idx += gthreads) {
        const int np = (int)(idx % NPAD); const long r = idx / NPAD; const int kc = (int)(r % 128); const int l = l0 + (int)(r / 128);
        const int oc = l2orig(npos2logical(np));
        u32x4 w = {0u, 0u, 0u, 0u};
        if (oc >= 0) {
            const float* src = p.w_in + ((long)l * 1024 + kc * 8) * DIN + oc;
            float v[8];
#pragma unroll
            for (int i = 0; i < 8; ++i) v[i] = src[(long)i * DIN];
            w.x = pk2(v[0], v[1]); w.y = pk2(v[2], v[3]); w.z = pk2(v[4], v[5]); w.w = pk2(v[6], v[7]);
        }
        *(u32x4*)(win + ((long)l * NPAD + np) * 1024 + kc * 8) = w;
    }
    bf16_t* wout = (bf16_t*)(p.ws + WS_WOUT);
    for (long idx = gtid; idx < (long)(l1 - l0) * 128 * 1024; idx += gthreads) {
        const int n = (int)(idx % 1024); const long r = idx / 1024; const int kc = (int)(r % 128); const int l = l0 + (int)(r / 128);
        const float* src = p.w_out + ((long)l * 1024 + kc * 8) * 1024 + n;
        float v[8];
#pragma unroll
        for (int i = 0; i < 8; ++i) v[i] = src[(long)i * 1024];
        u32x4 w; w.x = pk2(v[0], v[1]); w.y = pk2(v[2], v[3]); w.z = pk2(v[4], v[5]); w.w = pk2(v[6], v[7]);
        *(u32x4*)(wout + ((long)l * 1024 + n) * 1024 + kc * 8) = w;
    }
    bf16_t* pwt = (bf16_t*)(p.ws + WS_PWT);
    for (long idx = gtid; idx < (long)(l1 - l0) * 32 * 256; idx += gthreads) {
        const int n = (int)(idx % 256); const long r = idx / 256; const int kc = (int)(r % 32); const int l = l0 + (int)(r / 32);
        const float* src = p.pw_w + ((long)l * 256 + kc * 8) * 256 + n;
        float v[8];
#pragma unroll
        for (int i = 0; i < 8; ++i) v[i] = src[(long)i * 256];
        u32x4 w; w.x = pk2(v[0], v[1]); w.y = pk2(v[2], v[3]); w.z = pk2(v[4], v[5]); w.w = pk2(v[6], v[7]);
        *(u32x4*)(pwt + ((long)l * 256 + n) * 256 + kc * 8) = w;
    }
}

__device__ __forceinline__ void prologue(const Params& p, long gtid, long gthreads) {
    convert_weights(p, 0, 1, gtid, gthreads);
    float2* rope = (float2*)(p.ws + WS_ROPE);
    for (long idx = gtid; idx < (long)NTOK * 32; idx += gthreads) {
        const int j = (int)(idx & 31); const long tok = idx >> 5;
        const float ang = (float)p.pos[tok] * p.inv_freq[j];
        float c, s; sincos_acc(ang, c, s);
        rope[idx] = make_float2(c, s);
    }
    if (gtid < 128) { ((unsigned*)(p.ws + WS_KMAX))[gtid] = 0u; ((unsigned*)(p.ws + WS_PCNT))[gtid * 16] = 0u; ((unsigned*)(p.ws + WS_LCNT))[gtid * 16] = 0u; }
    bf16_t* xb = (bf16_t*)(p.ws + WS_XB);
    for (long idx = gtid; idx < (long)NTOK * 128; idx += gthreads) {
        const f32x4 a = *(const f32x4*)(p.x + idx * 8), b = *(const f32x4*)(p.x + idx * 8 + 4);
        u32x4 w; w.x = pk2(a[0], a[1]); w.y = pk2(a[2], a[3]); w.z = pk2(b[0], b[1]); w.w = pk2(b[2], b[3]);
        *(u32x4*)(xb + idx * 8) = w;
    }
}

constexpr int BM = 256, BK = 64, HALF = 128, HT = HALF * BK;
__device__ __forceinline__ int lds_byte(int r, int c) {
    int st = (r >> 4) * 2 + (c >> 5), rr = r & 15, cc = c & 31, ob = rr * 64 + cc * 2;
    return st * 1024 + (ob ^ (((ob >> 9) & 1) << 5));
}
__device__ __forceinline__ void stage_rc(int b, int& R, int& C) {
    int st = b / 1024, sb = b % 1024, swz = sb ^ (((sb >> 9) & 1) << 5);
    R = (st >> 1) * 16 + swz / 64; C = (st & 1) * 32 + (swz % 64) / 2;
}
__device__ __forceinline__ void tile_of(int L, int nM, int nN, int& pm, int& pn) {
    const int nwg = nM * nN; int wgid = L;
    { const int q = nwg / 8, r = nwg % 8, xcd = wgid % 8, off = wgid / 8; wgid = (xcd < r ? xcd * (q + 1) : r * (q + 1) + (xcd - r) * q) + off; }
    const int nig = 8 * nN, gid = wgid / nig, fm = gid * 8, gsz = (nM - fm) < 8 ? (nM - fm) : 8;
    pm = fm + ((wgid % nig) % gsz); pn = (wgid % nig) / gsz;
}

#define LAS __attribute__((address_space(3)))
template <class Epi>
__device__ __forceinline__ void gemm_tile(LAS unsigned char* lds, const bf16_t* A, int lda, const bf16_t* Bt, int K, int pm, int pn, const Epi& epi, int wid_s) {
    const int tid = otid(wid_s), wid = __builtin_amdgcn_readfirstlane(tid >> 6), lane = tid & 63, wr = wid >> 2, wc = wid & 3, fr = lane & 15, fq = lane >> 4;
    const int nt = K / BK;
    unsigned voffA[2], voffB[2];
#pragma unroll
    for (int i = 0; i < 2; ++i) { int R, C; stage_rc(tid * 16 + i * 8192, R, C); voffA[i] = (unsigned)(R * lda + C) * 2u; voffB[i] = (unsigned)(R * K + C) * 2u; }
    const size_t kstep = (size_t)(BK * 2), hstepA = (size_t)HALF * lda * 2, hstepB = (size_t)HALF * K * 2;
    const unsigned ldsw = (unsigned)wid * 1024u;
    const int aoff = lds_byte(wr * 64 + fr, fq * 8), boff = lds_byte(wc * 32 + fr, fq * 8);
    const char* cA = (const char*)A + (size_t)pm * 2 * hstepA; const char* cB = (const char*)Bt + (size_t)pn * 2 * hstepB;
#define HTB (HALF * BK * 2)
#define SA(b, h) (((b) * 2 + (h)) * HTB)
#define SB(b, h) ((4 + (b) * 2 + (h)) * HTB)
#define STAGE(bufoff, gbase, voff) do { _Pragma("unroll") for (int _i = 0; _i < 2; ++_i) \
        __builtin_amdgcn_global_load_lds((const unsigned*)((const char*)(gbase) + (voff)[_i]), (LAS unsigned*)(lds + (bufoff) + ldsw + _i * 8192), 16, 0, 0); } while (0)
#define LDA(dst, b, h) do { _Pragma("unroll") for (int m = 0; m < 4; ++m) _Pragma("unroll") for (int k = 0; k < 2; ++k) dst[m][k] = *(const LAS bf16x8*)(lds + SA(b, h) + aoff + m * 2048 + k * 1024); } while (0)
#define LDB(dst, b, h) do { _Pragma("unroll") for (int n = 0; n < 2; ++n) _Pragma("unroll") for (int k = 0; k < 2; ++k) dst[n][k] = *(const LAS bf16x8*)(lds + SB(b, h) + boff + n * 2048 + k * 1024); } while (0)
#define MMA(ai, bj, At_, Bt_) do { __builtin_amdgcn_s_setprio(1); _Pragma("unroll") for (int m = 0; m < 4; ++m) _Pragma("unroll") for (int n = 0; n < 2; ++n) _Pragma("unroll") for (int k = 0; k < 2; ++k) \
        acc[ai][bj][m][n] = __builtin_amdgcn_mfma_f32_16x16x32_bf16(Bt_[n][k], At_[m][k], acc[ai][bj][m][n], 0, 0, 0); __builtin_amdgcn_s_setprio(0); } while (0)
#define WAIT_V(n) asm volatile("s_waitcnt vmcnt(" #n ")" ::: "memory")
#define WAIT_L(n) asm volatile("s_waitcnt lgkmcnt(" #n ")" ::: "memory")
#define BAR __builtin_amdgcn_s_barrier()
#define SCHED __builtin_amdgcn_sched_barrier(0)
    f32x4 acc[2][2][4][2];
#pragma unroll
    for (int a = 0; a < 2; ++a)
#pragma unroll
        for (int b = 0; b < 2; ++b)
#pragma unroll
            for (int m = 0; m < 4; ++m)
#pragma unroll
                for (int n = 0; n < 2; ++n) acc[a][b][m][n] = (f32x4){0.f, 0.f, 0.f, 0.f};
    bf16x8 At[4][2], B0[2][2], B1[2][2];
    STAGE(SB(0, 0), cB, voffB); STAGE(SA(0, 0), cA, voffA); STAGE(SB(0, 1), cB + hstepB, voffB); STAGE(SA(0, 1), cA + hstepA, voffA);
    if (wr == 1) BAR;
    WAIT_V(4); BAR;
    STAGE(SB(1, 0), cB + kstep, voffB); STAGE(SA(1, 0), cA + kstep, voffA); STAGE(SB(1, 1), cB + hstepB + kstep, voffB);
    WAIT_V(6); BAR;
    for (int t = 0; t < nt - 2; t += 2) {
        const char* a1 = cA + (size_t)(t + 1) * kstep; const char* a2 = cA + (size_t)(t + 2) * kstep; const char* b2 = cB + (size_t)(t + 2) * kstep;
        const char* a3 = a2 + kstep; const char* b3 = b2 + kstep;
        LDB(B0, 0, 0); SCHED; LDA(At, 0, 0); STAGE(SA(1, 1), a1 + hstepA, voffA);
        WAIT_L(8); BAR; WAIT_L(0); MMA(0, 0, At, B0); BAR; SCHED;
        LDB(B1, 0, 1); STAGE(SB(0, 0), b2, voffB);
        BAR; WAIT_L(0); MMA(0, 1, At, B1); BAR;
        LDA(At, 0, 1); STAGE(SA(0, 0), a2, voffA);
        BAR; WAIT_L(0); MMA(1, 0, At, B0); BAR; SCHED;
        STAGE(SB(0, 1), b2 + hstepB, voffB);
        WAIT_V(6); BAR; MMA(1, 1, At, B1); BAR;
        LDB(B0, 1, 0); SCHED; LDA(At, 1, 0); STAGE(SA(0, 1), a2 + hstepA, voffA);
        WAIT_L(8); BAR; WAIT_L(0); MMA(0, 0, At, B0); BAR; SCHED;
        LDB(B1, 1, 1); STAGE(SB(1, 0), b3, voffB);
        BAR; WAIT_L(0); MMA(0, 1, At, B1); BAR;
        LDA(At, 1, 1); STAGE(SA(1, 0), a3, voffA);
        BAR; WAIT_L(0); MMA(1, 0, At, B0); BAR; SCHED;
        STAGE(SB(1, 1), b3 + hstepB, voffB);
        WAIT_V(6); BAR; MMA(1, 1, At, B1); BAR;
    }
    { const char* a1 = cA + (size_t)(nt - 1) * kstep;
      LDB(B0, 0, 0); LDA(At, 0, 0); STAGE(SA(1, 1), a1 + hstepA, voffA);
      BAR; WAIT_L(0); MMA(0, 0, At, B0); BAR;
      LDB(B1, 0, 1); BAR; WAIT_L(0); MMA(0, 1, At, B1); BAR;
      LDA(At, 0, 1); WAIT_V(4); BAR; WAIT_L(0); MMA(1, 0, At, B0); MMA(1, 1, At, B1); BAR; }
    { LDB(B0, 1, 0); LDA(At, 1, 0); WAIT_V(2); BAR; WAIT_L(0); MMA(0, 0, At, B0); BAR;
      LDB(B1, 1, 1); WAIT_V(0); BAR; WAIT_L(0); MMA(0, 1, At, B1); BAR;
      LDA(At, 1, 1); BAR; WAIT_L(0); MMA(1, 0, At, B0); MMA(1, 1, At, B1); BAR; }
    if (wr == 0) BAR;
    epi(acc, pm * BM, pn * BM, wr, wc, fr, fq);
#undef SA
#undef SB
#undef STAGE
#undef LDA
#undef LDB
#undef MMA
}

struct EpiIn {
    bf16_t* H; float* side; const float* rope; bf16_t* VT; bf16_t* KF; unsigned* kmax; bool dry;
    __device__ __forceinline__ void operator()(f32x4 (&acc)[2][2][4][2], int brow, int bcol, int wr, int wc, int fr, int fq) const {
#pragma unroll
        for (int bj = 0; bj < 2; ++bj) {
            const int hb = bcol + bj * HALF;
            if (hb >= 4224 || dry) continue;
            const int gbase = hb + (wc >> 1) * 64, g64 = gbase >> 6, d0 = (wc & 1) * 16 + 4 * fq;
            const bool rp = (g64 < 16) || (g64 >= 24 && g64 <= 32);
            const float qs = (g64 < 8) ? QSCALE : 1.f;
            float kabs = 0.f;
#pragma unroll
            for (int ai = 0; ai < 2; ++ai)
#pragma unroll
                for (int m = 0; m < 4; ++m) {
                    const long row = brow + ai * HALF + wr * 64 + m * 16 + fr;
                    f32x4 o1 = acc[ai][bj][m][0], o2 = acc[ai][bj][m][1];
                    if (rp) {
                        const f32x4 c0 = *(const f32x4*)(rope + (row * 32 + d0) * 2), c1 = *(const f32x4*)(rope + (row * 32 + d0) * 2 + 4);
                        const f32x4 x1 = o1, x2 = o2;
                        o1[0] = (x1[0] * c0[0] - x2[0] * c0[1]) * qs; o2[0] = (x2[0] * c0[0] + x1[0] * c0[1]) * qs;
                        o1[1] = (x1[1] * c0[2] - x2[1] * c0[3]) * qs; o2[1] = (x2[1] * c0[2] + x1[1] * c0[3]) * qs;
                        o1[2] = (x1[2] * c1[0] - x2[2] * c1[1]) * qs; o2[2] = (x2[2] * c1[0] + x1[2] * c1[1]) * qs;
                        o1[3] = (x1[3] * c1[2] - x2[3] * c1[3]) * qs; o2[3] = (x2[3] * c1[2] + x1[3] * c1[3]) * qs;
                    }
                    if (g64 >= 8 && g64 < 24) {
                        const int bb = (int)(row >> 13), tt = (int)(row & (T - 1)), tile = tt >> 5, tk = tt & 31;
                        if (g64 < 16) {
                            kabs = fmaxf(kabs, fmaxf(fmaxf(fabsf(o1[0]), fabsf(o1[1])), fmaxf(fabsf(o1[2]), fabsf(o1[3]))));
                            kabs = fmaxf(kabs, fmaxf(fmaxf(fabsf(o2[0]), fabsf(o2[1])), fmaxf(fabsf(o2[2]), fabsf(o2[3]))));
                            const long base = ((long)(bb * 8 + (g64 - 8)) * 256 + tile) * 4;
                            const int ks = d0 >> 4, hk = (d0 >> 3) & 1, j0 = d0 & 7;
                            u32x2 w1, w2; w1.x = pk2(o1[0], o1[1]); w1.y = pk2(o1[2], o1[3]); w2.x = pk2(o2[0], o2[1]); w2.y = pk2(o2[2], o2[3]);
                            const auto sx = __builtin_amdgcn_permlane16_swap(w1.x, w2.x, false, false), sy = __builtin_amdgcn_permlane16_swap(w1.y, w2.y, false, false);
                            u32x4 wv; long slot;
                            if (fq & 1) { wv.x = sx[0]; wv.y = sy[0]; wv.z = w2.x; wv.w = w2.y; slot = (base + ks + 2) * 64 + hk * 32 + tk; }
                            else { wv.x = w1.x; wv.y = w1.y; wv.z = sx[1]; wv.w = sy[1]; slot = (base + ks) * 64 + hk * 32 + tk; }
                            *(u32x4*)(KF + slot * 8) = wv;
                        } else {
                            const int s = tk >> 4, u = tk & 15, hv = (u >> 2) & 1, jv = (u >> 3) * 4 + (u & 3);
                            const long base = (((long)(bb * 8 + (g64 - 16)) * 256 + tile) * 2) * 2 + s;
                            bf16_t* v0 = VT + ((base) * 64 + hv * 32 + d0) * 8 + jv;
                            bf16_t* v1 = VT + ((base + 2) * 64 + hv * 32 + d0) * 8 + jv;
#pragma unroll
                            for (int j = 0; j < 4; ++j) { v0[j * 8] = (bf16_t)f2bf(o1[j]); v1[j * 8] = (bf16_t)f2bf(o2[j]); }
                        }
                    } else if (gbase < 4160) {
                        bf16_t* hp = H + row * HP + gbase + d0;
                        u32x2 w1, w2; w1.x = pk2(o1[0], o1[1]); w1.y = pk2(o1[2], o1[3]); w2.x = pk2(o2[0], o2[1]); w2.y = pk2(o2[2], o2[3]);
                        const auto sx = __builtin_amdgcn_permlane16_swap(w1.x, w2.x, false, false), sy = __builtin_amdgcn_permlane16_swap(w1.y, w2.y, false, false);
                        u32x4 wv;
                        if (fq & 1) { wv.x = sx[0]; wv.y = sy[0]; wv.z = w2.x; wv.w = w2.y; hp += 32 - 4; }
                        else { wv.x = w1.x; wv.y = w1.y; wv.z = sx[1]; wv.w = sy[1]; }
                        *(u32x4*)hp = wv;
                    } else if (d0 < 8) { *(f32x4*)(side + row * 24 + d0) = o1 * WI_SCALE; }
                    else if (d0 < 24) { *(f32x4*)(side + row * 24 + d0) = o1; }
                }
            if (g64 >= 8 && g64 < 16) {
#pragma unroll
                for (int o = 32; o >= 1; o >>= 1) kabs = fmaxf(kabs, sxor_f(kabs, fq * 16 + fr, o));
                if ((threadIdx.x & 63) == 0) atomicMax(kmax + (brow >> 13) * 8 + (g64 - 8), __float_as_uint(kabs));
            }
        }
    }
};
struct EpiOut {
    const float* xres; float* out; bool dry;
    __device__ __forceinline__ void operator()(f32x4 (&acc)[2][2][4][2], int brow, int bcol, int wr, int wc, int fr, int fq) const {
#pragma unroll
        for (int ai = 0; ai < 2; ++ai)
#pragma unroll
            for (int m = 0; m < 4; ++m)
#pragma unroll
                for (int bj = 0; bj < 2; ++bj)
#pragma unroll
                    for (int n = 0; n < 2; ++n) {
                        const long idx = (long)(brow + ai * HALF + wr * 64 + m * 16 + fr) * DM + (bcol + bj * HALF + wc * 32 + n * 16 + 4 * fq);
                        const f32x4 xr = *(const f32x4*)(xres + idx);
                        if (!dry) *(f32x4*)(out + idx) = xr * ALPHA + acc[ai][bj][m][n];
                    }
    }
};

__device__ __forceinline__ void ln_phase(const Params& p, int layer, int row_begin, int row_end, int row_step, int lane, bool dry) {
    bf16_t* xb = (bf16_t*)(p.ws + WS_XB);
    const float* g = p.ln_g + layer * DM; const float* bb = p.ln_b + layer * DM;
    for (int row = row_begin; row < row_end; row += row_step) {
        float* zr = p.out + (long)row * DM;
        f32x4 v[4]; float s = 0.f;
#pragma unroll
        for (int r = 0; r < 4; ++r) { v[r] = *(const f32x4*)(zr + r * 256 + lane * 4); s += v[r][0] + v[r][1] + v[r][2] + v[r][3]; }
        const float mu = wave_sum(s, lane) * (1.f / DM);
        float q = 0.f;
#pragma unroll
        for (int r = 0; r < 4; ++r)
#pragma unroll
            for (int e = 0; e < 4; ++e) { const float d = v[r][e] - mu; q += d * d; }
        const float rstd = rsqrtf(wave_sum(q, lane) * (1.f / DM) + EPS);
#pragma unroll
        for (int r = 0; r < 4; ++r) {
            const f32x4 gg = *(const f32x4*)(g + r * 256 + lane * 4), bv = *(const f32x4*)(bb + r * 256 + lane * 4);
            f32x4 y;
#pragma unroll
            for (int e = 0; e < 4; ++e) y[e] = (v[r][e] - mu) * rstd * gg[e] + bv[e];
            if (dry) continue;
            *(f32x4*)(zr + r * 256 + lane * 4) = y;
            u32x2 w; w.x = pk2(y[0], y[1]); w.y = pk2(y[2], y[3]);
            *(u32x2*)(xb + (long)row * DM + r * 256 + lane * 4) = w;
        }
    }
}

__device__ __forceinline__ void conformer_tile(const Params& p, int layer, unsigned char* lds, int tile, bool dry, int wid_s) {
    bf16_t* H = (bf16_t*)(p.ws + WS_H);
    const int tid = otid(wid_s), lane = tid & 63, w = tid >> 6;
    const int tok0 = tile * 64, b = tok0 / T, tl0 = tok0 % T;
    bf16_t* hg = (bf16_t*)lds;
    float* cv = (float*)(lds + 49152);
    for (int idx = tid; idx < 94 * 32; idx += 512) {
        const int r = idx >> 5, cc = (idx & 31) * 8, tl = tl0 - 30 + r;
        u32x4 o = {0u, 0u, 0u, 0u};
        if (tl >= 0) {
            const bf16_t* src = H + ((long)b * T + tl) * HP + HGLU + cc;
            const u32x4 va = *(const u32x4*)src, ga = *(const u32x4*)(src + 256);
            o.x = pk2(bflo(va.x) * sigmoid_f(bflo(ga.x)), bfhi(va.x) * sigmoid_f(bfhi(ga.x)));
            o.y = pk2(bflo(va.y) * sigmoid_f(bflo(ga.y)), bfhi(va.y) * sigmoid_f(bfhi(ga.y)));
            o.z = pk2(bflo(va.z) * sigmoid_f(bflo(ga.z)), bfhi(va.z) * sigmoid_f(bfhi(ga.z)));
            o.w = pk2(bflo(va.w) * sigmoid_f(bflo(ga.w)), bfhi(va.w) * sigmoid_f(bfhi(ga.w)));
        }
        *(u32x4*)(hg + r * 256 + cc) = o;
    }
    __syncthreads();
    {
        const int c = tid & 255, half = tid >> 8;
        const float* cw = p.conv_w + (long)layer * 31 * 256 + c;
        float wj[31];
#pragma unroll
        for (int j = 0; j < 31; ++j) wj[j] = cw[j * 256];
        const float cb = p.conv_b[layer * 256 + c];
        float win[62];
#pragma unroll
        for (int r = 0; r < 62; ++r) win[r] = bf2f(hg[(half * 32 + r) * 256 + c]);
#pragma unroll
        for (int tt = 0; tt < 32; ++tt) {
            float a = cb;
#pragma unroll
            for (int j = 0; j < 31; ++j) a = fmaf(win[tt + j], wj[j], a);
            cv[(half * 32 + tt) * 256 + c] = a;
        }
    }
    __syncthreads();
    bf16_t* at = (bf16_t*)lds;
    {
        const f32x4 gg = *(const f32x4*)(p.cln_g + layer * 256 + lane * 4), bv = *(const f32x4*)(p.cln_b + layer * 256 + lane * 4);
#pragma unroll
        for (int tt = 0; tt < 8; ++tt) {
            const int t = w * 8 + tt;
            const f32x4 v = *(const f32x4*)(cv + t * 256 + lane * 4);
            const float mu = wave_sum(v[0] + v[1] + v[2] + v[3], lane) * (1.f / 256.f);
            float q = 0.f;
#pragma unroll
            for (int e = 0; e < 4; ++e) { const float d = v[e] - mu; q += d * d; }
            const float rstd = rsqrtf(wave_sum(q, lane) * (1.f / 256.f) + EPS);
            float y[4];
#pragma unroll
            for (int e = 0; e < 4; ++e) y[e] = silu_f((v[e] - mu) * rstd * gg[e] + bv[e]);
            u32x2 o; o.x = pk2(y[0], y[1]); o.y = pk2(y[2], y[3]);
            *(u32x2*)(at + t * 264 + lane * 4) = o;
        }
    }
    __syncthreads();
    {
        f32x16 acc0 = {}, acc1 = {};
        const bf16_t* pwt = (const bf16_t*)(p.ws + WS_PWT) + (long)layer * 65536 + (w * 32 + (lane & 31)) * 256 + 8 * (lane >> 5);
        const bf16_t* ap = at + (lane & 31) * 264 + 8 * (lane >> 5);
#pragma unroll 4
        for (int ks = 0; ks < 16; ++ks) {
            const bf16x8 bfr = *(const bf16x8*)(pwt + ks * 16);
            const bf16x8 a0 = *(const bf16x8*)(ap + ks * 16), a1 = *(const bf16x8*)(ap + 32 * 264 + ks * 16);
            acc0 = __builtin_amdgcn_mfma_f32_32x32x16_bf16(a0, bfr, acc0, 0, 0, 0);
            acc1 = __builtin_amdgcn_mfma_f32_32x32x16_bf16(a1, bfr, acc1, 0, 0, 0);
        }
        const int ch = w * 32 + (lane & 31);
        const float pb = p.pw_b[layer * 256 + ch];
#pragma unroll
        for (int i = 0; i < 16; ++i) {
            const int row = (i & 3) + 8 * (i >> 2) + 4 * (lane >> 5);
            bf16_t* g0 = H + (long)(tok0 + row) * HP + HBG + ch;
            bf16_t* g1 = H + (long)(tok0 + 32 + row) * HP + HBG + ch;
            const unsigned r0 = f2bf((acc0[i] + pb) * silu_f(bf2f(*g0))), r1 = f2bf((acc1[i] + pb) * silu_f(bf2f(*g1)));
            if (!dry) { *g0 = (bf16_t)r0; *g1 = (bf16_t)r1; }
        }
    }
    __syncthreads();
}

__device__ __forceinline__ float rdlane(float v, int l) { return __uint_as_float(__builtin_amdgcn_readlane(__float_as_uint(v), l)); }

__device__ __forceinline__ void gla_local_item(const Params& p, int layer, int item_, int lane, bool dry) {
    const int item = __builtin_amdgcn_readfirstlane(item_);
    bf16_t* H = (bf16_t*)(p.ws + WS_H);
    const float* side = (const float*)(p.ws + WS_SIDE);
    float* bcum = (float*)(p.ws + WS_BCUM); float* U = (float*)(p.ws + WS_U); float* DEC = (float*)(p.ws + WS_DEC);
    const int bh = item >> 7, c = item & 127, b = bh >> 2, h = bh & 3;
    const long tok0 = (long)b * T + c * 64, tok = tok0 + lane;
    float clr[16];
#pragma unroll
    for (int r = 0; r < 4; ++r) { const f32x4 v = *(const f32x4*)(side + tok * 24 + 8 + r * 4); clr[r * 4] = v[0]; clr[r * 4 + 1] = v[1]; clr[r * 4 + 2] = v[2]; clr[r * 4 + 3] = v[3]; }
    const float* gw = p.gate_w2 + (long)layer * 16 * 128 + h * 32; const float* gb = p.gate_b + layer * 128 + h * 32;
    float* bcp = bcum + tok * 128 + h * 32;
#pragma unroll 1
    for (int d = 0; d < 32; ++d) {
        float z = gb[d];
#pragma unroll
        for (int r = 0; r < 16; ++r) z = fmaf(clr[r], gw[r * 128 + d], z);
        float g = (fminf(z, 0.f) - __logf(1.f + __expf(-fabsf(z)))) * (1.f / 16.f);
#pragma unroll
        for (int o = 1; o < 64; o <<= 1) { const float up = __int_as_float(bperm_i((lane - o) & 63, __float_as_int(g))); if (lane >= o) g += up; }
        bcp[d] = g;
    }
    float bc[32];
#pragma unroll
    for (int r = 0; r < 8; ++r) { const f32x4 v = *(const f32x4*)(bcp + r * 4); bc[r * 4] = v[0]; bc[r * 4 + 1] = v[1]; bc[r * 4 + 2] = v[2]; bc[r * 4 + 3] = v[3]; }
    float kk[32];
    {
        const bf16_t* kp = H + tok * HP + HCK + h * 32;
#pragma unroll
        for (int r = 0; r < 4; ++r) {
            const u32x4 kv = *(const u32x4*)(kp + r * 8);
            kk[r * 8 + 0] = bflo(kv.x); kk[r * 8 + 1] = bfhi(kv.x); kk[r * 8 + 2] = bflo(kv.y); kk[r * 8 + 3] = bfhi(kv.y);
            kk[r * 8 + 4] = bflo(kv.z); kk[r * 8 + 5] = bfhi(kv.z); kk[r * 8 + 6] = bflo(kv.w); kk[r * 8 + 7] = bfhi(kv.w);
        }
#pragma unroll
        for (int d = 0; d < 32; ++d) { const float bl = rdlane(bc[d], 63); kk[d] *= __expf(bl - bc[d]); }
    }
    float acc[32];
#pragma unroll
    for (int d = 0; d < 32; ++d) acc[d] = 0.f;
    const bf16_t* vp = H + tok0 * HP + HCV + h * 64 + lane;
#pragma unroll 1
    for (int t8 = 0; t8 < 64; t8 += 8) {
        float vv[8];
#pragma unroll
        for (int u = 0; u < 8; ++u) vv[u] = bf2f(vp[(long)(t8 + u) * HP]);
#pragma unroll
        for (int u = 0; u < 8; ++u)
#pragma unroll
            for (int d = 0; d < 32; ++d) acc[d] = fmaf(rdlane(kk[d], t8 + u), vv[u], acc[d]);
    }
#pragma unroll
    for (int d = 0; d < 32; ++d) if (!dry) U[(long)item * 2048 + d * 64 + lane] = acc[d];
    if (lane == 63) {
#pragma unroll
        for (int r = 0; r < 8; ++r) { f32x4 v = {__expf(bc[r * 4]), __expf(bc[r * 4 + 1]), __expf(bc[r * 4 + 2]), __expf(bc[r * 4 + 3])}; *(f32x4*)(DEC + item * 32 + r * 4) = v; }
    }
}

__device__ __forceinline__ void gla_scan(const Params& p, int gt) {
    float* U = (float*)(p.ws + WS_U); const float* DEC = (const float*)(p.ws + WS_DEC);
    const int bh = gt >> 11, de = gt & 2047, d = de >> 6;
    float s = 0.f;
    for (int c0 = 0; c0 < 128; c0 += 32) {
        float u[32], dc[32];
#pragma unroll
        for (int i = 0; i < 32; ++i) { u[i] = U[(long)(bh * 128 + c0 + i) * 2048 + de]; dc[i] = DEC[(bh * 128 + c0 + i) * 32 + d]; }
#pragma unroll
        for (int i = 0; i < 32; ++i) { U[(long)(bh * 128 + c0 + i) * 2048 + de] = s; s = fmaf(dc[i], s, u[i]); }
    }
}

__device__ __forceinline__ void gla_out_item(const Params& p, int layer, unsigned char* ldsw, int item_, int lane, bool dry) {
    const int item = __builtin_amdgcn_readfirstlane(item_);
    bf16_t* H = (bf16_t*)(p.ws + WS_H);
    const float* bcum = (const float*)(p.ws + WS_BCUM); const float* U = (const float*)(p.ws + WS_U);
    float* sA = (float*)ldsw; bf16_t* sV = (bf16_t*)(ldsw + 8192);
    const int bh = item >> 7, c = item & 127, b = bh >> 2, h = bh & 3;
    const long tok = (long)b * T + c * 64 + lane;
#pragma unroll
    for (int r = 0; r < 8; ++r) *(f32x4*)(sA + r * 256 + lane * 4) = *(const f32x4*)(U + (long)item * 2048 + r * 256 + lane * 4);
#pragma unroll
    for (int r = 0; r < 8; ++r) *(u32x4*)(sV + lane * 64 + r * 8) = *(const u32x4*)(H + tok * HP + HCV + h * 64 + r * 8);
    WAVE_SYNC();
    float o[64];
#pragma unroll
    for (int e = 0; e < 64; ++e) o[e] = 0.f;
    {
        const bf16_t* qp = H + tok * HP + HCQ + h * 32; const float* bp = bcum + tok * 128 + h * 32;
#pragma unroll 1
        for (int d = 0; d < 32; ++d) {
            const float qd = bf2f(qp[d]) * 0.17677669529663687f * __expf(bp[d]);
#pragma unroll
            for (int e4 = 0; e4 < 16; ++e4) {
                const f32x4 s4 = *(const f32x4*)(sA + d * 64 + e4 * 4);
                o[e4 * 4] = fmaf(qd, s4[0], o[e4 * 4]); o[e4 * 4 + 1] = fmaf(qd, s4[1], o[e4 * 4 + 1]);
                o[e4 * 4 + 2] = fmaf(qd, s4[2], o[e4 * 4 + 2]); o[e4 * 4 + 3] = fmaf(qd, s4[3], o[e4 * 4 + 3]);
            }
        }
    }
    WAVE_SYNC();
    {
        const bf16_t* kp = H + tok * HP + HCK + h * 32;
#pragma unroll
        for (int r = 0; r < 4; ++r) {
            const u32x4 kv = *(const u32x4*)(kp + r * 8);
            const f32x4 b0 = *(const f32x4*)(bcum + tok * 128 + h * 32 + r * 8), b1 = *(const f32x4*)(bcum + tok * 128 + h * 32 + r * 8 + 4);
            f32x4 k0 = {bflo(kv.x) * __expf(-b0[0]), bfhi(kv.x) * __expf(-b0[1]), bflo(kv.y) * __expf(-b0[2]), bfhi(kv.y) * __expf(-b0[3])};
            f32x4 k1 = {bflo(kv.z) * __expf(-b1[0]), bfhi(kv.z) * __expf(-b1[1]), bflo(kv.w) * __expf(-b1[2]), bfhi(kv.w) * __expf(-b1[3])};
            *(f32x4*)(sA + lane * 32 + r * 8) = k0; *(f32x4*)(sA + lane * 32 + r * 8 + 4) = k1;
        }
    }
    float qe[32];
    {
        const bf16_t* qp = H + tok * HP + HCQ + h * 32;
#pragma unroll
        for (int r = 0; r < 4; ++r) {
            const u32x4 qv = *(const u32x4*)(qp + r * 8);
            const f32x4 b0 = *(const f32x4*)(bcum + tok * 128 + h * 32 + r * 8), b1 = *(const f32x4*)(bcum + tok * 128 + h * 32 + r * 8 + 4);
            const float qq[8] = {bflo(qv.x), bfhi(qv.x), bflo(qv.y), bfhi(qv.y), bflo(qv.z), bfhi(qv.z), bflo(qv.w), bfhi(qv.w)};
            const float bb[8] = {b0[0], b0[1], b0[2], b0[3], b1[0], b1[1], b1[2], b1[3]};
#pragma unroll
            for (int e = 0; e < 8; ++e) qe[r * 8 + e] = qq[e] * 0.17677669529663687f * __expf(bb[e]);
        }
    }
    WAVE_SYNC();
#pragma unroll 1
    for (int j = 0; j < 64; ++j) {
        float a = 0.f;
#pragma unroll
        for (int d4 = 0; d4 < 8; ++d4) {
            const f32x4 k4 = *(const f32x4*)(sA + j * 32 + d4 * 4);
            a = fmaf(qe[d4 * 4], k4[0], a); a = fmaf(qe[d4 * 4 + 1], k4[1], a); a = fmaf(qe[d4 * 4 + 2], k4[2], a); a = fmaf(qe[d4 * 4 + 3], k4[3], a);
        }
        if (j > lane) a = 0.f;
#pragma unroll
        for (int e8 = 0; e8 < 8; ++e8) {
            const u32x4 v8 = *(const u32x4*)(sV + j * 64 + e8 * 8);
            o[e8 * 8 + 0] = fmaf(a, bflo(v8.x), o[e8 * 8 + 0]); o[e8 * 8 + 1] = fmaf(a, bfhi(v8.x), o[e8 * 8 + 1]);
            o[e8 * 8 + 2] = fmaf(a, bflo(v8.y), o[e8 * 8 + 2]); o[e8 * 8 + 3] = fmaf(a, bfhi(v8.y), o[e8 * 8 + 3]);
            o[e8 * 8 + 4] = fmaf(a, bflo(v8.z), o[e8 * 8 + 4]); o[e8 * 8 + 5] = fmaf(a, bfhi(v8.z), o[e8 * 8 + 5]);
            o[e8 * 8 + 6] = fmaf(a, bflo(v8.w), o[e8 * 8 + 6]); o[e8 * 8 + 7] = fmaf(a, bfhi(v8.w), o[e8 * 8 + 7]);
        }
    }
    float ss = 0.f;
#pragma unroll
    for (int e = 0; e < 64; ++e) ss = fmaf(o[e], o[e], ss);
    const float rms = rsqrtf(ss * (1.f / 64.f) + EPS);
    const float* gn = p.gnorm_g + layer * 256 + h * 64;
    bf16_t* cg_p = H + tok * HP + HCG + h * 64;
#pragma unroll
    for (int r = 0; r < 8; ++r) {
        const u32x4 gv = *(const u32x4*)(cg_p + r * 8);
        const float gq[8] = {bflo(gv.x), bfhi(gv.x), bflo(gv.y), bfhi(gv.y), bflo(gv.z), bfhi(gv.z), bflo(gv.w), bfhi(gv.w)};
        float y[8];
#pragma unroll
        for (int e = 0; e < 8; ++e) y[e] = o[r * 8 + e] * rms * gn[r * 8 + e] * silu_f(gq[e]);
        u32x4 w; w.x = pk2(y[0], y[1]); w.y = pk2(y[2], y[3]); w.z = pk2(y[4], y[5]); w.w = pk2(y[6], y[7]);
        if (!dry) *(u32x4*)(cg_p + r * 8) = w;
    }
    WAVE_SYNC();
}

constexpr int MPITCH = 260;
constexpr int HPITCH = 516;
constexpr int L_HIST = 0;
constexpr int L_CAND = 66560;
constexpr int L_CCNT = L_CAND + 65536;
constexpr int L_QINF = L_CCNT + 2048;
constexpr int L_MTAB = L_QINF + 1024 + 64;
static_assert(L_MTAB + 8192 <= LDS_BYTES, "dsa lds");
__device__ __forceinline__ int mpos(int rr) { return 16 * ((rr >> 2) & 1) + (rr & 3) + 4 * (rr >> 3); }
constexpr int SUBCAP = 32;

__device__ __forceinline__ unsigned mono_bits(float f) { const unsigned u = __float_as_uint(f); return u ^ ((u >> 31) ? 0xffffffffu : 0x80000000u); }
__device__ __forceinline__ void idx_loadk(const bf16_t* Hb, int s0, int lane, bf16x8 (&kf)[2][2]) {
    const bf16_t* kp = Hb + (long)(s0 + (lane & 15)) * HP + HKI + 8 * (lane >> 4);
#pragma unroll
    for (int kb = 0; kb < 2; ++kb)
#pragma unroll
        for (int ks = 0; ks < 2; ++ks) kf[kb][ks] = *(const bf16x8*)(kp + (long)kb * 16 * HP + ks * 32);
}
__device__ __forceinline__ void idx_scores(const bf16x8 (&kf)[2][2], const bf16x8 (&qf)[8][2], const bf16x8 (&ql)[2][2], const float (&wh)[8], float (&score)[8]) {
    f32x4 lin[2];
#pragma unroll
    for (int kb = 0; kb < 2; ++kb) {
        lin[kb] = (f32x4){0.f, 0.f, 0.f, 0.f};
#pragma unroll
        for (int ks = 0; ks < 2; ++ks) {
            lin[kb] = __builtin_amdgcn_mfma_f32_16x16x32_bf16(kf[kb][ks], ql[0][ks], lin[kb], 0, 0, 0);
            lin[kb] = __builtin_amdgcn_mfma_f32_16x16x32_bf16(kf[kb][ks], ql[1][ks], lin[kb], 0, 0, 0);
        }
    }
#pragma unroll
    for (int i = 0; i < 8; ++i) score[i] = lin[i >> 2][i & 3];
#pragma unroll
    for (int hd = 0; hd < 8; ++hd) {
        f32x4 acc[2];
#pragma unroll
        for (int kb = 0; kb < 2; ++kb) {
            acc[kb] = (f32x4){0.f, 0.f, 0.f, 0.f};
#pragma unroll
            for (int ks = 0; ks < 2; ++ks) acc[kb] = __builtin_amdgcn_mfma_f32_16x16x32_bf16(kf[kb][ks], qf[hd][ks], acc[kb], 0, 0, 0);
        }
#pragma unroll
        for (int kb = 0; kb < 2; ++kb)
#pragma unroll
            for (int i = 0; i < 4; ++i) score[kb * 4 + i] = fmaf(fabsf(acc[kb][i]), wh[hd], score[kb * 4 + i]);
        if ((hd & 3) == 3) __builtin_amdgcn_sched_barrier(0);
    }
}

template <bool FAST>
__device__ __forceinline__ void attn_tile(const bf16x8 (&kf)[4], const bf16x8 (&vf)[4], const bf16x8 (&qfr)[2][4], f32x16 (&O)[2][2], float (&mrun)[2], float (&lrun)[2],
                                          const unsigned* hist, const float* mtab, int r32, int hh, int tile) {
#pragma unroll
    for (int qb = 0; qb < 2; ++qb) {
        f32x16 S;
        const unsigned mw = hist[(qb * 32 + r32) * MPITCH + tile] >> (16 * hh);
#pragma unroll
        for (int g8 = 0; g8 < 2; ++g8) {
            const float* mt = mtab + ((mw >> (8 * g8)) & 255u) * 8;
            const f32x4 ma = *(const f32x4*)mt, mb = *(const f32x4*)(mt + 4);
            S[8 * g8] = ma[0]; S[8 * g8 + 1] = ma[1]; S[8 * g8 + 2] = ma[2]; S[8 * g8 + 3] = ma[3];
            S[8 * g8 + 4] = mb[0]; S[8 * g8 + 5] = mb[1]; S[8 * g8 + 6] = mb[2]; S[8 * g8 + 7] = mb[3];
        }
#pragma unroll
        for (int ks = 0; ks < 4; ++ks) S = __builtin_amdgcn_mfma_f32_32x32x16_bf16(kf[ks], qfr[qb][ks], S, 0, 0, 0);
        float pr[16]; float ps = 0.f;
        if (FAST) {
#pragma unroll
            for (int i = 0; i < 16; ++i) { pr[i] = __builtin_amdgcn_exp2f(S[i]); ps += pr[i]; }
        } else {
            float mx = fmaxf(fmaxf(S[0], S[1]), S[2]);
#pragma unroll
            for (int i = 3; i < 15; i += 2) mx = fmaxf(fmaxf(mx, S[i]), S[i + 1]);
            mx = fmaxf(mx, S[15]);
            { const auto sw = __builtin_amdgcn_permlane32_swap(__float_as_uint(mx), __float_as_uint(mx), false, false); mx = fmaxf(__uint_as_float(sw[0]), __uint_as_float(sw[1])); }
            if (__any(mx > mrun[qb])) {
                const float mnew = fmaxf(mx, mrun[qb]);
                const float alpha = __builtin_amdgcn_exp2f(mrun[qb] - mnew);
                mrun[qb] = mnew; lrun[qb] *= alpha;
#pragma unroll
                for (int db = 0; db < 2; ++db)
#pragma unroll
                    for (int i = 0; i < 16; ++i) O[db][qb][i] *= alpha;
            }
            const float mref = fmaxf(mrun[qb], -1000.f);
#pragma unroll
            for (int i = 0; i < 16; ++i) { pr[i] = __builtin_amdgcn_exp2f(S[i] - mref); ps += pr[i]; }
        }
        lrun[qb] += ps;
        bf16x8 pf[2];
#pragma unroll
        for (int s = 0; s < 2; ++s) {
            u32x4 pw; pw.x = pk2(pr[8 * s], pr[8 * s + 1]); pw.y = pk2(pr[8 * s + 2], pr[8 * s + 3]); pw.z = pk2(pr[8 * s + 4], pr[8 * s + 5]); pw.w = pk2(pr[8 * s + 6], pr[8 * s + 7]);
            pf[s] = __builtin_bit_cast(bf16x8, pw);
        }
#pragma unroll
        for (int db = 0; db < 2; ++db)
#pragma unroll
            for (int s = 0; s < 2; ++s) O[db][qb] = __builtin_amdgcn_mfma_f32_32x32x16_bf16(vf[db * 2 + s], pf[s], O[db][qb], 0, 0, 0);
    }
}
template <bool FAST>
__device__ __forceinline__ void attn_loop(const bf16_t* Kp, const bf16_t* Vp, const bf16x8 (&qfr)[2][4], f32x16 (&O)[2][2], float (&mrun)[2], float (&lrun)[2],
                                          const unsigned* hist, const float* mtab, int r32, int hh, int nt32, bool dry2) {
    bf16x8 kf[4], vf[4], kg[4], vg[4];
#pragma unroll
    for (int ks = 0; ks < 4; ++ks) { kf[ks] = *(const bf16x8*)(Kp + ks * 512); vf[ks] = *(const bf16x8*)(Vp + ks * 512); }
#pragma unroll 1
    for (int tile = 0; tile < nt32; tile += 2) {
        {
            const int tn = dry2 ? 0 : tile + 1;
#pragma unroll
            for (int ks = 0; ks < 4; ++ks) { kg[ks] = *(const bf16x8*)(Kp + (long)tn * 2048 + ks * 512); vg[ks] = *(const bf16x8*)(Vp + (long)tn * 2048 + ks * 512); }
        }
        attn_tile<FAST>(kf, vf, qfr, O, mrun, lrun, hist, mtab, r32, hh, tile);
        {
            const int tn = dry2 ? 0 : ((tile + 2 < nt32) ? tile + 2 : tile);
#pragma unroll
            for (int ks = 0; ks < 4; ++ks) { kf[ks] = *(const bf16x8*)(Kp + (long)tn * 2048 + ks * 512); vf[ks] = *(const bf16x8*)(Vp + (long)tn * 2048 + ks * 512); }
        }
        attn_tile<FAST>(kg, vg, qfr, O, mrun, lrun, hist, mtab, r32, hh, tile + 1);
    }
}

__device__ __forceinline__ void dsa_item(const Params& p, unsigned char* lds, int b, int qblk, bool dry, int wid_s, const unsigned* kmaxL) {
    bf16_t* H = (bf16_t*)(p.ws + WS_H);
    const float* side = (const float*)(p.ws + WS_SIDE);
    const bf16_t* Hb = H + (long)b * T * HP;
    const int tid = otid(wid_s), lane = tid & 63, w = tid >> 6, hq = lane >> 4;
    const int qg = w & 3, kh = w >> 2;
    const int t0 = qblk * 64, qloc = qg * 16 + (lane & 15), t = t0 + qloc;
    unsigned* hist = (unsigned*)(lds + L_HIST);
    unsigned* cand = (unsigned*)(lds + L_CAND);
    unsigned* ccnt = (unsigned*)(lds + L_CCNT);
    int* qinf = (int*)(lds + L_QINF);

    for (int i = tid; i < 64 * MPITCH; i += 512) hist[i] = 0u;
    for (int i = tid; i < 2048; i += 512) ((float*)(lds + L_MTAB))[i] = ((i >> 3) >> (i & 7)) & 1 ? 0.f : -1e30f;
    bf16x8 qf[8][2]; bf16x8 ql[2][2]; float wi[8]; float inv, fb0c;
    {
        const bf16_t* qp = Hb + (long)t * HP + HQI + 8 * hq;
#pragma unroll
        for (int hd = 0; hd < 8; ++hd)
#pragma unroll
            for (int ks = 0; ks < 2; ++ks) qf[hd][ks] = *(const bf16x8*)(qp + hd * 64 + ks * 32);
        const float* sp = side + ((long)b * T + t) * 24;
        const f32x4 w0 = *(const f32x4*)sp, w1 = *(const f32x4*)(sp + 4);
        wi[0] = w0[0]; wi[1] = w0[1]; wi[2] = w0[2]; wi[3] = w0[3]; wi[4] = w1[0]; wi[5] = w1[1]; wi[6] = w1[2]; wi[7] = w1[3];
        float n2 = 0.f;
#pragma unroll
        for (int i = 0; i < 8; ++i) n2 = fmaf(wi[i], wi[i], n2);
        const float nrm = fmaxf(SIG_UNIT * sqrtf(n2), 1e-30f);
        inv = 64.f / nrm;
        fb0c = 256.f - 64.f * 3.19f * (wi[0] + wi[1] + wi[2] + wi[3] + wi[4] + wi[5] + wi[6] + wi[7]) / nrm;
#pragma unroll
        for (int i = 0; i < 8; ++i) wi[i] *= 0.5f;
#pragma unroll
        for (int ks = 0; ks < 2; ++ks) {
            float ql_f[8];
#pragma unroll
            for (int j = 0; j < 8; ++j) ql_f[j] = 0.f;
#pragma unroll
            for (int hd = 0; hd < 8; ++hd) {
                const u32x4 qv = __builtin_bit_cast(u32x4, qf[hd][ks]);
                ql_f[0] = fmaf(wi[hd], bflo(qv.x), ql_f[0]); ql_f[1] = fmaf(wi[hd], bfhi(qv.x), ql_f[1]); ql_f[2] = fmaf(wi[hd], bflo(qv.y), ql_f[2]); ql_f[3] = fmaf(wi[hd], bfhi(qv.y), ql_f[3]);
                ql_f[4] = fmaf(wi[hd], bflo(qv.z), ql_f[4]); ql_f[5] = fmaf(wi[hd], bfhi(qv.z), ql_f[5]); ql_f[6] = fmaf(wi[hd], bflo(qv.w), ql_f[6]); ql_f[7] = fmaf(wi[hd], bfhi(qv.w), ql_f[7]);
            }
            u32x4 hi4; hi4.x = pk2(ql_f[0], ql_f[1]); hi4.y = pk2(ql_f[2], ql_f[3]); hi4.z = pk2(ql_f[4], ql_f[5]); hi4.w = pk2(ql_f[6], ql_f[7]);
            u32x4 lo4;
            lo4.x = pk2(ql_f[0] - bflo(hi4.x), ql_f[1] - bfhi(hi4.x)); lo4.y = pk2(ql_f[2] - bflo(hi4.y), ql_f[3] - bfhi(hi4.y));
            lo4.z = pk2(ql_f[4] - bflo(hi4.z), ql_f[5] - bfhi(hi4.z)); lo4.w = pk2(ql_f[6] - bflo(hi4.w), ql_f[7] - bfhi(hi4.w));
            ql[0][ks] = __builtin_bit_cast(bf16x8, hi4); ql[1][ks] = __builtin_bit_cast(bf16x8, lo4);
        }
    }
    const int ntile = (t0 + 64 + 127) >> 7;
    const int tmaxw = t0 + qg * 16 + 15;
    __syncthreads();
    int nit = 0;
    { const int v = tmaxw - kh * 64; if (v >= 0) nit = 2 * (v >> 7) + (((v & 127) >= 32) ? 2 : 1); }
    float fa = inv, fbias = fb0c;
    bool active = true;
#pragma unroll 1
    for (int level = 0; level < 2; ++level) {
        unsigned* hbase = level ? cand : hist;
        const bool wave_on = __any(active);
        if (wave_on) {
            const unsigned incv = 1u << ((qloc & 1) * 16);
            unsigned* hrow = hbase + (qloc >> 1) * HPITCH;
            bf16x8 kf[2][2];
            idx_loadk(Hb, kh * 64, lane, kf);
#pragma unroll 1
            for (int it = 0; it < nit; ++it) {
                const int s0 = (it >> 1) * 128 + kh * 64 + (it & 1) * 32;
                const int itn = (it + 1 < nit) ? it + 1 : it;
                bf16x8 kn[2][2];
                idx_loadk(Hb, (itn >> 1) * 128 + kh * 64 + (itn & 1) * 32, lane, kn);
                float score[8];
                idx_scores(kf, qf, ql, wi, score);
                if (s0 + 31 <= t0 + qg * 16) {
#pragma unroll
                    for (int i = 0; i < 8; ++i) { const unsigned bin = (unsigned)__builtin_amdgcn_fmed3f(fmaf(score[i], fa, fbias), 0.f, 511.5f); atomicAdd(hrow + bin, incv); }
                } else {
#pragma unroll
                    for (int i = 0; i < 8; ++i) {
                        const int s = s0 + (i >> 2) * 16 + hq * 4 + (i & 3);
                        if (s <= t) { const unsigned bin = (unsigned)__builtin_amdgcn_fmed3f(fmaf(score[i], fa, fbias), 0.f, 511.5f); atomicAdd(hrow + bin, incv); }
                    }
                }
#pragma unroll
                for (int kb = 0; kb < 2; ++kb)
#pragma unroll
                    for (int ks = 0; ks < 2; ++ks) kf[kb][ks] = kn[kb][ks];
            }
        }
        __syncthreads();
#pragma unroll 1
        for (int qq = 0; qq < 8; ++qq) {
            const int q = w * 8 + qq;
            if (level && !qinf[q * 4 + 3]) continue;
            const u32x4 wa = *(const u32x4*)(hbase + (q >> 1) * HPITCH + 8 * lane), wb = *(const u32x4*)(hbase + (q >> 1) * HPITCH + 8 * lane + 4);
            const int sh = (q & 1) * 16;
            const unsigned c[8] = {(wa.x >> sh) & 0xffffu, (wa.y >> sh) & 0xffffu, (wa.z >> sh) & 0xffffu, (wa.w >> sh) & 0xffffu, (wb.x >> sh) & 0xffffu, (wb.y >> sh) & 0xffffu, (wb.z >> sh) & 0xffffu, (wb.w >> sh) & 0xffffu};
            const unsigned tot = c[0] + c[1] + c[2] + c[3] + c[4] + c[5] + c[6] + c[7];
            unsigned S = tot;
#pragma unroll
            for (int o = 1; o < 64; o <<= 1) { const unsigned dn = (unsigned)bperm_i((lane + o) & 63, (int)S); if (lane + o < 64) S += dn; }
            const unsigned total = (unsigned)__builtin_amdgcn_readfirstlane((int)S);
            const u64 bal = __ballot(S >= 256u);
            int b1 = -1, r1 = 0, n1 = 0;
            if (total >= 256u) {
                const int Ls = 63 - __clzll(bal);
                unsigned cum = S - tot; bool found = false; int lb = -1, lr = 0, ln = 0;
#pragma unroll
                for (int j = 7; j >= 0; --j) { const bool hit = !found && (cum + c[j] >= 256u); if (hit) { lb = 8 * lane + j; lr = 256 - (int)cum; ln = (int)c[j]; found = true; } cum += c[j]; }
                b1 = bperm_i(Ls, lb); r1 = bperm_i(Ls, lr); n1 = bperm_i(Ls, ln);
            }
            if (lane == 0) { qinf[q * 4] = b1; qinf[q * 4 + 1] = r1; qinf[q * 4 + 2] = n1; }
        }
        __syncthreads();
        if (level == 0) { for (int i = tid; i < 64 * MPITCH; i += 512) hist[i] = 0u; }
        if (tid == 0) qinf[256] = 0;
        __syncthreads();
        if (wave_on) {
            const int b1 = qinf[qloc * 4];
            const float fsel = !active ? __builtin_inff() : ((b1 < 0) ? -__builtin_inff() : ((b1 >= 511) ? __builtin_inff() : (float)(b1 + 1)));
            const float fcand = !active ? __builtin_inff() : ((b1 <= 0) ? -__builtin_inff() : (float)b1);
            const float fb1 = (float)(b1 < 0 ? 0 : b1);
            unsigned* cslot = cand + (qloc * 8 + kh * 4 + hq) * SUBCAP; int ncand = 0;
            bf16x8 kf[2][2];
            idx_loadk(Hb, kh * 64, lane, kf);
#pragma unroll 1
            for (int it = 0; it < nit; ++it) {
                const int s0 = (it >> 1) * 128 + kh * 64 + (it & 1) * 32;
                const int itn = (it + 1 < nit) ? it + 1 : it;
                bf16x8 kn[2][2];
                idx_loadk(Hb, (itn >> 1) * 128 + kh * 64 + (itn & 1) * 32, lane, kn);
                float score[8];
                idx_scores(kf, qf, ql, wi, score);
                unsigned m0 = 0u;
                if (s0 + 31 <= t0 + qg * 16) {
#pragma unroll
                    for (int i = 0; i < 8; ++i) {
                        const int rr = (i >> 2) * 16 + hq * 4 + (i & 3), s = s0 + rr;
                        const float fb = fmaf(score[i], fa, fbias);
                        if (fb >= fcand) {
                            if (fb >= fsel) m0 |= 1u << (16 * (hq & 1) + 4 * (hq >> 1) + (i & 3) + 8 * (i >> 2));
                            else {
                                const unsigned q19 = (unsigned)__builtin_amdgcn_fmed3f((fb - fb1) * 524288.f, 0.f, 524287.f);
                                if (ncand < SUBCAP) cslot[ncand] = (q19 << 13) | (unsigned)(8191 - s);
                                ++ncand;
                            }
                        }
                    }
                } else {
#pragma unroll
                    for (int i = 0; i < 8; ++i) {
                        const int rr = (i >> 2) * 16 + hq * 4 + (i & 3), s = s0 + rr;
                        const float fb = fmaf(score[i], fa, fbias);
                        if (fb >= fcand && s <= t) {
                            if (fb >= fsel) m0 |= 1u << (16 * (hq & 1) + 4 * (hq >> 1) + (i & 3) + 8 * (i >> 2));
                            else {
                                const unsigned q19 = (unsigned)__builtin_amdgcn_fmed3f((fb - fb1) * 524288.f, 0.f, 524287.f);
                                if (ncand < SUBCAP) cslot[ncand] = (q19 << 13) | (unsigned)(8191 - s);
                                ++ncand;
                            }
                        }
                    }
                }
                if (m0) atomicOr(&hist[qloc * MPITCH + (s0 >> 5)], m0);
#pragma unroll
                for (int kb = 0; kb < 2; ++kb)
#pragma unroll
                    for (int ks = 0; ks < 2; ++ks) kf[kb][ks] = kn[kb][ks];
            }
            ccnt[qloc * 8 + kh * 4 + hq] = (unsigned)ncand;
        } else ccnt[qloc * 8 + kh * 4 + hq] = 0u;
        __syncthreads();
#pragma unroll 1
        for (int qq = 0; qq < 8; ++qq) {
            const int q = w * 8 + qq;
            if (level && !qinf[q * 4 + 3]) continue;
            const int r1 = qinf[q * 4 + 1];
            const int wr_ = lane >> 3, sl0 = (lane & 7) * 4;
            int cw = (int)ccnt[q * 8 + wr_];
            const bool ovf = __any(cw > SUBCAP) && (level == 0);
            if (lane == 0) { qinf[q * 4 + 3] = ovf ? 1 : 0; if (ovf) qinf[256] = 1; }
            if (ovf || r1 <= 0) continue;
            if (cw > SUBCAP) cw = SUBCAP;
            const u32x4 mine = *(const u32x4*)(cand + (q * 8 + wr_) * SUBCAP + sl0);
            int rk0 = 0, rk1 = 0, rk2 = 0, rk3 = 0;
#pragma unroll 1
            for (int ww = 0; ww < 8; ++ww) {
                int cn = (int)ccnt[q * 8 + ww]; if (cn > SUBCAP) cn = SUBCAP;
                const unsigned* cl = cand + (q * 8 + ww) * SUBCAP;
#pragma unroll 1
                for (int j = 0; j < cn; ++j) { const unsigned cv = cl[j]; rk0 += (cv > mine.x); rk1 += (cv > mine.y); rk2 += (cv > mine.z); rk3 += (cv > mine.w); }
            }
            if (sl0 + 0 < cw && rk0 < r1) { const int s = 8191 - (int)(mine.x & 8191u); atomicOr(&hist[q * MPITCH + (s >> 5)], 1u << mpos(s & 31)); }
            if (sl0 + 1 < cw && rk1 < r1) { const int s = 8191 - (int)(mine.y & 8191u); atomicOr(&hist[q * MPITCH + (s >> 5)], 1u << mpos(s & 31)); }
            if (sl0 + 2 < cw && rk2 < r1) { const int s = 8191 - (int)(mine.z & 8191u); atomicOr(&hist[q * MPITCH + (s >> 5)], 1u << mpos(s & 31)); }
            if (sl0 + 3 < cw && rk3 < r1) { const int s = 8191 - (int)(mine.w & 8191u); atomicOr(&hist[q * MPITCH + (s >> 5)], 1u << mpos(s & 31)); }
        }
        __syncthreads();
        if (level == 1 || qinf[256] == 0) break;
        {
            const bool mine_ovf = qinf[qloc * 4 + 3] != 0;
            const int b1 = qinf[qloc * 4];
            active = mine_ovf;
            fa = mine_ovf ? inv * 510.f : 0.f;
            fbias = mine_ovf ? fmaf(fb0c - (float)b1, 510.f, 1.f) : -1.f;
        }
        for (int i = tid; i < 32 * HPITCH; i += 512) cand[i] = 0u;
        __syncthreads();
    }
    for (int rep2_ = ((PROBE_PHASE == 41) ? 0 : 1); rep2_ < 2; ++rep2_) {
        const bool dry2 = dry || ((PROBE_PHASE == 41) && (rep2_ == 0) && (p.pos[0] == 0));
        const int head = w, r32 = lane & 31, hh = lane >> 5;
        bf16x8 qfr[2][4];
        float q1 = 0.f;
#pragma unroll
        for (int qb = 0; qb < 2; ++qb) {
            float qa = 0.f;
#pragma unroll
            for (int ks = 0; ks < 4; ++ks) {
                qfr[qb][ks] = *(const bf16x8*)(Hb + (long)(t0 + qb * 32 + r32) * HP + HQ + head * 64 + ks * 16 + 8 * hh);
                const u32x4 qv = __builtin_bit_cast(u32x4, qfr[qb][ks]);
                qa += fabsf(bflo(qv.x)) + fabsf(bfhi(qv.x)) + fabsf(bflo(qv.y)) + fabsf(bfhi(qv.y)) + fabsf(bflo(qv.z)) + fabsf(bfhi(qv.z)) + fabsf(bflo(qv.w)) + fabsf(bfhi(qv.w));
            }
            q1 = fmaxf(q1, qa);
        }
        q1 += sxor_f(q1, lane, 32);
#pragma unroll
        for (int o = 16; o >= 1; o >>= 1) q1 = fmaxf(q1, sxor_f(q1, lane, o));
        const float kmx = __uint_as_float(kmaxL[b * 8 + head]);
        const bool fast = (q1 * kmx * 1.02f) < 100.f;
        f32x16 O[2][2];
#pragma unroll
        for (int a = 0; a < 2; ++a)
#pragma unroll
            for (int c2 = 0; c2 < 2; ++c2)
#pragma unroll
                for (int i = 0; i < 16; ++i) O[a][c2][i] = 0.f;
        float mrun[2] = {-1e30f, -1e30f}, lrun[2] = {0.f, 0.f};
        const bf16_t* Kp = (const bf16_t*)(p.ws + WS_KF) + ((long)(b * 8 + head) * 256 * 4 * 64 + lane) * 8;
        const bf16_t* Vp = (const bf16_t*)(p.ws + WS_VT) + ((long)(b * 8 + head) * 256 * 4 * 64 + lane) * 8;
        const int nt32 = (t0 + 64) >> 5;
        if (fast) attn_loop<true>(Kp, Vp, qfr, O, mrun, lrun, hist, (const float*)(lds + L_MTAB), r32, hh, nt32, dry2);
        else attn_loop<false>(Kp, Vp, qfr, O, mrun, lrun, hist, (const float*)(lds + L_MTAB), r32, hh, nt32, dry2);
#pragma unroll
        for (int qb = 0; qb < 2; ++qb) {
            const float lt = lrun[qb] + sxor_f(lrun[qb], lane, 32);
            const float il = 1.f / lt;
            bf16_t* gp = H + ((long)b * T + t0 + qb * 32 + r32) * HP + HAG + head * 64 + 4 * hh;
#pragma unroll
            for (int db = 0; db < 2; ++db)
#pragma unroll
                for (int g4 = 0; g4 < 4; ++g4) {
                    bf16_t* gq = gp + db * 32 + 8 * g4;
                    const u32x2 gv = *(const u32x2*)gq;
                    u32x2 wv;
                    wv.x = pk2(O[db][qb][4 * g4] * il * silu_f(bflo(gv.x)), O[db][qb][4 * g4 + 1] * il * silu_f(bfhi(gv.x)));
                    wv.y = pk2(O[db][qb][4 * g4 + 2] * il * silu_f(bflo(gv.y)), O[db][qb][4 * g4 + 3] * il * silu_f(bfhi(gv.y)));
                    if (!dry2) *(u32x2*)gq = wv;
                }
        }
    }
    __syncthreads();
}

__device__ __forceinline__ void gbar(unsigned* ctr, unsigned target) {
    __syncthreads();
    if (threadIdx.x == 0) {
        __builtin_amdgcn_fence(__ATOMIC_RELEASE, "agent");
        __hip_atomic_fetch_add(ctr, 1u, __ATOMIC_RELAXED, __HIP_MEMORY_SCOPE_AGENT);
        while (__hip_atomic_load(ctr, __ATOMIC_RELAXED, __HIP_MEMORY_SCOPE_AGENT) < target) __builtin_amdgcn_s_sleep(2);
        __builtin_amdgcn_fence(__ATOMIC_ACQUIRE, "agent");
    }
    __syncthreads();
}

__device__ __forceinline__ void ho_arrive(unsigned* ctr) {
    __syncthreads();
    if (threadIdx.x == 0) { __builtin_amdgcn_fence(__ATOMIC_RELEASE, "agent"); __hip_atomic_fetch_add(ctr, 1u, __ATOMIC_RELAXED, __HIP_MEMORY_SCOPE_AGENT); }
}
__device__ __forceinline__ void ho_wait(unsigned* ctr, unsigned target) {
    if (threadIdx.x == 0) {
        while (__hip_atomic_load(ctr, __ATOMIC_RELAXED, __HIP_MEMORY_SCOPE_AGENT) < target) __builtin_amdgcn_s_sleep(2);
        __builtin_amdgcn_fence(__ATOMIC_ACQUIRE, "agent");
    }
    __syncthreads();
}

__global__ void __launch_bounds__(512) fwd_megakernel(Params p0) {
    extern __shared__ __attribute__((aligned(16))) unsigned char lds[];
    cg::grid_group grid = cg::this_grid();
    const int G = gridDim.x, c = blockIdx.x;
    const int wid_s = __builtin_amdgcn_readfirstlane((int)(threadIdx.x >> 6));

    unsigned* barctr = (unsigned*)(p0.ws + WS_BAR); unsigned bar_n = 0;
    if (c == 0 && threadIdx.x < 3) __hip_atomic_store(barctr + 16 * threadIdx.x, 0u, __ATOMIC_RELAXED, __HIP_MEMORY_SCOPE_AGENT);
    for (int rep0_ = (PROBE_PHASE == 8 ? 0 : 1); rep0_ < 2; ++rep0_) prologue(p0, (long)c * 512 + threadIdx.x, (long)G * 512);
    grid.sync();

#pragma unroll 1
    for (int layer = 0; layer < DEPTH; ++layer) {
        Params p = p0;
        { size_t zoff = 0; asm volatile("" : "+s"(zoff)); p.ws = p0.ws + zoff; }
        bf16_t* H = (bf16_t*)(p.ws + WS_H);
        {
for (int rep_ = (PROBE_PHASE == 1 ? 0 : 1); rep_ < 2; ++rep_) { const bool dry = (PROBE_PHASE == 1) && (rep_ == 0) && (p.pos[0] == 0);
            EpiIn e; e.H = H; e.side = (float*)(p.ws + WS_SIDE); e.rope = (const float*)(p.ws + WS_ROPE); e.VT = (bf16_t*)(p.ws + WS_VT); e.KF = (bf16_t*)(p.ws + WS_KF); e.kmax = (unsigned*)(p.ws + WS_KMAX) + layer * 32; e.dry = dry;
            const bf16_t* A = (const bf16_t*)(p.ws + WS_XB);
            const bf16_t* Bt = (const bf16_t*)(p.ws + WS_WIN) + (long)layer * NPAD * 1024;
            if (layer) {
                if (otid(wid_s) == 0) {
                    const unsigned* lc = (const unsigned*)(p.ws + WS_LCNT);
#pragma unroll 1
                    for (int L = c; L < 128 * 17; L += G) {
                        int pm, pn; tile_of(L, 128, 17, pm, pn);
                        while (__hip_atomic_load(lc + pm * 16, __ATOMIC_RELAXED, __HIP_MEMORY_SCOPE_AGENT) < 2u * (unsigned)layer) __builtin_amdgcn_s_sleep(2);
                    }
                    __builtin_amdgcn_fence(__ATOMIC_ACQUIRE, "agent");
                }
                __syncthreads();
            }
#pragma unroll 1
            for (int L = c; L < 128 * 17; L += G) { int pm, pn; tile_of(L, 128, 17, pm, pn); gemm_tile((LAS unsigned char*)lds, A, 1024, Bt, 1024, pm, pn, e, wid_s); }
            {
                const int rem = (128 * 17) % G;
                if (layer + 1 < DEPTH && c >= rem) convert_weights(p, layer + 1, layer + 2, (long)(c - rem) * 512 + otid(wid_s), (long)(G - rem) * 512);
            }
}
        }
        gbar(barctr, (++bar_n) * (unsigned)G); if (PROBE_PHASE == 9) gbar(barctr, (++bar_n) * (unsigned)G);
        {
for (int rep_ = (PROBE_PHASE == 2 ? 0 : 1); rep_ < 2; ++rep_) { const bool dry = (PROBE_PHASE == 2) && (rep_ == 0) && (p.pos[0] == 0);
            const int tid = otid(wid_s), lane = tid & 63, w = tid >> 6;
#pragma unroll 1
            for (int g = c; g < 256; g += G) gla_local_item(p, layer, g * 8 + w, lane, dry);
}
        }
        ho_arrive(barctr + 16);
        if (c < 64) {
            ho_wait(barctr + 16, (unsigned)(layer + 1) * (unsigned)G);
            const int tid = otid(wid_s);
#pragma unroll 1
            for (int g = c; g < 64; g += G) gla_scan(p, g * 512 + tid);
            ho_arrive(barctr + 32);
        }
for (int rep_ = (PROBE_PHASE == 3 ? 0 : 1); rep_ < 2; ++rep_) { const bool dry = (PROBE_PHASE == 3) && (rep_ == 0) && (p.pos[0] == 0);
#pragma unroll 1
        for (int tile = c; tile < 512; tile += G) conformer_tile(p, layer, lds, tile, dry, wid_s);
}
for (int rep_ = (PROBE_PHASE == 4 ? 0 : 1); rep_ < 2; ++rep_) { const bool dry = (PROBE_PHASE == 4) && (rep_ == 0) && (p.pos[0] == 0);
#pragma unroll 1
        for (int it = c; it < 512; it += G) {
            const int pr = it >> 1, second = it & 1;
            const int xcd = pr & 7, j = pr >> 3, b = xcd >> 1, par = xcd & 1;
            const int qblk = second ? (2 * j + par) : 127 - (2 * j + par);
            dsa_item(p, lds, b, qblk, dry, wid_s, (const unsigned*)(p.ws + WS_KMAX) + layer * 32);
        }
}
        ho_wait(barctr + 32, (unsigned)(layer + 1) * (unsigned)(G < 64 ? G : 64));
        {
for (int rep_ = (PROBE_PHASE == 5 ? 0 : 1); rep_ < 2; ++rep_) { const bool dry = (PROBE_PHASE == 5) && (rep_ == 0) && (p.pos[0] == 0);
            const int tid = otid(wid_s), lane = tid & 63, w = tid >> 6;
#pragma unroll 1
            for (int g = c; g < 256; g += G) gla_out_item(p, layer, lds + w * 16384, g * 8 + w, lane, dry);
}
        }
        gbar(barctr, (++bar_n) * (unsigned)G); if (PROBE_PHASE == 9) gbar(barctr, (++bar_n) * (unsigned)G);
        {
for (int rep_ = (PROBE_PHASE == 6 ? 0 : 1); rep_ < 2; ++rep_) { const bool dry = (PROBE_PHASE == 6) && (rep_ == 0) && (p.pos[0] == 0);
            EpiOut e; e.xres = (layer == 0) ? p.x : p.out; e.out = p.out; e.dry = dry;
            const bf16_t* A = H + HAG;
            const bf16_t* Bt = (const bf16_t*)(p.ws + WS_WOUT) + (long)layer * 1024 * 1024;
#pragma unroll 1
            for (int L = c; L < 128 * 4; L += G) { int pm, pn; tile_of(L, 128, 4, pm, pn); gemm_tile((LAS unsigned char*)lds, A, HP, Bt, 1024, pm, pn, e, wid_s); ho_arrive((unsigned*)(p.ws + WS_PCNT) + pm * 16); }
}
        }
        {
for (int rep_ = (PROBE_PHASE == 7 ? 0 : 1); rep_ < 2; ++rep_) { const bool dry = (PROBE_PHASE == 7) && (rep_ == 0) && (p.pos[0] == 0);
            const int tid = otid(wid_s), lane = tid & 63, w = tid >> 6;
#pragma unroll 1
            for (int hp = c; hp < 256; hp += G) {
                ho_wait((unsigned*)(p.ws + WS_PCNT) + (hp >> 1) * 16, 4u * (unsigned)(layer + 1));
                const int base = (hp >> 1) * 256 + (hp & 1) * 128;
                ln_phase(p, layer, base + w, base + 128, 8, lane, dry);
                ho_arrive((unsigned*)(p.ws + WS_LCNT) + (hp >> 1) * 16);
            }
}
        }
    }
}

extern "C" void kernel_launch(void* const* d_in, const int* in_sizes, int n_in, void* d_out, int out_size, void* d_ws, size_t ws_size, hipStream_t stream) {
    static int grid_blocks = 0;
    if (grid_blocks == 0) {
        if (n_in != 15 || ws_size < WS_END) { fprintf(stderr, "kernel_launch: unexpected inputs (n_in %d, ws %zu < %zu)\n", n_in, ws_size, (size_t)WS_END); grid_blocks = -1; return; }
        int dev = 0, cus = 0, per_cu = 0;
        hipGetDevice(&dev);
        hipDeviceGetAttribute(&cus, hipDeviceAttributeMultiprocessorCount, dev);
        if (hipFuncSetAttribute((const void*)fwd_megakernel, hipFuncAttributeMaxDynamicSharedMemorySize, LDS_BYTES) != hipSuccess) { fprintf(stderr, "kernel_launch: hipFuncSetAttribute failed\n"); grid_blocks = -1; return; }
        hipOccupancyMaxActiveBlocksPerMultiprocessor(&per_cu, (const void*)fwd_megakernel, 512, LDS_BYTES);
        if (per_cu < 1) per_cu = 1;
        grid_blocks = cus * per_cu;
    }
    if (grid_blocks < 0) return;
    Params p{};
    p.x = (const float*)d_in[0]; p.pos = (const int*)d_in[1]; p.w_in = (const float*)d_in[2]; p.conv_w = (const float*)d_in[3]; p.conv_b = (const float*)d_in[4];
    p.cln_g = (const float*)d_in[5]; p.cln_b = (const float*)d_in[6]; p.pw_w = (const float*)d_in[7]; p.pw_b = (const float*)d_in[8];
    p.gate_w2 = (const float*)d_in[9]; p.gate_b = (const float*)d_in[10]; p.gnorm_g = (const float*)d_in[11]; p.w_out = (const float*)d_in[12];
    p.ln_g = (const float*)d_in[13]; p.ln_b = (const float*)d_in[14];
    p.out = (float*)d_out; p.ws = (unsigned char*)d_ws;
    for (int j = 0; j < 32; ++j) p.inv_freq[j] = (float)pow(10000.0, -(double)j / 32.0);
    void* args[] = {&p};
    hipError_t e = hipLaunchCooperativeKernel((const void*)fwd_megakernel, dim3(grid_blocks), dim3(512), args, LDS_BYTES, stream);
    if (e != hipSuccess) fprintf(stderr, "cooperative launch failed: %s (grid %d)\n", hipGetErrorString(e), grid_blocks);
}
```

```cpp
#include <hip/hip_runtime.h>
#include <hip/hip_cooperative_groups.h>
#include <cstdio>
#include <cmath>
namespace cg = cooperative_groups;

typedef unsigned short bf16_t;
typedef short bf16x8 __attribute__((ext_vector_type(8)));
typedef float f32x4 __attribute__((ext_vector_type(4)));
typedef float f32x16 __attribute__((ext_vector_type(16)));
typedef unsigned u32x4 __attribute__((ext_vector_type(4)));
typedef unsigned u32x2 __attribute__((ext_vector_type(2)));
typedef unsigned long long u64;

constexpr int NB = 4, T = 8192, NTOK = NB * T, DM = 1024, DIN = 4184, NPAD = 4352, HP = 4160, DEPTH = 4;
constexpr int HQ = 0, HK = 512, HV = 1024, HQI = 1536, HKI = 2048, HGLU = 2112, HCQ = 2624, HCK = 2752, HCV = 2880, HAG = 3136, HBG = 3648, HCG = 3904;
constexpr float EPS = 1e-5f;
constexpr float ALPHA = 1.6817928305074290f;
constexpr float QSCALE = 0.125f * 1.4426950408889634f;
constexpr float WI_SCALE = 0.04419417382415922f;
constexpr float SIG_UNIT = 5.66f;
constexpr int CAP = 128;

constexpr size_t WS_WIN = 0;
constexpr size_t WS_WOUT = WS_WIN + (size_t)DEPTH * NPAD * 1024 * 2;
constexpr size_t WS_PWT = WS_WOUT + (size_t)DEPTH * 1024 * 1024 * 2;
constexpr size_t WS_ROPE = WS_PWT + (size_t)DEPTH * 256 * 256 * 2;
constexpr size_t WS_XB = WS_ROPE + (size_t)NTOK * 32 * 8;
constexpr size_t WS_H = WS_XB + (size_t)NTOK * 1024 * 2;
constexpr size_t WS_SIDE = WS_H + (size_t)NTOK * HP * 2;
constexpr size_t WS_BCUM = WS_SIDE + (size_t)NTOK * 24 * 4;
constexpr size_t WS_U = WS_BCUM + (size_t)NTOK * 128 * 4;
constexpr size_t WS_DEC = WS_U + (size_t)2048 * 2048 * 4;
constexpr size_t WS_VT = WS_DEC + (size_t)2048 * 32 * 4;
constexpr size_t WS_KF = WS_VT + (size_t)NTOK * 512 * 2;
constexpr size_t WS_BAR = WS_KF + (size_t)NTOK * 512 * 2;
constexpr size_t WS_KMAX = WS_BAR + 256;
constexpr size_t WS_PCNT = WS_KMAX + 512;
constexpr size_t WS_LCNT = WS_PCNT + 128 * 64;
constexpr size_t WS_END = WS_LCNT + 128 * 64;

#ifndef PROBE_PHASE
#define PROBE_PHASE 0
#endif
constexpr int LDS_BYTES = 147456;

struct Params {
    const float* x; const int* pos; const float* w_in; const float* conv_w; const float* conv_b; const float* cln_g; const float* cln_b;
    const float* pw_w; const float* pw_b; const float* gate_w2; const float* gate_b; const float* gnorm_g; const float* w_out; const float* ln_g; const float* ln_b;
    float* out; unsigned char* ws;
    float inv_freq[32];
};

__device__ __forceinline__ unsigned f2bf(float f) { unsigned u = __float_as_uint(f); return (u + 0x7fffu + ((u >> 16) & 1u)) >> 16; }
__device__ __forceinline__ float bf2f(unsigned b) { return __uint_as_float(b << 16); }
typedef float f32x2_t __attribute__((ext_vector_type(2)));
typedef __bf16 bf16x2_t __attribute__((ext_vector_type(2)));
__device__ __forceinline__ unsigned pk2(float lo, float hi) { f32x2_t v = {lo, hi}; bf16x2_t b = __builtin_convertvector(v, bf16x2_t); return __builtin_bit_cast(unsigned, b); }
__device__ __forceinline__ float bflo(unsigned w) { return __uint_as_float(w << 16); }
__device__ __forceinline__ float bfhi(unsigned w) { return __uint_as_float(w & 0xffff0000u); }
__device__ __forceinline__ float silu_f(float v) { return v / (1.f + __expf(-v)); }
__device__ __forceinline__ float sigmoid_f(float v) { return 1.f / (1.f + __expf(-v)); }
__device__ __forceinline__ int bperm_i(int idx, int v) { return __builtin_amdgcn_ds_bpermute(idx << 2, v); }
__device__ __forceinline__ float sxor_f(float v, int lane, int m) { return __int_as_float(bperm_i(lane ^ m, __float_as_int(v))); }
__device__ __forceinline__ int sxor_i(int v, int lane, int m) { return bperm_i(lane ^ m, v); }
__device__ __forceinline__ float wave_sum(float v, int lane) {
#pragma unroll
    for (int o = 32; o >= 1; o >>= 1) v += sxor_f(v, lane, o);
    return v;
}
__device__ __forceinline__ int otid(int wid_s) { int l; asm volatile("v_mbcnt_lo_u32_b32 %0, -1, 0\n\tv_mbcnt_hi_u32_b32 %0, -1, %0" : "=v"(l)); return (wid_s << 6) | l; }
#define WAVE_SYNC() do { __builtin_amdgcn_fence(__ATOMIC_RELEASE, "wavefront"); __builtin_amdgcn_wave_barrier(); __builtin_amdgcn_fence(__ATOMIC_ACQUIRE, "wavefront"); } while (0)

__device__ __forceinline__ int l2orig(int l) {
    if (l < 1536) return l;
    if (l < 2048) return 2048 + (l - 1536);
    if (l < 2112) return 2560 + (l - 2048);
    if (l < 2624) return 2632 + (l - 2112);
    if (l < 2752) return 3400 + (l - 2624);
    if (l < 2880) return 3528 + (l - 2752);
    if (l < 3136) return 3656 + (l - 2880);
    if (l < 3648) return 1536 + (l - 3136);
    if (l < 3904) return 3144 + (l - 3648);
    if (l < 4160) return 3912 + (l - 3904);
    if (l < 4168) return 2624 + (l - 4160);
    if (l < 4184) return 4168 + (l - 4168);
    return -1;
}
__device__ __forceinline__ int npos2logical(int np) {
    const int hb = np & ~127, p = np & 127, wc = p >> 5, n = (p >> 4) & 1, fr = p & 15;
    return hb + (wc >> 1) * 64 + n * 32 + (wc & 1) * 16 + fr;
}

__device__ __forceinline__ void sincos_acc(float angf, float& c, float& s) {
    const double a = (double)angf;
    const double n = rint(a * 0.15915494309189535);
    double r = fma(-n, 6.283185307179586, a);
    r = fma(-n, 2.4492935982947064e-16, r);
    const double r2 = r * r;
    double ts = r, tc = 1.0, ss = r, cc = 1.0;
#pragma unroll
    for (int k = 1; k <= 14; ++k) {
        tc = -tc * r2 * (1.0 / (double)((2 * k - 1) * (2 * k)));
        ts = -ts * r2 * (1.0 / (double)((2 * k) * (2 * k + 1)));
        cc += tc; ss += ts;
    }
    c = (float)cc; s = (float)ss;
}

__device__ __forceinline__ void convert_weights(const Params& p, int l0, int l1, long gtid, long gthreads) {
    bf16_t* win = (bf16_t*)(p.ws + WS_WIN);
    for (long idx = gtid; idx < (long)(l1 - l0) * 128 * NPAD; idx += gthreads) {
        const int np = (int)(idx % NPAD); const long r = idx / NPAD; const int kc = (int)(r % 128); const int l = l0 + (int)(r / 128);
        const int oc = l2orig(npos2logical(np));
        u32x4 w = {0u, 0u, 0u, 0u};
        if (oc >= 0) {
            const float* src = p.w_in + ((long)l * 1024 + kc * 8) * DIN + oc;
            float v[8];
#pragma unroll
            for (int i = 0; i < 8; ++i) v[i] = src[(long)i * DIN];
            w.x = pk2(v[0], v[1]); w.y = pk2(v[2], v[3]); w.z = pk2(v[4], v[5]); w.w = pk2(v[6], v[7]);
        }
        *(u32x4*)(win + ((long)l * NPAD + np) * 1024 + kc * 8) = w;
    }
    bf16_t* wout = (bf16_t*)(p.ws + WS_WOUT);
    for (long idx = gtid; idx < (long)(l1 - l0) * 128 * 1024; idx += gthreads) {
        const int n = (int)(idx % 1024); const long r = idx / 1024; const int kc = (int)(r % 128); const int l = l0 + (int)(r / 128);
        const float* src = p.w_out + ((long)l * 1024 + kc * 8) * 1024 + n;
        float v[8];
#pragma unroll
        for (int i = 0; i < 8; ++i) v[i] = src[(long)i * 1024];
        u32x4 w; w.x = pk2(v[0], v[1]); w.y = pk2(v[2], v[3]); w.z = pk2(v[4], v[5]); w.w = pk2(v[6], v[7]);
        *(u32x4*)(wout + ((long)l * 1024 + n) * 1024 + kc * 8) = w;
    }
    bf16_t* pwt = (bf16_t*)(p.ws + WS_PWT);
    for (long idx = gtid; idx < (long)(l1 - l0) * 32 * 256; idx += gthreads) {
        const int n = (int)(idx % 256); const long r = idx / 256; const int kc = (int)(r % 32); const int l = l0 + (int)(r / 32);
        const float* src = p.pw_w + ((long)l * 256 + kc * 8) * 256 + n;
        float v[8];
#pragma unroll
        for (int i = 0; i < 8; ++i) v[i] = src[(long)i * 256];
        u32x4 w; w.x = pk2(v[0], v[1]); w.y = pk2(v[2], v[3]); w.z = pk2(v[4], v[5]); w.w = pk2(v[6], v[7]);
        *(u32x4*)(pwt + ((long)l * 256 + n) * 256 + kc * 8) = w;
    }
}

__device__ __forceinline__ void prologue(const Params& p, long gtid, long gthreads) {
    convert_weights(p, 0, 1, gtid, gthreads);
    float2* rope = (float2*)(p.ws + WS_ROPE);
    for (long idx = gtid; idx < (long)NTOK * 32; idx += gthreads) {
        const int j = (int)(idx & 31); const long tok = idx >> 5;
        const float ang = (float)p.pos[tok] * p.inv_freq[j];
        float c, s; sincos_acc(ang, c, s);
        rope[idx] = make_float2(c, s);
    }
    if (gtid < 128) { ((unsigned*)(p.ws + WS_KMAX))[gtid] = 0u; ((unsigned*)(p.ws + WS_PCNT))[gtid * 16] = 0u; ((unsigned*)(p.ws + WS_LCNT))[gtid * 16] = 0u; }
    bf16_t* xb = (bf16_t*)(p.ws + WS_XB);
    for (long idx = gtid; idx < (long)NTOK * 128; idx += gthreads) {
        const f32x4 a = *(const f32x4*)(p.x + idx * 8), b = *(const f32x4*)(p.x + idx * 8 + 4);
        u32x4 w; w.x = pk2(a[0], a[1]); w.y = pk2(a[2], a[3]); w.z = pk2(b[0], b[1]); w.w = pk2(b[2], b[3]);
        *(u32x4*)(xb + idx * 8) = w;
    }
}

constexpr int BM = 256, BK = 64, HALF = 128, HT = HALF * BK;
__device__ __forceinline__ int lds_byte(int r, int c) {
    int st = (r >> 4) * 2 + (c >> 5), rr = r & 15, cc = c & 31, ob = rr * 64 + cc * 2;
    return st * 1024 + (ob ^ (((ob >> 9) & 1) << 5));
}
__device__ __forceinline__ void stage_rc(int b, int& R, int& C) {
    int st = b / 1024, sb = b % 1024, swz = sb ^ (((sb >> 9) & 1) << 5);
    R = (st >> 1) * 16 + swz / 64; C = (st & 1) * 32 + (swz % 64) / 2;
}
__device__ __forceinline__ void tile_of(int L, int nM, int nN, int& pm, int& pn) {
    const int nwg = nM * nN; int wgid = L;
    { const int q = nwg / 8, r = nwg % 8, xcd = wgid % 8, off = wgid / 8; wgid = (xcd < r ? xcd * (q + 1) : r * (q + 1) + (xcd - r) * q) + off; }
    const int nig = 8 * nN, gid = wgid / nig, fm = gid * 8, gsz = (nM - fm) < 8 ? (nM - fm) : 8;
    pm = fm + ((wgid % nig) % gsz); pn = (wgid % nig) / gsz;
}

#define LAS __attribute__((address_space(3)))
template <class Epi>
__device__ __forceinline__ void gemm_tile(LAS unsigned char* lds, const bf16_t* A, int lda, const bf16_t* Bt, int K, int pm, int pn, const Epi& epi, int wid_s) {
    const int tid = otid(wid_s), wid = __builtin_amdgcn_readfirstlane(tid >> 6), lane = tid & 63, wr = wid >> 2, wc = wid & 3, fr = lane & 15, fq = lane >> 4;
    const int nt = K / BK;
    unsigned voffA[2], voffB[2];
#pragma unroll
    for (int i = 0; i < 2; ++i) { int R, C; stage_rc(tid * 16 + i * 8192, R, C); voffA[i] = (unsigned)(R * lda + C) * 2u; voffB[i] = (unsigned)(R * K + C) * 2u; }
    const size_t kstep = (size_t)(BK * 2), hstepA = (size_t)HALF * lda * 2, hstepB = (size_t)HALF * K * 2;
    const unsigned ldsw = (unsigned)wid * 1024u;
    const int aoff = lds_byte(wr * 64 + fr, fq * 8), boff = lds_byte(wc * 32 + fr, fq * 8);
    const char* cA = (const char*)A + (size_t)pm * 2 * hstepA; const char* cB = (const char*)Bt + (size_t)pn * 2 * hstepB;
#define HTB (HALF * BK * 2)
#define SA(b, h) (((b) * 2 + (h)) * HTB)
#define SB(b, h) ((4 + (b) * 2 + (h)) * HTB)
#define STAGE(bufoff, gbase, voff) do { _Pragma("unroll") for (int _i = 0; _i < 2; ++_i) \
        __builtin_amdgcn_global_load_lds((const unsigned*)((const char*)(gbase) + (voff)[_i]), (LAS unsigned*)(lds + (bufoff) + ldsw + _i * 8192), 16, 0, 0); } while (0)
#define LDA(dst, b, h) do { _Pragma("unroll") for (int m = 0; m < 4; ++m) _Pragma("unroll") for (int k = 0; k < 2; ++k) dst[m][k] = *(const LAS bf16x8*)(lds + SA(b, h) + aoff + m * 2048 + k * 1024); } while (0)
#define LDB(dst, b, h) do { _Pragma("unroll") for (int n = 0; n < 2; ++n) _Pragma("unroll") for (int k = 0; k < 2; ++k) dst[n][k] = *(const LAS bf16x8*)(lds + SB(b, h) + boff + n * 2048 + k * 1024); } while (0)
#define MMA(ai, bj, At_, Bt_) do { __builtin_amdgcn_s_setprio(1); _Pragma("unroll") for (int m = 0; m < 4; ++m) _Pragma("unroll") for (int n = 0; n < 2; ++n) _Pragma("unroll") for (int k = 0; k < 2; ++k) \
        acc[ai][bj][m][n] = __builtin_amdgcn_mfma_f32_16x16x32_bf16(Bt_[n][k], At_[m][k], acc[ai][bj][m][n], 0, 0, 0); __builtin_amdgcn_s_setprio(0); } while (0)
#define WAIT_V(n) asm volatile("s_waitcnt vmcnt(" #n ")" ::: "memory")
#define WAIT_L(n) asm volatile("s_waitcnt lgkmcnt(" #n ")" ::: "memory")
#define BAR __builtin_amdgcn_s_barrier()
#define SCHED __builtin_amdgcn_sched_barrier(0)
    f32x4 acc[2][2][4][2];
#pragma unroll
    for (int a = 0; a < 2; ++a)
#pragma unroll
        for (int b = 0; b < 2; ++b)
#pragma unroll
            for (int m = 0; m < 4; ++m)
#pragma unroll
                for (int n = 0; n < 2; ++n) acc[a][b][m][n] = (f32x4){0.f, 0.f, 0.f, 0.f};
    bf16x8 At[4][2], B0[2][2], B1[2][2];
    STAGE(SB(0, 0), cB, voffB); STAGE(SA(0, 0), cA, voffA); STAGE(SB(0, 1), cB + hstepB, voffB); STAGE(SA(0, 1), cA + hstepA, voffA);
    if (wr == 1) BAR;
    WAIT_V(4); BAR;
    STAGE(SB(1, 0), cB + kstep, voffB); STAGE(SA(1, 0), cA + kstep, voffA); STAGE(SB(1, 1), cB + hstepB + kstep, voffB);
    WAIT_V(6); BAR;
    for (int t = 0; t < nt - 2; t += 2) {
        const char* a1 = cA + (size_t)(t + 1) * kstep; const char* a2 = cA + (size_t)(t + 2) * kstep; const char* b2 = cB + (size_t)(t + 2) * kstep;
        const char* a3 = a2 + kstep; const char* b3 = b2 + kstep;
        LDB(B0, 0, 0); SCHED; LDA(At, 0, 0); STAGE(SA(1, 1), a1 + hstepA, voffA);
        WAIT_L(8); BAR; WAIT_L(0); MMA(0, 0, At, B0); BAR; SCHED;
        LDB(B1, 0, 1); STAGE(SB(0, 0), b2, voffB);
        BAR; WAIT_L(0); MMA(0, 1, At, B1); BAR;
        LDA(At, 0, 1); STAGE(SA(0, 0), a2, voffA);
        BAR; WAIT_L(0); MMA(1, 0, At, B0); BAR; SCHED;
        STAGE(SB(0, 1), b2 + hstepB, voffB);
        WAIT_V(6); BAR; MMA(1, 1, At, B1); BAR;
        LDB(B0, 1, 0); SCHED; LDA(At, 1, 0); STAGE(SA(0, 1), a2 + hstepA, voffA);
        WAIT_L(8); BAR; WAIT_L(0); MMA(0, 0, At, B0); BAR; SCHED;
        LDB(B1, 1, 1); STAGE(SB(1, 0), b3, voffB);
        BAR; WAIT_L(0); MMA(0, 1, At, B1); BAR;
        LDA(At, 1, 1); STAGE(SA(1, 0), a3, voffA);
        BAR; WAIT_L(0); MMA(1, 0, At, B0); BAR; SCHED;
        STAGE(SB(1, 1), b3 + hstepB, voffB);
        WAIT_V(6); BAR; MMA(1, 1, At, B1); BAR;
    }
    { const char* a1 = cA + (size_t)(nt - 1) * kstep;
      LDB(B0, 0, 0); LDA(At, 0, 0); STAGE(SA(1, 1), a1 + hstepA, voffA);
      BAR; WAIT_L(0); MMA(0, 0, At, B0); BAR;
      LDB(B1, 0, 1); BAR; WAIT_L(0); MMA(0, 1, At, B1); BAR;
      LDA(At, 0, 1); WAIT_V(4); BAR; WAIT_L(0); MMA(1, 0, At, B0); MMA(1, 1, At, B1); BAR; }
    { LDB(B0, 1, 0); LDA(At, 1, 0); WAIT_V(2); BAR; WAIT_L(0); MMA(0, 0, At, B0); BAR;
      LDB(B1, 1, 1); WAIT_V(0); BAR; WAIT_L(0); MMA(0, 1, At, B1); BAR;
      LDA(At, 1, 1); BAR; WAIT_L(0); MMA(1, 0, At, B0); MMA(1, 1, At, B1); BAR; }
    if (wr == 0) BAR;
    epi(acc, pm * BM, pn * BM, wr, wc, fr, fq);
#undef SA
#undef SB
#undef STAGE
#undef LDA
#undef LDB
#undef MMA
}

struct EpiIn {
    bf16_t* H; float* side; const float* rope; bf16_t* VT; bf16_t* KF; unsigned* kmax; bool dry;
    __device__ __forceinline__ void operator()(f32x4 (&acc)[2][2][4][2], int brow, int bcol, int wr, int wc, int fr, int fq) const {
#pragma unroll
        for (int bj = 0; bj < 2; ++bj) {
            const int hb = bcol + bj * HALF;
            if (hb >= 4224 || dry) continue;
            const int gbase = hb + (wc >> 1) * 64, g64 = gbase >> 6, d0 = (wc & 1) * 16 + 4 * fq;
            const bool rp = (g64 < 16) || (g64 >= 24 && g64 <= 32);
            const float qs = (g64 < 8) ? QSCALE : 1.f;
            float kabs = 0.f;
#pragma unroll
            for (int ai = 0; ai < 2; ++ai)
#pragma unroll
                for (int m = 0; m < 4; ++m) {
                    const long row = brow + ai * HALF + wr * 64 + m * 16 + fr;
                    f32x4 o1 = acc[ai][bj][m][0], o2 = acc[ai][bj][m][1];
                    if (rp) {
                        const f32x4 c0 = *(const f32x4*)(rope + (row * 32 + d0) * 2), c1 = *(const f32x4*)(rope + (row * 32 + d0) * 2 + 4);
                        const f32x4 x1 = o1, x2 = o2;
                        o1[0] = (x1[0] * c0[0] - x2[0] * c0[1]) * qs; o2[0] = (x2[0] * c0[0] + x1[0] * c0[1]) * qs;
                        o1[1] = (x1[1] * c0[2] - x2[1] * c0[3]) * qs; o2[1] = (x2[1] * c0[2] + x1[1] * c0[3]) * qs;
                        o1[2] = (x1[2] * c1[0] - x2[2] * c1[1]) * qs; o2[2] = (x2[2] * c1[0] + x1[2] * c1[1]) * qs;
                        o1[3] = (x1[3] * c1[2] - x2[3] * c1[3]) * qs; o2[3] = (x2[3] * c1[2] + x1[3] * c1[3]) * qs;
                    }
                    if (g64 >= 8 && g64 < 24) {
                        const int bb = (int)(row >> 13), tt = (int)(row & (T - 1)), tile = tt >> 5, tk = tt & 31;
                        if (g64 < 16) {
                            kabs = fmaxf(kabs, fmaxf(fmaxf(fabsf(o1[0]), fabsf(o1[1])), fmaxf(fabsf(o1[2]), fabsf(o1[3]))));
                            kabs = fmaxf(kabs, fmaxf(fmaxf(fabsf(o2[0]), fabsf(o2[1])), fmaxf(fabsf(o2[2]), fabsf(o2[3]))));
                            const long base = ((long)(bb * 8 + (g64 - 8)) * 256 + tile) * 4;
                            const int ks = d0 >> 4, hk = (d0 >> 3) & 1, j0 = d0 & 7;
                            u32x2 w1, w2; w1.x = pk2(o1[0], o1[1]); w1.y = pk2(o1[2], o1[3]); w2.x = pk2(o2[0], o2[1]); w2.y = pk2(o2[2], o2[3]);
                            const auto sx = __builtin_amdgcn_permlane16_swap(w1.x, w2.x, false, false), sy = __builtin_amdgcn_permlane16_swap(w1.y, w2.y, false, false);
                            u32x4 wv; long slot;
                            if (fq & 1) { wv.x = sx[0]; wv.y = sy[0]; wv.z = w2.x; wv.w = w2.y; slot = (base + ks + 2) * 64 + hk * 32 + tk; }
                            else { wv.x = w1.x; wv.y = w1.y; wv.z = sx[1]; wv.w = sy[1]; slot = (base + ks) * 64 + hk * 32 + tk; }
                            *(u32x4*)(KF + slot * 8) = wv;
                        } else {
                            const int s = tk >> 4, u = tk & 15, hv = (u >> 2) & 1, jv = (u >> 3) * 4 + (u & 3);
                            const long base = (((long)(bb * 8 + (g64 - 16)) * 256 + tile) * 2) * 2 + s;
                            bf16_t* v0 = VT + ((base) * 64 + hv * 32 + d0) * 8 + jv;
                            bf16_t* v1 = VT + ((base + 2) * 64 + hv * 32 + d0) * 8 + jv;
#pragma unroll
                            for (int j = 0; j < 4; ++j) { v0[j * 8] = (bf16_t)f2bf(o1[j]); v1[j * 8] = (bf16_t)f2bf(o2[j]); }
                        }
                    } else if (gbase < 4160) {
                        bf16_t* hp = H + row * HP + gbase + d0;
                        u32x2 w1, w2; w1.x = pk2(o1[0], o1[1]); w1.y = pk2(o1[2], o1[3]); w2.x = pk2(o2[0], o2[1]); w2.y = pk2(o2[2], o2[3]);
                        const auto sx = __builtin_amdgcn_permlane16_swap(w1.x, w2.x, false, false), sy = __builtin_amdgcn_permlane16_swap(w1.y, w2.y, false, false);
                        u32x4 wv;
                        if (fq & 1) { wv.x = sx[0]; wv.y = sy[0]; wv.z = w2.x; wv.w = w2.y; hp += 32 - 4; }
                        else { wv.x = w1.x; wv.y = w1.y; wv.z = sx[1]; wv.w = sy[1]; }
                        *(u32x4*)hp = wv;
                    } else if (d0 < 8) { *(f32x4*)(side + row * 24 + d0) = o1 * WI_SCALE; }
                    else if (d0 < 24) { *(f32x4*)(side + row * 24 + d0) = o1; }
                }
            if (g64 >= 8 && g64 < 16) {
#pragma unroll
                for (int o = 32; o >= 1; o >>= 1) kabs = fmaxf(kabs, sxor_f(kabs, fq * 16 + fr, o));
                if ((threadIdx.x & 63) == 0) atomicMax(kmax + (brow >> 13) * 8 + (g64 - 8), __float_as_uint(kabs));
            }
        }
    }
};
struct EpiOut {
    const float* xres; float* out; bool dry;
    __device__ __forceinline__ void operator()(f32x4 (&acc)[2][2][4][2], int brow, int bcol, int wr, int wc, int fr, int fq) const {
#pragma unroll
        for (int ai = 0; ai < 2; ++ai)
#pragma unroll
            for (int m = 0; m < 4; ++m)
#pragma unroll
                for (int bj = 0; bj < 2; ++bj)
#pragma unroll
                    for (int n = 0; n < 2; ++n) {
                        const long idx = (long)(brow + ai * HALF + wr * 64 + m * 16 + fr) * DM + (bcol + bj * HALF + wc * 32 + n * 16 + 4 * fq);
                        const f32x4 xr = *(const f32x4*)(xres + idx);
                        if (!dry) *(f32x4*)(out + idx) = xr * ALPHA + acc[ai][bj][m][n];
                    }
    }
};

__device__ __forceinline__ void ln_phase(const Params& p, int layer, int row_begin, int row_end, int row_step, int lane, bool dry) {
    bf16_t* xb = (bf16_t*)(p.ws + WS_XB);
    const float* g = p.ln_g + layer * DM; const float* bb = p.ln_b + layer * DM;
    for (int row = row_begin; row < row_end; row += row_step) {
        float* zr = p.out + (long)row * DM;
        f32x4 v[4]; float s = 0.f;
#pragma unroll
        for (int r = 0; r < 4; ++r) { v[r] = *(const f32x4*)(zr + r * 256 + lane * 4); s += v[r][0] + v[r][1] + v[r][2] + v[r][3]; }
        const float mu = wave_sum(s, lane) * (1.f / DM);
        float q = 0.f;
#pragma unroll
        for (int r = 0; r < 4; ++r)
#pragma unroll
            for (int e = 0; e < 4; ++e) { const float d = v[r][e] - mu; q += d * d; }
        const float rstd = rsqrtf(wave_sum(q, lane) * (1.f / DM) + EPS);
#pragma unroll
        for (int r = 0; r < 4; ++r) {
            const f32x4 gg = *(const f32x4*)(g + r * 256 + lane * 4), bv = *(const f32x4*)(bb + r * 256 + lane * 4);
            f32x4 y;
#pragma unroll
            for (int e = 0; e < 4; ++e) y[e] = (v[r][e] - mu) * rstd * gg[e] + bv[e];
            if (dry) continue;
            *(f32x4*)(zr + r * 256 + lane * 4) = y;
            u32x2 w; w.x = pk2(y[0], y[1]); w.y = pk2(y[2], y[3]);
            *(u32x2*)(xb + (long)row * DM + r * 256 + lane * 4) = w;
        }
    }
}

__device__ __forceinline__ void conformer_tile(const Params& p, int layer, unsigned char* lds, int tile, bool dry, int wid_s) {
    bf16_t* H = (bf16_t*)(p.ws + WS_H);
    const int tid = otid(wid_s), lane = tid & 63, w = tid >> 6;
    const int tok0 = tile * 64, b = tok0 / T, tl0 = tok0 % T;
    bf16_t* hg = (bf16_t*)lds;
    float* cv = (float*)(lds + 49152);
    for (int idx = tid; idx < 94 * 32; idx += 512) {
        const int r = idx >> 5, cc = (idx & 31) * 8, tl = tl0 - 30 + r;
        u32x4 o = {0u, 0u, 0u, 0u};
        if (tl >= 0) {
            const bf16_t* src = H + ((long)b * T + tl) * HP + HGLU + cc;
            const u32x4 va = *(const u32x4*)src, ga = *(const u32x4*)(src + 256);
            o.x = pk2(bflo(va.x) * sigmoid_f(bflo(ga.x)), bfhi(va.x) * sigmoid_f(bfhi(ga.x)));
            o.y = pk2(bflo(va.y) * sigmoid_f(bflo(ga.y)), bfhi(va.y) * sigmoid_f(bfhi(ga.y)));
            o.z = pk2(bflo(va.z) * sigmoid_f(bflo(ga.z)), bfhi(va.z) * sigmoid_f(bfhi(ga.z)));
            o.w = pk2(bflo(va.w) * sigmoid_f(bflo(ga.w)), bfhi(va.w) * sigmoid_f(bfhi(ga.w)));
        }
        *(u32x4*)(hg + r * 256 + cc) = o;
    }
    __syncthreads();
    {
        const int c = tid & 255, half = tid >> 8;
        const float* cw = p.conv_w + (long)layer * 31 * 256 + c;
        float wj[31];
#pragma unroll
        for (int j = 0; j < 31; ++j) wj[j] = cw[j * 256];
        const float cb = p.conv_b[layer * 256 + c];
        float win[62];
#pragma unroll
        for (int r = 0; r < 62; ++r) win[r] = bf2f(hg[(half * 32 + r) * 256 + c]);
#pragma unroll
        for (int tt = 0; tt < 32; ++tt) {
            float a = cb;
#pragma unroll
            for (int j = 0; j < 31; ++j) a = fmaf(win[tt + j], wj[j], a);
            cv[(half * 32 + tt) * 256 + c] = a;
        }
    }
    __syncthreads();
    bf16_t* at = (bf16_t*)lds;
    {
        const f32x4 gg = *(const f32x4*)(p.cln_g + layer * 256 + lane * 4), bv = *(const f32x4*)(p.cln_b + layer * 256 + lane * 4);
#pragma unroll
        for (int tt = 0; tt < 8; ++tt) {
            const int t = w * 8 + tt;
            const f32x4 v = *(const f32x4*)(cv + t * 256 + lane * 4);
            const float mu = wave_sum(v[0] + v[1] + v[2] + v[3], lane) * (1.f / 256.f);
            float q = 0.f;
#pragma unroll
            for (int e = 0; e < 4; ++e) { const float d = v[e] - mu; q += d * d; }
            const float rstd = rsqrtf(wave_sum(q, lane) * (1.f / 256.f) + EPS);
            float y[4];
#pragma unroll
            for (int e = 0; e < 4; ++e) y[e] = silu_f((v[e] - mu) * rstd * gg[e] + bv[e]);
            u32x2 o; o.x = pk2(y[0], y[1]); o.y = pk2(y[2], y[3]);
            *(u32x2*)(at + t * 264 + lane * 4) = o;
        }
    }
    __syncthreads();
    {
        f32x16 acc0 = {}, acc1 = {};
        const bf16_t* pwt = (const bf16_t*)(p.ws + WS_PWT) + (long)layer * 65536 + (w * 32 + (lane & 31)) * 256 + 8 * (lane >> 5);
        const bf16_t* ap = at + (lane & 31) * 264 + 8 * (lane >> 5);
#pragma unroll 4
        for (int ks = 0; ks < 16; ++ks) {
            const bf16x8 bfr = *(const bf16x8*)(pwt + ks * 16);
            const bf16x8 a0 = *(const bf16x8*)(ap + ks * 16), a1 = *(const bf16x8*)(ap + 32 * 264 + ks * 16);
            acc0 = __builtin_amdgcn_mfma_f32_32x32x16_bf16(a0, bfr, acc0, 0, 0, 0);
            acc1 = __builtin_amdgcn_mfma_f32_32x32x16_bf16(a1, bfr, acc1, 0, 0, 0);
        }
        const int ch = w * 32 + (lane & 31);
        const float pb = p.pw_b[layer * 256 + ch];
#pragma unroll
        for (int i = 0; i < 16; ++i) {
            const int row = (i & 3) + 8 * (i >> 2) + 4 * (lane >> 5);
            bf16_t* g0 = H + (long)(tok0 + row) * HP + HBG + ch;
            bf16_t* g1 = H + (long)(tok0 + 32 + row) * HP + HBG + ch;
            const unsigned r0 = f2bf((acc0[i] + pb) * silu_f(bf2f(*g0))), r1 = f2bf((acc1[i] + pb) * silu_f(bf2f(*g1)));
            if (!dry) { *g0 = (bf16_t)r0; *g1 = (bf16_t)r1; }
        }
    }
    __syncthreads();
}

__device__ __forceinline__ float rdlane(float v, int l) { return __uint_as_float(__builtin_amdgcn_readlane(__float_as_uint(v), l)); }

__device__ __forceinline__ void gla_local_item(const Params& p, int layer, int item_, int lane, bool dry) {
    const int item = __builtin_amdgcn_readfirstlane(item_);
    bf16_t* H = (bf16_t*)(p.ws + WS_H);
    const float* side = (const float*)(p.ws + WS_SIDE);
    float* bcum = (float*)(p.ws + WS_BCUM); float* U = (float*)(p.ws + WS_U); float* DEC = (float*)(p.ws + WS_DEC);
    const int bh = item >> 7, c = item & 127, b = bh >> 2, h = bh & 3;
    const long tok0 = (long)b * T + c * 64, tok = tok0 + lane;
    float clr[16];
#pragma unroll
    for (int r = 0; r < 4; ++r) { const f32x4 v = *(const f32x4*)(side + tok * 24 + 8 + r * 4); clr[r * 4] = v[0]; clr[r * 4 + 1] = v[1]; clr[r * 4 + 2] = v[2]; clr[r * 4 + 3] = v[3]; }
    const float* gw = p.gate_w2 + (long)layer * 16 * 128 + h * 32; const float* gb = p.gate_b + layer * 128 + h * 32;
    float* bcp = bcum + tok * 128 + h * 32;
#pragma unroll 1
    for (int d = 0; d < 32; ++d) {
        float z = gb[d];
#pragma unroll
        for (int r = 0; r < 16; ++r) z = fmaf(clr[r], gw[r * 128 + d], z);
        float g = (fminf(z, 0.f) - __logf(1.f + __expf(-fabsf(z)))) * (1.f / 16.f);
#pragma unroll
        for (int o = 1; o < 64; o <<= 1) { const float up = __int_as_float(bperm_i((lane - o) & 63, __float_as_int(g))); if (lane >= o) g += up; }
        bcp[d] = g;
    }
    float bc[32];
#pragma unroll
    for (int r = 0; r < 8; ++r) { const f32x4 v = *(const f32x4*)(bcp + r * 4); bc[r * 4] = v[0]; bc[r * 4 + 1] = v[1]; bc[r * 4 + 2] = v[2]; bc[r * 4 + 3] = v[3]; }
    float kk[32];
    {
        const bf16_t* kp = H + tok * HP + HCK + h * 32;
#pragma unroll
        for (int r = 0; r < 4; ++r) {
            const u32x4 kv = *(const u32x4*)(kp + r * 8);
            kk[r * 8 + 0] = bflo(kv.x); kk[r * 8 + 1] = bfhi(kv.x); kk[r * 8 + 2] = bflo(kv.y); kk[r * 8 + 3] = bfhi(kv.y);
            kk[r * 8 + 4] = bflo(kv.z); kk[r * 8 + 5] = bfhi(kv.z); kk[r * 8 + 6] = bflo(kv.w); kk[r * 8 + 7] = bfhi(kv.w);
        }
#pragma unroll
        for (int d = 0; d < 32; ++d) { const float bl = rdlane(bc[d], 63); kk[d] *= __expf(bl - bc[d]); }
    }
    float acc[32];
#pragma unroll
    for (int d = 0; d < 32; ++d) acc[d] = 0.f;
    const bf16_t* vp = H + tok0 * HP + HCV + h * 64 + lane;
#pragma unroll 1
    for (int t8 = 0; t8 < 64; t8 += 8) {
        float vv[8];
#pragma unroll
        for (int u = 0; u < 8; ++u) vv[u] = bf2f(vp[(long)(t8 + u) * HP]);
#pragma unroll
        for (int u = 0; u < 8; ++u)
#pragma unroll
            for (int d = 0; d < 32; ++d) acc[d] = fmaf(rdlane(kk[d], t8 + u), vv[u], acc[d]);
    }
#pragma unroll
    for (int d = 0; d < 32; ++d) if (!dry) U[(long)item * 2048 + d * 64 + lane] = acc[d];
    if (lane == 63) {
#pragma unroll
        for (int r = 0; r < 8; ++r) { f32x4 v = {__expf(bc[r * 4]), __expf(bc[r * 4 + 1]), __expf(bc[r * 4 + 2]), __expf(bc[r * 4 + 3])}; *(f32x4*)(DEC + item * 32 + r * 4) = v; }
    }
}

__device__ __forceinline__ void gla_scan(const Params& p, int gt) {
    float* U = (float*)(p.ws + WS_U); const float* DEC = (const float*)(p.ws + WS_DEC);
    const int bh = gt >> 11, de = gt & 2047, d = de >> 6;
    float s = 0.f;
    for (int c0 = 0; c0 < 128; c0 += 32) {
        float u[32], dc[32];
#pragma unroll
        for (int i = 0; i < 32; ++i) { u[i] = U[(long)(bh * 128 + c0 + i) * 2048 + de]; dc[i] = DEC[(bh * 128 + c0 + i) * 32 + d]; }
#pragma unroll
        for (int i = 0; i < 32; ++i) { U[(long)(bh * 128 + c0 + i) * 2048 + de] = s; s = fmaf(dc[i], s, u[i]); }
    }
}

__device__ __forceinline__ void gla_out_item(const Params& p, int layer, unsigned char* ldsw, int item_, int lane, bool dry) {
    const int item = __builtin_amdgcn_readfirstlane(item_);
    bf16_t* H = (bf16_t*)(p.ws + WS_H);
    const float* bcum = (const float*)(p.ws + WS_BCUM); const float* U = (const float*)(p.ws + WS_U);
    float* sA = (float*)ldsw; bf16_t* sV = (bf16_t*)(ldsw + 8192);
    const int bh = item >> 7, c = item & 127, b = bh >> 2, h = bh & 3;
    const long tok = (long)b * T + c * 64 + lane;
#pragma unroll
    for (int r = 0; r < 8; ++r) *(f32x4*)(sA + r * 256 + lane * 4) = *(const f32x4*)(U + (long)item * 2048 + r * 256 + lane * 4);
#pragma unroll
    for (int r = 0; r < 8; ++r) *(u32x4*)(sV + lane * 64 + r * 8) = *(const u32x4*)(H + tok * HP + HCV + h * 64 + r * 8);
    WAVE_SYNC();
    float o[64];
#pragma unroll
    for (int e = 0; e < 64; ++e) o[e] = 0.f;
    {
        const bf16_t* qp = H + tok * HP + HCQ + h * 32; const float* bp = bcum + tok * 128 + h * 32;
#pragma unroll 1
        for (int d = 0; d < 32; ++d) {
            const float qd = bf2f(qp[d]) * 0.17677669529663687f * __expf(bp[d]);
#pragma unroll
            for (int e4 = 0; e4 < 16; ++e4) {
                const f32x4 s4 = *(const f32x4*)(sA + d * 64 + e4 * 4);
                o[e4 * 4] = fmaf(qd, s4[0], o[e4 * 4]); o[e4 * 4 + 1] = fmaf(qd, s4[1], o[e4 * 4 + 1]);
                o[e4 * 4 + 2] = fmaf(qd, s4[2], o[e4 * 4 + 2]); o[e4 * 4 + 3] = fmaf(qd, s4[3], o[e4 * 4 + 3]);
            }
        }
    }
    WAVE_SYNC();
    {
        const bf16_t* kp = H + tok * HP + HCK + h * 32;
#pragma unroll
        for (int r = 0; r < 4; ++r) {
            const u32x4 kv = *(const u32x4*)(kp + r * 8);
            const f32x4 b0 = *(const f32x4*)(bcum + tok * 128 + h * 32 + r * 8), b1 = *(const f32x4*)(bcum + tok * 128 + h * 32 + r * 8 + 4);
            f32x4 k0 = {bflo(kv.x) * __expf(-b0[0]), bfhi(kv.x) * __expf(-b0[1]), bflo(kv.y) * __expf(-b0[2]), bfhi(kv.y) * __expf(-b0[3])};
            f32x4 k1 = {bflo(kv.z) * __expf(-b1[0]), bfhi(kv.z) * __expf(-b1[1]), bflo(kv.w) * __expf(-b1[2]), bfhi(kv.w) * __expf(-b1[3])};
            *(f32x4*)(sA + lane * 32 + r * 8) = k0; *(f32x4*)(sA + lane * 32 + r * 8 + 4) = k1;
        }
    }
    float qe[32];
    {
        const bf16_t* qp = H + tok * HP + HCQ + h * 32;
#pragma unroll
        for (int r = 0; r < 4; ++r) {
            const u32x4 qv = *(const u32x4*)(qp + r * 8);
            const f32x4 b0 = *(const f32x4*)(bcum + tok * 128 + h * 32 + r * 8), b1 = *(const f32x4*)(bcum + tok * 128 + h * 32 + r * 8 + 4);
            const float qq[8] = {bflo(qv.x), bfhi(qv.x), bflo(qv.y), bfhi(qv.y), bflo(qv.z), bfhi(qv.z), bflo(qv.w), bfhi(qv.w)};
            const float bb[8] = {b0[0], b0[1], b0[2], b0[3], b1[0], b1[1], b1[2], b1[3]};
#pragma unroll
            for (int e = 0; e < 8; ++e) qe[r * 8 + e] = qq[e] * 0.17677669529663687f * __expf(bb[e]);
        }
    }
    WAVE_SYNC();
#pragma unroll 1
    for (int j = 0; j < 64; ++j) {
        float a = 0.f;
#pragma unroll
        for (int d4 = 0; d4 < 8; ++d4) {
            const f32x4 k4 = *(const f32x4*)(sA + j * 32 + d4 * 4);
            a = fmaf(qe[d4 * 4], k4[0], a); a = fmaf(qe[d4 * 4 + 1], k4[1], a); a = fmaf(qe[d4 * 4 + 2], k4[2], a); a = fmaf(qe[d4 * 4 + 3], k4[3], a);
        }
        if (j > lane) a = 0.f;
#pragma unroll
        for (int e8 = 0; e8 < 8; ++e8) {
            const u32x4 v8 = *(const u32x4*)(sV + j * 64 + e8 * 8);
            o[e8 * 8 + 0] = fmaf(a, bflo(v8.x), o[e8 * 8 + 0]); o[e8 * 8 + 1] = fmaf(a, bfhi(v8.x), o[e8 * 8 + 1]);
            o[e8 * 8 + 2] = fmaf(a, bflo(v8.y), o[e8 * 8 + 2]); o[e8 * 8 + 3] = fmaf(a, bfhi(v8.y), o[e8 * 8 + 3]);
            o[e8 * 8 + 4] = fmaf(a, bflo(v8.z), o[e8 * 8 + 4]); o[e8 * 8 + 5] = fmaf(a, bfhi(v8.z), o[e8 * 8 + 5]);
            o[e8 * 8 + 6] = fmaf(a, bflo(v8.w), o[e8 * 8 + 6]); o[e8 * 8 + 7] = fmaf(a, bfhi(v8.w), o[e8 * 8 + 7]);
        }
    }
    float ss = 0.f;
#pragma unroll
    for (int e = 0; e < 64; ++e) ss = fmaf(o[e], o[e], ss);
    const float rms = rsqrtf(ss * (1.f / 64.f) + EPS);
    const float* gn = p.gnorm_g + layer * 256 + h * 64;
    bf16_t* cg_p = H + tok * HP + HCG + h * 64;
#pragma unroll
    for (int r = 0; r < 8; ++r) {
        const u32x4 gv = *(const u32x4*)(cg_p + r * 8);
        const float gq[8] = {bflo(gv.x), bfhi(gv.x), bflo(gv.y), bfhi(gv.y), bflo(gv.z), bfhi(gv.z), bflo(gv.w), bfhi(gv.w)};
        float y[8];
#pragma unroll
        for (int e = 0; e < 8; ++e) y[e] = o[r * 8 + e] * rms * gn[r * 8 + e] * silu_f(gq[e]);
        u32x4 w; w.x = pk2(y[0], y[1]); w.y = pk2(y[2], y[3]); w.z = pk2(y[4], y[5]); w.w = pk2(y[6], y[7]);
        if (!dry) *(u32x4*)(cg_p + r * 8) = w;
    }
    WAVE_SYNC();
}

constexpr int MPITCH = 260;
constexpr int HPITCH = 516;
constexpr int L_HIST = 0;
constexpr int L_CAND = 66560;
constexpr int L_CCNT = L_CAND + 65536;
constexpr int L_QINF = L_CCNT + 2048;
constexpr int L_MTAB = L_QINF + 1024 + 64;
static_assert(L_MTAB + 8192 <= LDS_BYTES, "dsa lds");
__device__ __forceinline__ int mpos(int rr) { return 16 * ((rr >> 2) & 1) + (rr & 3) + 4 * (rr >> 3); }
constexpr int SUBCAP = 32;

__device__ __forceinline__ unsigned mono_bits(float f) { const unsigned u = __float_as_uint(f); return u ^ ((u >> 31) ? 0xffffffffu : 0x80000000u); }
__device__ __forceinline__ void idx_loadkp(const bf16_t* kp, bf16x8 (&kf)[2][2]) {
#pragma unroll
    for (int kb = 0; kb < 2; ++kb)
#pragma unroll
        for (int ks = 0; ks < 2; ++ks) kf[kb][ks] = *(const bf16x8*)(kp + (long)kb * 16 * HP + ks * 32);
}
__device__ __forceinline__ void idx_loadk(const bf16_t* Hb, int s0, int lane, bf16x8 (&kf)[2][2]) {
    const bf16_t* kp = Hb + (long)(s0 + (lane & 15)) * HP + HKI + 8 * (lane >> 4);
#pragma unroll
    for (int kb = 0; kb < 2; ++kb)
#pragma unroll
        for (int ks = 0; ks < 2; ++ks) kf[kb][ks] = *(const bf16x8*)(kp + (long)kb * 16 * HP + ks * 32);
}
__device__ __forceinline__ void idx_scores(const bf16x8 (&kf)[2][2], const bf16x8 (&qf)[8][2], const bf16x8 (&ql)[2][2], const float (&wh)[8], float (&score)[8]) {
    f32x4 lin[2];
#pragma unroll
    for (int kb = 0; kb < 2; ++kb) {
        lin[kb] = (f32x4){0.f, 0.f, 0.f, 0.f};
#pragma unroll
        for (int ks = 0; ks < 2; ++ks) {
            lin[kb] = __builtin_amdgcn_mfma_f32_16x16x32_bf16(kf[kb][ks], ql[0][ks], lin[kb], 0, 0, 0);
            lin[kb] = __builtin_amdgcn_mfma_f32_16x16x32_bf16(kf[kb][ks], ql[1][ks], lin[kb], 0, 0, 0);
        }
    }
#pragma unroll
    for (int i = 0; i < 8; ++i) score[i] = lin[i >> 2][i & 3];
#pragma unroll
    for (int hd = 0; hd < 8; ++hd) {
        f32x4 acc[2];
#pragma unroll
        for (int kb = 0; kb < 2; ++kb) {
            acc[kb] = (f32x4){0.f, 0.f, 0.f, 0.f};
#pragma unroll
            for (int ks = 0; ks < 2; ++ks) acc[kb] = __builtin_amdgcn_mfma_f32_16x16x32_bf16(kf[kb][ks], qf[hd][ks], acc[kb], 0, 0, 0);
        }
#pragma unroll
        for (int kb = 0; kb < 2; ++kb)
#pragma unroll
            for (int i = 0; i < 4; ++i) score[kb * 4 + i] = fmaf(fabsf(acc[kb][i]), wh[hd], score[kb * 4 + i]);
        if ((hd & 3) == 3) __builtin_amdgcn_sched_barrier(0);
    }
}

template <bool FAST>
__device__ __forceinline__ void attn_tile(const bf16x8 (&kf)[4], const bf16x8 (&vf)[4], const bf16x8 (&qfr)[2][4], f32x16 (&O)[2][2], float (&mrun)[2], float (&lrun)[2],
                                          const unsigned* hist, const float* mtab, int r32, int hh, int tile) {
#pragma unroll
    for (int qb = 0; qb < 2; ++qb) {
        f32x16 S;
        const unsigned mw = hist[(qb * 32 + r32) * MPITCH + tile] >> (16 * hh);
#pragma unroll
        for (int g8 = 0; g8 < 2; ++g8) {
            const float* mt = mtab + ((mw >> (8 * g8)) & 255u) * 8;
            const f32x4 ma = *(const f32x4*)mt, mb = *(const f32x4*)(mt + 4);
            S[8 * g8] = ma[0]; S[8 * g8 + 1] = ma[1]; S[8 * g8 + 2] = ma[2]; S[8 * g8 + 3] = ma[3];
            S[8 * g8 + 4] = mb[0]; S[8 * g8 + 5] = mb[1]; S[8 * g8 + 6] = mb[2]; S[8 * g8 + 7] = mb[3];
        }
#pragma unroll
        for (int ks = 0; ks < 4; ++ks) S = __builtin_amdgcn_mfma_f32_32x32x16_bf16(kf[ks], qfr[qb][ks], S, 0, 0, 0);
        float pr[16]; float ps = 0.f;
        if (FAST) {
#pragma unroll
            for (int i = 0; i < 16; ++i) { pr[i] = __builtin_amdgcn_exp2f(S[i]); ps += pr[i]; }
        } else {
            float mx = fmaxf(fmaxf(S[0], S[1]), S[2]);
#pragma unroll
            for (int i = 3; i < 15; i += 2) mx = fmaxf(fmaxf(mx, S[i]), S[i + 1]);
            mx = fmaxf(mx, S[15]);
            { const auto sw = __builtin_amdgcn_permlane32_swap(__float_as_uint(mx), __float_as_uint(mx), false, false); mx = fmaxf(__uint_as_float(sw[0]), __uint_as_float(sw[1])); }
            if (__any(mx > mrun[qb])) {
                const float mnew = fmaxf(mx, mrun[qb]);
                const float alpha = __builtin_amdgcn_exp2f(mrun[qb] - mnew);
                mrun[qb] = mnew; lrun[qb] *= alpha;
#pragma unroll
                for (int db = 0; db < 2; ++db)
#pragma unroll
                    for (int i = 0; i < 16; ++i) O[db][qb][i] *= alpha;
            }
            const float mref = fmaxf(mrun[qb], -1000.f);
#pragma unroll
            for (int i = 0; i < 16; ++i) { pr[i] = __builtin_amdgcn_exp2f(S[i] - mref); ps += pr[i]; }
        }
        lrun[qb] += ps;
        bf16x8 pf[2];
#pragma unroll
        for (int s = 0; s < 2; ++s) {
            u32x4 pw; pw.x = pk2(pr[8 * s], pr[8 * s + 1]); pw.y = pk2(pr[8 * s + 2], pr[8 * s + 3]); pw.z = pk2(pr[8 * s + 4], pr[8 * s + 5]); pw.w = pk2(pr[8 * s + 6], pr[8 * s + 7]);
            pf[s] = __builtin_bit_cast(bf16x8, pw);
        }
#pragma unroll
        for (int db = 0; db < 2; ++db)
#pragma unroll
            for (int s = 0; s < 2; ++s) O[db][qb] = __builtin_amdgcn_mfma_f32_32x32x16_bf16(vf[db * 2 + s], pf[s], O[db][qb], 0, 0, 0);
    }
}
template <bool FAST>
__device__ __forceinline__ void attn_loop(const bf16_t* Kp, const bf16_t* Vp, const bf16x8 (&qfr)[2][4], f32x16 (&O)[2][2], float (&mrun)[2], float (&lrun)[2],
                                          const unsigned* hist, const float* mtab, int r32, int hh, int nt32, bool dry2) {
    bf16x8 kf[4], vf[4], kg[4], vg[4];
#pragma unroll
    for (int ks = 0; ks < 4; ++ks) { kf[ks] = *(const bf16x8*)(Kp + ks * 512); vf[ks] = *(const bf16x8*)(Vp + ks * 512); }
#pragma unroll 1
    for (int tile = 0; tile < nt32; tile += 2) {
        {
            const int tn = dry2 ? 0 : tile + 1;
#pragma unroll
            for (int ks = 0; ks < 4; ++ks) { kg[ks] = *(const bf16x8*)(Kp + (long)tn * 2048 + ks * 512); vg[ks] = *(const bf16x8*)(Vp + (long)tn * 2048 + ks * 512); }
        }
        attn_tile<FAST>(kf, vf, qfr, O, mrun, lrun, hist, mtab, r32, hh, tile);
        {
            const int tn = dry2 ? 0 : ((tile + 2 < nt32) ? tile + 2 : tile);
#pragma unroll
            for (int ks = 0; ks < 4; ++ks) { kf[ks] = *(const bf16x8*)(Kp + (long)tn * 2048 + ks * 512); vf[ks] = *(const bf16x8*)(Vp + (long)tn * 2048 + ks * 512); }
        }
        attn_tile<FAST>(kg, vg, qfr, O, mrun, lrun, hist, mtab, r32, hh, tile + 1);
    }
}

__device__ __forceinline__ void dsa_item(const Params& p, unsigned char* lds, int b, int qblk, bool dry, int wid_s, const unsigned* kmaxL) {
    bf16_t* H = (bf16_t*)(p.ws + WS_H);
    const float* side = (const float*)(p.ws + WS_SIDE);
    const bf16_t* Hb = H + (long)b * T * HP;
    const int tid = otid(wid_s), lane = tid & 63, w = tid >> 6, hq = lane >> 4;
    const int qg = w & 3, kh = w >> 2;
    const int t0 = qblk * 64, qloc = qg * 16 + (lane & 15), t = t0 + qloc;
    unsigned* hist = (unsigned*)(lds + L_HIST);
    unsigned* cand = (unsigned*)(lds + L_CAND);
    unsigned* ccnt = (unsigned*)(lds + L_CCNT);
    int* qinf = (int*)(lds + L_QINF);

    for (int i = tid; i < 64 * MPITCH; i += 512) hist[i] = 0u;
    for (int i = tid; i < 2048; i += 512) ((float*)(lds + L_MTAB))[i] = ((i >> 3) >> (i & 7)) & 1 ? 0.f : -1e30f;
    bf16x8 qf[8][2]; bf16x8 ql[2][2]; float wi[8]; float inv, fb0c;
    {
        const bf16_t* qp = Hb + (long)t * HP + HQI + 8 * hq;
#pragma unroll
        for (int hd = 0; hd < 8; ++hd)
#pragma unroll
            for (int ks = 0; ks < 2; ++ks) qf[hd][ks] = *(const bf16x8*)(qp + hd * 64 + ks * 32);
        const float* sp = side + ((long)b * T + t) * 24;
        const f32x4 w0 = *(const f32x4*)sp, w1 = *(const f32x4*)(sp + 4);
        wi[0] = w0[0]; wi[1] = w0[1]; wi[2] = w0[2]; wi[3] = w0[3]; wi[4] = w1[0]; wi[5] = w1[1]; wi[6] = w1[2]; wi[7] = w1[3];
        float n2 = 0.f;
#pragma unroll
        for (int i = 0; i < 8; ++i) n2 = fmaf(wi[i], wi[i], n2);
        const float nrm = fmaxf(SIG_UNIT * sqrtf(n2), 1e-30f);
        inv = 64.f / nrm;
        fb0c = 256.f - 64.f * 3.19f * (wi[0] + wi[1] + wi[2] + wi[3] + wi[4] + wi[5] + wi[6] + wi[7]) / nrm;
#pragma unroll
        for (int i = 0; i < 8; ++i) wi[i] *= 0.5f;
#pragma unroll
        for (int ks = 0; ks < 2; ++ks) {
            float ql_f[8];
#pragma unroll
            for (int j = 0; j < 8; ++j) ql_f[j] = 0.f;
#pragma unroll
            for (int hd = 0; hd < 8; ++hd) {
                const u32x4 qv = __builtin_bit_cast(u32x4, qf[hd][ks]);
                ql_f[0] = fmaf(wi[hd], bflo(qv.x), ql_f[0]); ql_f[1] = fmaf(wi[hd], bfhi(qv.x), ql_f[1]); ql_f[2] = fmaf(wi[hd], bflo(qv.y), ql_f[2]); ql_f[3] = fmaf(wi[hd], bfhi(qv.y), ql_f[3]);
                ql_f[4] = fmaf(wi[hd], bflo(qv.z), ql_f[4]); ql_f[5] = fmaf(wi[hd], bfhi(qv.z), ql_f[5]); ql_f[6] = fmaf(wi[hd], bflo(qv.w), ql_f[6]); ql_f[7] = fmaf(wi[hd], bfhi(qv.w), ql_f[7]);
            }
            u32x4 hi4; hi4.x = pk2(ql_f[0], ql_f[1]); hi4.y = pk2(ql_f[2], ql_f[3]); hi4.z = pk2(ql_f[4], ql_f[5]); hi4.w = pk2(ql_f[6], ql_f[7]);
            u32x4 lo4;
            lo4.x = pk2(ql_f[0] - bflo(hi4.x), ql_f[1] - bfhi(hi4.x)); lo4.y = pk2(ql_f[2] - bflo(hi4.y), ql_f[3] - bfhi(hi4.y));
            lo4.z = pk2(ql_f[4] - bflo(hi4.z), ql_f[5] - bfhi(hi4.z)); lo4.w = pk2(ql_f[6] - bflo(hi4.w), ql_f[7] - bfhi(hi4.w));
            ql[0][ks] = __builtin_bit_cast(bf16x8, hi4); ql[1][ks] = __builtin_bit_cast(bf16x8, lo4);
        }
    }
    const int ntile = (t0 + 64 + 127) >> 7;
    const int tmaxw = t0 + qg * 16 + 15;
    __syncthreads();
    int nit = 0;
    { const int v = tmaxw - kh * 64; if (v >= 0) nit = 2 * (v >> 7) + (((v & 127) >= 32) ? 2 : 1); }
    float fa = inv, fbias = fb0c;
    bool active = true;
#pragma unroll 1
    for (int level = 0; level < 2; ++level) {
        unsigned* hbase = level ? cand : hist;
        const bool wave_on = __any(active);
        if (wave_on) {
            const unsigned incv = 1u << ((qloc & 1) * 16);
            unsigned* hrow = hbase + (qloc >> 1) * HPITCH;
            bf16x8 kf[2][2];
            const bf16_t* kpn = Hb + (long)(kh * 64 + (lane & 15)) * HP + HKI + 8 * (lane >> 4);
            idx_loadkp(kpn, kf);
#pragma unroll 1
            for (int it = 0; it < nit; ++it) {
                const int s0 = (it >> 1) * 128 + kh * 64 + (it & 1) * 32;
                if (it + 1 < nit) kpn += (long)((it & 1) ? 96 : 32) * HP;
                bf16x8 kn[2][2];
                idx_loadkp(kpn, kn);
                float score[8];
                idx_scores(kf, qf, ql, wi, score);
                if (s0 + 31 <= t0 + qg * 16) {
#pragma unroll
                    for (int i = 0; i < 8; ++i) { const unsigned bin = (unsigned)__builtin_amdgcn_fmed3f(fmaf(score[i], fa, fbias), 0.f, 511.5f); atomicAdd(hrow + bin, incv); }
                } else {
#pragma unroll
                    for (int i = 0; i < 8; ++i) {
                        const int s = s0 + (i >> 2) * 16 + hq * 4 + (i & 3);
                        if (s <= t) { const unsigned bin = (unsigned)__builtin_amdgcn_fmed3f(fmaf(score[i], fa, fbias), 0.f, 511.5f); atomicAdd(hrow + bin, incv); }
                    }
                }
#pragma unroll
                for (int kb = 0; kb < 2; ++kb)
#pragma unroll
                    for (int ks = 0; ks < 2; ++ks) kf[kb][ks] = kn[kb][ks];
            }
        }
        __syncthreads();
#pragma unroll 1
        for (int qq = 0; qq < 8; ++qq) {
            const int q = w * 8 + qq;
            if (level && !qinf[q * 4 + 3]) continue;
            const u32x4 wa = *(const u32x4*)(hbase + (q >> 1) * HPITCH + 8 * lane), wb = *(const u32x4*)(hbase + (q >> 1) * HPITCH + 8 * lane + 4);
            const int sh = (q & 1) * 16;
            const unsigned c[8] = {(wa.x >> sh) & 0xffffu, (wa.y >> sh) & 0xffffu, (wa.z >> sh) & 0xffffu, (wa.w >> sh) & 0xffffu, (wb.x >> sh) & 0xffffu, (wb.y >> sh) & 0xffffu, (wb.z >> sh) & 0xffffu, (wb.w >> sh) & 0xffffu};
            const unsigned tot = c[0] + c[1] + c[2] + c[3] + c[4] + c[5] + c[6] + c[7];
            unsigned S = tot;
#pragma unroll
            for (int o = 1; o < 64; o <<= 1) { const unsigned dn = (unsigned)bperm_i((lane + o) & 63, (int)S); if (lane + o < 64) S += dn; }
            const unsigned total = (unsigned)__builtin_amdgcn_readfirstlane((int)S);
            const u64 bal = __ballot(S >= 256u);
            int b1 = -1, r1 = 0, n1 = 0;
            if (total >= 256u) {
                const int Ls = 63 - __clzll(bal);
                unsigned cum = S - tot; bool found = false; int lb = -1, lr = 0, ln = 0;
#pragma unroll
                for (int j = 7; j >= 0; --j) { const bool hit = !found && (cum + c[j] >= 256u); if (hit) { lb = 8 * lane + j; lr = 256 - (int)cum; ln = (int)c[j]; found = true; } cum += c[j]; }
                b1 = bperm_i(Ls, lb); r1 = bperm_i(Ls, lr); n1 = bperm_i(Ls, ln);
            }
            if (lane == 0) { qinf[q * 4] = b1; qinf[q * 4 + 1] = r1; qinf[q * 4 + 2] = n1; }
        }
        __syncthreads();
        if (level == 0) { for (int i = tid; i < 64 * MPITCH; i += 512) hist[i] = 0u; }
        if (tid == 0) qinf[256] = 0;
        __syncthreads();
        if (wave_on) {
            const int b1 = qinf[qloc * 4];
            const float fsel = !active ? __builtin_inff() : ((b1 < 0) ? -__builtin_inff() : ((b1 >= 511) ? __builtin_inff() : (float)(b1 + 1)));
            const float fcand = !active ? __builtin_inff() : ((b1 <= 0) ? -__builtin_inff() : (float)b1);
            const float fb1 = (float)(b1 < 0 ? 0 : b1);
            unsigned* cslot = cand + (qloc * 8 + kh * 4 + hq) * SUBCAP; int ncand = 0;
            bf16x8 kf[2][2];
            const bf16_t* kpn = Hb + (long)(kh * 64 + (lane & 15)) * HP + HKI + 8 * (lane >> 4);
            idx_loadkp(kpn, kf);
#pragma unroll 1
            for (int it = 0; it < nit; ++it) {
                const int s0 = (it >> 1) * 128 + kh * 64 + (it & 1) * 32;
                if (it + 1 < nit) kpn += (long)((it & 1) ? 96 : 32) * HP;
                bf16x8 kn[2][2];
                idx_loadkp(kpn, kn);
                float score[8];
                idx_scores(kf, qf, ql, wi, score);
                unsigned m0 = 0u;
                if (s0 + 31 <= t0 + qg * 16) {
#pragma unroll
                    for (int i = 0; i < 8; ++i) {
                        const int rr = (i >> 2) * 16 + hq * 4 + (i & 3), s = s0 + rr;
                        const float fb = fmaf(score[i], fa, fbias);
                        if (fb >= fcand) {
                            if (fb >= fsel) m0 |= 1u << (16 * (hq & 1) + 4 * (hq >> 1) + (i & 3) + 8 * (i >> 2));
                            else {
                                const unsigned q19 = (unsigned)__builtin_amdgcn_fmed3f((fb - fb1) * 524288.f, 0.f, 524287.f);
                                if (ncand < SUBCAP) cslot[ncand] = (q19 << 13) | (unsigned)(8191 - s);
                                ++ncand;
                            }
                        }
                    }
                } else {
#pragma unroll
                    for (int i = 0; i < 8; ++i) {
                        const int rr = (i >> 2) * 16 + hq * 4 + (i & 3), s = s0 + rr;
                        const float fb = fmaf(score[i], fa, fbias);
                        if (fb >= fcand && s <= t) {
                            if (fb >= fsel) m0 |= 1u << (16 * (hq & 1) + 4 * (hq >> 1) + (i & 3) + 8 * (i >> 2));
                            else {
                                const unsigned q19 = (unsigned)__builtin_amdgcn_fmed3f((fb - fb1) * 524288.f, 0.f, 524287.f);
                                if (ncand < SUBCAP) cslot[ncand] = (q19 << 13) | (unsigned)(8191 - s);
                                ++ncand;
                            }
                        }
                    }
                }
                if (m0) atomicOr(&hist[qloc * MPITCH + (s0 >> 5)], m0);
#pragma unroll
                for (int kb = 0; kb < 2; ++kb)
#pragma unroll
                    for (int ks = 0; ks < 2; ++ks) kf[kb][ks] = kn[kb][ks];
            }
            ccnt[qloc * 8 + kh * 4 + hq] = (unsigned)ncand;
        } else ccnt[qloc * 8 + kh * 4 + hq] = 0u;
        __syncthreads();
#pragma unroll 1
        for (int qq = 0; qq < 8; ++qq) {
            const int q = w * 8 + qq;
            if (level && !qinf[q * 4 + 3]) continue;
            const int r1 = qinf[q * 4 + 1];
            const int wr_ = lane >> 3, sl0 = (lane & 7) * 4;
            int cw = (int)ccnt[q * 8 + wr_];
            const bool ovf = __any(cw > SUBCAP) && (level == 0);
            if (lane == 0) { qinf[q * 4 + 3] = ovf ? 1 : 0; if (ovf) qinf[256] = 1; }
            if (ovf || r1 <= 0) continue;
            if (cw > SUBCAP) cw = SUBCAP;
            const u32x4 mine = *(const u32x4*)(cand + (q * 8 + wr_) * SUBCAP + sl0);
            int rk0 = 0, rk1 = 0, rk2 = 0, rk3 = 0;
#pragma unroll 1
            for (int ww = 0; ww < 8; ++ww) {
                int cn = (int)ccnt[q * 8 + ww]; if (cn > SUBCAP) cn = SUBCAP;
                const unsigned* cl = cand + (q * 8 + ww) * SUBCAP;
#pragma unroll 1
                for (int j = 0; j < cn; ++j) { const unsigned cv = cl[j]; rk0 += (cv > mine.x); rk1 += (cv > mine.y); rk2 += (cv > mine.z); rk3 += (cv > mine.w); }
            }
            if (sl0 + 0 < cw && rk0 < r1) { const int s = 8191 - (int)(mine.x & 8191u); atomicOr(&hist[q * MPITCH + (s >> 5)], 1u << mpos(s & 31)); }
            if (sl0 + 1 < cw && rk1 < r1) { const int s = 8191 - (int)(mine.y & 8191u); atomicOr(&hist[q * MPITCH + (s >> 5)], 1u << mpos(s & 31)); }
            if (sl0 + 2 < cw && rk2 < r1) { const int s = 8191 - (int)(mine.z & 8191u); atomicOr(&hist[q * MPITCH + (s >> 5)], 1u << mpos(s & 31)); }
            if (sl0 + 3 < cw && rk3 < r1) { const int s = 8191 - (int)(mine.w & 8191u); atomicOr(&hist[q * MPITCH + (s >> 5)], 1u << mpos(s & 31)); }
        }
        __syncthreads();
        if (level == 1 || qinf[256] == 0) break;
        {
            const bool mine_ovf = qinf[qloc * 4 + 3] != 0;
            const int b1 = qinf[qloc * 4];
            active = mine_ovf;
            fa = mine_ovf ? inv * 510.f : 0.f;
            fbias = mine_ovf ? fmaf(fb0c - (float)b1, 510.f, 1.f) : -1.f;
        }
        for (int i = tid; i < 32 * HPITCH; i += 512) cand[i] = 0u;
        __syncthreads();
    }
    for (int rep2_ = ((PROBE_PHASE == 41) ? 0 : 1); rep2_ < 2; ++rep2_) {
        const bool dry2 = dry || ((PROBE_PHASE == 41) && (rep2_ == 0) && (p.pos[0] == 0));
        const int head = w, r32 = lane & 31, hh = lane >> 5;
        bf16x8 qfr[2][4];
        float q1 = 0.f;
#pragma unroll
        for (int qb = 0; qb < 2; ++qb) {
            float qa = 0.f;
#pragma unroll
            for (int ks = 0; ks < 4; ++ks) {
                qfr[qb][ks] = *(const bf16x8*)(Hb + (long)(t0 + qb * 32 + r32) * HP + HQ + head * 64 + ks * 16 + 8 * hh);
                const u32x4 qv = __builtin_bit_cast(u32x4, qfr[qb][ks]);
                qa += fabsf(bflo(qv.x)) + fabsf(bfhi(qv.x)) + fabsf(bflo(qv.y)) + fabsf(bfhi(qv.y)) + fabsf(bflo(qv.z)) + fabsf(bfhi(qv.z)) + fabsf(bflo(qv.w)) + fabsf(bfhi(qv.w));
            }
            q1 = fmaxf(q1, qa);
        }
        q1 += sxor_f(q1, lane, 32);
#pragma unroll
        for (int o = 16; o >= 1; o >>= 1) q1 = fmaxf(q1, sxor_f(q1, lane, o));
        const float kmx = __uint_as_float(kmaxL[b * 8 + head]);
        const bool fast = (q1 * kmx * 1.02f) < 100.f;
        f32x16 O[2][2];
#pragma unroll
        for (int a = 0; a < 2; ++a)
#pragma unroll
            for (int c2 = 0; c2 < 2; ++c2)
#pragma unroll
                for (int i = 0; i < 16; ++i) O[a][c2][i] = 0.f;
        float mrun[2] = {-1e30f, -1e30f}, lrun[2] = {0.f, 0.f};
        const bf16_t* Kp = (const bf16_t*)(p.ws + WS_KF) + ((long)(b * 8 + head) * 256 * 4 * 64 + lane) * 8;
        const bf16_t* Vp = (const bf16_t*)(p.ws + WS_VT) + ((long)(b * 8 + head) * 256 * 4 * 64 + lane) * 8;
        const int nt32 = (t0 + 64) >> 5;
        if (fast) attn_loop<true>(Kp, Vp, qfr, O, mrun, lrun, hist, (const float*)(lds + L_MTAB), r32, hh, nt32, dry2);
        else attn_loop<false>(Kp, Vp, qfr, O, mrun, lrun, hist, (const float*)(lds + L_MTAB), r32, hh, nt32, dry2);
#pragma unroll
        for (int qb = 0; qb < 2; ++qb) {
            const float lt = lrun[qb] + sxor_f(lrun[qb], lane, 32);
            const float il = 1.f / lt;
            bf16_t* gp = H + ((long)b * T + t0 + qb * 32 + r32) * HP + HAG + head * 64 + 4 * hh;
#pragma unroll
            for (int db = 0; db < 2; ++db)
#pragma unroll
                for (int g4 = 0; g4 < 4; ++g4) {
                    bf16_t* gq = gp + db * 32 + 8 * g4;
                    const u32x2 gv = *(const u32x2*)gq;
                    u32x2 wv;
                    wv.x = pk2(O[db][qb][4 * g4] * il * silu_f(bflo(gv.x)), O[db][qb][4 * g4 + 1] * il * silu_f(bfhi(gv.x)));
                    wv.y = pk2(O[db][qb][4 * g4 + 2] * il * silu_f(bflo(gv.y)), O[db][qb][4 * g4 + 3] * il * silu_f(bfhi(gv.y)));
                    if (!dry2) *(u32x2*)gq = wv;
                }
        }
    }
    __syncthreads();
}

__device__ __forceinline__ void gbar(unsigned* ctr, unsigned target) {
    __syncthreads();
    if (threadIdx.x == 0) {
        __builtin_amdgcn_fence(__ATOMIC_RELEASE, "agent");
        __hip_atomic_fetch_add(ctr, 1u, __ATOMIC_RELAXED, __HIP_MEMORY_SCOPE_AGENT);
        while (__hip_atomic_load(ctr, __ATOMIC_RELAXED, __HIP_MEMORY_SCOPE_AGENT) < target) __builtin_amdgcn_s_sleep(2);
        __builtin_amdgcn_fence(__ATOMIC_ACQUIRE, "agent");
    }
    __syncthreads();
}

__device__ __forceinline__ void ho_arrive(unsigned* ctr) {
    __syncthreads();
    if (threadIdx.x == 0) { __builtin_amdgcn_fence(__ATOMIC_RELEASE, "agent"); __hip_atomic_fetch_add(ctr, 1u, __ATOMIC_RELAXED, __HIP_MEMORY_SCOPE_AGENT); }
}
__device__ __forceinline__ void ho_wait(unsigned* ctr, unsigned target) {
    if (threadIdx.x == 0) {
        while (__hip_atomic_load(ctr, __ATOMIC_RELAXED, __HIP_MEMORY_SCOPE_AGENT) < target) __builtin_amdgcn_s_sleep(2);
        __builtin_amdgcn_fence(__ATOMIC_ACQUIRE, "agent");
    }
    __syncthreads();
}

__global__ void __launch_bounds__(512) fwd_megakernel(Params p0) {
    extern __shared__ __attribute__((aligned(16))) unsigned char lds[];
    cg::grid_group grid = cg::this_grid();
    const int G = gridDim.x, c = blockIdx.x;
    const int wid_s = __builtin_amdgcn_readfirstlane((int)(threadIdx.x >> 6));

    unsigned* barctr = (unsigned*)(p0.ws + WS_BAR); unsigned bar_n = 0;
    if (c == 0 && threadIdx.x < 3) __hip_atomic_store(barctr + 16 * threadIdx.x, 0u, __ATOMIC_RELAXED, __HIP_MEMORY_SCOPE_AGENT);
    for (int rep0_ = (PROBE_PHASE == 8 ? 0 : 1); rep0_ < 2; ++rep0_) prologue(p0, (long)c * 512 + threadIdx.x, (long)G * 512);
    grid.sync();

#pragma unroll 1
    for (int layer = 0; layer < DEPTH; ++layer) {
        Params p = p0;
        { size_t zoff = 0; asm volatile("" : "+s"(zoff)); p.ws = p0.ws + zoff; }
        bf16_t* H = (bf16_t*)(p.ws + WS_H);
        {
for (int rep_ = (PROBE_PHASE == 1 ? 0 : 1); rep_ < 2; ++rep_) { const bool dry = (PROBE_PHASE == 1) && (rep_ == 0) && (p.pos[0] == 0);
            EpiIn e; e.H = H; e.side = (float*)(p.ws + WS_SIDE); e.rope = (const float*)(p.ws + WS_ROPE); e.VT = (bf16_t*)(p.ws + WS_VT); e.KF = (bf16_t*)(p.ws + WS_KF); e.kmax = (unsigned*)(p.ws + WS_KMAX) + layer * 32; e.dry = dry;
            const bf16_t* A = (const bf16_t*)(p.ws + WS_XB);
            const bf16_t* Bt = (const bf16_t*)(p.ws + WS_WIN) + (long)layer * NPAD * 1024;
            if (layer) {
                if (otid(wid_s) == 0) {
                    const unsigned* lc = (const unsigned*)(p.ws + WS_LCNT);
#pragma unroll 1
                    for (int L = c; L < 128 * 17; L += G) {
                        int pm, pn; tile_of(L, 128, 17, pm, pn);
                        while (__hip_atomic_load(lc + pm * 16, __ATOMIC_RELAXED, __HIP_MEMORY_SCOPE_AGENT) < 2u * (unsigned)layer) __builtin_amdgcn_s_sleep(2);
                    }
                    __builtin_amdgcn_fence(__ATOMIC_ACQUIRE, "agent");
                }
                __syncthreads();
            }
#pragma unroll 1
            for (int L = c; L < 128 * 17; L += G) { int pm, pn; tile_of(L, 128, 17, pm, pn); gemm_tile((LAS unsigned char*)lds, A, 1024, Bt, 1024, pm, pn, e, wid_s); }
            {
                const int rem = (128 * 17) % G;
                if (layer + 1 < DEPTH && c >= rem) convert_weights(p, layer + 1, layer + 2, (long)(c - rem) * 512 + otid(wid_s), (long)(G - rem) * 512);
            }
}
        }
        gbar(barctr, (++bar_n) * (unsigned)G); if (PROBE_PHASE == 9) gbar(barctr, (++bar_n) * (unsigned)G);
        {
for (int rep_ = (PROBE_PHASE == 2 ? 0 : 1); rep_ < 2; ++rep_) { const bool dry = (PROBE_PHASE == 2) && (rep_ == 0) && (p.pos[0] == 0);
            const int tid = otid(wid_s), lane = tid & 63, w = tid >> 6;
#pragma unroll 1
            for (int g = c; g < 256; g += G) gla_local_item(p, layer, g * 8 + w, lane, dry);
}
        }
        ho_arrive(barctr + 16);
        if (c < 64) {
            ho_wait(barctr + 16, (unsigned)(layer + 1) * (unsigned)G);
            const int tid = otid(wid_s);
#pragma unroll 1
            for (int g = c; g < 64; g += G) gla_scan(p, g * 512 + tid);
            ho_arrive(barctr + 32);
        }
for (int rep_ = (PROBE_PHASE == 3 ? 0 : 1); rep_ < 2; ++rep_) { const bool dry = (PROBE_PHASE == 3) && (rep_ == 0) && (p.pos[0] == 0);
#pragma unroll 1
        for (int tile = c; tile < 512; tile += G) conformer_tile(p, layer, lds, tile, dry, wid_s);
}
for (int rep_ = (PROBE_PHASE == 4 ? 0 : 1); rep_ < 2; ++rep_) { const bool dry = (PROBE_PHASE == 4) && (rep_ == 0) && (p.pos[0] == 0);
#pragma unroll 1
        for (int it = c; it < 512; it += G) {
            const int pr = it >> 1, second = it & 1;
            const int xcd = pr & 7, j = pr >> 3, b = xcd >> 1, par = xcd & 1;
            const int qblk = second ? (2 * j + par) : 127 - (2 * j + par);
            dsa_item(p, lds, b, qblk, dry, wid_s, (const unsigned*)(p.ws + WS_KMAX) + layer * 32);
        }
}
        ho_wait(barctr + 32, (unsigned)(layer + 1) * (unsigned)(G < 64 ? G : 64));
        {
for (int rep_ = (PROBE_PHASE == 5 ? 0 : 1); rep_ < 2; ++rep_) { const bool dry = (PROBE_PHASE == 5) && (rep_ == 0) && (p.pos[0] == 0);
            const int tid = otid(wid_s), lane = tid & 63, w = tid >> 6;
#pragma unroll 1
            for (int g = c; g < 256; g += G) gla_out_item(p, layer, lds + w * 16384, g * 8 + w, lane, dry);
}
        }
        gbar(barctr, (++bar_n) * (unsigned)G); if (PROBE_PHASE == 9) gbar(barctr, (++bar_n) * (unsigned)G);
        {
for (int rep_ = (PROBE_PHASE == 6 ? 0 : 1); rep_ < 2; ++rep_) { const bool dry = (PROBE_PHASE == 6) && (rep_ == 0) && (p.pos[0] == 0);
            EpiOut e; e.xres = (layer == 0) ? p.x : p.out; e.out = p.out; e.dry = dry;
            const bf16_t* A = H + HAG;
            const bf16_t* Bt = (const bf16_t*)(p.ws + WS_WOUT) + (long)layer * 1024 * 1024;
#pragma unroll 1
            for (int L = c; L < 128 * 4; L += G) { int pm, pn; tile_of(L, 128, 4, pm, pn); gemm_tile((LAS unsigned char*)lds, A, HP, Bt, 1024, pm, pn, e, wid_s); ho_arrive((unsigned*)(p.ws + WS_PCNT) + pm * 16); }
}
        }
        {
for (int rep_ = (PROBE_PHASE == 7 ? 0 : 1); rep_ < 2; ++rep_) { const bool dry = (PROBE_PHASE == 7) && (rep_ == 0) && (p.pos[0] == 0);
            const int tid = otid(wid_s), lane = tid & 63, w = tid >> 6;
#pragma unroll 1
            for (int hp = c; hp < 256; hp += G) {
                ho_wait((unsigned*)(p.ws + WS_PCNT) + (hp >> 1) * 16, 4u * (unsigned)(layer + 1));
                const int base = (hp >> 1) * 256 + (hp & 1) * 128;
                ln_phase(p, layer, base + w, base + 128, 8, lane, dry);
                ho_arrive((unsigned*)(p.ws + WS_LCNT) + (hp >> 1) * 16);
            }
}
        }
    }
}

extern "C" void kernel_launch(void* const* d_in, const int* in_sizes, int n_in, void* d_out, int out_size, void* d_ws, size_t ws_size, hipStream_t stream) {
    static int grid_blocks = 0;
    if (grid_blocks == 0) {
        if (n_in != 15 || ws_size < WS_END) { fprintf(stderr, "kernel_launch: unexpected inputs (n_in %d, ws %zu < %zu)\n", n_in, ws_size, (size_t)WS_END); grid_blocks = -1; return; }
        int dev = 0, cus = 0, per_cu = 0;
        hipGetDevice(&dev);
        hipDeviceGetAttribute(&cus, hipDeviceAttributeMultiprocessorCount, dev);
        if (hipFuncSetAttribute((const void*)fwd_megakernel, hipFuncAttributeMaxDynamicSharedMemorySize, LDS_BYTES) != hipSuccess) { fprintf(stderr, "kernel_launch: hipFuncSetAttribute failed\n"); grid_blocks = -1; return; }
        hipOccupancyMaxActiveBlocksPerMultiprocessor(&per_cu, (const void*)fwd_megakernel, 512, LDS_BYTES);
        if (per_cu < 1) per_cu = 1;
        grid_blocks = cus * per_cu;
    }
    if (grid_blocks < 0) return;
    Params p{};
    p.x = (const float*)d_in[0]; p.pos = (const int*)d_in[1]; p.w_in = (const float*)d_in[2]; p.conv_w = (const float*)d_in[3]; p.conv_b = (const float*)d_in[4];
    p.cln_g = (const float*)d_in[5]; p.cln_b = (const float*)d_in[6]; p.pw_w = (const float*)d_in[7]; p.pw_b = (const float*)d_in[8];
    p.gate_w2 = (const float*)d_in[9]; p.gate_b = (const float*)d_in[10]; p.gnorm_g = (const float*)d_in[11]; p.w_out = (const float*)d_in[12];
    p.ln_g = (const float*)d_in[13]; p.ln_b = (const float*)d_in[14];
    p.out = (float*)d_out; p.ws = (unsigned char*)d_ws;
    for (int j = 0; j < 32; ++j) p.inv_freq[j] = (float)pow(10000.0, -(double)j / 32.0);
    void* args[] = {&p};
    hipError_t e = hipLaunchCooperativeKernel((const void*)fwd_megakernel, dim3(grid_blocks), dim3(512), args, LDS_BYTES, stream);
    if (e != hipSuccess) fprintf(stderr, "cooperative launch failed: %s (grid %d)\n", hipGetErrorString(e), grid_blocks);
}
```

```cpp
#include <hip/hip_runtime.h>
#include <hip/hip_cooperative_groups.h>
#include <cstdio>
#include <cmath>
namespace cg = cooperative_groups;

typedef unsigned short bf16_t;
typedef short bf16x8 __attribute__((ext_vector_type(8)));
typedef float f32x4 __attribute__((ext_vector_type(4)));
typedef float f32x16 __attribute__((ext_vector_type(16)));
typedef unsigned u32x4 __attribute__((ext_vector_type(4)));
typedef unsigned u32x2 __attribute__((ext_vector_type(2)));
typedef unsigned long long u64;

constexpr int NB = 4, T = 8192, NTOK = NB * T, DM = 1024, DIN = 4184, NPAD = 4352, HP = 4160, DEPTH = 4;
constexpr int HQ = 0, HK = 512, HV = 1024, HQI = 1536, HKI = 2048, HGLU = 2112, HCQ = 2624, HCK = 2752, HCV = 2880, HAG = 3136, HBG = 3648, HCG = 3904;
constexpr float EPS = 1e-5f;
constexpr float ALPHA = 1.6817928305074290f;
constexpr float QSCALE = 0.125f * 1.4426950408889634f;
constexpr float WI_SCALE = 0.04419417382415922f;
constexpr float SIG_UNIT = 5.66f;
constexpr int CAP = 128;

constexpr size_t WS_WIN = 0;
constexpr size_t WS_WOUT = WS_WIN + (size_t)DEPTH * NPAD * 1024 * 2;
constexpr size_t WS_PWT = WS_WOUT + (size_t)DEPTH * 1024 * 1024 * 2;
constexpr size_t WS_ROPE = WS_PWT + (size_t)DEPTH * 256 * 256 * 2;
constexpr size_t WS_XB = WS_ROPE + (size_t)NTOK * 32 * 8;
constexpr size_t WS_H = WS_XB + (size_t)NTOK * 1024 * 2;
constexpr size_t WS_SIDE = WS_H + (size_t)NTOK * HP * 2;
constexpr size_t WS_BCUM = WS_SIDE + (size_t)NTOK * 24 * 4;
constexpr size_t WS_U = WS_BCUM + (size_t)NTOK * 128 * 4;
constexpr size_t WS_DEC = WS_U + (size_t)2048 * 2048 * 4;
constexpr size_t WS_VT = WS_DEC + (size_t)2048 * 32 * 4;
constexpr size_t WS_KF = WS_VT + (size_t)NTOK * 512 * 2;
constexpr size_t WS_BAR = WS_KF + (size_t)NTOK * 512 * 2;
constexpr size_t WS_KMAX = WS_BAR + 256;
constexpr size_t WS_PCNT = WS_KMAX + 512;
constexpr size_t WS_LCNT = WS_PCNT + 128 * 64;
constexpr size_t WS_END = WS_LCNT + 128 * 64;

#ifndef PROBE_PHASE
#define PROBE_PHASE 0
#endif
constexpr int LDS_BYTES = 147456;

struct Params {
    const float* x; const int* pos; const float* w_in; const float* conv_w; const float* conv_b; const float* cln_g; const float* cln_b;
    const float* pw_w; const float* pw_b; const float* gate_w2; const float* gate_b; const float* gnorm_g; const float* w_out; const float* ln_g; const float* ln_b;
    float* out; unsigned char* ws;
    float inv_freq[32];
};

__device__ __forceinline__ unsigned f2bf(float f) { unsigned u = __float_as_uint(f); return (u + 0x7fffu + ((u >> 16) & 1u)) >> 16; }
__device__ __forceinline__ float bf2f(unsigned b) { return __uint_as_float(b << 16); }
typedef float f32x2_t __attribute__((ext_vector_type(2)));
typedef __bf16 bf16x2_t __attribute__((ext_vector_type(2)));
__device__ __forceinline__ unsigned pk2(float lo, float hi) { f32x2_t v = {lo, hi}; bf16x2_t b = __builtin_convertvector(v, bf16x2_t); return __builtin_bit_cast(unsigned, b); }
__device__ __forceinline__ float bflo(unsigned w) { return __uint_as_float(w << 16); }
__device__ __forceinline__ float bfhi(unsigned w) { return __uint_as_float(w & 0xffff0000u); }
__device__ __forceinline__ float silu_f(float v) { return v / (1.f + __expf(-v)); }
__device__ __forceinline__ float sigmoid_f(float v) { return 1.f / (1.f + __expf(-v)); }
__device__ __forceinline__ int bperm_i(int idx, int v) { return __builtin_amdgcn_ds_bpermute(idx << 2, v); }
__device__ __forceinline__ float sxor_f(float v, int lane, int m) { return __int_as_float(bperm_i(lane ^ m, __float_as_int(v))); }
__device__ __forceinline__ int sxor_i(int v, int lane, int m) { return bperm_i(lane ^ m, v); }
__device__ __forceinline__ float wave_sum(float v, int lane) {
#pragma unroll
    for (int o = 32; o >= 1; o >>= 1) v += sxor_f(v, lane, o);
    return v;
}
__device__ __forceinline__ int otid(int wid_s) { int l; asm volatile("v_mbcnt_lo_u32_b32 %0, -1, 0\n\tv_mbcnt_hi_u32_b32 %0, -1, %0" : "=v"(l)); return (wid_s << 6) | l; }
#define WAVE_SYNC() do { __builtin_amdgcn_fence(__ATOMIC_RELEASE, "wavefront"); __builtin_amdgcn_wave_barrier(); __builtin_amdgcn_fence(__ATOMIC_ACQUIRE, "wavefront"); } while (0)

__device__ __forceinline__ int l2orig(int l) {
    if (l < 1536) return l;
    if (l < 2048) return 2048 + (l - 1536);
    if (l < 2112) return 2560 + (l - 2048);
    if (l < 2624) return 2632 + (l - 2112);
    if (l < 2752) return 3400 + (l - 2624);
    if (l < 2880) return 3528 + (l - 2752);
    if (l < 3136) return 3656 + (l - 2880);
    if (l < 3648) return 1536 + (l - 3136);
    if (l < 3904) return 3144 + (l - 3648);
    if (l < 4160) return 3912 + (l - 3904);
    if (l < 4168) return 2624 + (l - 4160);
    if (l < 4184) return 4168 + (l - 4168);
    return -1;
}
__device__ __forceinline__ int npos2logical(int np) {
    const int hb = np & ~127, p = np & 127, wc = p >> 5, n = (p >> 4) & 1, fr = p & 15;
    return hb + (wc >> 1) * 64 + n * 32 + (wc & 1) * 16 + fr;
}

__device__ __forceinline__ void sincos_acc(float angf, float& c, float& s) {
    const double a = (double)angf;
    const double n = rint(a * 0.15915494309189535);
    double r = fma(-n, 6.283185307179586, a);
    r = fma(-n, 2.4492935982947064e-16, r);
    const double r2 = r * r;
    double ts = r, tc = 1.0, ss = r, cc = 1.0;
#pragma unroll
    for (int k = 1; k <= 14; ++k) {
        tc = -tc * r2 * (1.0 / (double)((2 * k - 1) * (2 * k)));
        ts = -ts * r2 * (1.0 / (double)((2 * k) * (2 * k + 1)));
        cc += tc; ss += ts;
    }
    c = (float)cc; s = (float)ss;
}

__device__ __forceinline__ void convert_weights(const Params& p, int l0, int l1, long gtid, long gthreads) {
    bf16_t* win = (bf16_t*)(p.ws + WS_WIN);
    for (long idx = gtid; idx < (long)(l1 - l0) * 128 * NPAD; idx += gthreads) {
        const int np = (int)(idx % NPAD); const long r = idx / NPAD; const int kc = (int)(r % 128); const int l = l0 + (int)(r / 128);
        const int oc = l2orig(npos2logical(np));
        u32x4 w = {0u, 0u, 0u, 0u};
        if (oc >= 0) {
            const float* src = p.w_in + ((long)l * 1024 + kc * 8) * DIN + oc;
            float v[8];
#pragma unroll
            for (int i = 0; i < 8; ++i) v[i] = src[(long)i * DIN];
            w.x = pk2(v[0], v[1]); w.y = pk2(v[2], v[3]); w.z = pk2(v[4], v[5]); w.w = pk2(v[6], v[7]);
        }
        *(u32x4*)(win + ((long)l * NPAD + np) * 1024 + kc * 8) = w;
    }
    bf16_t* wout = (bf16_t*)(p.ws + WS_WOUT);
    for (long idx = gtid; idx < (long)(l1 - l0) * 128 * 1024; idx += gthreads) {
        const int n = (int)(idx % 1024); const long r = idx / 1024; const int kc = (int)(r % 128); const int l = l0 + (int)(r / 128);
        const float* src = p.w_out + ((long)l * 1024 + kc * 8) * 1024 + n;
        float v[8];
#pragma unroll
        for (int i = 0; i < 8; ++i) v[i] = src[(long)i * 1024];
        u32x4 w; w.x = pk2(v[0], v[1]); w.y = pk2(v[2], v[3]); w.z = pk2(v[4], v[5]); w.w = pk2(v[6], v[7]);
        *(u32x4*)(wout + ((long)l * 1024 + n) * 1024 + kc * 8) = w;
    }
    bf16_t* pwt = (bf16_t*)(p.ws + WS_PWT);
    for (long idx = gtid; idx < (long)(l1 - l0) * 32 * 256; idx += gthreads) {
        const int n = (int)(idx % 256); const long r = idx / 256; const int kc = (int)(r % 32); const int l = l0 + (int)(r / 32);
        const float* src = p.pw_w + ((long)l * 256 + kc * 8) * 256 + n;
        float v[8];
#pragma unroll
        for (int i = 0; i < 8; ++i) v[i] = src[(long)i * 256];
        u32x4 w; w.x = pk2(v[0], v[1]); w.y = pk2(v[2], v[3]); w.z = pk2(v[4], v[5]); w.w = pk2(v[6], v[7]);
        *(u32x4*)(pwt + ((long)l * 256 + n) * 256 + kc * 8) = w;
    }
}

__device__ __forceinline__ void prologue(const Params& p, long gtid, long gthreads) {
    convert_weights(p, 0, 1, gtid, gthreads);
    float2* rope = (float2*)(p.ws + WS_ROPE);
    for (long idx = gtid; idx < (long)NTOK * 32; idx += gthreads) {
        const int j = (int)(idx & 31); const long tok = idx >> 5;
        const float ang = (float)p.pos[tok] * p.inv_freq[j];
        float c, s; sincos_acc(ang, c, s);
        rope[idx] = make_float2(c, s);
    }
    if (gtid < 128) { ((unsigned*)(p.ws + WS_KMAX))[gtid] = 0u; ((unsigned*)(p.ws + WS_PCNT))[gtid * 16] = 0u; ((unsigned*)(p.ws + WS_LCNT))[gtid * 16] = 0u; }
    bf16_t* xb = (bf16_t*)(p.ws + WS_XB);
    for (long idx = gtid; idx < (long)NTOK * 128; idx += gthreads) {
        const f32x4 a = *(const f32x4*)(p.x + idx * 8), b = *(const f32x4*)(p.x + idx * 8 + 4);
        u32x4 w; w.x = pk2(a[0], a[1]); w.y = pk2(a[2], a[3]); w.z = pk2(b[0], b[1]); w.w = pk2(b[2], b[3]);
        *(u32x4*)(xb + idx * 8) = w;
    }
}

constexpr int BM = 256, BK = 64, HALF = 128, HT = HALF * BK;
__device__ __forceinline__ int lds_byte(int r, int c) {
    int st = (r >> 4) * 2 + (c >> 5), rr = r & 15, cc = c & 31, ob = rr * 64 + cc * 2;
    return st * 1024 + (ob ^ (((ob >> 9) & 1) << 5));
}
__device__ __forceinline__ void stage_rc(int b, int& R, int& C) {
    int st = b / 1024, sb = b % 1024, swz = sb ^ (((sb >> 9) & 1) << 5);
    R = (st >> 1) * 16 + swz / 64; C = (st & 1) * 32 + (swz % 64) / 2;
}
__device__ __forceinline__ void tile_of(int L, int nM, int nN, int& pm, int& pn) {
    const int nwg = nM * nN; int wgid = L;
    { const int q = nwg / 8, r = nwg % 8, xcd = wgid % 8, off = wgid / 8; wgid = (xcd < r ? xcd * (q + 1) : r * (q + 1) + (xcd - r) * q) + off; }
    const int nig = 8 * nN, gid = wgid / nig, fm = gid * 8, gsz = (nM - fm) < 8 ? (nM - fm) : 8;
    pm = fm + ((wgid % nig) % gsz); pn = (wgid % nig) / gsz;
}

#define LAS __attribute__((address_space(3)))
template <class Epi>
__device__ __forceinline__ void gemm_tile(LAS unsigned char* lds, const bf16_t* A, int lda, const bf16_t* Bt, int K, int pm, int pn, const Epi& epi, int wid_s) {
    const int tid = otid(wid_s), wid = __builtin_amdgcn_readfirstlane(tid >> 6), lane = tid & 63, wr = wid >> 2, wc = wid & 3, fr = lane & 15, fq = lane >> 4;
    const int nt = K / BK;
    unsigned voffA[2], voffB[2];
#pragma unroll
    for (int i = 0; i < 2; ++i) { int R, C; stage_rc(tid * 16 + i * 8192, R, C); voffA[i] = (unsigned)(R * lda + C) * 2u; voffB[i] = (unsigned)(R * K + C) * 2u; }
    const size_t kstep = (size_t)(BK * 2), hstepA = (size_t)HALF * lda * 2, hstepB = (size_t)HALF * K * 2;
    const unsigned ldsw = (unsigned)wid * 1024u;
    const int aoff = lds_byte(wr * 64 + fr, fq * 8), boff = lds_byte(wc * 32 + fr, fq * 8);
    const char* cA = (const char*)A + (size_t)pm * 2 * hstepA; const char* cB = (const char*)Bt + (size_t)pn * 2 * hstepB;
#define HTB (HALF * BK * 2)
#define SA(b, h) (((b) * 2 + (h)) * HTB)
#define SB(b, h) ((4 + (b) * 2 + (h)) * HTB)
#define STAGE(bufoff, gbase, voff) do { _Pragma("unroll") for (int _i = 0; _i < 2; ++_i) \
        __builtin_amdgcn_global_load_lds((const unsigned*)((const char*)(gbase) + (voff)[_i]), (LAS unsigned*)(lds + (bufoff) + ldsw + _i * 8192), 16, 0, 0); } while (0)
#define LDA(dst, b, h) do { _Pragma("unroll") for (int m = 0; m < 4; ++m) _Pragma("unroll") for (int k = 0; k < 2; ++k) dst[m][k] = *(const LAS bf16x8*)(lds + SA(b, h) + aoff + m * 2048 + k * 1024); } while (0)
#define LDB(dst, b, h) do { _Pragma("unroll") for (int n = 0; n < 2; ++n) _Pragma("unroll") for (int k = 0; k < 2; ++k) dst[n][k] = *(const LAS bf16x8*)(lds + SB(b, h) + boff + n * 2048 + k * 1024); } while (0)
#define MMA(ai, bj, At_, Bt_) do { __builtin_amdgcn_s_setprio(1); _Pragma("unroll") for (int m = 0; m < 4; ++m) _Pragma("unroll") for (int n = 0; n < 2; ++n) _Pragma("unroll") for (int k = 0; k < 2; ++k) \
        acc[ai][bj][m][n] = __builtin_amdgcn_mfma_f32_16x16x32_bf16(Bt_[n][k], At_[m][k], acc[ai][bj][m][n], 0, 0, 0); __builtin_amdgcn_s_setprio(0); } while (0)
#define WAIT_V(n) asm volatile("s_waitcnt vmcnt(" #n ")" ::: "memory")
#define WAIT_L(n) asm volatile("s_waitcnt lgkmcnt(" #n ")" ::: "memory")
#define BAR __builtin_amdgcn_s_barrier()
#define SCHED __builtin_amdgcn_sched_barrier(0)
    f32x4 acc[2][2][4][2];
#pragma unroll
    for (int a = 0; a < 2; ++a)
#pragma unroll
        for (int b = 0; b < 2; ++b)
#pragma unroll
            for (int m = 0; m < 4; ++m)
#pragma unroll
                for (int n = 0; n < 2; ++n) acc[a][b][m][n] = (f32x4){0.f, 0.f, 0.f, 0.f};
    bf16x8 At[4][2], B0[2][2], B1[2][2];
    STAGE(SB(0, 0), cB, voffB); STAGE(SA(0, 0), cA, voffA); STAGE(SB(0, 1), cB + hstepB, voffB); STAGE(SA(0, 1), cA + hstepA, voffA);
    if (wr == 1) BAR;
    WAIT_V(4); BAR;
    STAGE(SB(1, 0), cB + kstep, voffB); STAGE(SA(1, 0), cA + kstep, voffA); STAGE(SB(1, 1), cB + hstepB + kstep, voffB);
    WAIT_V(6); BAR;
    for (int t = 0; t < nt - 2; t += 2) {
        const char* a1 = cA + (size_t)(t + 1) * kstep; const char* a2 = cA + (size_t)(t + 2) * kstep; const char* b2 = cB + (size_t)(t + 2) * kstep;
        const char* a3 = a2 + kstep; const char* b3 = b2 + kstep;
        LDB(B0, 0, 0); SCHED; LDA(At, 0, 0); STAGE(SA(1, 1), a1 + hstepA, voffA);
        WAIT_L(8); BAR; WAIT_L(0); MMA(0, 0, At, B0); BAR; SCHED;
        LDB(B1, 0, 1); STAGE(SB(0, 0), b2, voffB);
        BAR; WAIT_L(0); MMA(0, 1, At, B1); BAR;
        LDA(At, 0, 1); STAGE(SA(0, 0), a2, voffA);
        BAR; WAIT_L(0); MMA(1, 0, At, B0); BAR; SCHED;
        STAGE(SB(0, 1), b2 + hstepB, voffB);
        WAIT_V(6); BAR; MMA(1, 1, At, B1); BAR;
        LDB(B0, 1, 0); SCHED; LDA(At, 1, 0); STAGE(SA(0, 1), a2 + hstepA, voffA);
        WAIT_L(8); BAR; WAIT_L(0); MMA(0, 0, At, B0); BAR; SCHED;
        LDB(B1, 1, 1); STAGE(SB(1, 0), b3, voffB);
        BAR; WAIT_L(0); MMA(0, 1, At, B1); BAR;
        LDA(At, 1, 1); STAGE(SA(1, 0), a3, voffA);
        BAR; WAIT_L(0); MMA(1, 0, At, B0); BAR; SCHED;
        STAGE(SB(1, 1), b3 + hstepB, voffB);
        WAIT_V(6); BAR; MMA(1, 1, At, B1); BAR;
    }
    { const char* a1 = cA + (size_t)(nt - 1) * kstep;
      LDB(B0, 0, 0); LDA(At, 0, 0); STAGE(SA(1, 1), a1 + hstepA, voffA);
      BAR; WAIT_L(0); MMA(0, 0, At, B0); BAR;
      LDB(B1, 0, 1); BAR; WAIT_L(0); MMA(0, 1, At, B1); BAR;
      LDA(At, 0, 1); WAIT_V(4); BAR; WAIT_L(0); MMA(1, 0, At, B0); MMA(1, 1, At, B1); BAR; }
    { LDB(B0, 1, 0); LDA(At, 1, 0); WAIT_V(2); BAR; WAIT_L(0); MMA(0, 0, At, B0); BAR;
      LDB(B1, 1, 1); WAIT_V(0); BAR; WAIT_L(0); MMA(0, 1, At, B1); BAR;
      LDA(At, 1, 1); BAR; WAIT_L(0); MMA(1, 0, At, B0); MMA(1, 1, At, B1); BAR; }
    if (wr == 0) BAR;
    epi(acc, pm * BM, pn * BM, wr, wc, fr, fq);
#undef SA
#undef SB
#undef STAGE
#undef LDA
#undef LDB
#undef MMA
}

struct EpiIn {
    bf16_t* H; float* side; const float* rope; bf16_t* VT; bf16_t* KF; unsigned* kmax; bool dry;
    __device__ __forceinline__ void operator()(f32x4 (&acc)[2][2][4][2], int brow, int bcol, int wr, int wc, int fr, int fq) const {
#pragma unroll
        for (int bj = 0; bj < 2; ++bj) {
            const int hb = bcol + bj * HALF;
            if (hb >= 4224 || dry) continue;
            const int gbase = hb + (wc >> 1) * 64, g64 = gbase >> 6, d0 = (wc & 1) * 16 + 4 * fq;
            const bool rp = (g64 < 16) || (g64 >= 24 && g64 <= 32);
            const float qs = (g64 < 8) ? QSCALE : 1.f;
            float kabs = 0.f;
#pragma unroll
            for (int ai = 0; ai < 2; ++ai)
#pragma unroll
                for (int m = 0; m < 4; ++m) {
                    const long row = brow + ai * HALF + wr * 64 + m * 16 + fr;
                    f32x4 o1 = acc[ai][bj][m][0], o2 = acc[ai][bj][m][1];
                    if (rp) {
                        const f32x4 c0 = *(const f32x4*)(rope + (row * 32 + d0) * 2), c1 = *(const f32x4*)(rope + (row * 32 + d0) * 2 + 4);
                        const f32x4 x1 = o1, x2 = o2;
                        o1[0] = (x1[0] * c0[0] - x2[0] * c0[1]) * qs; o2[0] = (x2[0] * c0[0] + x1[0] * c0[1]) * qs;
                        o1[1] = (x1[1] * c0[2] - x2[1] * c0[3]) * qs; o2[1] = (x2[1] * c0[2] + x1[1] * c0[3]) * qs;
                        o1[2] = (x1[2] * c1[0] - x2[2] * c1[1]) * qs; o2[2] = (x2[2] * c1[0] + x1[2] * c1[1]) * qs;
                        o1[3] = (x1[3] * c1[2] - x2[3] * c1[3]) * qs; o2[3] = (x2[3] * c1[2] + x1[3] * c1[3]) * qs;
                    }
                    if (g64 >= 8 && g64 < 24) {
                        const int bb = (int)(row >> 13), tt = (int)(row & (T - 1)), tile = tt >> 5, tk = tt & 31;
                        if (g64 < 16) {
                            kabs = fmaxf(kabs, fmaxf(fmaxf(fabsf(o1[0]), fabsf(o1[1])), fmaxf(fabsf(o1[2]), fabsf(o1[3]))));
                            kabs = fmaxf(kabs, fmaxf(fmaxf(fabsf(o2[0]), fabsf(o2[1])), fmaxf(fabsf(o2[2]), fabsf(o2[3]))));
                            const long base = ((long)(bb * 8 + (g64 - 8)) * 256 + tile) * 4;
                            const int ks = d0 >> 4, hk = (d0 >> 3) & 1, j0 = d0 & 7;
                            u32x2 w1, w2; w1.x = pk2(o1[0], o1[1]); w1.y = pk2(o1[2], o1[3]); w2.x = pk2(o2[0], o2[1]); w2.y = pk2(o2[2], o2[3]);
                            const auto sx = __builtin_amdgcn_permlane16_swap(w1.x, w2.x, false, false), sy = __builtin_amdgcn_permlane16_swap(w1.y, w2.y, false, false);
                            u32x4 wv; long slot;
                            if (fq & 1) { wv.x = sx[0]; wv.y = sy[0]; wv.z = w2.x; wv.w = w2.y; slot = (base + ks + 2) * 64 + hk * 32 + tk; }
                            else { wv.x = w1.x; wv.y = w1.y; wv.z = sx[1]; wv.w = sy[1]; slot = (base + ks) * 64 + hk * 32 + tk; }
                            *(u32x4*)(KF + slot * 8) = wv;
                        } else {
                            const int s = tk >> 4, u = tk & 15, hv = (u >> 2) & 1, jv = (u >> 3) * 4 + (u & 3);
                            const long base = (((long)(bb * 8 + (g64 - 16)) * 256 + tile) * 2) * 2 + s;
                            bf16_t* v0 = VT + ((base) * 64 + hv * 32 + d0) * 8 + jv;
                            bf16_t* v1 = VT + ((base + 2) * 64 + hv * 32 + d0) * 8 + jv;
#pragma unroll
                            for (int j = 0; j < 4; ++j) { v0[j * 8] = (bf16_t)f2bf(o1[j]); v1[j * 8] = (bf16_t)f2bf(o2[j]); }
                        }
                    } else if (gbase < 4160) {
                        bf16_t* hp = H + row * HP + gbase + d0;
                        u32x2 w1, w2; w1.x = pk2(o1[0], o1[1]); w1.y = pk2(o1[2], o1[3]); w2.x = pk2(o2[0], o2[1]); w2.y = pk2(o2[2], o2[3]);
                        const auto sx = __builtin_amdgcn_permlane16_swap(w1.x, w2.x, false, false), sy = __builtin_amdgcn_permlane16_swap(w1.y, w2.y, false, false);
                        u32x4 wv;
                        if (fq & 1) { wv.x = sx[0]; wv.y = sy[0]; wv.z = w2.x; wv.w = w2.y; hp += 32 - 4; }
                        else { wv.x = w1.x; wv.y = w1.y; wv.z = sx[1]; wv.w = sy[1]; }
                        *(u32x4*)hp = wv;
                    } else if (d0 < 8) { *(f32x4*)(side + row * 24 + d0) = o1 * WI_SCALE; }
                    else if (d0 < 24) { *(f32x4*)(side + row * 24 + d0) = o1; }
                }
            if (g64 >= 8 && g64 < 16) {
#pragma unroll
                for (int o = 32; o >= 1; o >>= 1) kabs = fmaxf(kabs, sxor_f(kabs, fq * 16 + fr, o));
                if ((threadIdx.x & 63) == 0) atomicMax(kmax + (brow >> 13) * 8 + (g64 - 8), __float_as_uint(kabs));
            }
        }
    }
};
struct EpiOut {
    const float* xres; float* out; bool dry;
    __device__ __forceinline__ void operator()(f32x4 (&acc)[2][2][4][2], int brow, int bcol, int wr, int wc, int fr, int fq) const {
#pragma unroll
        for (int ai = 0; ai < 2; ++ai)
#pragma unroll
            for (int m = 0; m < 4; ++m)
#pragma unroll
                for (int bj = 0; bj < 2; ++bj)
#pragma unroll
                    for (int n = 0; n < 2; ++n) {
                        const long idx = (long)(brow + ai * HALF + wr * 64 + m * 16 + fr) * DM + (bcol + bj * HALF + wc * 32 + n * 16 + 4 * fq);
                        const f32x4 xr = *(const f32x4*)(xres + idx);
                        if (!dry) *(f32x4*)(out + idx) = xr * ALPHA + acc[ai][bj][m][n];
                    }
    }
};

__device__ __forceinline__ void ln_phase(const Params& p, int layer, int row_begin, int row_end, int row_step, int lane, bool dry) {
    bf16_t* xb = (bf16_t*)(p.ws + WS_XB);
    const float* g = p.ln_g + layer * DM; const float* bb = p.ln_b + layer * DM;
    for (int row = row_begin; row < row_end; row += row_step) {
        float* zr = p.out + (long)row * DM;
        f32x4 v[4]; float s = 0.f;
#pragma unroll
        for (int r = 0; r < 4; ++r) { v[r] = *(const f32x4*)(zr + r * 256 + lane * 4); s += v[r][0] + v[r][1] + v[r][2] + v[r][3]; }
        const float mu = wave_sum(s, lane) * (1.f / DM);
        float q = 0.f;
#pragma unroll
        for (int r = 0; r < 4; ++r)
#pragma unroll
            for (int e = 0; e < 4; ++e) { const float d = v[r][e] - mu; q += d * d; }
        const float rstd = rsqrtf(wave_sum(q, lane) * (1.f / DM) + EPS);
#pragma unroll
        for (int r = 0; r < 4; ++r) {
            const f32x4 gg = *(const f32x4*)(g + r * 256 + lane * 4), bv = *(const f32x4*)(bb + r * 256 + lane * 4);
            f32x4 y;
#pragma unroll
            for (int e = 0; e < 4; ++e) y[e] = (v[r][e] - mu) * rstd * gg[e] + bv[e];
            if (dry) continue;
            *(f32x4*)(zr + r * 256 + lane * 4) = y;
            u32x2 w; w.x = pk2(y[0], y[1]); w.y = pk2(y[2], y[3]);
            *(u32x2*)(xb + (long)row * DM + r * 256 + lane * 4) = w;
        }
    }
}

__device__ __forceinline__ void conformer_tile(const Params& p, int layer, unsigned char* lds, int tile, bool dry, int wid_s) {
    bf16_t* H = (bf16_t*)(p.ws + WS_H);
    const int tid = otid(wid_s), lane = tid & 63, w = tid >> 6;
    const int tok0 = tile * 64, b = tok0 / T, tl0 = tok0 % T;
    bf16_t* hg = (bf16_t*)lds;
    float* cv = (float*)(lds + 49152);
    for (int idx = tid; idx < 94 * 32; idx += 512) {
        const int r = idx >> 5, cc = (idx & 31) * 8, tl = tl0 - 30 + r;
        u32x4 o = {0u, 0u, 0u, 0u};
        if (tl >= 0) {
            const bf16_t* src = H + ((long)b * T + tl) * HP + HGLU + cc;
            const u32x4 va = *(const u32x4*)src, ga = *(const u32x4*)(src + 256);
            o.x = pk2(bflo(va.x) * sigmoid_f(bflo(ga.x)), bfhi(va.x) * sigmoid_f(bfhi(ga.x)));
            o.y = pk2(bflo(va.y) * sigmoid_f(bflo(ga.y)), bfhi(va.y) * sigmoid_f(bfhi(ga.y)));
            o.z = pk2(bflo(va.z) * sigmoid_f(bflo(ga.z)), bfhi(va.z) * sigmoid_f(bfhi(ga.z)));
            o.w = pk2(bflo(va.w) * sigmoid_f(bflo(ga.w)), bfhi(va.w) * sigmoid_f(bfhi(ga.w)));
        }
        *(u32x4*)(hg + r * 256 + cc) = o;
    }
    __syncthreads();
    {
        const int c = tid & 255, half = tid >> 8;
        const float* cw = p.conv_w + (long)layer * 31 * 256 + c;
        float wj[31];
#pragma unroll
        for (int j = 0; j < 31; ++j) wj[j] = cw[j * 256];
        const float cb = p.conv_b[layer * 256 + c];
        float win[62];
#pragma unroll
        for (int r = 0; r < 62; ++r) win[r] = bf2f(hg[(half * 32 + r) * 256 + c]);
#pragma unroll
        for (int tt = 0; tt < 32; ++tt) {
            float a = cb;
#pragma unroll
            for (int j = 0; j < 31; ++j) a = fmaf(win[tt + j], wj[j], a);
            cv[(half * 32 + tt) * 256 + c] = a;
        }
    }
    __syncthreads();
    bf16_t* at = (bf16_t*)lds;
    {
        const f32x4 gg = *(const f32x4*)(p.cln_g + layer * 256 + lane * 4), bv = *(const f32x4*)(p.cln_b + layer * 256 + lane * 4);
#pragma unroll
        for (int tt = 0; tt < 8; ++tt) {
            const int t = w * 8 + tt;
            const f32x4 v = *(const f32x4*)(cv + t * 256 + lane * 4);
            const float mu = wave_sum(v[0] + v[1] + v[2] + v[3], lane) * (1.f / 256.f);
            float q = 0.f;
#pragma unroll
            for (int e = 0; e < 4; ++e) { const float d = v[e] - mu; q += d * d; }
            const float rstd = rsqrtf(wave_sum(q, lane) * (1.f / 256.f) + EPS);
            float y[4];
#pragma unroll
            for (int e = 0; e < 4; ++e) y[e] = silu_f((v[e] - mu) * rstd * gg[e] + bv[e]);
            u32x2 o; o.x = pk2(y[0], y[1]); o.y = pk2(y[2], y[3]);
            *(u32x2*)(at + t * 264 + lane * 4) = o;
        }
    }
    __syncthreads();
    {
        f32x16 acc0 = {}, acc1 = {};
        const bf16_t* pwt = (const bf16_t*)(p.ws + WS_PWT) + (long)layer * 65536 + (w * 32 + (lane & 31)) * 256 + 8 * (lane >> 5);
        const bf16_t* ap = at + (lane & 31) * 264 + 8 * (lane >> 5);
#pragma unroll 4
        for (int ks = 0; ks < 16; ++ks) {
            const bf16x8 bfr = *(const bf16x8*)(pwt + ks * 16);
            const bf16x8 a0 = *(const bf16x8*)(ap + ks * 16), a1 = *(const bf16x8*)(ap + 32 * 264 + ks * 16);
            acc0 = __builtin_amdgcn_mfma_f32_32x32x16_bf16(a0, bfr, acc0, 0, 0, 0);
            acc1 = __builtin_amdgcn_mfma_f32_32x32x16_bf16(a1, bfr, acc1, 0, 0, 0);
        }
        const int ch = w * 32 + (lane & 31);
        const float pb = p.pw_b[layer * 256 + ch];
#pragma unroll
        for (int i = 0; i < 16; ++i) {
            const int row = (i & 3) + 8 * (i >> 2) + 4 * (lane >> 5);
            bf16_t* g0 = H + (long)(tok0 + row) * HP + HBG + ch;
            bf16_t* g1 = H + (long)(tok0 + 32 + row) * HP + HBG + ch;
            const unsigned r0 = f2bf((acc0[i] + pb) * silu_f(bf2f(*g0))), r1 = f2bf((acc1[i] + pb) * silu_f(bf2f(*g1)));
            if (!dry) { *g0 = (bf16_t)r0; *g1 = (bf16_t)r1; }
        }
    }
    __syncthreads();
}

__device__ __forceinline__ float rdlane(float v, int l) { return __uint_as_float(__builtin_amdgcn_readlane(__float_as_uint(v), l)); }

__device__ __forceinline__ void gla_local_item(const Params& p, int layer, int item_, int lane, bool dry) {
    const int item = __builtin_amdgcn_readfirstlane(item_);
    bf16_t* H = (bf16_t*)(p.ws + WS_H);
    const float* side = (const float*)(p.ws + WS_SIDE);
    float* bcum = (float*)(p.ws + WS_BCUM); float* U = (float*)(p.ws + WS_U); float* DEC = (float*)(p.ws + WS_DEC);
    const int bh = item >> 7, c = item & 127, b = bh >> 2, h = bh & 3;
    const long tok0 = (long)b * T + c * 64, tok = tok0 + lane;
    float clr[16];
#pragma unroll
    for (int r = 0; r < 4; ++r) { const f32x4 v = *(const f32x4*)(side + tok * 24 + 8 + r * 4); clr[r * 4] = v[0]; clr[r * 4 + 1] = v[1]; clr[r * 4 + 2] = v[2]; clr[r * 4 + 3] = v[3]; }
    const float* gw = p.gate_w2 + (long)layer * 16 * 128 + h * 32; const float* gb = p.gate_b + layer * 128 + h * 32;
    float* bcp = bcum + tok * 128 + h * 32;
#pragma unroll 1
    for (int d = 0; d < 32; ++d) {
        float z = gb[d];
#pragma unroll
        for (int r = 0; r < 16; ++r) z = fmaf(clr[r], gw[r * 128 + d], z);
        float g = (fminf(z, 0.f) - __logf(1.f + __expf(-fabsf(z)))) * (1.f / 16.f);
#pragma unroll
        for (int o = 1; o < 64; o <<= 1) { const float up = __int_as_float(bperm_i((lane - o) & 63, __float_as_int(g))); if (lane >= o) g += up; }
        bcp[d] = g;
    }
    float bc[32];
#pragma unroll
    for (int r = 0; r < 8; ++r) { const f32x4 v = *(const f32x4*)(bcp + r * 4); bc[r * 4] = v[0]; bc[r * 4 + 1] = v[1]; bc[r * 4 + 2] = v[2]; bc[r * 4 + 3] = v[3]; }
    float kk[32];
    {
        const bf16_t* kp = H + tok * HP + HCK + h * 32;
#pragma unroll
        for (int r = 0; r < 4; ++r) {
            const u32x4 kv = *(const u32x4*)(kp + r * 8);
            kk[r * 8 + 0] = bflo(kv.x); kk[r * 8 + 1] = bfhi(kv.x); kk[r * 8 + 2] = bflo(kv.y); kk[r * 8 + 3] = bfhi(kv.y);
            kk[r * 8 + 4] = bflo(kv.z); kk[r * 8 + 5] = bfhi(kv.z); kk[r * 8 + 6] = bflo(kv.w); kk[r * 8 + 7] = bfhi(kv.w);
        }
#pragma unroll
        for (int d = 0; d < 32; ++d) { const float bl = rdlane(bc[d], 63); kk[d] *= __expf(bl - bc[d]); }
    }
    float acc[32];
#pragma unroll
    for (int d = 0; d < 32; ++d) acc[d] = 0.f;
    const bf16_t* vp = H + tok0 * HP + HCV + h * 64 + lane;
#pragma unroll 1
    for (int t8 = 0; t8 < 64; t8 += 8) {
        float vv[8];
#pragma unroll
        for (int u = 0; u < 8; ++u) vv[u] = bf2f(vp[(long)(t8 + u) * HP]);
#pragma unroll
        for (int u = 0; u < 8; ++u)
#pragma unroll
            for (int d = 0; d < 32; ++d) acc[d] = fmaf(rdlane(kk[d], t8 + u), vv[u], acc[d]);
    }
#pragma unroll
    for (int d = 0; d < 32; ++d) if (!dry) U[(long)item * 2048 + d * 64 + lane] = acc[d];
    if (lane == 63) {
#pragma unroll
        for (int r = 0; r < 8; ++r) { f32x4 v = {__expf(bc[r * 4]), __expf(bc[r * 4 + 1]), __expf(bc[r * 4 + 2]), __expf(bc[r * 4 + 3])}; *(f32x4*)(DEC + item * 32 + r * 4) = v; }
    }
}

__device__ __forceinline__ void gla_scan(const Params& p, int gt) {
    float* U = (float*)(p.ws + WS_U); const float* DEC = (const float*)(p.ws + WS_DEC);
    const int bh = gt >> 11, de = gt & 2047, d = de >> 6;
    float s = 0.f;
    for (int c0 = 0; c0 < 128; c0 += 32) {
        float u[32], dc[32];
#pragma unroll
        for (int i = 0; i < 32; ++i) { u[i] = U[(long)(bh * 128 + c0 + i) * 2048 + de]; dc[i] = DEC[(bh * 128 + c0 + i) * 32 + d]; }
#pragma unroll
        for (int i = 0; i < 32; ++i) { U[(long)(bh * 128 + c0 + i) * 2048 + de] = s; s = fmaf(dc[i], s, u[i]); }
    }
}

__device__ __forceinline__ void gla_out_item(const Params& p, int layer, unsigned char* ldsw, int item_, int lane, bool dry) {
    const int item = __builtin_amdgcn_readfirstlane(item_);
    bf16_t* H = (bf16_t*)(p.ws + WS_H);
    const float* bcum = (const float*)(p.ws + WS_BCUM); const float* U = (const float*)(p.ws + WS_U);
    float* sA = (float*)ldsw; bf16_t* sV = (bf16_t*)(ldsw + 8192);
    const int bh = item >> 7, c = item & 127, b = bh >> 2, h = bh & 3;
    const long tok = (long)b * T + c * 64 + lane;
#pragma unroll
    for (int r = 0; r < 8; ++r) *(f32x4*)(sA + r * 256 + lane * 4) = *(const f32x4*)(U + (long)item * 2048 + r * 256 + lane * 4);
#pragma unroll
    for (int r = 0; r < 8; ++r) *(u32x4*)(sV + lane * 64 + r * 8) = *(const u32x4*)(H + tok * HP + HCV + h * 64 + r * 8);
    WAVE_SYNC();
    float o[64];
#pragma unroll
    for (int e = 0; e < 64; ++e) o[e] = 0.f;
    {
        const bf16_t* qp = H + tok * HP + HCQ + h * 32; const float* bp = bcum + tok * 128 + h * 32;
#pragma unroll 1
        for (int d = 0; d < 32; ++d) {
            const float qd = bf2f(qp[d]) * 0.17677669529663687f * __expf(bp[d]);
#pragma unroll
            for (int e4 = 0; e4 < 16; ++e4) {
                const f32x4 s4 = *(const f32x4*)(sA + d * 64 + e4 * 4);
                o[e4 * 4] = fmaf(qd, s4[0], o[e4 * 4]); o[e4 * 4 + 1] = fmaf(qd, s4[1], o[e4 * 4 + 1]);
                o[e4 * 4 + 2] = fmaf(qd, s4[2], o[e4 * 4 + 2]); o[e4 * 4 + 3] = fmaf(qd, s4[3], o[e4 * 4 + 3]);
            }
        }
    }
    WAVE_SYNC();
    {
        const bf16_t* kp = H + tok * HP + HCK + h * 32;
#pragma unroll
        for (int r = 0; r < 4; ++r) {
            const u32x4 kv = *(const u32x4*)(kp + r * 8);
            const f32x4 b0 = *(const f32x4*)(bcum + tok * 128 + h * 32 + r * 8), b1 = *(const f32x4*)(bcum + tok * 128 + h * 32 + r * 8 + 4);
            f32x4 k0 = {bflo(kv.x) * __expf(-b0[0]), bfhi(kv.x) * __expf(-b0[1]), bflo(kv.y) * __expf(-b0[2]), bfhi(kv.y) * __expf(-b0[3])};
            f32x4 k1 = {bflo(kv.z) * __expf(-b1[0]), bfhi(kv.z) * __expf(-b1[1]), bflo(kv.w) * __expf(-b1[2]), bfhi(kv.w) * __expf(-b1[3])};
            *(f32x4*)(sA + lane * 32 + r * 8) = k0; *(f32x4*)(sA + lane * 32 + r * 8 + 4) = k1;
        }
    }
    float qe[32];
    {
        const bf16_t* qp = H + tok * HP + HCQ + h * 32;
#pragma unroll
        for (int r = 0; r < 4; ++r) {
            const u32x4 qv = *(const u32x4*)(qp + r * 8);
            const f32x4 b0 = *(const f32x4*)(bcum + tok * 128 + h * 32 + r * 8), b1 = *(const f32x4*)(bcum + tok * 128 + h * 32 + r * 8 + 4);
            const float qq[8] = {bflo(qv.x), bfhi(qv.x), bflo(qv.y), bfhi(qv.y), bflo(qv.z), bfhi(qv.z), bflo(qv.w), bfhi(qv.w)};
            const float bb[8] = {b0[0], b0[1], b0[2], b0[3], b1[0], b1[1], b1[2], b1[3]};
#pragma unroll
            for (int e = 0; e < 8; ++e) qe[r * 8 + e] = qq[e] * 0.17677669529663687f * __expf(bb[e]);
        }
    }
    WAVE_SYNC();
#pragma unroll 1
    for (int j = 0; j < 64; ++j) {
        float a = 0.f;
#pragma unroll
        for (int d4 = 0; d4 < 8; ++d4) {
            const f32x4 k4 = *(const f32x4*)(sA + j * 32 + d4 * 4);
            a = fmaf(qe[d4 * 4], k4[0], a); a = fmaf(qe[d4 * 4 + 1], k4[1], a); a = fmaf(qe[d4 * 4 + 2], k4[2], a); a = fmaf(qe[d4 * 4 + 3], k4[3], a);
        }
        if (j > lane) a = 0.f;
#pragma unroll
        for (int e8 = 0; e8 < 8; ++e8) {
            const u32x4 v8 = *(const u32x4*)(sV + j * 64 + e8 * 8);
            o[e8 * 8 + 0] = fmaf(a, bflo(v8.x), o[e8 * 8 + 0]); o[e8 * 8 + 1] = fmaf(a, bfhi(v8.x), o[e8 * 8 + 1]);
            o[e8 * 8 + 2] = fmaf(a, bflo(v8.y), o[e8 * 8 + 2]); o[e8 * 8 + 3] = fmaf(a, bfhi(v8.y), o[e8 * 8 + 3]);
            o[e8 * 8 + 4] = fmaf(a, bflo(v8.z), o[e8 * 8 + 4]); o[e8 * 8 + 5] = fmaf(a, bfhi(v8.z), o[e8 * 8 + 5]);
            o[e8 * 8 + 6] = fmaf(a, bflo(v8.w), o[e8 * 8 + 6]); o[e8 * 8 + 7] = fmaf(a, bfhi(v8.w), o[e8 * 8 + 7]);
        }
    }
    float ss = 0.f;
#pragma unroll
    for (int e = 0; e < 64; ++e) ss = fmaf(o[e], o[e], ss);
    const float rms = rsqrtf(ss * (1.f / 64.f) + EPS);
    const float* gn = p.gnorm_g + layer * 256 + h * 64;
    bf16_t* cg_p = H + tok * HP + HCG + h * 64;
#pragma unroll
    for (int r = 0; r < 8; ++r) {
        const u32x4 gv = *(const u32x4*)(cg_p + r * 8);
        const float gq[8] = {bflo(gv.x), bfhi(gv.x), bflo(gv.y), bfhi(gv.y), bflo(gv.z), bfhi(gv.z), bflo(gv.w), bfhi(gv.w)};
        float y[8];
#pragma unroll
        for (int e = 0; e < 8; ++e) y[e] = o[r * 8 + e] * rms * gn[r * 8 + e] * silu_f(gq[e]);
        u32x4 w; w.x = pk2(y[0], y[1]); w.y = pk2(y[2], y[3]); w.z = pk2(y[4], y[5]); w.w = pk2(y[6], y[7]);
        if (!dry) *(u32x4*)(cg_p + r * 8) = w;
    }
    WAVE_SYNC();
}

constexpr int MPITCH = 260;
constexpr int HPITCH = 516;
constexpr int L_HIST = 0;
constexpr int L_CAND = 66560;
constexpr int L_CCNT = L_CAND + 65536;
constexpr int L_QINF = L_CCNT + 2048;
constexpr int L_MTAB = L_QINF + 1024 + 64;
static_assert(L_MTAB + 8192 <= LDS_BYTES, "dsa lds");
__device__ __forceinline__ int mpos(int rr) { return 16 * ((rr >> 2) & 1) + (rr & 3) + 4 * (rr >> 3); }
constexpr int SUBCAP = 32;

__device__ __forceinline__ unsigned mono_bits(float f) { const unsigned u = __float_as_uint(f); return u ^ ((u >> 31) ? 0xffffffffu : 0x80000000u); }
__device__ __forceinline__ void idx_loadkp(const bf16_t* kp, bf16x8 (&kf)[2][2]) {
#pragma unroll
    for (int kb = 0; kb < 2; ++kb)
#pragma unroll
        for (int ks = 0; ks < 2; ++ks) kf[kb][ks] = *(const bf16x8*)(kp + (long)kb * 16 * HP + ks * 32);
}
__device__ __forceinline__ void idx_loadk(const bf16_t* Hb, int s0, int lane, bf16x8 (&kf)[2][2]) {
    const bf16_t* kp = Hb + (long)(s0 + (lane & 15)) * HP + HKI + 8 * (lane >> 4);
#pragma unroll
    for (int kb = 0; kb < 2; ++kb)
#pragma unroll
        for (int ks = 0; ks < 2; ++ks) kf[kb][ks] = *(const bf16x8*)(kp + (long)kb * 16 * HP + ks * 32);
}
__device__ __forceinline__ void idx_scores(const bf16x8 (&kf)[2][2], const bf16x8 (&qf)[8][2], const bf16x8 (&ql)[2][2], const float (&wh)[8], float (&score)[8]) {
    f32x4 lin[2];
#pragma unroll
    for (int kb = 0; kb < 2; ++kb) {
        lin[kb] = (f32x4){0.f, 0.f, 0.f, 0.f};
#pragma unroll
        for (int ks = 0; ks < 2; ++ks) {
            lin[kb] = __builtin_amdgcn_mfma_f32_16x16x32_bf16(kf[kb][ks], ql[0][ks], lin[kb], 0, 0, 0);
            lin[kb] = __builtin_amdgcn_mfma_f32_16x16x32_bf16(kf[kb][ks], ql[1][ks], lin[kb], 0, 0, 0);
        }
    }
#pragma unroll
    for (int i = 0; i < 8; ++i) score[i] = lin[i >> 2][i & 3];
#pragma unroll
    for (int hd = 0; hd < 8; ++hd) {
        f32x4 acc[2];
#pragma unroll
        for (int kb = 0; kb < 2; ++kb) {
            acc[kb] = (f32x4){0.f, 0.f, 0.f, 0.f};
#pragma unroll
            for (int ks = 0; ks < 2; ++ks) acc[kb] = __builtin_amdgcn_mfma_f32_16x16x32_bf16(kf[kb][ks], qf[hd][ks], acc[kb], 0, 0, 0);
        }
#pragma unroll
        for (int kb = 0; kb < 2; ++kb)
#pragma unroll
            for (int i = 0; i < 4; ++i) score[kb * 4 + i] = fmaf(fabsf(acc[kb][i]), wh[hd], score[kb * 4 + i]);
        if ((hd & 3) == 3) __builtin_amdgcn_sched_barrier(0);
    }
}

template <bool FAST>
__device__ __forceinline__ void attn_tile(const bf16x8 (&kf)[4], const bf16x8 (&vf)[4], const bf16x8 (&qfr)[2][4], f32x16 (&O)[2][2], float (&mrun)[2], float (&lrun)[2],
                                          const unsigned* hist, const float* mtab, int r32, int hh, int tile) {
#pragma unroll
    for (int qb = 0; qb < 2; ++qb) {
        f32x16 S;
        const unsigned mw = hist[(qb * 32 + r32) * MPITCH + tile] >> (16 * hh);
#pragma unroll
        for (int g8 = 0; g8 < 2; ++g8) {
            const float* mt = mtab + ((mw >> (8 * g8)) & 255u) * 8;
            const f32x4 ma = *(const f32x4*)mt, mb = *(const f32x4*)(mt + 4);
            S[8 * g8] = ma[0]; S[8 * g8 + 1] = ma[1]; S[8 * g8 + 2] = ma[2]; S[8 * g8 + 3] = ma[3];
            S[8 * g8 + 4] = mb[0]; S[8 * g8 + 5] = mb[1]; S[8 * g8 + 6] = mb[2]; S[8 * g8 + 7] = mb[3];
        }
#pragma unroll
        for (int ks = 0; ks < 4; ++ks) S = __builtin_amdgcn_mfma_f32_32x32x16_bf16(kf[ks], qfr[qb][ks], S, 0, 0, 0);
        float pr[16]; float ps = 0.f;
        if (FAST) {
#pragma unroll
            for (int i = 0; i < 16; ++i) { pr[i] = __builtin_amdgcn_exp2f(S[i]); ps += pr[i]; }
        } else {
            float mx = fmaxf(fmaxf(S[0], S[1]), S[2]);
#pragma unroll
            for (int i = 3; i < 15; i += 2) mx = fmaxf(fmaxf(mx, S[i]), S[i + 1]);
            mx = fmaxf(mx, S[15]);
            { const auto sw = __builtin_amdgcn_permlane32_swap(__float_as_uint(mx), __float_as_uint(mx), false, false); mx = fmaxf(__uint_as_float(sw[0]), __uint_as_float(sw[1])); }
            if (__any(mx > mrun[qb])) {
                const float mnew = fmaxf(mx, mrun[qb]);
                const float alpha = __builtin_amdgcn_exp2f(mrun[qb] - mnew);
                mrun[qb] = mnew; lrun[qb] *= alpha;
#pragma unroll
                for (int db = 0; db < 2; ++db)
#pragma unroll
                    for (int i = 0; i < 16; ++i) O[db][qb][i] *= alpha;
            }
            const float mref = fmaxf(mrun[qb], -1000.f);
#pragma unroll
            for (int i = 0; i < 16; ++i) { pr[i] = __builtin_amdgcn_exp2f(S[i] - mref); ps += pr[i]; }
        }
        lrun[qb] += ps;
        bf16x8 pf[2];
#pragma unroll
        for (int s = 0; s < 2; ++s) {
            u32x4 pw; pw.x = pk2(pr[8 * s], pr[8 * s + 1]); pw.y = pk2(pr[8 * s + 2], pr[8 * s + 3]); pw.z = pk2(pr[8 * s + 4], pr[8 * s + 5]); pw.w = pk2(pr[8 * s + 6], pr[8 * s + 7]);
            pf[s] = __builtin_bit_cast(bf16x8, pw);
        }
#pragma unroll
        for (int db = 0; db < 2; ++db)
#pragma unroll
            for (int s = 0; s < 2; ++s) O[db][qb] = __builtin_amdgcn_mfma_f32_32x32x16_bf16(vf[db * 2 + s], pf[s], O[db][qb], 0, 0, 0);
    }
}
template <bool FAST>
__device__ __forceinline__ void attn_loop(const bf16_t* Kp, const bf16_t* Vp, const bf16x8 (&qfr)[2][4], f32x16 (&O)[2][2], float (&mrun)[2], float (&lrun)[2],
                                          const unsigned* hist, const float* mtab, int r32, int hh, int nt32, bool dry2) {
    bf16x8 kf[4], vf[4], kg[4], vg[4];
#pragma unroll
    for (int ks = 0; ks < 4; ++ks) { kf[ks] = *(const bf16x8*)(Kp + ks * 512); vf[ks] = *(const bf16x8*)(Vp + ks * 512); }
#pragma unroll 1
    for (int tile = 0; tile < nt32; tile += 2) {
        {
            const int tn = dry2 ? 0 : tile + 1;
#pragma unroll
            for (int ks = 0; ks < 4; ++ks) { kg[ks] = *(const bf16x8*)(Kp + (long)tn * 2048 + ks * 512); vg[ks] = *(const bf16x8*)(Vp + (long)tn * 2048 + ks * 512); }
        }
        attn_tile<FAST>(kf, vf, qfr, O, mrun, lrun, hist, mtab, r32, hh, tile);
        {
            const int tn = dry2 ? 0 : ((tile + 2 < nt32) ? tile + 2 : tile);
#pragma unroll
            for (int ks = 0; ks < 4; ++ks) { kf[ks] = *(const bf16x8*)(Kp + (long)tn * 2048 + ks * 512); vf[ks] = *(const bf16x8*)(Vp + (long)tn * 2048 + ks * 512); }
        }
        attn_tile<FAST>(kg, vg, qfr, O, mrun, lrun, hist, mtab, r32, hh, tile + 1);
    }
}

__device__ __forceinline__ void dsa_item(const Params& p, unsigned char* lds, int b, int qblk, bool dry, int wid_s, const unsigned* kmaxL) {
    bf16_t* H = (bf16_t*)(p.ws + WS_H);
    const float* side = (const float*)(p.ws + WS_SIDE);
    const bf16_t* Hb = H + (long)b * T * HP;
    const int tid = otid(wid_s), lane = tid & 63, w = tid >> 6, hq = lane >> 4;
    const int qg = w & 3, kh = w >> 2;
    const int t0 = qblk * 64, qloc = qg * 16 + (lane & 15), t = t0 + qloc;
    unsigned* hist = (unsigned*)(lds + L_HIST);
    unsigned* cand = (unsigned*)(lds + L_CAND);
    unsigned* ccnt = (unsigned*)(lds + L_CCNT);
    int* qinf = (int*)(lds + L_QINF);

    for (int i = tid; i < 64 * MPITCH; i += 512) hist[i] = 0u;
    for (int i = tid; i < 2048; i += 512) ((float*)(lds + L_MTAB))[i] = ((i >> 3) >> (i & 7)) & 1 ? 0.f : -1e30f;
    bf16x8 qf[8][2]; bf16x8 ql[2][2]; float wi[8]; float inv, fb0c;
    {
        const bf16_t* qp = Hb + (long)t * HP + HQI + 8 * hq;
#pragma unroll
        for (int hd = 0; hd < 8; ++hd)
#pragma unroll
            for (int ks = 0; ks < 2; ++ks) qf[hd][ks] = *(const bf16x8*)(qp + hd * 64 + ks * 32);
        const float* sp = side + ((long)b * T + t) * 24;
        const f32x4 w0 = *(const f32x4*)sp, w1 = *(const f32x4*)(sp + 4);
        wi[0] = w0[0]; wi[1] = w0[1]; wi[2] = w0[2]; wi[3] = w0[3]; wi[4] = w1[0]; wi[5] = w1[1]; wi[6] = w1[2]; wi[7] = w1[3];
        float n2 = 0.f;
#pragma unroll
        for (int i = 0; i < 8; ++i) n2 = fmaf(wi[i], wi[i], n2);
        const float nrm = fmaxf(SIG_UNIT * sqrtf(n2), 1e-30f);
        inv = 64.f / nrm;
        fb0c = 256.f - 64.f * 3.19f * (wi[0] + wi[1] + wi[2] + wi[3] + wi[4] + wi[5] + wi[6] + wi[7]) / nrm;
#pragma unroll
        for (int i = 0; i < 8; ++i) wi[i] *= 0.5f;
#pragma unroll
        for (int ks = 0; ks < 2; ++ks) {
            float ql_f[8];
#pragma unroll
            for (int j = 0; j < 8; ++j) ql_f[j] = 0.f;
#pragma unroll
            for (int hd = 0; hd < 8; ++hd) {
                const u32x4 qv = __builtin_bit_cast(u32x4, qf[hd][ks]);
                ql_f[0] = fmaf(wi[hd], bflo(qv.x), ql_f[0]); ql_f[1] = fmaf(wi[hd], bfhi(qv.x), ql_f[1]); ql_f[2] = fmaf(wi[hd], bflo(qv.y), ql_f[2]); ql_f[3] = fmaf(wi[hd], bfhi(qv.y), ql_f[3]);
                ql_f[4] = fmaf(wi[hd], bflo(qv.z), ql_f[4]); ql_f[5] = fmaf(wi[hd], bfhi(qv.z), ql_f[5]); ql_f[6] = fmaf(wi[hd], bflo(qv.w), ql_f[6]); ql_f[7] = fmaf(wi[hd], bfhi(qv.w), ql_f[7]);
            }
            u32x4 hi4; hi4.x = pk2(ql_f[0], ql_f[1]); hi4.y = pk2(ql_f[2], ql_f[3]); hi4.z = pk2(ql_f[4], ql_f[5]); hi4.w = pk2(ql_f[6], ql_f[7]);
            u32x4 lo4;
            lo4.x = pk2(ql_f[0] - bflo(hi4.x), ql_f[1] - bfhi(hi4.x)); lo4.y = pk2(ql_f[2] - bflo(hi4.y), ql_f[3] - bfhi(hi4.y));
            lo4.z = pk2(ql_f[4] - bflo(hi4.z), ql_f[5] - bfhi(hi4.z)); lo4.w = pk2(ql_f[6] - bflo(hi4.w), ql_f[7] - bfhi(hi4.w));
            ql[0][ks] = __builtin_bit_cast(bf16x8, hi4); ql[1][ks] = __builtin_bit_cast(bf16x8, lo4);
        }
    }
    const int ntile = (t0 + 64 + 127) >> 7;
    const int tmaxw = t0 + qg * 16 + 15;
    __syncthreads();
    int nit = 0;
    { const int v = tmaxw - kh * 64; if (v >= 0) nit = 2 * (v >> 7) + (((v & 127) >= 32) ? 2 : 1); }
    float fa = inv, fbias = fb0c;
    bool active = true;
#pragma unroll 1
    for (int level = 0; level < 2; ++level) {
        unsigned* hbase = level ? cand : hist;
        const bool wave_on = __any(active);
        if (wave_on) {
            const unsigned incv = 1u << ((qloc & 1) * 16);
            unsigned* hrow = hbase + (qloc >> 1) * HPITCH;
            bf16x8 kf[2][2];
            const bf16_t* kpn = Hb + (long)(kh * 64 + (lane & 15)) * HP + HKI + 8 * (lane >> 4);
            idx_loadkp(kpn, kf);
#pragma unroll 2
            for (int it = 0; it < nit; ++it) {
                const int s0 = (it >> 1) * 128 + kh * 64 + (it & 1) * 32;
                if (it + 1 < nit) kpn += (long)((it & 1) ? 96 : 32) * HP;
                bf16x8 kn[2][2];
                idx_loadkp(kpn, kn);
                float score[8];
                idx_scores(kf, qf, ql, wi, score);
                if (s0 + 31 <= t0 + qg * 16) {
#pragma unroll
                    for (int i = 0; i < 8; ++i) { const unsigned bin = (unsigned)__builtin_amdgcn_fmed3f(fmaf(score[i], fa, fbias), 0.f, 511.5f); atomicAdd(hrow + bin, incv); }
                } else {
#pragma unroll
                    for (int i = 0; i < 8; ++i) {
                        const int s = s0 + (i >> 2) * 16 + hq * 4 + (i & 3);
                        if (s <= t) { const unsigned bin = (unsigned)__builtin_amdgcn_fmed3f(fmaf(score[i], fa, fbias), 0.f, 511.5f); atomicAdd(hrow + bin, incv); }
                    }
                }
#pragma unroll
                for (int kb = 0; kb < 2; ++kb)
#pragma unroll
                    for (int ks = 0; ks < 2; ++ks) kf[kb][ks] = kn[kb][ks];
            }
        }
        __syncthreads();
#pragma unroll 1
        for (int qq = 0; qq < 8; ++qq) {
            const int q = w * 8 + qq;
            if (level && !qinf[q * 4 + 3]) continue;
            const u32x4 wa = *(const u32x4*)(hbase + (q >> 1) * HPITCH + 8 * lane), wb = *(const u32x4*)(hbase + (q >> 1) * HPITCH + 8 * lane + 4);
            const int sh = (q & 1) * 16;
            const unsigned c[8] = {(wa.x >> sh) & 0xffffu, (wa.y >> sh) & 0xffffu, (wa.z >> sh) & 0xffffu, (wa.w >> sh) & 0xffffu, (wb.x >> sh) & 0xffffu, (wb.y >> sh) & 0xffffu, (wb.z >> sh) & 0xffffu, (wb.w >> sh) & 0xffffu};
            const unsigned tot = c[0] + c[1] + c[2] + c[3] + c[4] + c[5] + c[6] + c[7];
            unsigned S = tot;
#pragma unroll
            for (int o = 1; o < 64; o <<= 1) { const unsigned dn = (unsigned)bperm_i((lane + o) & 63, (int)S); if (lane + o < 64) S += dn; }
            const unsigned total = (unsigned)__builtin_amdgcn_readfirstlane((int)S);
            const u64 bal = __ballot(S >= 256u);
            int b1 = -1, r1 = 0, n1 = 0;
            if (total >= 256u) {
                const int Ls = 63 - __clzll(bal);
                unsigned cum = S - tot; bool found = false; int lb = -1, lr = 0, ln = 0;
#pragma unroll
                for (int j = 7; j >= 0; --j) { const bool hit = !found && (cum + c[j] >= 256u); if (hit) { lb = 8 * lane + j; lr = 256 - (int)cum; ln = (int)c[j]; found = true; } cum += c[j]; }
                b1 = bperm_i(Ls, lb); r1 = bperm_i(Ls, lr); n1 = bperm_i(Ls, ln);
            }
            if (lane == 0) { qinf[q * 4] = b1; qinf[q * 4 + 1] = r1; qinf[q * 4 + 2] = n1; }
        }
        __syncthreads();
        if (level == 0) { for (int i = tid; i < 64 * MPITCH; i += 512) hist[i] = 0u; }
        if (tid == 0) qinf[256] = 0;
        __syncthreads();
        if (wave_on) {
            const int b1 = qinf[qloc * 4];
            const float fsel = !active ? __builtin_inff() : ((b1 < 0) ? -__builtin_inff() : ((b1 >= 511) ? __builtin_inff() : (float)(b1 + 1)));
            const float fcand = !active ? __builtin_inff() : ((b1 <= 0) ? -__builtin_inff() : (float)b1);
            const float fb1 = (float)(b1 < 0 ? 0 : b1);
            unsigned* cslot = cand + (qloc * 8 + kh * 4 + hq) * SUBCAP; int ncand = 0;
            bf16x8 kf[2][2];
            const bf16_t* kpn = Hb + (long)(kh * 64 + (lane & 15)) * HP + HKI + 8 * (lane >> 4);
            idx_loadkp(kpn, kf);
#pragma unroll 2
            for (int it = 0; it < nit; ++it) {
                const int s0 = (it >> 1) * 128 + kh * 64 + (it & 1) * 32;
                if (it + 1 < nit) kpn += (long)((it & 1) ? 96 : 32) * HP;
                bf16x8 kn[2][2];
                idx_loadkp(kpn, kn);
                float score[8];
                idx_scores(kf, qf, ql, wi, score);
                unsigned m0 = 0u;
                if (s0 + 31 <= t0 + qg * 16) {
#pragma unroll
                    for (int i = 0; i < 8; ++i) {
                        const int rr = (i >> 2) * 16 + hq * 4 + (i & 3), s = s0 + rr;
                        const float fb = fmaf(score[i], fa, fbias);
                        if (fb >= fcand) {
                            if (fb >= fsel) m0 |= 1u << (16 * (hq & 1) + 4 * (hq >> 1) + (i & 3) + 8 * (i >> 2));
                            else {
                                const unsigned q19 = (unsigned)__builtin_amdgcn_fmed3f((fb - fb1) * 524288.f, 0.f, 524287.f);
                                if (ncand < SUBCAP) cslot[ncand] = (q19 << 13) | (unsigned)(8191 - s);
                                ++ncand;
                            }
                        }
                    }
                } else {
#pragma unroll
                    for (int i = 0; i < 8; ++i) {
                        const int rr = (i >> 2) * 16 + hq * 4 + (i & 3), s = s0 + rr;
                        const float fb = fmaf(score[i], fa, fbias);
                        if (fb >= fcand && s <= t) {
                            if (fb >= fsel) m0 |= 1u << (16 * (hq & 1) + 4 * (hq >> 1) + (i & 3) + 8 * (i >> 2));
                            else {
                                const unsigned q19 = (unsigned)__builtin_amdgcn_fmed3f((fb - fb1) * 524288.f, 0.f, 524287.f);
                                if (ncand < SUBCAP) cslot[ncand] = (q19 << 13) | (unsigned)(8191 - s);
                                ++ncand;
                            }
                        }
                    }
                }
                if (m0) atomicOr(&hist[qloc * MPITCH + (s0 >> 5)], m0);
#pragma unroll
                for (int kb = 0; kb < 2; ++kb)
#pragma unroll
                    for (int ks = 0; ks < 2; ++ks) kf[kb][ks] = kn[kb][ks];
            }
            ccnt[qloc * 8 + kh * 4 + hq] = (unsigned)ncand;
        } else ccnt[qloc * 8 + kh * 4 + hq] = 0u;
        __syncthreads();
#pragma unroll 1
        for (int qq = 0; qq < 8; ++qq) {
            const int q = w * 8 + qq;
            if (level && !qinf[q * 4 + 3]) continue;
            const int r1 = qinf[q * 4 + 1];
            const int wr_ = lane >> 3, sl0 = (lane & 7) * 4;
            int cw = (int)ccnt[q * 8 + wr_];
            const bool ovf = __any(cw > SUBCAP) && (level == 0);
            if (lane == 0) { qinf[q * 4 + 3] = ovf ? 1 : 0; if (ovf) qinf[256] = 1; }
            if (ovf || r1 <= 0) continue;
            if (cw > SUBCAP) cw = SUBCAP;
            const u32x4 mine = *(const u32x4*)(cand + (q * 8 + wr_) * SUBCAP + sl0);
            int rk0 = 0, rk1 = 0, rk2 = 0, rk3 = 0;
#pragma unroll 1
            for (int ww = 0; ww < 8; ++ww) {
                int cn = (int)ccnt[q * 8 + ww]; if (cn > SUBCAP) cn = SUBCAP;
                const unsigned* cl = cand + (q * 8 + ww) * SUBCAP;
#pragma unroll 1
                for (int j = 0; j < cn; ++j) { const unsigned cv = cl[j]; rk0 += (cv > mine.x); rk1 += (cv > mine.y); rk2 += (cv > mine.z); rk3 += (cv > mine.w); }
            }
            if (sl0 + 0 < cw && rk0 < r1) { const int s = 8191 - (int)(mine.x & 8191u); atomicOr(&hist[q * MPITCH + (s >> 5)], 1u << mpos(s & 31)); }
            if (sl0 + 1 < cw && rk1 < r1) { const int s = 8191 - (int)(mine.y & 8191u); atomicOr(&hist[q * MPITCH + (s >> 5)], 1u << mpos(s & 31)); }
            if (sl0 + 2 < cw && rk2 < r1) { const int s = 8191 - (int)(mine.z & 8191u); atomicOr(&hist[q * MPITCH + (s >> 5)], 1u << mpos(s & 31)); }
            if (sl0 + 3 < cw && rk3 < r1) { const int s = 8191 - (int)(mine.w & 8191u); atomicOr(&hist[q * MPITCH + (s >> 5)], 1u << mpos(s & 31)); }
        }
        __syncthreads();
        if (level == 1 || qinf[256] == 0) break;
        {
            const bool mine_ovf = qinf[qloc * 4 + 3] != 0;
            const int b1 = qinf[qloc * 4];
            active = mine_ovf;
            fa = mine_ovf ? inv * 510.f : 0.f;
            fbias = mine_ovf ? fmaf(fb0c - (float)b1, 510.f, 1.f) : -1.f;
        }
        for (int i = tid; i < 32 * HPITCH; i += 512) cand[i] = 0u;
        __syncthreads();
    }
    for (int rep2_ = ((PROBE_PHASE == 41) ? 0 : 1); rep2_ < 2; ++rep2_) {
        const bool dry2 = dry || ((PROBE_PHASE == 41) && (rep2_ == 0) && (p.pos[0] == 0));
        const int head = w, r32 = lane & 31, hh = lane >> 5;
        bf16x8 qfr[2][4];
        float q1 = 0.f;
#pragma unroll
        for (int qb = 0; qb < 2; ++qb) {
            float qa = 0.f;
#pragma unroll
            for (int ks = 0; ks < 4; ++ks) {
                qfr[qb][ks] = *(const bf16x8*)(Hb + (long)(t0 + qb * 32 + r32) * HP + HQ + head * 64 + ks * 16 + 8 * hh);
                const u32x4 qv = __builtin_bit_cast(u32x4, qfr[qb][ks]);
                qa += fabsf(bflo(qv.x)) + fabsf(bfhi(qv.x)) + fabsf(bflo(qv.y)) + fabsf(bfhi(qv.y)) + fabsf(bflo(qv.z)) + fabsf(bfhi(qv.z)) + fabsf(bflo(qv.w)) + fabsf(bfhi(qv.w));
            }
            q1 = fmaxf(q1, qa);
        }
        q1 += sxor_f(q1, lane, 32);
#pragma unroll
        for (int o = 16; o >= 1; o >>= 1) q1 = fmaxf(q1, sxor_f(q1, lane, o));
        const float kmx = __uint_as_float(kmaxL[b * 8 + head]);
        const bool fast = (q1 * kmx * 1.02f) < 100.f;
        f32x16 O[2][2];
#pragma unroll
        for (int a = 0; a < 2; ++a)
#pragma unroll
            for (int c2 = 0; c2 < 2; ++c2)
#pragma unroll
                for (int i = 0; i < 16; ++i) O[a][c2][i] = 0.f;
        float mrun[2] = {-1e30f, -1e30f}, lrun[2] = {0.f, 0.f};
        const bf16_t* Kp = (const bf16_t*)(p.ws + WS_KF) + ((long)(b * 8 + head) * 256 * 4 * 64 + lane) * 8;
        const bf16_t* Vp = (const bf16_t*)(p.ws + WS_VT) + ((long)(b * 8 + head) * 256 * 4 * 64 + lane) * 8;
        const int nt32 = (t0 + 64) >> 5;
        if (fast) attn_loop<true>(Kp, Vp, qfr, O, mrun, lrun, hist, (const float*)(lds + L_MTAB), r32, hh, nt32, dry2);
        else attn_loop<false>(Kp, Vp, qfr, O, mrun, lrun, hist, (const float*)(lds + L_MTAB), r32, hh, nt32, dry2);
#pragma unroll
        for (int qb = 0; qb < 2; ++qb) {
            const float lt = lrun[qb] + sxor_f(lrun[qb], lane, 32);
            const float il = 1.f / lt;
            bf16_t* gp = H + ((long)b * T + t0 + qb * 32 + r32) * HP + HAG + head * 64 + 4 * hh;
#pragma unroll
            for (int db = 0; db < 2; ++db)
#pragma unroll
                for (int g4 = 0; g4 < 4; ++g4) {
                    bf16_t* gq = gp + db * 32 + 8 * g4;
                    const u32x2 gv = *(const u32x2*)gq;
                    u32x2 wv;
                    wv.x = pk2(O[db][qb][4 * g4] * il * silu_f(bflo(gv.x)), O[db][qb][4 * g4 + 1] * il * silu_f(bfhi(gv.x)));
                    wv.y = pk2(O[db][qb][4 * g4 + 2] * il * silu_f(bflo(gv.y)), O[db][qb][4 * g4 + 3] * il * silu_f(bfhi(gv.y)));
                    if (!dry2) *(u32x2*)gq = wv;
                }
        }
    }
    __syncthreads();
}

__device__ __forceinline__ void gbar(unsigned* ctr, unsigned target) {
    __syncthreads();
    if (threadIdx.x == 0) {
        __builtin_amdgcn_fence(__ATOMIC_RELEASE, "agent");
        __hip_atomic_fetch_add(ctr, 1u, __ATOMIC_RELAXED, __HIP_MEMORY_SCOPE_AGENT);
        while (__hip_atomic_load(ctr, __ATOMIC_RELAXED, __HIP_MEMORY_SCOPE_AGENT) < target) __builtin_amdgcn_s_sleep(2);
        __builtin_amdgcn_fence(__ATOMIC_ACQUIRE, "agent");
    }
    __syncthreads();
}

__device__ __forceinline__ void ho_arrive(unsigned* ctr) {
    __syncthreads();
    if (threadIdx.x == 0) { __builtin_amdgcn_fence(__ATOMIC_RELEASE, "agent"); __hip_atomic_fetch_add(ctr, 1u, __ATOMIC_RELAXED, __HIP_MEMORY_SCOPE_AGENT); }
}
__device__ __forceinline__ void ho_wait(unsigned* ctr, unsigned target) {
    if (threadIdx.x == 0) {
        while (__hip_atomic_load(ctr, __ATOMIC_RELAXED, __HIP_MEMORY_SCOPE_AGENT) < target) __builtin_amdgcn_s_sleep(2);
        __builtin_amdgcn_fence(__ATOMIC_ACQUIRE, "agent");
    }
    __syncthreads();
}

__global__ void __launch_bounds__(512) fwd_megakernel(Params p0) {
    extern __shared__ __attribute__((aligned(16))) unsigned char lds[];
    cg::grid_group grid = cg::this_grid();
    const int G = gridDim.x, c = blockIdx.x;
    const int wid_s = __builtin_amdgcn_readfirstlane((int)(threadIdx.x >> 6));

    unsigned* barctr = (unsigned*)(p0.ws + WS_BAR); unsigned bar_n = 0;
    if (c == 0 && threadIdx.x < 3) __hip_atomic_store(barctr + 16 * threadIdx.x, 0u, __ATOMIC_RELAXED, __HIP_MEMORY_SCOPE_AGENT);
    for (int rep0_ = (PROBE_PHASE == 8 ? 0 : 1); rep0_ < 2; ++rep0_) prologue(p0, (long)c * 512 + threadIdx.x, (long)G * 512);
    grid.sync();

#pragma unroll 1
    for (int layer = 0; layer < DEPTH; ++layer) {
        Params p = p0;
        { size_t zoff = 0; asm volatile("" : "+s"(zoff)); p.ws = p0.ws + zoff; }
        bf16_t* H = (bf16_t*)(p.ws + WS_H);
        {
for (int rep_ = (PROBE_PHASE == 1 ? 0 : 1); rep_ < 2; ++rep_) { const bool dry = (PROBE_PHASE == 1) && (rep_ == 0) && (p.pos[0] == 0);
            EpiIn e; e.H = H; e.side = (float*)(p.ws + WS_SIDE); e.rope = (const float*)(p.ws + WS_ROPE); e.VT = (bf16_t*)(p.ws + WS_VT); e.KF = (bf16_t*)(p.ws + WS_KF); e.kmax = (unsigned*)(p.ws + WS_KMAX) + layer * 32; e.dry = dry;
            const bf16_t* A = (const bf16_t*)(p.ws + WS_XB);
            const bf16_t* Bt = (const bf16_t*)(p.ws + WS_WIN) + (long)layer * NPAD * 1024;
            if (layer) {
                if (otid(wid_s) == 0) {
                    const unsigned* lc = (const unsigned*)(p.ws + WS_LCNT);
#pragma unroll 1
                    for (int L = c; L < 128 * 17; L += G) {
                        int pm, pn; tile_of(L, 128, 17, pm, pn);
                        while (__hip_atomic_load(lc + pm * 16, __ATOMIC_RELAXED, __HIP_MEMORY_SCOPE_AGENT) < 2u * (unsigned)layer) __builtin_amdgcn_s_sleep(2);
                    }
                    __builtin_amdgcn_fence(__ATOMIC_ACQUIRE, "agent");
                }
                __syncthreads();
            }
#pragma unroll 1
            for (int L = c; L < 128 * 17; L += G) { int pm, pn; tile_of(L, 128, 17, pm, pn); gemm_tile((LAS unsigned char*)lds, A, 1024, Bt, 1024, pm, pn, e, wid_s); }
            {
                const int rem = (128 * 17) % G;
                if (layer + 1 < DEPTH && c >= rem) convert_weights(p, layer + 1, layer + 2, (long)(c - rem) * 512 + otid(wid_s), (long)(G - rem) * 512);
            }
}
        }
        gbar(barctr, (++bar_n) * (unsigned)G); if (PROBE_PHASE == 9) gbar(barctr, (++bar_n) * (unsigned)G);
        {
for (int rep_ = (PROBE_PHASE == 2 ? 0 : 1); rep_ < 2; ++rep_) { const bool dry = (PROBE_PHASE == 2) && (rep_ == 0) && (p.pos[0] == 0);
            const int tid = otid(wid_s), lane = tid & 63, w = tid >> 6;
#pragma unroll 1
            for (int g = c; g < 256; g += G) gla_local_item(p, layer, g * 8 + w, lane, dry);
}
        }
        ho_arrive(barctr + 16);
        if (c < 64) {
            ho_wait(barctr + 16, (unsigned)(layer + 1) * (unsigned)G);
            const int tid = otid(wid_s);
#pragma unroll 1
            for (int g = c; g < 64; g += G) gla_scan(p, g * 512 + tid);
            ho_arrive(barctr + 32);
        }
for (int rep_ = (PROBE_PHASE == 3 ? 0 : 1); rep_ < 2; ++rep_) { const bool dry = (PROBE_PHASE == 3) && (rep_ == 0) && (p.pos[0] == 0);
#pragma unroll 1
        for (int tile = c; tile < 512; tile += G) conformer_tile(p, layer, lds, tile, dry, wid_s);
}
for (int rep_ = (PROBE_PHASE == 4 ? 0 : 1); rep_ < 2; ++rep_) { const bool dry = (PROBE_PHASE == 4) && (rep_ == 0) && (p.pos[0] == 0);
#pragma unroll 1
        for (int it = c; it < 512; it += G) {
            const int pr = it >> 1, second = it & 1;
            const int xcd = pr & 7, j = pr >> 3, b = xcd >> 1, par = xcd & 1;
            const int qblk = second ? (2 * j + par) : 127 - (2 * j + par);
            dsa_item(p, lds, b, qblk, dry, wid_s, (const unsigned*)(p.ws + WS_KMAX) + layer * 32);
        }
}
        ho_wait(barctr + 32, (unsigned)(layer + 1) * (unsigned)(G < 64 ? G : 64));
        {
for (int rep_ = (PROBE_PHASE == 5 ? 0 : 1); rep_ < 2; ++rep_) { const bool dry = (PROBE_PHASE == 5) && (rep_ == 0) && (p.pos[0] == 0);
            const int tid = otid(wid_s), lane = tid & 63, w = tid >> 6;
#pragma unroll 1
            for (int g = c; g < 256; g += G) gla_out_item(p, layer, lds + w * 16384, g * 8 + w, lane, dry);
}
        }
        gbar(barctr, (++bar_n) * (unsigned)G); if (PROBE_PHASE == 9) gbar(barctr, (++bar_n) * (unsigned)G);
        {
for (int rep_ = (PROBE_PHASE == 6 ? 0 : 1); rep_ < 2; ++rep_) { const bool dry = (PROBE_PHASE == 6) && (rep_ == 0) && (p.pos[0] == 0);
            EpiOut e; e.xres = (layer == 0) ? p.x : p.out; e.out = p.out; e.dry = dry;
            const bf16_t* A = H + HAG;
            const bf16_t* Bt = (const bf16_t*)(p.ws + WS_WOUT) + (long)layer * 1024 * 1024;
#pragma unroll 1
            for (int L = c; L < 128 * 4; L += G) { int pm, pn; tile_of(L, 128, 4, pm, pn); gemm_tile((LAS unsigned char*)lds, A, HP, Bt, 1024, pm, pn, e, wid_s); ho_arrive((unsigned*)(p.ws + WS_PCNT) + pm * 16); }
}
        }
        {
for (int rep_ = (PROBE_PHASE == 7 ? 0 : 1); rep_ < 2; ++rep_) { const bool dry = (PROBE_PHASE == 7) && (rep_ == 0) && (p.pos[0] == 0);
            const int tid = otid(wid_s), lane = tid & 63, w = tid >> 6;
#pragma unroll 1
            for (int hp = c; hp < 256; hp += G) {
                ho_wait((unsigned*)(p.ws + WS_PCNT) + (hp >> 1) * 16, 4u * (unsigned)(layer + 1));
                const int base = (hp >> 1) * 256 + (hp & 1) * 128;
                ln_phase(p, layer, base + w, base + 128, 8, lane, dry);
                ho_arrive((unsigned*)(p.ws + WS_LCNT) + (hp >> 1) * 16);
            }
}
        }
    }
}

extern "C" void kernel_launch(void* const* d_in, const int* in_sizes, int n_in, void* d_out, int out_size, void* d_ws, size_t ws_size, hipStream_t stream) {
    static int grid_blocks = 0;
    if (grid_blocks == 0) {
        if (n_in != 15 || ws_size < WS_END) { fprintf(stderr, "kernel_launch: unexpected inputs (n_in %d, ws %zu < %zu)\n", n_in, ws_size, (size_t)WS_END); grid_blocks = -1; return; }
        int dev = 0, cus = 0, per_cu = 0;
        hipGetDevice(&dev);
        hipDeviceGetAttribute(&cus, hipDeviceAttributeMultiprocessorCount, dev);
        if (hipFuncSetAttribute((const void*)fwd_megakernel, hipFuncAttributeMaxDynamicSharedMemorySize, LDS_BYTES) != hipSuccess) { fprintf(stderr, "kernel_launch: hipFuncSetAttribute failed\n"); grid_blocks = -1; return; }
        hipOccupancyMaxActiveBlocksPerMultiprocessor(&per_cu, (const void*)fwd_megakernel, 512, LDS_BYTES);
        if (per_cu < 1) per_cu = 1;
        grid_blocks = cus * per_cu;
    }
    if (grid_blocks < 0) return;
    Params p{};
    p.x = (const float*)d_in[0]; p.pos = (const int*)d_in[1]; p.w_in = (const float*)d_in[2]; p.conv_w = (const float*)d_in[3]; p.conv_b = (const float*)d_in[4];
    p.cln_g = (const float*)d_in[5]; p.cln_b = (const float*)d_in[6]; p.pw_w = (const float*)d_in[7]; p.pw_b = (const float*)d_in[8];
    p.gate_w2 = (const float*)d_in[9]; p.gate_b = (const float*)d_in[10]; p.gnorm_g = (const float*)d_in[11]; p.w_out = (const float*)d_in[12];
    p.ln_g = (const float*)d_in[13]; p.ln_b = (const float*)d_in[14];
    p.out = (float*)d_out; p.ws = (unsigned char*)d_ws;
    for (int j = 0; j < 32; ++j) p.inv_freq[j] = (float)pow(10000.0, -(double)j / 32.0);
    void* args[] = {&p};
    hipError_t e = hipLaunchCooperativeKernel((const void*)fwd_megakernel, dim3(grid_blocks), dim3(512), args, LDS_BYTES, stream);
    if (e != hipSuccess) fprintf(stderr, "cooperative launch failed: %s (grid %d)\n", hipGetErrorString(e), grid_blocks);
}
```
